# Optimizing an MI355X kernel written in HIP

```python
import math
import jax, jax.numpy as jnp
from jax import lax
import numpy as np

D_MODEL = 2048
BATCH = 4
SEQ = 2048
DEPTH = 2
DEC_BATCH = 128
DEC_SEQ = 1
PAST_LEN = 16384
PAGE_SIZE = 128

N_BRANCH = 4
BRANCH_W = D_MODEL // 2
EPS = 1e-6
LRU_W = BRANCH_W
LRU_BLOCKS = 8
LRU_BLOCK = LRU_W // LRU_BLOCKS
LRU_C = 8.0
CONV_W = 4
HG_HEADS = 8
HG_DK = BRANCH_W // HG_HEADS
HG_DV = BRANCH_W // HG_HEADS
HG_CHUNK = 32
SSD_HEADDIM = 64
SSD_HEADS = BRANCH_W // SSD_HEADDIM
SSD_GROUPS = 2
SSD_STATE = 128
SSD_CONV_DIM = BRANCH_W + 2 * SSD_GROUPS * SSD_STATE
SSD_CHUNK = 64
RET_HEADS = 8
RET_DK = BRANCH_W // RET_HEADS
RET_DV = BRANCH_W // RET_HEADS
RET_CHUNK = 64
ROPE_BASE = 10000.0
D_FF = 5632
FFN_CONV_W = 3
IN_SIZES = (LRU_W, LRU_W,
            HG_HEADS * HG_DK, HG_HEADS * HG_DK, HG_HEADS * HG_DV, HG_HEADS * HG_DV,
            BRANCH_W, SSD_CONV_DIM, SSD_HEADS,
            RET_HEADS * RET_DK, RET_HEADS * RET_DK, RET_HEADS * RET_DV, RET_HEADS * RET_DV)
N_IN = sum(IN_SIZES)

kernel_name = 'hybrid_lru_hgrn2_ssd_retention_step'


def _rms(x):
    return x * lax.rsqrt(jnp.mean(x * x, axis=-1, keepdims=True) + EPS)


def rmsnorm(x, g):
    xf = x.astype(jnp.float32)
    return (_rms(xf) * g.astype(jnp.float32)).astype(x.dtype)


def causal_dwconv(x, buf, w, b):
    width = w.shape[0]
    T = x.shape[1]
    xc = jnp.concatenate([buf.astype(x.dtype), x], axis=1)
    y = b
    for j in range(width):
        y = y + xc[:, j:j + T] * w[j]
    return y, xc[:, T:]


def diag_linear_scan(a, u, h0):
    def combine(left, right):
        a_l, u_l = left
        a_r, u_r = right
        return a_l * a_r, a_r * u_l + u_r
    a_cum, u_cum = lax.associative_scan(combine, (a, u), axis=1)
    h = a_cum * h0[:, None] + u_cum
    return h, h[:, -1]


def _chunk(T, C):
    return C if T % C == 0 else T


def _masked_exp(diff, mask):
    return jnp.where(mask, jnp.exp(jnp.where(mask, diff, 0.0)), 0.0)


def gla_chunked(q, k, v, logf, S0, chunk):
    B, T, H, K = q.shape
    V = v.shape[-1]
    C = _chunk(T, chunk)
    N = T // C
    to_chunks = lambda z: jnp.moveaxis(z.reshape(B, N, C, H, z.shape[-1]), 1, 0)
    qc, kc, vc = to_chunks(q), to_chunks(k), to_chunks(v)
    bc = jnp.cumsum(to_chunks(logf), axis=2)
    mask = jnp.tril(jnp.ones((C, C), dtype=bool))[None, :, :, None, None]

    def step(S, inp):
        qi, ki, vi, bi = inp
        dec = _masked_exp(bi[:, :, None] - bi[:, None], mask)
        att = jnp.einsum('btshk,bshk->bhts', qi[:, :, None] * dec, ki)
        o = (jnp.einsum('bhts,bshv->bthv', att, vi)
             + jnp.einsum('bthk,bhkv->bthv', qi * jnp.exp(bi), S))
        b_last = bi[:, -1]
        S = (S * jnp.exp(b_last)[..., None]
             + jnp.einsum('bshk,bshv->bhkv', ki * jnp.exp(b_last[:, None] - bi), vi))
        return S, o

    S, o = lax.scan(step, S0, (qc, kc, vc, bc))
    return jnp.moveaxis(o, 0, 1).reshape(B, T, H, V), S


def scalar_decay_chunked(q, k, v, logd, S0, chunk):
    B, T, H, K = q.shape
    V = v.shape[-1]
    C = _chunk(T, chunk)
    N = T // C
    rs = lambda z: z.reshape((B, N, C) + z.shape[2:])
    q, k, v, logd = rs(q), rs(k), rs(v), rs(logd)
    b = jnp.cumsum(logd, axis=2)
    mask = jnp.tril(jnp.ones((C, C), dtype=bool))[None, None, :, :, None]
    L = _masked_exp(b[:, :, :, None] - b[:, :, None], mask)
    scores = jnp.einsum('bnthk,bnshk->bntsh', q, k) * L
    o_intra = jnp.einsum('bntsh,bnshv->bnthv', scores, v)
    b_last = b[:, :, -1]
    U = jnp.einsum('bnsh,bnshk,bnshv->bnhkv', jnp.exp(b_last[:, :, None] - b), k, v)
    q_in = q * jnp.exp(b)[..., None]

    def step(S, inp):
        qi, ui, di = inp
        o = jnp.einsum('bthk,bhkv->bthv', qi, S)
        return S * di[..., None, None] + ui, o

    S, o_inter = lax.scan(step, S0, (jnp.moveaxis(q_in, 1, 0), jnp.moveaxis(U, 1, 0),
                                     jnp.moveaxis(jnp.exp(b_last), 1, 0)))
    o = o_intra + jnp.moveaxis(o_inter, 0, 1)
    return o.reshape(B, T, H, V), S


def rope(x, pos):
    half = x.shape[-1] // 2
    freqs = ROPE_BASE ** (-jnp.arange(half, dtype=jnp.float32) / half)
    ang = pos[:, None] * freqs[None]
    cos = jnp.cos(ang)[None, :, None]
    sin = jnp.sin(ang)[None, :, None]
    x1, x2 = x[..., :half], x[..., half:]
    return jnp.concatenate([x1 * cos - x2 * sin, x1 * sin + x2 * cos], axis=-1)


def token_mixers(h, pos, lru_h, lru_conv, hg_S, ssd_S, ssd_conv, ret_S, P, lb):
    f32 = jnp.float32
    B, T, _ = h.shape
    proj = jnp.matmul(h, P['w_in']).astype(f32)
    splits = np.cumsum(IN_SIZES)[:-1].tolist()
    (xa, ya, hq, hf, hi, hg, sz, sxbc, sdt, rq, rk, rv, rg) = jnp.split(proj, splits, axis=-1)

    xa, lru_conv_new = causal_dwconv(xa, lru_conv.astype(f32), P['lru_conv_w'].astype(f32),
                                     P['lru_conv_b'].astype(f32))
    xblk = xa.reshape(B, T, LRU_BLOCKS, LRU_BLOCK)
    r = jax.nn.sigmoid(jnp.einsum('btnc,ncd->btnd', xblk, P['lru_wa'].astype(f32))
                       + P['lru_ba'].astype(f32)).reshape(B, T, LRU_W)
    i = jax.nn.sigmoid(jnp.einsum('btnc,ncd->btnd', xblk, P['lru_wx'].astype(f32))
                       + P['lru_bx'].astype(f32)).reshape(B, T, LRU_W)
    log_a = -LRU_C * r * jax.nn.softplus(-P['lru_lambda'].astype(f32))
    u = jnp.sqrt(-jnp.expm1(2.0 * log_a)) * (i * xa)
    hs, lru_h_new = diag_linear_scan(jnp.exp(log_a), u, lru_h.astype(f32))
    out_a = hs * jax.nn.gelu(ya)

    q_b = jax.nn.silu(hq).reshape(B, T, HG_HEADS, HG_DK)
    f = lb + (1.0 - lb) * jax.nn.sigmoid(hf)
    logf = jnp.log(f).reshape(B, T, HG_HEADS, HG_DK)
    k_b = ((1.0 - lb) * jax.nn.sigmoid(-hf)).reshape(B, T, HG_HEADS, HG_DK)
    o_b, hg_S_new = gla_chunked(q_b, k_b, hi.reshape(B, T, HG_HEADS, HG_DV), logf,
                                hg_S.astype(f32), HG_CHUNK)
    o_b = _rms(o_b) * P['hg_norm_w'].astype(f32) * jax.nn.silu(hg.reshape(B, T, HG_HEADS, HG_DV))
    out_b = o_b.reshape(B, T, BRANCH_W)

    xbc, ssd_conv_new = causal_dwconv(sxbc, ssd_conv.astype(f32), P['ssd_conv_w'].astype(f32),
                                      P['ssd_conv_b'].astype(f32))
    xbc = jax.nn.silu(xbc)
    xs_, Bm, Cm = jnp.split(xbc, [BRANCH_W, BRANCH_W + SSD_GROUPS * SSD_STATE], axis=-1)
    xs_ = xs_.reshape(B, T, SSD_HEADS, SSD_HEADDIM)
    rep = SSD_HEADS // SSD_GROUPS
    Bh = jnp.repeat(Bm.reshape(B, T, SSD_GROUPS, SSD_STATE), rep, axis=2)
    Ch = jnp.repeat(Cm.reshape(B, T, SSD_GROUPS, SSD_STATE), rep, axis=2)
    dt = jax.nn.softplus(sdt + P['ssd_dt_bias'].astype(f32))
    A = -jnp.exp(P['ssd_a_log'].astype(f32))
    y, ssd_S_new = scalar_decay_chunked(Ch, Bh, xs_ * dt[..., None], dt * A,
                                        ssd_S.astype(f32), SSD_CHUNK)
    y = y + P['ssd_d'].astype(f32)[:, None] * xs_
    y = (y.reshape(B, T, BRANCH_W) * jax.nn.silu(sz)).reshape(B, T, SSD_GROUPS, BRANCH_W // SSD_GROUPS)
    out_c = (_rms(y) * P['ssd_norm_w'].astype(f32).reshape(SSD_GROUPS, -1)).reshape(B, T, BRANCH_W)

    q_d = rope(rq.reshape(B, T, RET_HEADS, RET_DK), pos)
    k_d = rope(rk.reshape(B, T, RET_HEADS, RET_DK), pos) * RET_DK ** -0.5
    log_gamma = jnp.log1p(-jnp.exp2(-5.0 - jnp.arange(RET_HEADS, dtype=f32)))
    o_d, ret_S_new = scalar_decay_chunked(q_d, k_d, rv.reshape(B, T, RET_HEADS, RET_DV),
                                          jnp.broadcast_to(log_gamma, (B, T, RET_HEADS)),
                                          ret_S.astype(f32), RET_CHUNK)
    out_d = (_rms(o_d) * jax.nn.silu(rg.reshape(B, T, RET_HEADS, RET_DV))).reshape(B, T, BRANCH_W)

    stacked = jnp.stack([out_a, out_b, out_c, out_d], axis=2).astype(h.dtype)
    branches = jnp.einsum('btkc,kcd->btkd', stacked, P['w_branch'])
    gates = jax.nn.sigmoid(jnp.einsum('btd,dke->btke', h, P['w_gate']).astype(f32))
    merged = jnp.sum(gates * branches.astype(f32), axis=2).astype(h.dtype)
    out = jnp.matmul(merged, P['w_out'])
    return out, (lru_h_new, lru_conv_new, hg_S_new, ssd_S_new, ssd_conv_new, ret_S_new)


def conv_ffn(h, buf, P):
    f32 = jnp.float32
    u = jnp.matmul(h, P['ffn_w_up']).astype(f32)
    v = jnp.matmul(h, P['ffn_w_val']).astype(f32)
    uc, buf_new = causal_dwconv(u, buf.astype(f32), P['ffn_conv_w'].astype(f32), P['ffn_conv_b'].astype(f32))
    a = (jax.nn.gelu(uc) * v).astype(h.dtype)
    return jnp.matmul(a, P['ffn_w_down']), buf_new


def trunk_layer(x, start, states, P, lb):
    T = x.shape[1]
    pos = jnp.arange(T, dtype=jnp.float32) + start
    mix, mix_states = token_mixers(rmsnorm(x, P['g_mix']), pos, states[0], states[1], states[2],
                                   states[3], states[4], states[5], P, lb)
    x = x + mix.astype(x.dtype)
    ffn, ffn_buf = conv_ffn(rmsnorm(x, P['g_ffn']), states[6], P)
    x = x + ffn.astype(x.dtype)
    new_states = tuple(s.astype(x.dtype) for s in mix_states + (ffn_buf,))
    return x, new_states


def setup_inputs(seed: int = 0) -> dict:
    key = jax.random.key(seed)
    ks = iter(jax.random.split(key, 48))
    f32 = jnp.float32
    L = DEPTH
    D = D_MODEL

    def nrm(shape, scale):
        return jax.random.normal(next(ks), shape, f32) * scale

    def unif(shape, lo, hi):
        return jax.random.uniform(next(ks), shape, f32, minval=lo, maxval=hi)

    x_prompt = nrm((BATCH, SEQ, D), 1.0)
    x_sample = nrm((DEC_BATCH, DEC_SEQ, D), 1.0)
    state_lru_h = nrm((L, DEC_BATCH, LRU_W), 0.5)
    state_lru_conv = nrm((L, DEC_BATCH, CONV_W - 1, LRU_W), 1.0)
    state_hgrn = nrm((L, DEC_BATCH, HG_HEADS, HG_DK, HG_DV), 0.5)
    state_ssd = nrm((L, DEC_BATCH, SSD_HEADS, SSD_STATE, SSD_HEADDIM), 0.5)
    state_ssd_conv = nrm((L, DEC_BATCH, CONV_W - 1, SSD_CONV_DIM), 1.0)
    state_ret = nrm((L, DEC_BATCH, RET_HEADS, RET_DK, RET_DV), 1.0)
    state_ffn_conv = nrm((L, DEC_BATCH, FFN_CONV_W - 1, D_FF), 1.0)

    g_mix = 1.0 + nrm((L, D), 0.02)
    g_ffn = 1.0 + nrm((L, D), 0.02)
    w_in = nrm((L, D, N_IN), D ** -0.5)
    lru_conv_w = nrm((L, CONV_W, LRU_W), CONV_W ** -0.5)
    lru_conv_b = nrm((L, LRU_W), 0.02)
    lru_wa = nrm((L, LRU_BLOCKS, LRU_BLOCK, LRU_BLOCK), LRU_BLOCK ** -0.5)
    lru_ba = nrm((L, LRU_BLOCKS, LRU_BLOCK), 0.02)
    lru_wx = nrm((L, LRU_BLOCKS, LRU_BLOCK, LRU_BLOCK), LRU_BLOCK ** -0.5)
    lru_bx = nrm((L, LRU_BLOCKS, LRU_BLOCK), 0.02)
    s = unif((L, LRU_W), 0.9, 0.999) ** (1.0 / LRU_C)
    lru_lambda = jnp.log(s) - jnp.log1p(-s)
    hg_lb_logits = nrm((L, HG_HEADS * HG_DK), 0.5)
    hg_norm_w = 1.0 + nrm((L, HG_DV), 0.02)
    ssd_conv_w = nrm((L, CONV_W, SSD_CONV_DIM), CONV_W ** -0.5)
    ssd_conv_b = nrm((L, SSD_CONV_DIM), 0.02)
    dt0 = jnp.exp(unif((L, SSD_HEADS), math.log(1e-3), math.log(1e-1)))
    ssd_dt_bias = dt0 + jnp.log(-jnp.expm1(-dt0))
    ssd_a_log = jnp.log(unif((L, SSD_HEADS), 1.0, 16.0))
    ssd_d = 1.0 + nrm((L, SSD_HEADS), 0.02)
    ssd_norm_w = 1.0 + nrm((L, BRANCH_W), 0.02)
    w_branch = nrm((L, N_BRANCH, BRANCH_W, D), BRANCH_W ** -0.5)
    w_gate = nrm((L, D, N_BRANCH, D), D ** -0.5)
    w_out = nrm((L, D, D), D ** -0.5)
    ffn_w_up = nrm((L, D, D_FF), D ** -0.5)
    ffn_w_val = nrm((L, D, D_FF), D ** -0.5)
    ffn_conv_w = nrm((L, FFN_CONV_W, D_FF), FFN_CONV_W ** -0.5)
    ffn_conv_b = nrm((L, D_FF), 0.02)
    ffn_w_down = nrm((L, D_FF, D), D_FF ** -0.5)
    g_final = 1.0 + nrm((D,), 0.02)
    return {'x_prompt': x_prompt, 'x_sample': x_sample,
            'state_lru_h': state_lru_h, 'state_lru_conv': state_lru_conv, 'state_hgrn': state_hgrn,
            'state_ssd': state_ssd, 'state_ssd_conv': state_ssd_conv, 'state_ret': state_ret,
            'state_ffn_conv': state_ffn_conv,
            'g_mix': g_mix, 'g_ffn': g_ffn, 'w_in': w_in,
            'lru_conv_w': lru_conv_w, 'lru_conv_b': lru_conv_b, 'lru_wa': lru_wa, 'lru_ba': lru_ba,
            'lru_wx': lru_wx, 'lru_bx': lru_bx, 'lru_lambda': lru_lambda,
            'hg_lb_logits': hg_lb_logits, 'hg_norm_w': hg_norm_w,
            'ssd_conv_w': ssd_conv_w, 'ssd_conv_b': ssd_conv_b, 'ssd_dt_bias': ssd_dt_bias,
            'ssd_a_log': ssd_a_log, 'ssd_d': ssd_d, 'ssd_norm_w': ssd_norm_w,
            'w_branch': w_branch, 'w_gate': w_gate, 'w_out': w_out,
            'ffn_w_up': ffn_w_up, 'ffn_w_val': ffn_w_val, 'ffn_conv_w': ffn_conv_w,
            'ffn_conv_b': ffn_conv_b, 'ffn_w_down': ffn_w_down, 'g_final': g_final}


def reference(x_prompt, x_sample, state_lru_h, state_lru_conv, state_hgrn, state_ssd, state_ssd_conv,
              state_ret, state_ffn_conv, g_mix, g_ffn, w_in, lru_conv_w, lru_conv_b, lru_wa, lru_ba,
              lru_wx, lru_bx, lru_lambda, hg_lb_logits, hg_norm_w, ssd_conv_w, ssd_conv_b, ssd_dt_bias,
              ssd_a_log, ssd_d, ssd_norm_w, w_branch, w_gate, w_out, ffn_w_up, ffn_w_val, ffn_conv_w,
              ffn_conv_b, ffn_w_down, g_final):
    f32 = jnp.float32
    ls = jax.nn.softmax(hg_lb_logits.astype(f32), axis=0)
    lbs = jnp.cumsum(ls, axis=0) - ls[0]

    bp = x_prompt.shape[0]
    dtp = x_prompt.dtype
    zero_states = (jnp.zeros((bp, LRU_W), dtp), jnp.zeros((bp, CONV_W - 1, LRU_W), dtp),
                   jnp.zeros((bp, HG_HEADS, HG_DK, HG_DV), dtp),
                   jnp.zeros((bp, SSD_HEADS, SSD_STATE, SSD_HEADDIM), dtp),
                   jnp.zeros((bp, CONV_W - 1, SSD_CONV_DIM), dtp),
                   jnp.zeros((bp, RET_HEADS, RET_DK, RET_DV), dtp),
                   jnp.zeros((bp, FFN_CONV_W - 1, D_FF), dtp))

    xp, xs = x_prompt, x_sample
    new_p, new_s = [], []
    for l in range(DEPTH):
        P = {'g_mix': g_mix[l], 'g_ffn': g_ffn[l], 'w_in': w_in[l],
             'lru_conv_w': lru_conv_w[l], 'lru_conv_b': lru_conv_b[l], 'lru_wa': lru_wa[l],
             'lru_ba': lru_ba[l], 'lru_wx': lru_wx[l], 'lru_bx': lru_bx[l], 'lru_lambda': lru_lambda[l],
             'hg_norm_w': hg_norm_w[l], 'ssd_conv_w': ssd_conv_w[l], 'ssd_conv_b': ssd_conv_b[l],
             'ssd_dt_bias': ssd_dt_bias[l], 'ssd_a_log': ssd_a_log[l], 'ssd_d': ssd_d[l],
             'ssd_norm_w': ssd_norm_w[l], 'w_branch': w_branch[l], 'w_gate': w_gate[l], 'w_out': w_out[l],
             'ffn_w_up': ffn_w_up[l], 'ffn_w_val': ffn_w_val[l], 'ffn_conv_w': ffn_conv_w[l],
             'ffn_conv_b': ffn_conv_b[l], 'ffn_w_down': ffn_w_down[l]}
        xp, sp = trunk_layer(xp, 0, zero_states, P, lbs[l])
        sample_states = (state_lru_h[l], state_lru_conv[l], state_hgrn[l], state_ssd[l],
                         state_ssd_conv[l], state_ret[l], state_ffn_conv[l])
        xs, ss = trunk_layer(xs, PAST_LEN, sample_states, P, lbs[l])
        new_p.append(sp)
        new_s.append(ss)

    def stack(lst, i):
        return jnp.stack([st[i] for st in lst], axis=0)

    y_prompt = rmsnorm(xp, g_final)
    y_sample = rmsnorm(xs, g_final)
    return (y_prompt, y_sample,
            stack(new_p, 0), stack(new_s, 0), stack(new_p, 1), stack(new_s, 1),
            stack(new_p, 2), stack(new_s, 2), stack(new_p, 3), stack(new_s, 3),
            stack(new_p, 4), stack(new_s, 4), stack(new_p, 5), stack(new_s, 5),
            stack(new_p, 6), stack(new_s, 6))
```

```cpp
#include <hip/hip_runtime.h>
#include <cstdio>
#include <cstdint>

#ifndef MK_SPLIT
#define MK_SPLIT 0
#endif

namespace pg8 {
#define PG8_LAS __attribute__((address_space(3)))
typedef unsigned short bf16_t;
typedef short bf16x8 __attribute__((ext_vector_type(8)));
typedef float f32x4 __attribute__((ext_vector_type(4)));
typedef unsigned u32x4 __attribute__((ext_vector_type(4)));
constexpr int BM = 256, BK = 64, HALF = 128, HTB = HALF * BK * 2, STAGE_BYTES = 8 * HTB, NXCD = 8, WGM = 8;

__host__ __device__ __forceinline__ int lds_byte(int r, int c) { const int st = (r >> 4) * 2 + (c >> 5), rr = r & 15, cc = c & 31, ob = rr * 64 + cc * 2; return st * 1024 + (ob ^ (((ob >> 9) & 1) << 5)); }
__host__ __device__ __forceinline__ void stage_rc(int b, int& R, int& C) { const int st = b / 1024, sb = b % 1024, swz = sb ^ (((sb >> 9) & 1) << 5); R = (st >> 1) * 16 + swz / 64; C = (st & 1) * 32 + (swz % 64) / 2; }
__host__ __device__ __forceinline__ int perm32(int rho) { const int n = rho >> 4, i = rho & 15; return 8 * (i >> 2) + 4 * n + (i & 3); }

struct Unit { int pm, pn, kz; };
struct Gemm { const bf16_t* A; const bf16_t* Bt; int lda, ldb, K; size_t azs, bzs; };

struct TileOrder {
    int nM, nN, nwg, G, c, nkz;
    __device__ void init(int M, int N, int G_, int c_, int nkz_) { nM = M / BM; nN = N / BM; nwg = nM * nN; G = G_; c = c_; nkz = nkz_; }
    __device__ bool next(int i, Unit& u) const {
        const int ti = i / nkz; u.kz = i - ti * nkz;
        const long L = (long)ti * G + c; if (L >= nwg) return false;
        int wgid = (int)L; { const int q = nwg / NXCD, r = nwg % NXCD, xcd = wgid % NXCD, off = wgid / NXCD; wgid = (xcd < r ? xcd * (q + 1) : r * (q + 1) + (xcd - r) * q) + off; }
        const int nig = WGM * nN, gid = wgid / nig, fm = gid * WGM, gsz = (nM - fm) < WGM ? (nM - fm) : WGM;
        u.pm = fm + ((wgid % nig) % gsz); u.pn = (wgid % nig) / gsz; return true;
    }
};

__device__ __forceinline__ unsigned cvt_pk_bf16(float lo, float hi) { unsigned r; asm volatile("v_cvt_pk_bf16_f32 %0, %1, %2" : "=v"(r) : "v"(lo), "v"(hi)); return r; }

template <class Epi, class Sched, bool ALIGN_EPI = true>
__device__ __forceinline__ void gemm_phase(PG8_LAS unsigned char* lds, const Gemm g, const Sched& S, const Epi& E) {
    int tid = threadIdx.x; asm volatile("" : "+v"(tid));
    const int wid = __builtin_amdgcn_readfirstlane(tid >> 6), lane = tid & 63, wr = wid >> 2, wc = wid & 3, fr = lane & 15, fq = lane >> 4;
    const int K = g.K, nt = K / BK;
    unsigned voffA[2], voffB[2];
#pragma unroll
    for (int i = 0; i < 2; ++i) { int R, C; stage_rc(tid * 16 + i * 8192, R, C); const int Rb = Epi::PERM ? ((R & ~31) + perm32(R & 31)) : R;
        voffA[i] = (unsigned)(R * g.lda + C) * 2u; voffB[i] = (unsigned)(Rb * g.ldb + C) * 2u; }
    const size_t kstep = (size_t)(BK * 2);
    const size_t hstepA = (size_t)HALF * g.lda * 2, hstepB = (size_t)HALF * g.ldb * 2;
    const size_t tstepA = 2 * hstepA, tstepB = 2 * hstepB;
    const unsigned ldsw = (unsigned)wid * 1024u;
    const int aoff = lds_byte(wr * 64 + fr, fq * 8), boff = lds_byte(wc * 32 + fr, fq * 8);
#define PG8_SA(b, h) (((b) * 2 + (h)) * HTB)
#define PG8_SB(b, h) ((4 + (b) * 2 + (h)) * HTB)
#define PG8_STAGE(bufoff, gbase, voff) do { _Pragma("unroll") for (int _i = 0; _i < 2; ++_i) \
        __builtin_amdgcn_global_load_lds((const unsigned*)((const char*)(gbase) + (voff)[_i]), (PG8_LAS unsigned*)(lds + (bufoff) + ldsw + _i * 8192), 16, 0, 0); } while (0)
#define PG8_LDA(dst, b, h) do { _Pragma("unroll") for (int m = 0; m < 4; ++m) _Pragma("unroll") for (int k = 0; k < 2; ++k) dst[m][k] = *(const PG8_LAS bf16x8*)(lds + PG8_SA(b, h) + aoff + m * 2048 + k * 1024); } while (0)
#define PG8_LDB(dst, b, h) do { _Pragma("unroll") for (int n = 0; n < 2; ++n) _Pragma("unroll") for (int k = 0; k < 2; ++k) dst[n][k] = *(const PG8_LAS bf16x8*)(lds + PG8_SB(b, h) + boff + n * 2048 + k * 1024); } while (0)
#define PG8_MMA(ai, bj, At, Bt) do { __builtin_amdgcn_s_setprio(1); _Pragma("unroll") for (int m = 0; m < 4; ++m) _Pragma("unroll") for (int n = 0; n < 2; ++n) _Pragma("unroll") for (int k = 0; k < 2; ++k) \
        acc[ai][bj][m][n] = __builtin_amdgcn_mfma_f32_16x16x32_bf16(Bt[n][k], At[m][k], acc[ai][bj][m][n], 0, 0, 0); __builtin_amdgcn_s_setprio(0); } while (0)
#define PG8_WAIT_V(n) asm volatile("s_waitcnt vmcnt(" #n ")" ::: "memory")
#define PG8_WAIT_L(n) asm volatile("s_waitcnt lgkmcnt(" #n ")" ::: "memory")
#define PG8_BAR __builtin_amdgcn_s_barrier()
#define PG8_SCHED __builtin_amdgcn_sched_barrier(0)
    Unit cur, nxt; int ui = 0;
    if (!S.next(0, cur)) return;
    f32x4 acc[2][2][4][2];
#pragma unroll
    for (int a = 0; a < 2; ++a)
#pragma unroll
        for (int b = 0; b < 2; ++b)
#pragma unroll
            for (int m = 0; m < 4; ++m)
#pragma unroll
                for (int n = 0; n < 2; ++n) acc[a][b][m][n] = (f32x4){0.f, 0.f, 0.f, 0.f};
    bf16x8 At[4][2], B0[2][2], B1[2][2];
    const char* cA = (const char*)g.A + (size_t)cur.kz * g.azs * 2 + (size_t)cur.pm * tstepA;
    const char* cB = (const char*)g.Bt + (size_t)cur.kz * g.bzs * 2 + (size_t)cur.pn * tstepB;
    PG8_STAGE(PG8_SB(0, 0), cB, voffB); PG8_STAGE(PG8_SB(0, 1), cB + hstepB, voffB); PG8_STAGE(PG8_SA(0, 0), cA, voffA); PG8_STAGE(PG8_SA(0, 1), cA + hstepA, voffA);
    if (wr == 1) PG8_BAR;
    PG8_WAIT_V(2); PG8_BAR;
    PG8_STAGE(PG8_SB(1, 0), cB + kstep, voffB); PG8_STAGE(PG8_SA(1, 0), cA + kstep, voffA); PG8_STAGE(PG8_SB(1, 1), cB + hstepB + kstep, voffB);
    PG8_WAIT_V(6); PG8_BAR;
    for (;;) {
        const bool has_next = S.next(ui + 1, nxt);
        const char* nA = has_next ? (const char*)g.A + (size_t)nxt.kz * g.azs * 2 + (size_t)nxt.pm * tstepA : cA;
        const char* nB = has_next ? (const char*)g.Bt + (size_t)nxt.kz * g.bzs * 2 + (size_t)nxt.pn * tstepB : cB;
        for (int t = 0; t < nt; t += 2) {
            const bool last = (t == nt - 2);
            const char* a1 = cA + (size_t)(t + 1) * kstep;
            const char* a2 = last ? nA : cA + (size_t)(t + 2) * kstep; const char* b2 = last ? nB : cB + (size_t)(t + 2) * kstep;
            const char* a3 = a2 + kstep; const char* b3 = b2 + kstep;
            PG8_LDB(B0, 0, 0); PG8_LDB(B1, 0, 1); PG8_SCHED; PG8_LDA(At, 0, 0); PG8_STAGE(PG8_SA(1, 1), a1 + hstepA, voffA);
            PG8_WAIT_V(8); PG8_WAIT_L(0); PG8_BAR; PG8_MMA(0, 0, At, B0); PG8_MMA(0, 1, At, B1); PG8_BAR; PG8_SCHED;
            PG8_LDA(At, 0, 1); PG8_STAGE(PG8_SB(0, 0), b2, voffB); PG8_STAGE(PG8_SB(0, 1), b2 + hstepB, voffB); PG8_STAGE(PG8_SA(0, 0), a2, voffA);
            PG8_WAIT_V(8); PG8_WAIT_L(0); PG8_BAR; PG8_MMA(1, 0, At, B0); PG8_MMA(1, 1, At, B1); PG8_BAR; PG8_SCHED;
            PG8_LDB(B0, 1, 0); PG8_LDB(B1, 1, 1); PG8_SCHED; PG8_LDA(At, 1, 0); PG8_STAGE(PG8_SA(0, 1), a2 + hstepA, voffA);
            PG8_WAIT_V(8); PG8_WAIT_L(0); PG8_BAR; PG8_MMA(0, 0, At, B0); PG8_MMA(0, 1, At, B1); PG8_BAR; PG8_SCHED;
            PG8_LDA(At, 1, 1); PG8_STAGE(PG8_SB(1, 0), b3, voffB); PG8_STAGE(PG8_SB(1, 1), b3 + hstepB, voffB); PG8_STAGE(PG8_SA(1, 0), a3, voffA);
            PG8_WAIT_V(8); PG8_WAIT_L(0); PG8_BAR; PG8_MMA(1, 0, At, B0); PG8_MMA(1, 1, At, B1); PG8_BAR; PG8_SCHED;
        }
        if constexpr (ALIGN_EPI) { if (wr == 0) PG8_BAR; }
        E(acc, cur, wr, wc, fr, fq);
        if (!has_next) break;
        if (!E.keep(cur)) {
#pragma unroll
            for (int a = 0; a < 2; ++a)
#pragma unroll
                for (int b = 0; b < 2; ++b)
#pragma unroll
                    for (int m = 0; m < 4; ++m)
#pragma unroll
                        for (int n = 0; n < 2; ++n) acc[a][b][m][n] = (f32x4){0.f, 0.f, 0.f, 0.f};
        }
        cur = nxt; cA = nA; cB = nB; ++ui;
        if constexpr (ALIGN_EPI) { if (wr == 1) PG8_BAR; }
    }
    PG8_WAIT_V(0);
    if constexpr (!ALIGN_EPI) { if (wr == 0) PG8_BAR; }
    PG8_BAR;
#undef PG8_SA
#undef PG8_SB
#undef PG8_STAGE
#undef PG8_LDA
#undef PG8_LDB
#undef PG8_MMA
#undef PG8_WAIT_V
#undef PG8_WAIT_L
#undef PG8_BAR
#undef PG8_SCHED
}
}

constexpr int NWAVES = 8, NTHR = 512;
constexpr int DM = 2048, NBATCH = 4, SEQ = 2048, MP = NBATCH * SEQ, MS = 128, MR = MP + MS, M = 8448;
constexpr int NLAYER = 2;
constexpr int NIN = 12816, NP = 13056, NG = 8192, N1 = NP + NG;
constexpr int DFF = 5632, NUV = 2 * DFF;
constexpr int BW = 1024;
constexpr float EPS = 1e-6f;
constexpr int C_XA = 0, C_YA = 1024, C_HQ = 2048, C_HF = 3072, C_HI = 4096, C_HGG = 5120, C_SZ = 6144, C_SX = 7168, C_SDT = 8704, C_RQ = 8960, C_RK = 9984, C_RV = 11008, C_RG = 12032;
constexpr int SRC_SPLIT = 8720;
constexpr int SSD_CD = 1536;

enum { I_XP = 0, I_XS, I_SLH, I_SLC, I_SHG, I_SSSD, I_SSC, I_SRET, I_SFC, I_GMIX, I_GFFN, I_WIN, I_LCW, I_LCB, I_LWA, I_LBA, I_LWX, I_LBX, I_LLAM, I_HGLB, I_HGNW,
       I_SCW, I_SCB, I_SDTB, I_SALOG, I_SD, I_SNW, I_WBR, I_WGATE, I_WOUT, I_WUP, I_WVAL, I_FCW, I_FCB, I_WDOWN, I_GFIN, N_INPUTS };

constexpr size_t O_YP = 0, O_YS = O_YP + (size_t)MP * DM, O_LH_P = O_YS + (size_t)MS * DM, O_LH_S = O_LH_P + 2 * 4 * 1024, O_LC_P = O_LH_S + 2 * 128 * 1024,
    O_LC_S = O_LC_P + 2 * 4 * 3 * 1024, O_HG_P = O_LC_S + 2 * 128 * 3 * 1024, O_HG_S = O_HG_P + (size_t)2 * 4 * 8 * 16384, O_SSD_P = O_HG_S + (size_t)2 * 128 * 8 * 16384,
    O_SSD_S = O_SSD_P + (size_t)2 * 4 * 16 * 8192, O_SC_P = O_SSD_S + (size_t)2 * 128 * 16 * 8192, O_SC_S = O_SC_P + 2 * 4 * 3 * 1536, O_RET_P = O_SC_S + 2 * 128 * 3 * 1536,
    O_RET_S = O_RET_P + (size_t)2 * 4 * 8 * 16384, O_FC_P = O_RET_S + (size_t)2 * 128 * 8 * 16384, O_FC_S = O_FC_P + 2 * 4 * 2 * 5632, O_END = O_FC_S + (size_t)2 * 128 * 2 * 5632;
static_assert(O_END == 126119936ull, "output size");

constexpr size_t AL(size_t x) { return (x + 4095) & ~(size_t)4095; }
constexpr size_t WS_CTL = 0, CTL_BYTES = 1u << 20;
constexpr size_t SZ_W1 = (size_t)N1 * DM * 2, SZ_WB = (size_t)4 * DM * BW * 2, SZ_WO = (size_t)DM * DM * 2, SZ_WUV = (size_t)NUV * DM * 2, SZ_WD = (size_t)DM * DFF * 2;
constexpr size_t WS_W1 = CTL_BYTES, WS_WB = WS_W1 + 2 * SZ_W1, WS_WO = WS_WB + 2 * SZ_WB, WS_WUV = WS_WO + 2 * SZ_WO, WS_WD = WS_WUV + 2 * SZ_WUV;
constexpr size_t WS_ROPE = WS_WD + 2 * SZ_WD, SZ_ROPE = AL((size_t)2049 * 64 * 8);
constexpr size_t SZ_X = (size_t)M * DM * 4;
constexpr size_t WS_X0 = WS_ROPE + SZ_ROPE, WS_X1 = WS_X0 + SZ_X;
constexpr size_t WS_H = WS_X1 + SZ_X, SZ_H = (size_t)M * DM * 2;
constexpr size_t WS_P = WS_H + SZ_H, SZ_P = (size_t)M * NP * 2;
constexpr size_t WS_G = WS_P + SZ_P, SZ_G = (size_t)M * NG * 2;
constexpr size_t WS_HF = WS_G + SZ_G, SZ_HF = (size_t)M * 1024 * 4;
constexpr size_t WS_DT = WS_HF + SZ_HF, SZ_DT = AL((size_t)M * 16 * 4);
constexpr size_t WS_OB = WS_DT + SZ_DT, SZ_O = (size_t)M * 1024 * 4;
constexpr size_t WS_BR = WS_OB + 3 * SZ_O, SZ_BR = (size_t)4 * M * BW * 2;
constexpr size_t WS_MG = WS_BR + SZ_BR, SZ_MG = (size_t)M * DM * 2;
constexpr size_t WS_END = WS_MG + SZ_MG;
static_assert((size_t)M * NUV * 2 <= SZ_P && (size_t)M * DFF * 2 <= SZ_G && 2 * SZ_O <= SZ_X, "overlays");

constexpr int RING_BYTES = 131072, LDSCTL_OFF = RING_BYTES, LDS_BYTES = 147456;

#define GAS __attribute__((address_space(1)))
#define LAS __attribute__((address_space(3)))
typedef unsigned short bf16;
typedef unsigned v4u __attribute__((ext_vector_type(4)));
typedef unsigned v2u __attribute__((ext_vector_type(2)));
typedef float f32x4 __attribute__((ext_vector_type(4)));
typedef float f32x2 __attribute__((ext_vector_type(2)));
typedef short bf16x8 __attribute__((ext_vector_type(8)));
#define LDS_WAIT() asm volatile("s_waitcnt lgkmcnt(0)" ::: "memory")
__device__ __forceinline__ unsigned f2bf(float f) { unsigned u = __builtin_bit_cast(unsigned, f); return (u + 0x7fffu + ((u >> 16) & 1u)) >> 16; }
__device__ __forceinline__ unsigned pk2(float lo, float hi) { return f2bf(lo) | (f2bf(hi) << 16); }
__device__ __forceinline__ float bf2f(unsigned short b) { return __uint_as_float(((unsigned)b) << 16); }
__device__ __forceinline__ float bflo(unsigned w) { return __uint_as_float(w << 16); }
__device__ __forceinline__ float bfhi(unsigned w) { return __uint_as_float(w & 0xffff0000u); }
__device__ __forceinline__ float sigm(float x) { return 1.f / (1.f + __expf(-x)); }
__device__ __forceinline__ float siluf(float x) { return x * sigm(x); }
__device__ __forceinline__ float geluf(float x) { return x * sigm(1.5957691216057308f * (x + 0.044715f * x * x * x)); }
__device__ __forceinline__ float softplusf(float x) { return x > 20.f ? x : log1pf(__expf(x)); }

#define XB_TMO      128
#define XB_XCNT(j)  (256  + 64 * (j))
#define XB_XSUB(j)  (1280 + 64 * (j))
#define XB_XGEN(j)  (2304 + 64 * (j))
#define XB_TOP      3328
#define XB_TOPGEN   3392
#define XCD_BAR_WORDS 3456
#define XB_SPIN_CAP (1u << 19)
__device__ __forceinline__ unsigned xb_ld(unsigned* p)              { return __hip_atomic_load(p, __ATOMIC_RELAXED, __HIP_MEMORY_SCOPE_AGENT); }
__device__ __forceinline__ unsigned xb_add(unsigned* p, unsigned v) { return __hip_atomic_fetch_add(p, v, __ATOMIC_RELAXED, __HIP_MEMORY_SCOPE_AGENT); }
__device__ __forceinline__ unsigned xb_xcc_id() { return (unsigned)__builtin_amdgcn_s_getreg((3 << 11) | 20) & 0xFu; }
#define XB_SPIN(cond, bar) do { unsigned _sp = 0; while (cond) { __builtin_amdgcn_s_sleep(1); \
    if ((++_sp & 255u) == 0u) { if (xb_ld(&(bar)[XB_TMO])) break; if (_sp > XB_SPIN_CAP) { atomicAdd(&(bar)[XB_TMO], 1u); break; } } } } while (0)
struct XcdBarrier { unsigned* bar; unsigned x; volatile LAS unsigned* st; };
__device__ __forceinline__ XcdBarrier xcd_barrier_post(unsigned* bar, volatile LAS unsigned* st) {
    XcdBarrier b; b.bar = bar; b.x = xb_xcc_id(); b.st = st;
    if (threadIdx.x == 0) (void)xb_add(&bar[XB_XCNT(b.x)], 1u);
    return b;
}
__device__ __forceinline__ void xcd_barrier_complete(unsigned* bar, unsigned x, unsigned& nloc, unsigned& nx) {
    const unsigned G = gridDim.x * gridDim.y * gridDim.z;
    unsigned sum, cnt, mine, sp = 0u;
    for (;;) {
        sum = 0u; cnt = 0u; mine = 0u;
#pragma unroll
        for (unsigned j = 0; j < 16; ++j) { const unsigned c = xb_ld(&bar[XB_XCNT(j)]); sum += c; cnt += (c > 0u) ? 1u : 0u; mine = (j == x) ? c : mine; }
        if (sum == G) break;
        __builtin_amdgcn_s_sleep(1);
        if ((++sp & 255u) == 0u) { if (xb_ld(&bar[XB_TMO])) break; if (sp > XB_SPIN_CAP) { atomicAdd(&bar[XB_TMO], 1u); break; } }
    }
    nloc = mine > 0u ? mine : 1u; nx = cnt > 0u ? cnt : 1u;
}
__device__ __forceinline__ void xcd_barrier(const XcdBarrier& b) {
    asm volatile("s_waitcnt vmcnt(0)" ::: "memory");
    __syncthreads();
    if (threadIdx.x == 0) {
        unsigned* bar = b.bar;
        __builtin_amdgcn_s_waitcnt(0);
        unsigned nloc = b.st[0], nx = b.st[1];
        if (nloc == 0u) { xcd_barrier_complete(bar, b.x, nloc, nx); b.st[0] = nloc; b.st[1] = nx; }
        const unsigned old = xb_add(&bar[XB_XSUB(b.x)], 1u);
        const unsigned gen = old / nloc;
        if (old + 1u == (gen + 1u) * nloc) {
            __builtin_amdgcn_fence(__ATOMIC_RELEASE, "agent");
            asm volatile("s_waitcnt vmcnt(0)" ::: "memory");
            const unsigned og = xb_add(&bar[XB_TOP], 1u);
            const unsigned tg = og / nx;
            if (og + 1u == (tg + 1u) * nx) xb_add(&bar[XB_TOPGEN], 1u);
            else XB_SPIN(xb_ld(&bar[XB_TOPGEN]) == tg, bar);
            __builtin_amdgcn_fence(__ATOMIC_ACQUIRE, "agent");
            xb_add(&bar[XB_XGEN(b.x)], 1u);
            asm volatile("s_waitcnt vmcnt(0)" ::: "memory");
        } else {
            XB_SPIN(xb_ld(&bar[XB_XGEN(b.x)]) == gen, bar);
            __builtin_amdgcn_fence(__ATOMIC_ACQUIRE, "agent");
            asm volatile("s_waitcnt vmcnt(0)" ::: "memory");
        }
    }
    __syncthreads();
}

struct Args { const float* in[N_INPUTS]; float* out; unsigned char* ws; int ph_lo, ph_hi; };

struct Frame {
    LAS unsigned char* lds;
    int tid, lane, wave, G, c;
    const float* const* in;
    float* out;
    unsigned char* ws;
};
#define WSP(T, off) ((T*)(F.ws + (off)))
__device__ __forceinline__ Frame launder(const Frame& F0) {
    Frame F = F0;
    asm volatile("" : "+v"(F.tid), "+v"(F.lane));
    asm volatile("" : "+s"(F.wave), "+s"(F.G), "+s"(F.c));
    { int z = 0; asm volatile("" : "+s"(z)); F.in += z; F.out += z; F.ws += z; }
    asm volatile("" : "+s"(F.lds));
    return F;
}

using pg8::f32x4;
using pg8::Unit;
using pg8::cvt_pk_bf16;

struct Epi1 {
    static constexpr bool PERM = true;
    bf16* P; float* HF; float* DT; bf16* Gt;
    __device__ __forceinline__ bool keep(const Unit&) const { return false; }
    __device__ __forceinline__ void operator()(f32x4 (&acc)[2][2][4][2], const Unit& u, int wr, int wc, int fr, int fq) const {
        const int row0 = u.pm * 256 + wr * 64 + fr, pn = u.pn;
        if (pn >= 51) {
            const int colb = (pn - 51) * 256 + wc * 32 + 8 * fq;
#pragma unroll
            for (int ai = 0; ai < 2; ++ai)
#pragma unroll
                for (int m = 0; m < 4; ++m) { bf16* rowp = Gt + (size_t)(row0 + ai * 128 + m * 16) * NG + colb;
#pragma unroll
                    for (int bj = 0; bj < 2; ++bj) { const f32x4 v0 = acc[ai][bj][m][0], v1 = acc[ai][bj][m][1]; pg8::u32x4 w;
                        w.x = cvt_pk_bf16(sigm(v0[0]), sigm(v0[1])); w.y = cvt_pk_bf16(sigm(v0[2]), sigm(v0[3])); w.z = cvt_pk_bf16(sigm(v1[0]), sigm(v1[1])); w.w = cvt_pk_bf16(sigm(v1[2]), sigm(v1[3]));
                        *(pg8::u32x4*)(rowp + bj * 128) = w; } }
        } else if (pn >= 12 && pn < 16) {
            const int colb = (pn - 12) * 256 + wc * 32 + 8 * fq;
#pragma unroll
            for (int ai = 0; ai < 2; ++ai)
#pragma unroll
                for (int m = 0; m < 4; ++m) { float* rowp = HF + (size_t)(row0 + ai * 128 + m * 16) * 1024 + colb;
#pragma unroll
                    for (int bj = 0; bj < 2; ++bj) { *(f32x4*)(rowp + bj * 128) = acc[ai][bj][m][0]; *(f32x4*)(rowp + bj * 128 + 4) = acc[ai][bj][m][1]; } }
        } else if (pn == 34) {
            if (wc == 0 && fq < 2) {
#pragma unroll
                for (int ai = 0; ai < 2; ++ai)
#pragma unroll
                    for (int m = 0; m < 4; ++m) { float* rowp = DT + (size_t)(row0 + ai * 128 + m * 16) * 16 + 8 * fq;
                        *(f32x4*)(rowp) = acc[ai][0][m][0]; *(f32x4*)(rowp + 4) = acc[ai][0][m][1]; }
            }
        } else {
            const int colb = pn * 256 + wc * 32 + 8 * fq;
#pragma unroll
            for (int ai = 0; ai < 2; ++ai)
#pragma unroll
                for (int m = 0; m < 4; ++m) { bf16* rowp = P + (size_t)(row0 + ai * 128 + m * 16) * NP + colb;
#pragma unroll
                    for (int bj = 0; bj < 2; ++bj) { const f32x4 v0 = acc[ai][bj][m][0], v1 = acc[ai][bj][m][1]; pg8::u32x4 w;
                        w.x = cvt_pk_bf16(v0[0], v0[1]); w.y = cvt_pk_bf16(v0[2], v0[3]); w.z = cvt_pk_bf16(v1[0], v1[1]); w.w = cvt_pk_bf16(v1[2], v1[3]);
                        *(pg8::u32x4*)(rowp + bj * 128) = w; } }
        }
    }
};

struct EpiB {
    static constexpr bool PERM = true;
    bf16* O; int ldc;
    __device__ __forceinline__ bool keep(const Unit&) const { return false; }
    __device__ __forceinline__ void operator()(f32x4 (&acc)[2][2][4][2], const Unit& u, int wr, int wc, int fr, int fq) const {
        const int row0 = u.pm * 256 + wr * 64 + fr, colb = u.pn * 256 + wc * 32 + 8 * fq;
#pragma unroll
        for (int ai = 0; ai < 2; ++ai)
#pragma unroll
            for (int m = 0; m < 4; ++m) { bf16* rowp = O + (size_t)(row0 + ai * 128 + m * 16) * ldc + colb;
#pragma unroll
                for (int bj = 0; bj < 2; ++bj) { const f32x4 v0 = acc[ai][bj][m][0], v1 = acc[ai][bj][m][1]; pg8::u32x4 w;
                    w.x = cvt_pk_bf16(v0[0], v0[1]); w.y = cvt_pk_bf16(v0[2], v0[3]); w.z = cvt_pk_bf16(v1[0], v1[1]); w.w = cvt_pk_bf16(v1[2], v1[3]);
                    *(pg8::u32x4*)(rowp + bj * 128) = w; } }
    }
};

struct EpiBr {
    static constexpr bool PERM = true;
    const bf16* Gt; bf16* O;
    __device__ __forceinline__ bool keep(const Unit& u) const { return u.kz < 3; }
    __device__ __forceinline__ void operator()(f32x4 (&acc)[2][2][4][2], const Unit& u, int wr, int wc, int fr, int fq) const {
        const int row0 = u.pm * 256 + wr * 64 + fr, colb = u.pn * 256 + wc * 32 + 8 * fq, kz = u.kz;
#pragma unroll
        for (int ai = 0; ai < 2; ++ai)
#pragma unroll
            for (int m = 0; m < 4; ++m) { const size_t r = (size_t)(row0 + ai * 128 + m * 16);
#pragma unroll
                for (int bj = 0; bj < 2; ++bj) {
                    const pg8::u32x4 ga = *(const pg8::u32x4*)(Gt + r * NG + kz * 2048 + colb + bj * 128);
                    float s[8] = {bflo(ga.x), bfhi(ga.x), bflo(ga.y), bfhi(ga.y), bflo(ga.z), bfhi(ga.z), bflo(ga.w), bfhi(ga.w)};
                    if (kz < 3) {
                        const pg8::u32x4 gb = *(const pg8::u32x4*)(Gt + r * NG + (kz + 1) * 2048 + colb + bj * 128);
                        const float d[8] = {bflo(gb.x), bfhi(gb.x), bflo(gb.y), bfhi(gb.y), bflo(gb.z), bfhi(gb.z), bflo(gb.w), bfhi(gb.w)};
#pragma unroll
                        for (int j = 0; j < 8; ++j) s[j] = s[j] * __builtin_amdgcn_rcpf(fmaxf(d[j], 1e-20f));
                    }
                    f32x4 v0 = acc[ai][bj][m][0], v1 = acc[ai][bj][m][1];
                    v0[0] *= s[0]; v0[1] *= s[1]; v0[2] *= s[2]; v0[3] *= s[3]; v1[0] *= s[4]; v1[1] *= s[5]; v1[2] *= s[6]; v1[3] *= s[7];
                    acc[ai][bj][m][0] = v0; acc[ai][bj][m][1] = v1;
                    if (kz == 3) { pg8::u32x4 w; w.x = cvt_pk_bf16(v0[0], v0[1]); w.y = cvt_pk_bf16(v0[2], v0[3]); w.z = cvt_pk_bf16(v1[0], v1[1]); w.w = cvt_pk_bf16(v1[2], v1[3]);
                        *(pg8::u32x4*)(O + r * DM + colb + bj * 128) = w; }
                }
                asm volatile("" ::: "memory"); }
    }
};

struct EpiRes {
    static constexpr bool PERM = false;
    const float* Xc; float* Xn;
    __device__ __forceinline__ bool keep(const Unit&) const { return false; }
    __device__ __forceinline__ void operator()(f32x4 (&acc)[2][2][4][2], const Unit& u, int wr, int wc, int fr, int fq) const {
        const int row0 = u.pm * 256 + wr * 64 + fr, col0 = u.pn * 256 + wc * 32 + 4 * fq;
#pragma unroll
        for (int ai = 0; ai < 2; ++ai)
#pragma unroll
            for (int m = 0; m < 4; ++m) { const size_t off = (size_t)(row0 + ai * 128 + m * 16) * DM + col0;
#pragma unroll
                for (int bj = 0; bj < 2; ++bj)
#pragma unroll
                    for (int n = 0; n < 2; ++n) { const f32x4 b = *(const f32x4*)(Xc + off + bj * 128 + n * 16); *(f32x4*)(Xn + off + bj * 128 + n * 16) = b + acc[ai][bj][m][n]; }
                asm volatile("" ::: "memory"); }
    }
};

__device__ __forceinline__ void tr_item(const float* W, int K, int N, bf16* WT, int ldt, int mode, int roff, LAS float* scr, int item, int lane) {
    const int nblk = (N + 31) >> 5, kb = item / nblk, nb = item - kb * nblk, k0 = 64 * kb, n0 = 32 * nb;
    const int nn = n0 + (lane & 31); const bool okn = nn < N;
#pragma unroll 8
    for (int i = 0; i < 32; ++i) { const int kk = 2 * i + (lane >> 5); scr[kk * 33 + (lane & 31)] = okn ? W[(size_t)(k0 + kk) * N + nn] : 0.f; }
    LDS_WAIT(); asm volatile("" ::: "memory");
    const int c = lane & 7;
#pragma unroll
    for (int j = 0; j < 4; ++j) { const int n = (lane >> 3) + 8 * j, gn = n0 + n; const LAS float* s = scr + (8 * c) * 33 + n;
        v4u o; o.x = pk2(s[0 * 33], s[1 * 33]); o.y = pk2(s[2 * 33], s[3 * 33]); o.z = pk2(s[4 * 33], s[5 * 33]); o.w = pk2(s[6 * 33], s[7 * 33]);
        if (gn < N) { const int dr = (mode == 1) ? (gn < SRC_SPLIT ? gn : gn + 240) : gn + roff; *(v4u*)(WT + (size_t)dr * ldt + k0 + 8 * c) = o; } }
    LDS_WAIT(); asm volatile("" ::: "memory");
}

__device__ __forceinline__ void phase_prologue(const Frame& F0) {
    Frame F = launder(F0);
    LAS float* scr = (LAS float*)(F.lds + F.wave * 8704);
    const int gw = F.c * NWAVES + F.wave, NGW = F.G * NWAVES;
    constexpr int I_IN = (DM / 64) * ((NIN + 31) / 32), I_GT = (DM / 64) * (NG / 32), I_BR = (BW / 64) * (DM / 32), I_OUT = (DM / 64) * (DM / 32), I_UP = (DM / 64) * (DFF / 32), I_DN = (DFF / 64) * (DM / 32);
    constexpr int I_LAYER = I_IN + I_GT + 4 * I_BR + I_OUT + 2 * I_UP + I_DN;
    for (int it = gw; it < NLAYER * I_LAYER; it += NGW) {
        const int l = it / I_LAYER; int r = it - l * I_LAYER;
        bf16* W1 = WSP(bf16, WS_W1 + l * SZ_W1);
        if (r < I_IN) { tr_item(F.in[I_WIN] + (size_t)l * DM * NIN, DM, NIN, W1, DM, 1, 0, scr, r, F.lane); continue; } r -= I_IN;
        if (r < I_GT) { tr_item(F.in[I_WGATE] + (size_t)l * DM * NG, DM, NG, W1, DM, 0, NP, scr, r, F.lane); continue; } r -= I_GT;
        if (r < 4 * I_BR) { const int k = r / I_BR; tr_item(F.in[I_WBR] + ((size_t)l * 4 + k) * BW * DM, BW, DM, WSP(bf16, WS_WB + l * SZ_WB) + (size_t)k * DM * BW, BW, 0, 0, scr, r - k * I_BR, F.lane); continue; } r -= 4 * I_BR;
        if (r < I_OUT) { tr_item(F.in[I_WOUT] + (size_t)l * DM * DM, DM, DM, WSP(bf16, WS_WO + l * SZ_WO), DM, 0, 0, scr, r, F.lane); continue; } r -= I_OUT;
        if (r < I_UP) { tr_item(F.in[I_WUP] + (size_t)l * DM * DFF, DM, DFF, WSP(bf16, WS_WUV + l * SZ_WUV), DM, 0, 0, scr, r, F.lane); continue; } r -= I_UP;
        if (r < I_UP) { tr_item(F.in[I_WVAL] + (size_t)l * DM * DFF, DM, DFF, WSP(bf16, WS_WUV + l * SZ_WUV), DM, 0, DFF, scr, r, F.lane); continue; } r -= I_UP;
        tr_item(F.in[I_WDOWN] + (size_t)l * DFF * DM, DFF, DM, WSP(bf16, WS_WD + l * SZ_WD), DFF, 0, 0, scr, r, F.lane);
    }
    const int gt = F.c * NTHR + F.tid, NGT = F.G * NTHR;
    for (int i = gt; i < NLAYER * 240 * (DM / 8); i += NGT) { const int l = i / (240 * (DM / 8)), r = i - l * (240 * (DM / 8));
        *(v4u*)(WSP(bf16, WS_W1 + l * SZ_W1) + (size_t)(SRC_SPLIT + r / (DM / 8)) * DM + (r % (DM / 8)) * 8) = (v4u){0u, 0u, 0u, 0u}; }
    for (int i = gt; i < 2049 * 64; i += NGT) { const int p = i >> 6, j = i & 63; const float pos = p < 2048 ? (float)p : 16384.f;
        const float fr = powf(10000.f, -(float)j / 64.f); const float ang = pos * fr; WSP(f32x2, WS_ROPE)[i] = (f32x2){cosf(ang), sinf(ang)}; }
    for (int i = gt; i < M * (DM / 4); i += NGT) { const int row = i / (DM / 4), c4 = i - row * (DM / 4);
        f32x4 v = (f32x4){0.f, 0.f, 0.f, 0.f};
        if (row < MP) v = ((const f32x4*)F.in[I_XP])[(size_t)row * (DM / 4) + c4]; else if (row < MR) v = ((const f32x4*)F.in[I_XS])[(size_t)(row - MP) * (DM / 4) + c4];
        WSP(f32x4, WS_X0)[i] = v; }
}

__device__ __forceinline__ float wave_sum(float v) {
#pragma unroll
    for (int o = 1; o < 64; o <<= 1) v += __shfl_xor(v, o);
    return v;
}
__device__ __forceinline__ void phase_norm(const Frame& F0, const float* X, const float* g, bf16* H) {
    Frame F = launder(F0);
    const int gw = F.c * NWAVES + F.wave, NGW = F.G * NWAVES;
    for (int row = gw; row < M; row += NGW) {
        v2u* o8 = (v2u*)(H + (size_t)row * DM) + F.lane;
        if (row >= MR) {
#pragma unroll
            for (int j = 0; j < 8; ++j) o8[64 * j] = (v2u){0u, 0u};
            continue; }
        const f32x4* xr = (const f32x4*)(X + (size_t)row * DM) + F.lane;
        f32x4 v[8]; float s = 0.f;
#pragma unroll
        for (int j = 0; j < 8; ++j) { v[j] = xr[64 * j]; s += (v[j].x * v[j].x + v[j].y * v[j].y) + (v[j].z * v[j].z + v[j].w * v[j].w); }
        const float rstd = rsqrtf(wave_sum(s) * (1.f / DM) + EPS);
#pragma unroll
        for (int j = 0; j < 8; ++j) { const f32x4 gv = ((const f32x4*)g)[F.lane + 64 * j];
            o8[64 * j] = (v2u){pk2(v[j].x * rstd * gv.x, v[j].y * rstd * gv.y), pk2(v[j].z * rstd * gv.z, v[j].w * rstd * gv.w)}; }
    }
}
__device__ __forceinline__ void phase_final(const Frame& F0, const float* X, const float* g) {
    Frame F = launder(F0);
    const int gw = F.c * NWAVES + F.wave, NGW = F.G * NWAVES;
    for (int row = gw; row < MR; row += NGW) {
        const f32x4* xr = (const f32x4*)(X + (size_t)row * DM) + F.lane;
        f32x4* o = (f32x4*)(F.out + (row < MP ? O_YP + (size_t)row * DM : O_YS + (size_t)(row - MP) * DM)) + F.lane;
        f32x4 v[8]; float s = 0.f;
#pragma unroll
        for (int j = 0; j < 8; ++j) { v[j] = xr[64 * j]; s += (v[j].x * v[j].x + v[j].y * v[j].y) + (v[j].z * v[j].z + v[j].w * v[j].w); }
        const float rstd = rsqrtf(wave_sum(s) * (1.f / DM) + EPS);
#pragma unroll
        for (int j = 0; j < 8; ++j) { const f32x4 gv = ((const f32x4*)g)[F.lane + 64 * j]; o[64 * j] = v[j] * rstd * gv; }
    }
}

constexpr int LW_STR = 136;
constexpr int L_WT = 0, L_XC = 256 * LW_STR * 2, L_XCF = L_XC + 64 * LW_STR * 2, LXF_STR = 132;
static_assert(L_XCF + 64 * LXF_STR * 4 <= RING_BYTES, "lru lds");
__device__ __forceinline__ void lru_stage_w(const Frame& F0, int l, int n) {
    Frame F = launder(F0);
    LAS bf16* WT = (LAS bf16*)(F.lds + L_WT);
    const float* wa = F.in[I_LWA] + ((size_t)l * 8 + n) * 16384; const float* wx = F.in[I_LWX] + ((size_t)l * 8 + n) * 16384;
    for (int i = F.tid; i < 16384; i += NTHR) { const int c = i >> 7, d = i & 127;
        WT[d * LW_STR + c] = (bf16)f2bf(wa[i]); WT[(128 + d) * LW_STR + c] = (bf16)f2bf(wx[i]); }
}
__device__ __forceinline__ void lru_tile(const Frame& F0, int l, int n, int tt) {
    Frame F = launder(F0);
    LAS bf16* WT = (LAS bf16*)(F.lds + L_WT); LAS bf16* XC = (LAS bf16*)(F.lds + L_XC); LAS float* XCF = (LAS float*)(F.lds + L_XCF);
    const bf16* P = WSP(bf16, WS_P);
    const float* cw = F.in[I_LCW] + (size_t)l * 4 * 1024; const float* cb = F.in[I_LCB] + (size_t)l * 1024;
    {
        const int tk = F.tid >> 3, c0 = (F.tid & 7) * 16, row = tt * 64 + tk, ch0 = n * 128 + c0;
        float acc[16];
#pragma unroll
        for (int j = 0; j < 16; ++j) acc[j] = cb[ch0 + j];
        if (row < MP) {
            const int t = row & (SEQ - 1);
#pragma unroll
            for (int jj = 0; jj < 4; ++jj) { if (t - 3 + jj >= 0) { const v4u* src = (const v4u*)(P + (size_t)(row - 3 + jj) * NP + C_XA + ch0); const v4u a = src[0], b = src[1];
                const unsigned w[8] = {a.x, a.y, a.z, a.w, b.x, b.y, b.z, b.w}; const float* wj = cw + jj * 1024 + ch0;
#pragma unroll
                for (int q = 0; q < 8; ++q) { acc[2 * q] += wj[2 * q] * bflo(w[q]); acc[2 * q + 1] += wj[2 * q + 1] * bfhi(w[q]); } } }
        } else if (row < MR) {
            const int s = row - MP; const float* st = F.in[I_SLC] + ((size_t)l * 128 + s) * 3 * 1024 + ch0;
#pragma unroll
            for (int jj = 0; jj < 3; ++jj) { const float* wj = cw + jj * 1024 + ch0;
#pragma unroll
                for (int q = 0; q < 16; ++q) acc[q] += wj[q] * st[jj * 1024 + q]; }
            const v4u* src = (const v4u*)(P + (size_t)row * NP + C_XA + ch0); const v4u a = src[0], b = src[1];
            const unsigned w[8] = {a.x, a.y, a.z, a.w, b.x, b.y, b.z, b.w}; const float* wj = cw + 3 * 1024 + ch0;
#pragma unroll
            for (int q = 0; q < 8; ++q) { acc[2 * q] += wj[2 * q] * bflo(w[q]); acc[2 * q + 1] += wj[2 * q + 1] * bfhi(w[q]); }
        }
#pragma unroll
        for (int q = 0; q < 16; ++q) { XCF[tk * LXF_STR + c0 + q] = acc[q]; }
#pragma unroll
        for (int q = 0; q < 8; ++q) *(LAS unsigned*)(XC + tk * LW_STR + c0 + 2 * q) = pk2(acc[2 * q], acc[2 * q + 1]);
    }
    __syncthreads();
    const int w = F.wave, lane = F.lane, fr = lane & 15, g = lane >> 4;
    f32x4 ar[4], ai_[4];
#pragma unroll
    for (int rt = 0; rt < 4; ++rt) { ar[rt] = (f32x4){0.f, 0.f, 0.f, 0.f}; ai_[rt] = (f32x4){0.f, 0.f, 0.f, 0.f}; }
#pragma unroll
    for (int ks = 0; ks < 4; ++ks) {
        const bf16x8 br = *(const LAS bf16x8*)(WT + (16 * w + fr) * LW_STR + 32 * ks + 8 * g);
        const bf16x8 bi = *(const LAS bf16x8*)(WT + (128 + 16 * w + fr) * LW_STR + 32 * ks + 8 * g);
#pragma unroll
        for (int rt = 0; rt < 4; ++rt) { const bf16x8 a = *(const LAS bf16x8*)(XC + (16 * rt + fr) * LW_STR + 32 * ks + 8 * g);
            ar[rt] = __builtin_amdgcn_mfma_f32_16x16x32_bf16(a, br, ar[rt], 0, 0, 0); ai_[rt] = __builtin_amdgcn_mfma_f32_16x16x32_bf16(a, bi, ai_[rt], 0, 0, 0); }
    }
    const int d = 16 * w + fr, ch = n * 128 + d;
    const float ba = F.in[I_LBA][(size_t)l * 1024 + ch], bx = F.in[I_LBX][(size_t)l * 1024 + ch], sp = softplusf(-F.in[I_LLAM][(size_t)l * 1024 + ch]);
    float* LA = WSP(float, WS_X1); float* LU = LA + (size_t)M * 1024;
#pragma unroll
    for (int rt = 0; rt < 4; ++rt)
#pragma unroll
        for (int reg = 0; reg < 4; ++reg) { const int tk = 16 * rt + 4 * g + reg, row = tt * 64 + tk;
            const float r = sigm(ar[rt][reg] + ba), iv = sigm(ai_[rt][reg] + bx), la = -8.f * r * sp, a = __expf(la), xc = XCF[tk * LXF_STR + d];
            const float uu = sqrtf(fmaxf(-expm1f(2.f * la), 0.f)) * (iv * xc);
            LA[(size_t)row * 1024 + ch] = a; LU[(size_t)row * 1024 + ch] = uu; }
    __syncthreads();
}

constexpr int TB = 16;
constexpr int R_DEC = 0, R_KK = TB * 128 * 4, R_Q = 2 * TB * 128 * 4, R_VV = 3 * TB * 128 * 4, R_XS = R_VV + TB * 64 * 4, R_DSC = R_XS + TB * 64 * 4;
template <int MODE>
__device__ __forceinline__ void rec_unit(const Frame& F0, int l, int unit) {
    Frame F = launder(F0);
    constexpr int V = (MODE == 2) ? 64 : 128, NH = (MODE == 2) ? 16 : 8;
    int b, h, vbase;
    if (MODE == 2) { b = unit >> 4; h = unit & 15; vbase = 0; } else { b = unit >> 4; h = (unit >> 1) & 7; vbase = (unit & 1) * 64; }
    LAS float* DEC = (LAS float*)(F.lds + R_DEC); LAS float* KK = (LAS float*)(F.lds + R_KK); LAS float* Q = (LAS float*)(F.lds + R_Q);
    LAS float* VV = (LAS float*)(F.lds + R_VV); LAS float* XS = (LAS float*)(F.lds + R_XS); LAS float* DSC = (LAS float*)(F.lds + R_DSC);
    const bf16* P = WSP(bf16, WS_P);
    const int lane = F.lane, kq = lane & 15, vg = lane >> 4, vl = 8 * F.wave + 2 * vg;
    float S[8][2];
#pragma unroll
    for (int i = 0; i < 8; ++i) { S[i][0] = 0.f; S[i][1] = 0.f; }
    float* OUT = WSP(float, WS_OB + (size_t)MODE * 0) ;
    if (MODE == 0) OUT = WSP(float, WS_OB); else if (MODE == 1) OUT = WSP(float, WS_OB + 2 * SZ_O); else OUT = WSP(float, WS_OB + SZ_O);
    const float ret_gamma = 1.f - exp2f(-5.f - (float)h);
    float ssd_A = 0.f, ssd_dtb = 0.f, ssd_D = 0.f;
    if (MODE == 2) { ssd_A = -__expf(F.in[I_SALOG][l * 16 + h]); ssd_dtb = F.in[I_SDTB][l * 16 + h]; ssd_D = F.in[I_SD][l * 16 + h]; }
    for (int blk = 0; blk < SEQ / TB; ++blk) {
        const int t0 = blk * TB, row0 = b * SEQ + t0;
        if (MODE == 0) {
#pragma unroll
            for (int r = 0; r < 4; ++r) { const int i = F.tid + NTHR * r, tok = i >> 7, k = i & 127; const size_t row = row0 + tok;
                const float hq = bf2f(P[row * NP + C_HQ + h * 128 + k]), hf = WSP(float, WS_HF)[row * 1024 + h * 128 + k];
                float lb = 0.f; if (l == 1) lb = sigm(F.in[I_HGLB][1024 + h * 128 + k] - F.in[I_HGLB][h * 128 + k]);
                const float sg = sigm(hf);
                DEC[tok * 128 + k] = lb + (1.f - lb) * sg; KK[tok * 128 + k] = (1.f - lb) * (1.f - sg); Q[tok * 128 + k] = siluf(hq); }
#pragma unroll
            for (int r = 0; r < 2; ++r) { const int i = F.tid + NTHR * r, tok = i >> 6, vv = i & 63; VV[tok * 64 + vv] = bf2f(P[(size_t)(row0 + tok) * NP + C_HI + h * 128 + vbase + vv]); }
        } else if (MODE == 1) {
#pragma unroll
            for (int r = 0; r < 2; ++r) { const int i = F.tid + NTHR * r, tok = i >> 6, j = i & 63; const size_t row = row0 + tok;
                const float q1 = bf2f(P[row * NP + C_RQ + h * 128 + j]), q2 = bf2f(P[row * NP + C_RQ + h * 128 + 64 + j]);
                const float k1 = bf2f(P[row * NP + C_RK + h * 128 + j]), k2 = bf2f(P[row * NP + C_RK + h * 128 + 64 + j]);
                const f32x2 cs = WSP(f32x2, WS_ROPE)[(t0 + tok) * 64 + j];
                Q[tok * 128 + j] = q1 * cs.x - q2 * cs.y; Q[tok * 128 + 64 + j] = q1 * cs.y + q2 * cs.x;
                KK[tok * 128 + j] = (k1 * cs.x - k2 * cs.y) * 0.08838834764831845f; KK[tok * 128 + 64 + j] = (k1 * cs.y + k2 * cs.x) * 0.08838834764831845f;
                VV[tok * 64 + j] = bf2f(P[row * NP + C_RV + h * 128 + vbase + j]); }
        } else {
            const float* cw = F.in[I_SCW] + (size_t)l * 4 * SSD_CD; const float* cb = F.in[I_SCB] + (size_t)l * SSD_CD;
            const int grp = h >> 3;
#pragma unroll 1
            for (int r = 0; r < 10; ++r) { const int i = F.tid + NTHR * r, tok = i / 320, ch = i - tok * 320; const int t = t0 + tok; const size_t row = row0 + tok;
                const int cidx = ch < 64 ? h * 64 + ch : (ch < 192 ? 1024 + grp * 128 + (ch - 64) : 1280 + grp * 128 + (ch - 192));
                float a = cb[cidx];
#pragma unroll
                for (int jj = 0; jj < 4; ++jj) if (t - 3 + jj >= 0) a += cw[jj * SSD_CD + cidx] * bf2f(P[(row - 3 + jj) * NP + C_SX + cidx]);
                const float val = siluf(a);
                if (ch < 64) { const float dtv = softplusf(WSP(float, WS_DT)[row * 16 + h] + ssd_dtb); XS[tok * 64 + ch] = val; VV[tok * 64 + ch] = val * dtv; if (ch == 0) DSC[tok] = __expf(dtv * ssd_A); }
                else if (ch < 192) KK[tok * 128 + ch - 64] = val; else Q[tok * 128 + ch - 192] = val; }
        }
        __syncthreads();
#pragma unroll 2
        for (int tt = 0; tt < TB; ++tt) {
            float dec[8], kk[8], q[8];
            { const f32x4 a = *(const LAS f32x4*)(KK + tt * 128 + 8 * kq), c = *(const LAS f32x4*)(KK + tt * 128 + 8 * kq + 4); kk[0] = a.x; kk[1] = a.y; kk[2] = a.z; kk[3] = a.w; kk[4] = c.x; kk[5] = c.y; kk[6] = c.z; kk[7] = c.w; }
            { const f32x4 a = *(const LAS f32x4*)(Q + tt * 128 + 8 * kq), c = *(const LAS f32x4*)(Q + tt * 128 + 8 * kq + 4); q[0] = a.x; q[1] = a.y; q[2] = a.z; q[3] = a.w; q[4] = c.x; q[5] = c.y; q[6] = c.z; q[7] = c.w; }
            if (MODE == 0) { const f32x4 a = *(const LAS f32x4*)(DEC + tt * 128 + 8 * kq), c = *(const LAS f32x4*)(DEC + tt * 128 + 8 * kq + 4); dec[0] = a.x; dec[1] = a.y; dec[2] = a.z; dec[3] = a.w; dec[4] = c.x; dec[5] = c.y; dec[6] = c.z; dec[7] = c.w; }
            else { const float dsc = (MODE == 1) ? ret_gamma : DSC[tt];
#pragma unroll
                for (int i = 0; i < 8; ++i) dec[i] = dsc; }
            const f32x2 vv = *(const LAS f32x2*)(VV + tt * 64 + vl);
            float o0 = 0.f, o1 = 0.f;
#pragma unroll
            for (int i = 0; i < 8; ++i) { S[i][0] = dec[i] * S[i][0] + kk[i] * vv.x; S[i][1] = dec[i] * S[i][1] + kk[i] * vv.y; o0 += q[i] * S[i][0]; o1 += q[i] * S[i][1]; }
#pragma unroll
            for (int o = 1; o < 16; o <<= 1) { o0 += __shfl_xor(o0, o); o1 += __shfl_xor(o1, o); }
            if (kq == 0) { if (MODE == 2) { const f32x2 xs = *(const LAS f32x2*)(XS + tt * 64 + vl); o0 += ssd_D * xs.x; o1 += ssd_D * xs.y; }
                *(f32x2*)(OUT + (size_t)(row0 + tt) * 1024 + h * V + vbase + vl) = (f32x2){o0, o1}; }
        }
        __syncthreads();
    }
    float* so = F.out + (MODE == 0 ? O_HG_P : (MODE == 1 ? O_RET_P : O_SSD_P)) + (((size_t)l * NBATCH + b) * NH + h) * (128 * V);
#pragma unroll
    for (int i = 0; i < 8; ++i) *(f32x2*)(so + (size_t)(8 * kq + i) * V + vbase + vl) = (f32x2){S[i][0], S[i][1]};
}

template <int MODE>
__device__ __forceinline__ void samp_unit(const Frame& F0, int l, int pair) {
    Frame F = launder(F0);
    constexpr int V = (MODE == 2) ? 64 : 128, NH = (MODE == 2) ? 16 : 8, NKR = (MODE == 2) ? 32 : 16, NJ = 128 / NKR;
    const int s = pair / NH, h = pair - s * NH; const size_t row = MP + s;
    LAS float* DEC = (LAS float*)(F.lds + R_DEC); LAS float* KK = (LAS float*)(F.lds + R_KK); LAS float* Q = (LAS float*)(F.lds + R_Q);
    LAS float* VV = (LAS float*)(F.lds + R_VV); LAS float* XS = (LAS float*)(F.lds + R_XS); LAS float* DSC = (LAS float*)(F.lds + R_DSC);
    LAS float* RED = (LAS float*)(F.lds + 65536);
    const bf16* P = WSP(bf16, WS_P);
    const int tid = F.tid;
    if (MODE == 0) {
        if (tid < 128) { const int k = tid; const float hq = bf2f(P[row * NP + C_HQ + h * 128 + k]), hf = WSP(float, WS_HF)[row * 1024 + h * 128 + k];
            float lb = 0.f; if (l == 1) lb = sigm(F.in[I_HGLB][1024 + h * 128 + k] - F.in[I_HGLB][h * 128 + k]);
            const float sg = sigm(hf); DEC[k] = lb + (1.f - lb) * sg; KK[k] = (1.f - lb) * (1.f - sg); Q[k] = siluf(hq);
            VV[k] = bf2f(P[row * NP + C_HI + h * 128 + k]); }
    } else if (MODE == 1) {
        if (tid < 64) { const int j = tid;
            const float q1 = bf2f(P[row * NP + C_RQ + h * 128 + j]), q2 = bf2f(P[row * NP + C_RQ + h * 128 + 64 + j]);
            const float k1 = bf2f(P[row * NP + C_RK + h * 128 + j]), k2 = bf2f(P[row * NP + C_RK + h * 128 + 64 + j]);
            const f32x2 cs = WSP(f32x2, WS_ROPE)[2048 * 64 + j];
            Q[j] = q1 * cs.x - q2 * cs.y; Q[64 + j] = q1 * cs.y + q2 * cs.x;
            KK[j] = (k1 * cs.x - k2 * cs.y) * 0.08838834764831845f; KK[64 + j] = (k1 * cs.y + k2 * cs.x) * 0.08838834764831845f; }
        else if (tid < 192) { const int v = tid - 64; VV[v] = bf2f(P[row * NP + C_RV + h * 128 + v]); DEC[v] = 1.f - exp2f(-5.f - (float)h); }
    } else {
        if (tid < 320) { const int ch = tid, grp = h >> 3;
            const float* cw = F.in[I_SCW] + (size_t)l * 4 * SSD_CD; const float* cb = F.in[I_SCB] + (size_t)l * SSD_CD;
            const int cidx = ch < 64 ? h * 64 + ch : (ch < 192 ? 1024 + grp * 128 + (ch - 64) : 1280 + grp * 128 + (ch - 192));
            const float* st = F.in[I_SSC] + ((size_t)l * 128 + s) * 3 * SSD_CD + cidx;
            float a = cb[cidx] + cw[cidx] * st[0] + cw[SSD_CD + cidx] * st[SSD_CD] + cw[2 * SSD_CD + cidx] * st[2 * SSD_CD] + cw[3 * SSD_CD + cidx] * bf2f(P[row * NP + C_SX + cidx]);
            const float val = siluf(a);
            if (ch < 64) { const float dtv = softplusf(WSP(float, WS_DT)[row * 16 + h] + F.in[I_SDTB][l * 16 + h]); XS[ch] = val; VV[ch] = val * dtv;
                if (ch == 0) DSC[0] = __expf(dtv * (-__expf(F.in[I_SALOG][l * 16 + h]))); }
            else if (ch < 192) KK[ch - 64] = val; else Q[ch - 192] = val; }
    }
    __syncthreads();
    const int v4 = (MODE == 2) ? (tid & 15) : (tid & 31), kr = (MODE == 2) ? (tid >> 4) : (tid >> 5);
    const float* sin_ = F.in[MODE == 0 ? I_SHG : (MODE == 1 ? I_SRET : I_SSSD)] + (((size_t)l * 128 + s) * NH + h) * (128 * V);
    float* sout = F.out + (MODE == 0 ? O_HG_S : (MODE == 1 ? O_RET_S : O_SSD_S)) + (((size_t)l * 128 + s) * NH + h) * (128 * V);
    const f32x4 vv = *(const LAS f32x4*)(VV + 4 * v4);
    f32x4 sv[NJ];
#pragma unroll
    for (int j = 0; j < NJ; ++j) sv[j] = *(const f32x4*)(sin_ + (size_t)(kr + NKR * j) * V + 4 * v4);
    f32x4 po = (f32x4){0.f, 0.f, 0.f, 0.f};
#pragma unroll
    for (int j = 0; j < NJ; ++j) { const int k = kr + NKR * j; const float dec = (MODE == 2) ? DSC[0] : DEC[k]; const float kk = KK[k], q = Q[k];
        const f32x4 sn = sv[j] * dec + vv * kk; *(f32x4*)(sout + (size_t)k * V + 4 * v4) = sn; po += sn * q; }
    *(LAS f32x4*)(RED + kr * V + 4 * v4) = po;
    __syncthreads();
    if (tid < V) { float o = 0.f;
#pragma unroll
        for (int r = 0; r < NKR; ++r) o += RED[r * V + tid];
        if (MODE == 2) o += F.in[I_SD][l * 16 + h] * XS[tid];
        float* OUT = (MODE == 0) ? WSP(float, WS_OB) : (MODE == 1 ? WSP(float, WS_OB + 2 * SZ_O) : WSP(float, WS_OB + SZ_O));
        OUT[row * 1024 + h * V + tid] = o; }
    __syncthreads();
}

__device__ __forceinline__ void phase_mix(Frame& F, int l) {
    { const int w = F.c;
        if (w < 64) {
#ifndef SK_R0
            rec_unit<0>(F, l, w);
#endif
        } else if (w < 128) {
#ifndef SK_R1
            rec_unit<1>(F, l, w - 64);
#endif
        } else if (w < 192) {
#ifndef SK_R2
            rec_unit<2>(F, l, w - 128);
#endif
        } else {
            const int ww = w - 192, n = ww & 7;
#ifndef SK_LRU
            lru_stage_w(F, l, n); __syncthreads();
            for (int tt = ww >> 3; tt < 130; tt += 8) lru_tile(F, l, n, tt);
#endif
#ifndef SK_S0
            for (int p = ww; p < 1024; p += 64) samp_unit<0>(F, l, p);
#endif
#ifndef SK_S1
            for (int p = ww; p < 1024; p += 64) samp_unit<1>(F, l, p);
#endif
#ifndef SK_S2
            for (int p = ww; p < 2048; p += 64) samp_unit<2>(F, l, p);
#endif
        }
    }
}

__device__ __forceinline__ void phase_post(const Frame& F0, int l) {
    Frame F = launder(F0);
    const bf16* P = WSP(bf16, WS_P);
    const float* LA = WSP(float, WS_X1); const float* LU = LA + (size_t)M * 1024;
    bf16* BR = WSP(bf16, WS_BR);
    const int NSCAN = 8;
    if (F.c < NSCAN) {
        const int gt = F.c * NTHR + F.tid, b = gt >> 10, ch = gt & 1023;
        float h = 0.f;
        for (int t0 = 0; t0 < SEQ; t0 += 8) {
            float a[8], u[8], y[8];
#pragma unroll
            for (int j = 0; j < 8; ++j) { const size_t row = (size_t)b * SEQ + t0 + j; a[j] = LA[row * 1024 + ch]; u[j] = LU[row * 1024 + ch]; y[j] = bf2f(P[row * NP + C_YA + ch]); }
#pragma unroll
            for (int j = 0; j < 8; ++j) { const size_t row = (size_t)b * SEQ + t0 + j; h = a[j] * h + u[j]; BR[row * BW + ch] = (bf16)f2bf(h * geluf(y[j])); }
        }
        F.out[O_LH_P + ((size_t)l * NBATCH + b) * 1024 + ch] = h;
    }
    if (F.c >= NSCAN || F.G <= NSCAN) {
        const int cc = F.G > NSCAN ? F.c - NSCAN : F.c, GG = F.G > NSCAN ? F.G - NSCAN : F.G;
        const int gt = cc * NTHR + F.tid, NGT = GG * NTHR, gw = cc * NWAVES + F.wave, NGW = GG * NWAVES;
        for (int i = gt; i < MS * 1024; i += NGT) { const int s = i >> 10, ch = i & 1023; const size_t row = MP + s;
            const float hp = F.in[I_SLH][((size_t)l * 128 + s) * 1024 + ch]; const float h = LA[row * 1024 + ch] * hp + LU[row * 1024 + ch];
            F.out[O_LH_S + ((size_t)l * 128 + s) * 1024 + ch] = h; BR[row * BW + ch] = (bf16)f2bf(h * geluf(bf2f(P[row * NP + C_YA + ch]))); }
        for (int i = gt; i < NBATCH * 3 * 1024; i += NGT) { const int b = i / 3072, r = i - b * 3072, j = r >> 10, c = r & 1023;
            F.out[O_LC_P + (size_t)l * NBATCH * 3072 + i] = bf2f(P[((size_t)b * SEQ + SEQ - 3 + j) * NP + C_XA + c]); }
        for (int i = gt; i < MS * 3 * 1024; i += NGT) { const int s = i / 3072, r = i - s * 3072, j = r >> 10, c = r & 1023;
            F.out[O_LC_S + (size_t)l * MS * 3072 + i] = j < 2 ? F.in[I_SLC][(size_t)l * MS * 3072 + (size_t)s * 3072 + (j + 1) * 1024 + c] : bf2f(P[((size_t)MP + s) * NP + C_XA + c]); }
        for (int i = gt; i < NBATCH * 3 * SSD_CD; i += NGT) { const int b = i / (3 * SSD_CD), r = i - b * 3 * SSD_CD, j = r / SSD_CD, c = r - j * SSD_CD;
            F.out[O_SC_P + (size_t)l * NBATCH * 3 * SSD_CD + i] = bf2f(P[((size_t)b * SEQ + SEQ - 3 + j) * NP + C_SX + c]); }
        for (int i = gt; i < MS * 3 * SSD_CD; i += NGT) { const int s = i / (3 * SSD_CD), r = i - s * 3 * SSD_CD, j = r / SSD_CD, c = r - j * SSD_CD;
            F.out[O_SC_S + (size_t)l * MS * 3 * SSD_CD + i] = j < 2 ? F.in[I_SSC][(size_t)l * MS * 3 * SSD_CD + (size_t)s * 3 * SSD_CD + (j + 1) * SSD_CD + c] : bf2f(P[((size_t)MP + s) * NP + C_SX + c]); }
        const int lane = F.lane;
        for (int task = gw; task < MR * 3; task += NGW) {
            const int row = task / 3, br = task - row * 3;
            const f32x4* src = (const f32x4*)(WSP(float, WS_OB + (size_t)br * SZ_O) + (size_t)row * 1024 + 16 * lane);
            float x[16];
#pragma unroll
            for (int j = 0; j < 4; ++j) { const f32x4 v = src[j]; x[4 * j] = v.x; x[4 * j + 1] = v.y; x[4 * j + 2] = v.z; x[4 * j + 3] = v.w; }
            const int gcol = (br == 0) ? C_HGG : (br == 1 ? C_SZ : C_RG);
            const v4u* gp = (const v4u*)(P + (size_t)row * NP + gcol + 16 * lane); const v4u ga = gp[0], gb = gp[1];
            const unsigned gw_[8] = {ga.x, ga.y, ga.z, ga.w, gb.x, gb.y, gb.z, gb.w};
            float gt_[16];
#pragma unroll
            for (int q = 0; q < 8; ++q) { gt_[2 * q] = siluf(bflo(gw_[q])); gt_[2 * q + 1] = siluf(bfhi(gw_[q])); }
            float o[16];
            if (br == 1) {
                float ss = 0.f;
#pragma unroll
                for (int j = 0; j < 16; ++j) { x[j] *= gt_[j]; ss += x[j] * x[j]; }
#pragma unroll
                for (int m = 1; m < 32; m <<= 1) ss += __shfl_xor(ss, m);
                const float rs = rsqrtf(ss * (1.f / 512.f) + EPS); const float* nw = F.in[I_SNW] + (size_t)l * 1024 + 16 * lane;
#pragma unroll
                for (int j = 0; j < 16; ++j) o[j] = x[j] * rs * nw[j];
            } else {
                float ss = 0.f;
#pragma unroll
                for (int j = 0; j < 16; ++j) ss += x[j] * x[j];
#pragma unroll
                for (int m = 1; m < 8; m <<= 1) ss += __shfl_xor(ss, m);
                const float rs = rsqrtf(ss * (1.f / 128.f) + EPS);
                if (br == 0) { const float* nw = F.in[I_HGNW] + (size_t)l * 128 + ((16 * lane) & 127);
#pragma unroll
                    for (int j = 0; j < 16; ++j) o[j] = x[j] * rs * nw[j] * gt_[j]; }
                else {
#pragma unroll
                    for (int j = 0; j < 16; ++j) o[j] = x[j] * rs * gt_[j]; }
            }
            v4u w0, w1; w0.x = pk2(o[0], o[1]); w0.y = pk2(o[2], o[3]); w0.z = pk2(o[4], o[5]); w0.w = pk2(o[6], o[7]); w1.x = pk2(o[8], o[9]); w1.y = pk2(o[10], o[11]); w1.z = pk2(o[12], o[13]); w1.w = pk2(o[14], o[15]);
            v4u* dst = (v4u*)(BR + (size_t)(br + 1) * M * BW + (size_t)row * BW + 16 * lane); dst[0] = w0; dst[1] = w1;
        }
    }
}

__device__ __forceinline__ void phase_act(const Frame& F0, int l) {
    Frame F = launder(F0);
    const bf16* UV = WSP(bf16, WS_P); bf16* A2 = WSP(bf16, WS_G);
    const float* cw = F.in[I_FCW] + (size_t)l * 3 * DFF; const float* cb = F.in[I_FCB] + (size_t)l * DFF;
    const int gt = F.c * NTHR + F.tid, NGT = F.G * NTHR;
    constexpr int C8 = DFF / 8;
    for (int i = gt; i < M * C8; i += NGT) {
        const int row = i / C8, c = (i - row * C8) * 8;
        v4u outw = (v4u){0u, 0u, 0u, 0u};
        if (row < MR) {
            const v4u uw = *(const v4u*)(UV + (size_t)row * NUV + c), vw = *(const v4u*)(UV + (size_t)row * NUV + DFF + c);
            float u0[8] = {bflo(uw.x), bfhi(uw.x), bflo(uw.y), bfhi(uw.y), bflo(uw.z), bfhi(uw.z), bflo(uw.w), bfhi(uw.w)};
            const float vv[8] = {bflo(vw.x), bfhi(vw.x), bflo(vw.y), bfhi(vw.y), bflo(vw.z), bfhi(vw.z), bflo(vw.w), bfhi(vw.w)};
            float u1[8], u2[8];
#pragma unroll
            for (int j = 0; j < 8; ++j) { u1[j] = 0.f; u2[j] = 0.f; }
            if (row < MP) { const int t = row & (SEQ - 1);
                if (t >= 1) { const v4u w = *(const v4u*)(UV + (size_t)(row - 1) * NUV + c); u1[0] = bflo(w.x); u1[1] = bfhi(w.x); u1[2] = bflo(w.y); u1[3] = bfhi(w.y); u1[4] = bflo(w.z); u1[5] = bfhi(w.z); u1[6] = bflo(w.w); u1[7] = bfhi(w.w); }
                if (t >= 2) { const v4u w = *(const v4u*)(UV + (size_t)(row - 2) * NUV + c); u2[0] = bflo(w.x); u2[1] = bfhi(w.x); u2[2] = bflo(w.y); u2[3] = bfhi(w.y); u2[4] = bflo(w.z); u2[5] = bfhi(w.z); u2[6] = bflo(w.w); u2[7] = bfhi(w.w); }
                if (t >= SEQ - 2) { float* so = F.out + O_FC_P + (((size_t)l * NBATCH + (row >> 11)) * 2 + (t - (SEQ - 2))) * DFF + c;
#pragma unroll
                    for (int j = 0; j < 8; ++j) so[j] = u0[j]; }
            } else { const int s = row - MP; const float* st = F.in[I_SFC] + ((size_t)l * MS + s) * 2 * DFF + c; float* so = F.out + O_FC_S + ((size_t)l * MS + s) * 2 * DFF + c;
#pragma unroll
                for (int j = 0; j < 8; ++j) { u2[j] = st[j]; u1[j] = st[DFF + j]; so[j] = st[DFF + j]; so[DFF + j] = u0[j]; } }
            float a[8];
#pragma unroll
            for (int j = 0; j < 8; ++j) { const float y = cb[c + j] + cw[c + j] * u2[j] + cw[DFF + c + j] * u1[j] + cw[2 * DFF + c + j] * u0[j]; a[j] = geluf(y) * vv[j]; }
            outw.x = pk2(a[0], a[1]); outw.y = pk2(a[2], a[3]); outw.z = pk2(a[4], a[5]); outw.w = pk2(a[6], a[7]);
        }
        *(v4u*)(A2 + (size_t)row * DFF + c) = outw;
    }
}

constexpr int PH_PER_LAYER = 10, NPHASE = 1 + NLAYER * PH_PER_LAYER + 1;
__global__ void __launch_bounds__(NTHR, 2) mk_fwd(Args args) {
    extern __shared__ __attribute__((aligned(16))) unsigned char lds_raw[];
    Frame F;
    F.lds = (LAS unsigned char*)lds_raw;
    F.tid = threadIdx.x; F.lane = F.tid & 63; F.wave = __builtin_amdgcn_readfirstlane(F.tid >> 6);
    F.G = gridDim.x; F.c = blockIdx.x;
    F.in = args.in; F.out = args.out; F.ws = args.ws;
    volatile LAS unsigned* MISC = (volatile LAS unsigned*)(F.lds + LDSCTL_OFF);
    if (F.tid < 64) MISC[F.tid] = 0u;
    __syncthreads();
    unsigned* barw = (unsigned*)(F.ws + WS_CTL) + 4096;
    XcdBarrier bar; bar.bar = barw; bar.x = 0; bar.st = nullptr;
    if (!MK_SPLIT) bar = xcd_barrier_post(barw, MISC + 8);
    const int lo = args.ph_lo, hi = args.ph_hi;
#define IN(k) (lo <= (k) && (k) < hi)
#define SEAM(k) do { if (IN(k) && IN((k) + 1)) xcd_barrier(bar); } while (0)
#define X0 WSP(float, WS_X0)
#define X1 WSP(float, WS_X1)
#define H WSP(bf16, WS_H)
#define ring (F.lds)

    if (IN(0)) {
#ifndef SK_PRO
 phase_prologue(F);
#endif
 } SEAM(0);

    for (int l = 0; l < NLAYER; ++l) {
        const int pb = 1 + l * PH_PER_LAYER;
        if (IN(pb + 0)) {
#ifndef SK_NORM
 phase_norm(F, X0, F.in[I_GMIX] + (size_t)l * DM, H);
#endif
 } SEAM(pb + 0);
        if (IN(pb + 1)) { const Frame F0 = F; Frame F = launder(F0);
            pg8::Gemm g{H, WSP(bf16, WS_W1 + l * SZ_W1), DM, DM, DM, 0, 0}; pg8::TileOrder S; S.init(M, N1, F.G, F.c, 1);
            Epi1 E{WSP(bf16, WS_P), WSP(float, WS_HF), WSP(float, WS_DT), WSP(bf16, WS_G)};
#ifndef SK_G1
            pg8::gemm_phase<Epi1, pg8::TileOrder>(ring, g, S, E);
#endif
        } SEAM(pb + 1);
        if (IN(pb + 2)) {
#ifndef SK_MIX
 phase_mix(F, l);
#endif
 } SEAM(pb + 2);
        if (IN(pb + 3)) {
#ifndef SK_POST
 phase_post(F, l);
#endif
 } SEAM(pb + 3);
        if (IN(pb + 4)) { const Frame F0 = F; Frame F = launder(F0);
            pg8::Gemm g{WSP(bf16, WS_BR), WSP(bf16, WS_WB + l * SZ_WB), BW, BW, BW, (size_t)M * BW, (size_t)DM * BW}; pg8::TileOrder S; S.init(M, DM, F.G, F.c, 4);
            EpiBr E{WSP(bf16, WS_G), WSP(bf16, WS_MG)};
#ifndef SK_GBR
            pg8::gemm_phase<EpiBr, pg8::TileOrder>(ring, g, S, E);
#endif
        } SEAM(pb + 4);
        if (IN(pb + 5)) { const Frame F0 = F; Frame F = launder(F0);
            pg8::Gemm g{WSP(bf16, WS_MG), WSP(bf16, WS_WO + l * SZ_WO), DM, DM, DM, 0, 0}; pg8::TileOrder S; S.init(M, DM, F.G, F.c, 1);
            EpiRes E{X0, X1};
#ifndef SK_GWO
            pg8::gemm_phase<EpiRes, pg8::TileOrder>(ring, g, S, E);
#endif
        } SEAM(pb + 5);
        if (IN(pb + 6)) {
#ifndef SK_NORM
 phase_norm(F, X1, F.in[I_GFFN] + (size_t)l * DM, H);
#endif
 } SEAM(pb + 6);
        if (IN(pb + 7)) { const Frame F0 = F; Frame F = launder(F0);
            pg8::Gemm g{H, WSP(bf16, WS_WUV + l * SZ_WUV), DM, DM, DM, 0, 0}; pg8::TileOrder S; S.init(M, NUV, F.G, F.c, 1);
            EpiB E{WSP(bf16, WS_P), NUV};
#ifndef SK_GUP
            pg8::gemm_phase<EpiB, pg8::TileOrder>(ring, g, S, E);
#endif
        } SEAM(pb + 7);
        if (IN(pb + 8)) {
#ifndef SK_ACT
 phase_act(F, l);
#endif
 } SEAM(pb + 8);
        if (IN(pb + 9)) { const Frame F0 = F; Frame F = launder(F0);
            pg8::Gemm g{WSP(bf16, WS_G), WSP(bf16, WS_WD + l * SZ_WD), DFF, DFF, DFF, 0, 0}; pg8::TileOrder S; S.init(M, DM, F.G, F.c, 1);
            EpiRes E{X1, X0};
#ifndef SK_GDN
            pg8::gemm_phase<EpiRes, pg8::TileOrder>(ring, g, S, E);
#endif
        } SEAM(pb + 9);
    }
    if (IN(NPHASE - 1)) {
#ifndef SK_FIN
 phase_final(F, WSP(float, WS_X0), F.in[I_GFIN]);
#endif
 }
#undef IN
#undef SEAM
#undef X0
#undef X1
#undef H
#undef ring
}

extern "C" void kernel_launch(void* const* d_in, const int* in_sizes, int n_in, void* d_out, int out_size, void* d_ws, size_t ws_size, hipStream_t stream) {
    static int grid = 0;
    if (grid == 0) {
        if (n_in != N_INPUTS || (size_t)out_size != O_END || ws_size < WS_END) { fprintf(stderr, "kernel_launch: unexpected shapes: n_in %d out %d ws %zu (need %zu)\n", n_in, out_size, ws_size, (size_t)WS_END); grid = -1; return; }
        int dev = 0, cus = 0, per_cu = 0;
        if (hipGetDevice(&dev) != hipSuccess || hipDeviceGetAttribute(&cus, hipDeviceAttributeMultiprocessorCount, dev) != hipSuccess) { grid = -1; return; }
        if (hipFuncSetAttribute((const void*)mk_fwd, hipFuncAttributeMaxDynamicSharedMemorySize, LDS_BYTES) != hipSuccess) { fprintf(stderr, "kernel_launch: hipFuncSetAttribute failed\n"); grid = -1; return; }
        if (hipOccupancyMaxActiveBlocksPerMultiprocessor(&per_cu, (const void*)mk_fwd, NTHR, LDS_BYTES) != hipSuccess || per_cu < 1) { fprintf(stderr, "kernel_launch: occupancy query says %d\n", per_cu); }
        (void)hipGetLastError();
        grid = cus;
    }
    if (grid < 0) return;
    (void)hipMemsetAsync((char*)d_ws + WS_CTL, 0, CTL_BYTES, stream);
    Args a{};
    for (int i = 0; i < N_INPUTS; ++i) a.in[i] = (const float*)d_in[i];
    a.out = (float*)d_out; a.ws = (unsigned char*)d_ws;
#if MK_SPLIT
    for (int p = 0; p < NPHASE; ++p) { a.ph_lo = p; a.ph_hi = p + 1; hipLaunchKernelGGL(mk_fwd, dim3(grid), dim3(NTHR), LDS_BYTES, stream, a); }
#else
    a.ph_lo = 0; a.ph_hi = NPHASE;
    hipLaunchKernelGGL(mk_fwd, dim3(grid), dim3(NTHR), LDS_BYTES, stream, a);
#endif
}
```

```cpp
#include <hip/hip_runtime.h>
#include <cstdio>
#include <cstdint>

#ifndef REP_G
#define REP_G 1
#endif
#ifndef REP_CONV
#define REP_CONV 1
#endif
#ifndef REP_MIX
#define REP_MIX 1
#endif
#ifndef REP_POST
#define REP_POST 1
#endif
#ifndef SKMASK
#define SKMASK 0
#endif
#ifndef MK_SPLIT
#define MK_SPLIT 0
#endif

namespace pg8 {
#define PG8_LAS __attribute__((address_space(3)))
typedef unsigned short bf16_t;
typedef short bf16x8 __attribute__((ext_vector_type(8)));
typedef float f32x4 __attribute__((ext_vector_type(4)));
typedef unsigned u32x4 __attribute__((ext_vector_type(4)));
constexpr int BM = 256, BK = 64, HALF = 128, HTB = HALF * BK * 2, STAGE_BYTES = 8 * HTB, NXCD = 8, WGM = 8;

__host__ __device__ __forceinline__ int lds_byte(int r, int c) { const int st = (r >> 4) * 2 + (c >> 5), rr = r & 15, cc = c & 31, ob = rr * 64 + cc * 2; return st * 1024 + (ob ^ (((ob >> 9) & 1) << 5)); }
__host__ __device__ __forceinline__ void stage_rc(int b, int& R, int& C) { const int st = b / 1024, sb = b % 1024, swz = sb ^ (((sb >> 9) & 1) << 5); R = (st >> 1) * 16 + swz / 64; C = (st & 1) * 32 + (swz % 64) / 2; }
__host__ __device__ __forceinline__ int perm32(int rho) { const int n = rho >> 4, i = rho & 15; return 8 * (i >> 2) + 4 * n + (i & 3); }

struct Unit { int pm, pn, kz; };
struct Gemm { const bf16_t* A; const bf16_t* Bt; int lda, ldb, K; size_t azs, bzs; };

struct TileOrder {
    int nM, nN, nwg, G, c, nkz;
    __device__ void init(int M, int N, int G_, int c_, int nkz_) { nM = M / BM; nN = N / BM; nwg = nM * nN; G = G_; c = c_; nkz = nkz_; }
    __device__ bool next(int i, Unit& u) const {
        const int ti = i / nkz; u.kz = i - ti * nkz;
        const long L = (long)ti * G + c; if (L >= nwg) return false;
        int wgid = (int)L; { const int q = nwg / NXCD, r = nwg % NXCD, xcd = wgid % NXCD, off = wgid / NXCD; wgid = (xcd < r ? xcd * (q + 1) : r * (q + 1) + (xcd - r) * q) + off; }
        const int nig = WGM * nN, gid = wgid / nig, fm = gid * WGM, gsz = (nM - fm) < WGM ? (nM - fm) : WGM;
        u.pm = fm + ((wgid % nig) % gsz); u.pn = (wgid % nig) / gsz; return true;
    }
};

__device__ __forceinline__ unsigned cvt_pk_bf16(float lo, float hi) { unsigned r; asm volatile("v_cvt_pk_bf16_f32 %0, %1, %2" : "=v"(r) : "v"(lo), "v"(hi)); return r; }

template <class Epi, class Sched, bool ALIGN_EPI = true>
__device__ __forceinline__ void gemm_phase(PG8_LAS unsigned char* lds, const Gemm g, const Sched& S, const Epi& E) {
    int tid = threadIdx.x; asm volatile("" : "+v"(tid));
    const int wid = __builtin_amdgcn_readfirstlane(tid >> 6), lane = tid & 63, wr = wid >> 2, wc = wid & 3, fr = lane & 15, fq = lane >> 4;
    const int K = g.K, nt = K / BK;
    unsigned voffA[2], voffB[2];
#pragma unroll
    for (int i = 0; i < 2; ++i) { int R, C; stage_rc(tid * 16 + i * 8192, R, C); const int Rb = Epi::PERM ? ((R & ~31) + perm32(R & 31)) : R;
        voffA[i] = (unsigned)(R * g.lda + C) * 2u; voffB[i] = (unsigned)(Rb * g.ldb + C) * 2u; }
    const size_t kstep = (size_t)(BK * 2);
    const size_t hstepA = (size_t)HALF * g.lda * 2, hstepB = (size_t)HALF * g.ldb * 2;
    const size_t tstepA = 2 * hstepA, tstepB = 2 * hstepB;
    const unsigned ldsw = (unsigned)wid * 1024u;
    const int aoff = lds_byte(wr * 64 + fr, fq * 8), boff = lds_byte(wc * 32 + fr, fq * 8);
#define PG8_SA(b, h) (((b) * 2 + (h)) * HTB)
#define PG8_SB(b, h) ((4 + (b) * 2 + (h)) * HTB)
#define PG8_STAGE(bufoff, gbase, voff) do { _Pragma("unroll") for (int _i = 0; _i < 2; ++_i) \
        __builtin_amdgcn_global_load_lds((const unsigned*)((const char*)(gbase) + (voff)[_i]), (PG8_LAS unsigned*)(lds + (bufoff) + ldsw + _i * 8192), 16, 0, 0); } while (0)
#define PG8_LDA(dst, b, h) do { _Pragma("unroll") for (int m = 0; m < 4; ++m) _Pragma("unroll") for (int k = 0; k < 2; ++k) dst[m][k] = *(const PG8_LAS bf16x8*)(lds + PG8_SA(b, h) + aoff + m * 2048 + k * 1024); } while (0)
#define PG8_LDB(dst, b, h) do { _Pragma("unroll") for (int n = 0; n < 2; ++n) _Pragma("unroll") for (int k = 0; k < 2; ++k) dst[n][k] = *(const PG8_LAS bf16x8*)(lds + PG8_SB(b, h) + boff + n * 2048 + k * 1024); } while (0)
#define PG8_MMA(ai, bj, At, Bt) do { __builtin_amdgcn_s_setprio(1); _Pragma("unroll") for (int m = 0; m < 4; ++m) _Pragma("unroll") for (int n = 0; n < 2; ++n) _Pragma("unroll") for (int k = 0; k < 2; ++k) \
        acc[ai][bj][m][n] = __builtin_amdgcn_mfma_f32_16x16x32_bf16(Bt[n][k], At[m][k], acc[ai][bj][m][n], 0, 0, 0); __builtin_amdgcn_s_setprio(0); } while (0)
#define PG8_WAIT_V(n) asm volatile("s_waitcnt vmcnt(" #n ")" ::: "memory")
#define PG8_WAIT_L(n) asm volatile("s_waitcnt lgkmcnt(" #n ")" ::: "memory")
#define PG8_BAR __builtin_amdgcn_s_barrier()
#define PG8_SCHED __builtin_amdgcn_sched_barrier(0)
    Unit cur, nxt; int ui = 0;
    if (!S.next(0, cur)) return;
    f32x4 acc[2][2][4][2];
#pragma unroll
    for (int a = 0; a < 2; ++a)
#pragma unroll
        for (int b = 0; b < 2; ++b)
#pragma unroll
            for (int m = 0; m < 4; ++m)
#pragma unroll
                for (int n = 0; n < 2; ++n) acc[a][b][m][n] = (f32x4){0.f, 0.f, 0.f, 0.f};
    bf16x8 At[4][2], B0[2][2], B1[2][2];
    const char* cA = (const char*)g.A + (size_t)cur.kz * g.azs * 2 + (size_t)cur.pm * tstepA;
    const char* cB = (const char*)g.Bt + (size_t)cur.kz * g.bzs * 2 + (size_t)cur.pn * tstepB;
    PG8_STAGE(PG8_SB(0, 0), cB, voffB); PG8_STAGE(PG8_SB(0, 1), cB + hstepB, voffB); PG8_STAGE(PG8_SA(0, 0), cA, voffA); PG8_STAGE(PG8_SA(0, 1), cA + hstepA, voffA);
    if (wr == 1) PG8_BAR;
    PG8_WAIT_V(2); PG8_BAR;
    PG8_STAGE(PG8_SB(1, 0), cB + kstep, voffB); PG8_STAGE(PG8_SA(1, 0), cA + kstep, voffA); PG8_STAGE(PG8_SB(1, 1), cB + hstepB + kstep, voffB);
    PG8_WAIT_V(6); PG8_BAR;
    for (;;) {
        const bool has_next = S.next(ui + 1, nxt);
        const char* nA = has_next ? (const char*)g.A + (size_t)nxt.kz * g.azs * 2 + (size_t)nxt.pm * tstepA : cA;
        const char* nB = has_next ? (const char*)g.Bt + (size_t)nxt.kz * g.bzs * 2 + (size_t)nxt.pn * tstepB : cB;
        for (int t = 0; t < nt; t += 2) {
            const bool last = (t == nt - 2);
            const char* a1 = cA + (size_t)(t + 1) * kstep;
            const char* a2 = last ? nA : cA + (size_t)(t + 2) * kstep; const char* b2 = last ? nB : cB + (size_t)(t + 2) * kstep;
            const char* a3 = a2 + kstep; const char* b3 = b2 + kstep;
            PG8_LDB(B0, 0, 0); PG8_LDB(B1, 0, 1); PG8_SCHED; PG8_LDA(At, 0, 0); PG8_STAGE(PG8_SA(1, 1), a1 + hstepA, voffA);
            PG8_WAIT_V(8); PG8_WAIT_L(0); PG8_BAR; PG8_MMA(0, 0, At, B0); PG8_MMA(0, 1, At, B1); PG8_BAR; PG8_SCHED;
            PG8_LDA(At, 0, 1); PG8_STAGE(PG8_SB(0, 0), b2, voffB); PG8_STAGE(PG8_SB(0, 1), b2 + hstepB, voffB); PG8_STAGE(PG8_SA(0, 0), a2, voffA);
            PG8_WAIT_V(8); PG8_WAIT_L(0); PG8_BAR; PG8_MMA(1, 0, At, B0); PG8_MMA(1, 1, At, B1); PG8_BAR; PG8_SCHED;
            PG8_LDB(B0, 1, 0); PG8_LDB(B1, 1, 1); PG8_SCHED; PG8_LDA(At, 1, 0); PG8_STAGE(PG8_SA(0, 1), a2 + hstepA, voffA);
            PG8_WAIT_V(8); PG8_WAIT_L(0); PG8_BAR; PG8_MMA(0, 0, At, B0); PG8_MMA(0, 1, At, B1); PG8_BAR; PG8_SCHED;
            PG8_LDA(At, 1, 1); PG8_STAGE(PG8_SB(1, 0), b3, voffB); PG8_STAGE(PG8_SB(1, 1), b3 + hstepB, voffB); PG8_STAGE(PG8_SA(1, 0), a3, voffA);
            PG8_WAIT_V(8); PG8_WAIT_L(0); PG8_BAR; PG8_MMA(1, 0, At, B0); PG8_MMA(1, 1, At, B1); PG8_BAR; PG8_SCHED;
        }
        if constexpr (ALIGN_EPI) { if (wr == 0) PG8_BAR; }
        E(acc, cur, wr, wc, fr, fq);
        if (!has_next) break;
        if (!E.keep(cur)) {
#pragma unroll
            for (int a = 0; a < 2; ++a)
#pragma unroll
                for (int b = 0; b < 2; ++b)
#pragma unroll
                    for (int m = 0; m < 4; ++m)
#pragma unroll
                        for (int n = 0; n < 2; ++n) acc[a][b][m][n] = (f32x4){0.f, 0.f, 0.f, 0.f};
        }
        cur = nxt; cA = nA; cB = nB; ++ui;
        if constexpr (ALIGN_EPI) { if (wr == 1) PG8_BAR; }
    }
    PG8_WAIT_V(0);
    if constexpr (!ALIGN_EPI) { if (wr == 0) PG8_BAR; }
    PG8_BAR;
#undef PG8_SA
#undef PG8_SB
#undef PG8_STAGE
#undef PG8_LDA
#undef PG8_LDB
#undef PG8_MMA
#undef PG8_WAIT_V
#undef PG8_WAIT_L
#undef PG8_BAR
#undef PG8_SCHED
}
}

constexpr int NWAVES = 8, NTHR = 512;
constexpr int DM = 2048, NBATCH = 4, SEQ = 2048, MP = NBATCH * SEQ, MS = 128, MR = MP + MS, M = 8448;
constexpr int NLAYER = 2;
constexpr int NIN = 12816, NP = 13056, NG = 8192, N1 = NP + NG;
constexpr int DFF = 5632, NUV = 2 * DFF;
constexpr int BW = 1024;
constexpr float EPS = 1e-6f;
constexpr int C_XA = 0, C_YA = 1024, C_HQ = 2048, C_HF = 3072, C_HI = 4096, C_HGG = 5120, C_SZ = 6144, C_SX = 7168, C_SDT = 8704, C_RQ = 8960, C_RK = 9984, C_RV = 11008, C_RG = 12032;
constexpr int SRC_SPLIT = 8720;
constexpr int SSD_CD = 1536;

enum { I_XP = 0, I_XS, I_SLH, I_SLC, I_SHG, I_SSSD, I_SSC, I_SRET, I_SFC, I_GMIX, I_GFFN, I_WIN, I_LCW, I_LCB, I_LWA, I_LBA, I_LWX, I_LBX, I_LLAM, I_HGLB, I_HGNW,
       I_SCW, I_SCB, I_SDTB, I_SALOG, I_SD, I_SNW, I_WBR, I_WGATE, I_WOUT, I_WUP, I_WVAL, I_FCW, I_FCB, I_WDOWN, I_GFIN, N_INPUTS };

constexpr size_t O_YP = 0, O_YS = O_YP + (size_t)MP * DM, O_LH_P = O_YS + (size_t)MS * DM, O_LH_S = O_LH_P + 2 * 4 * 1024, O_LC_P = O_LH_S + 2 * 128 * 1024,
    O_LC_S = O_LC_P + 2 * 4 * 3 * 1024, O_HG_P = O_LC_S + 2 * 128 * 3 * 1024, O_HG_S = O_HG_P + (size_t)2 * 4 * 8 * 16384, O_SSD_P = O_HG_S + (size_t)2 * 128 * 8 * 16384,
    O_SSD_S = O_SSD_P + (size_t)2 * 4 * 16 * 8192, O_SC_P = O_SSD_S + (size_t)2 * 128 * 16 * 8192, O_SC_S = O_SC_P + 2 * 4 * 3 * 1536, O_RET_P = O_SC_S + 2 * 128 * 3 * 1536,
    O_RET_S = O_RET_P + (size_t)2 * 4 * 8 * 16384, O_FC_P = O_RET_S + (size_t)2 * 128 * 8 * 16384, O_FC_S = O_FC_P + 2 * 4 * 2 * 5632, O_END = O_FC_S + (size_t)2 * 128 * 2 * 5632;
static_assert(O_END == 126119936ull, "output size");

constexpr size_t AL(size_t x) { return (x + 4095) & ~(size_t)4095; }
constexpr size_t WS_CTL = 0, CTL_BYTES = 1u << 20;
constexpr size_t SZ_W1 = (size_t)N1 * DM * 2, SZ_WB = (size_t)4 * DM * BW * 2, SZ_WO = (size_t)DM * DM * 2, SZ_WUV = (size_t)NUV * DM * 2, SZ_WD = (size_t)DM * DFF * 2;
constexpr size_t WS_W1 = CTL_BYTES, WS_WB = WS_W1 + 2 * SZ_W1, WS_WO = WS_WB + 2 * SZ_WB, WS_WUV = WS_WO + 2 * SZ_WO, WS_WD = WS_WUV + 2 * SZ_WUV;
constexpr size_t WS_ROPE = WS_WD + 2 * SZ_WD, SZ_ROPE = AL((size_t)2049 * 64 * 8);
constexpr size_t SZ_X = (size_t)M * DM * 4;
constexpr size_t WS_X0 = WS_ROPE + SZ_ROPE, WS_X1 = WS_X0 + SZ_X;
constexpr size_t WS_H = WS_X1 + SZ_X, SZ_H = (size_t)M * DM * 2;
constexpr size_t WS_P = WS_H + SZ_H, SZ_P = (size_t)M * NP * 2;
constexpr size_t WS_G = WS_P + SZ_P, SZ_G = (size_t)M * NG * 2;
constexpr size_t WS_HF = WS_G + SZ_G, SZ_HF = (size_t)M * 1024 * 4;
constexpr size_t WS_DT = WS_HF + SZ_HF, SZ_DT = AL((size_t)M * 16 * 4);
constexpr size_t WS_OB = WS_DT + SZ_DT, SZ_O = (size_t)M * 1024 * 4;
constexpr size_t WS_BR = WS_OB + 3 * SZ_O, SZ_BR = (size_t)4 * M * BW * 2;
constexpr size_t WS_MG = WS_BR + SZ_BR, SZ_MG = (size_t)M * DM * 2;
constexpr size_t WS_XBC = WS_MG + SZ_MG, SZ_XBC = (size_t)M * SSD_CD * 2;
constexpr size_t WS_LB = WS_XBC + SZ_XBC, SZ_LB = AL((size_t)NLAYER * 1024 * 4);
constexpr size_t WS_END = WS_LB + SZ_LB;
static_assert((size_t)M * NUV * 2 <= SZ_P && (size_t)M * DFF * 2 <= SZ_G && 2 * SZ_O <= SZ_X, "overlays");

constexpr int RING_BYTES = 131072, LDSCTL_OFF = RING_BYTES, LDS_BYTES = 147456;

#define GAS __attribute__((address_space(1)))
#define LAS __attribute__((address_space(3)))
typedef unsigned short bf16;
typedef unsigned v4u __attribute__((ext_vector_type(4)));
typedef unsigned v2u __attribute__((ext_vector_type(2)));
typedef float f32x4 __attribute__((ext_vector_type(4)));
typedef float f32x2 __attribute__((ext_vector_type(2)));
typedef short bf16x8 __attribute__((ext_vector_type(8)));
#define LDS_WAIT() asm volatile("s_waitcnt lgkmcnt(0)" ::: "memory")
__device__ __forceinline__ unsigned f2bf(float f) { unsigned u = __builtin_bit_cast(unsigned, f); return (u + 0x7fffu + ((u >> 16) & 1u)) >> 16; }
__device__ __forceinline__ unsigned pk2(float lo, float hi) { return f2bf(lo) | (f2bf(hi) << 16); }
__device__ __forceinline__ float bf2f(unsigned short b) { return __uint_as_float(((unsigned)b) << 16); }
__device__ __forceinline__ float bflo(unsigned w) { return __uint_as_float(w << 16); }
__device__ __forceinline__ float bfhi(unsigned w) { return __uint_as_float(w & 0xffff0000u); }
__device__ __forceinline__ float sigm(float x) { return 1.f / (1.f + __expf(-x)); }
__device__ __forceinline__ float siluf(float x) { return x * sigm(x); }
__device__ __forceinline__ float geluf(float x) { return x * sigm(1.5957691216057308f * (x + 0.044715f * x * x * x)); }
__device__ __forceinline__ float softplusf(float x) { return x > 20.f ? x : log1pf(__expf(x)); }

#define XB_TMO      128
#define XB_XCNT(j)  (256  + 64 * (j))
#define XB_XSUB(j)  (1280 + 64 * (j))
#define XB_XGEN(j)  (2304 + 64 * (j))
#define XB_TOP      3328
#define XB_TOPGEN   3392
#define XCD_BAR_WORDS 3456
#define XB_SPIN_CAP (1u << 19)
__device__ __forceinline__ unsigned xb_ld(unsigned* p)              { return __hip_atomic_load(p, __ATOMIC_RELAXED, __HIP_MEMORY_SCOPE_AGENT); }
__device__ __forceinline__ unsigned xb_add(unsigned* p, unsigned v) { return __hip_atomic_fetch_add(p, v, __ATOMIC_RELAXED, __HIP_MEMORY_SCOPE_AGENT); }
__device__ __forceinline__ unsigned xb_xcc_id() { return (unsigned)__builtin_amdgcn_s_getreg((3 << 11) | 20) & 0xFu; }
#define XB_SPIN(cond, bar) do { unsigned _sp = 0; while (cond) { __builtin_amdgcn_s_sleep(1); \
    if ((++_sp & 255u) == 0u) { if (xb_ld(&(bar)[XB_TMO])) break; if (_sp > XB_SPIN_CAP) { atomicAdd(&(bar)[XB_TMO], 1u); break; } } } } while (0)
struct XcdBarrier { unsigned* bar; unsigned x; volatile LAS unsigned* st; };
__device__ __forceinline__ XcdBarrier xcd_barrier_post(unsigned* bar, volatile LAS unsigned* st) {
    XcdBarrier b; b.bar = bar; b.x = xb_xcc_id(); b.st = st;
    if (threadIdx.x == 0) (void)xb_add(&bar[XB_XCNT(b.x)], 1u);
    return b;
}
__device__ __forceinline__ void xcd_barrier_complete(unsigned* bar, unsigned x, unsigned& nloc, unsigned& nx) {
    const unsigned G = gridDim.x * gridDim.y * gridDim.z;
    unsigned sum, cnt, mine, sp = 0u;
    for (;;) {
        sum = 0u; cnt = 0u; mine = 0u;
#pragma unroll
        for (unsigned j = 0; j < 16; ++j) { const unsigned c = xb_ld(&bar[XB_XCNT(j)]); sum += c; cnt += (c > 0u) ? 1u : 0u; mine = (j == x) ? c : mine; }
        if (sum == G) break;
        __builtin_amdgcn_s_sleep(1);
        if ((++sp & 255u) == 0u) { if (xb_ld(&bar[XB_TMO])) break; if (sp > XB_SPIN_CAP) { atomicAdd(&bar[XB_TMO], 1u); break; } }
    }
    nloc = mine > 0u ? mine : 1u; nx = cnt > 0u ? cnt : 1u;
}
__device__ __forceinline__ void xcd_barrier(const XcdBarrier& b) {
    asm volatile("s_waitcnt vmcnt(0)" ::: "memory");
    __syncthreads();
    if (threadIdx.x == 0) {
        unsigned* bar = b.bar;
        __builtin_amdgcn_s_waitcnt(0);
        unsigned nloc = b.st[0], nx = b.st[1];
        if (nloc == 0u) { xcd_barrier_complete(bar, b.x, nloc, nx); b.st[0] = nloc; b.st[1] = nx; }
        const unsigned old = xb_add(&bar[XB_XSUB(b.x)], 1u);
        const unsigned gen = old / nloc;
        if (old + 1u == (gen + 1u) * nloc) {
            __builtin_amdgcn_fence(__ATOMIC_RELEASE, "agent");
            asm volatile("s_waitcnt vmcnt(0)" ::: "memory");
            const unsigned og = xb_add(&bar[XB_TOP], 1u);
            const unsigned tg = og / nx;
            if (og + 1u == (tg + 1u) * nx) xb_add(&bar[XB_TOPGEN], 1u);
            else XB_SPIN(xb_ld(&bar[XB_TOPGEN]) == tg, bar);
            __builtin_amdgcn_fence(__ATOMIC_ACQUIRE, "agent");
            xb_add(&bar[XB_XGEN(b.x)], 1u);
            asm volatile("s_waitcnt vmcnt(0)" ::: "memory");
        } else {
            XB_SPIN(xb_ld(&bar[XB_XGEN(b.x)]) == gen, bar);
            __builtin_amdgcn_fence(__ATOMIC_ACQUIRE, "agent");
            asm volatile("s_waitcnt vmcnt(0)" ::: "memory");
        }
    }
    __syncthreads();
}

struct Args { const float* in[N_INPUTS]; float* out; unsigned char* ws; int ph_lo, ph_hi; };

struct Frame {
    LAS unsigned char* lds;
    int tid, lane, wave, G, c;
    const float* const* in;
    float* out;
    unsigned char* ws;
};
#define WSP(T, off) ((T*)(F.ws + (off)))
__device__ __forceinline__ Frame launder(const Frame& F0) {
    Frame F = F0;
    asm volatile("" : "+v"(F.tid), "+v"(F.lane));
    asm volatile("" : "+s"(F.wave), "+s"(F.G), "+s"(F.c));
    { int z = 0; asm volatile("" : "+s"(z)); F.in += z; F.out += z; F.ws += z; }
    asm volatile("" : "+s"(F.lds));
    return F;
}

using pg8::f32x4;
using pg8::Unit;
using pg8::cvt_pk_bf16;

struct Epi1 {
    static constexpr bool PERM = true;
    bf16* P; float* HF; float* DT; bf16* Gt; const float* LB;
    __device__ __forceinline__ bool keep(const Unit&) const { return false; }
    template <int ACT> __device__ __forceinline__ void store_act(f32x4 (&acc)[2][2][4][2], bf16* base, int ld, int row0, int colb) const {
#pragma unroll
        for (int ai = 0; ai < 2; ++ai)
#pragma unroll
            for (int m = 0; m < 4; ++m) { bf16* rowp = base + (size_t)(row0 + ai * 128 + m * 16) * ld + colb;
#pragma unroll
                for (int bj = 0; bj < 2; ++bj) { f32x4 v0 = acc[ai][bj][m][0], v1 = acc[ai][bj][m][1];
#pragma unroll
                    for (int j = 0; j < 4; ++j) { if (ACT == 1) { v0[j] = geluf(v0[j]); v1[j] = geluf(v1[j]); } if (ACT == 2) { v0[j] = siluf(v0[j]); v1[j] = siluf(v1[j]); } if (ACT == 3) { v0[j] = sigm(v0[j]); v1[j] = sigm(v1[j]); } }
                    pg8::u32x4 w; w.x = cvt_pk_bf16(v0[0], v0[1]); w.y = cvt_pk_bf16(v0[2], v0[3]); w.z = cvt_pk_bf16(v1[0], v1[1]); w.w = cvt_pk_bf16(v1[2], v1[3]);
                    *(pg8::u32x4*)(rowp + bj * 128) = w; }
                asm volatile("" ::: "memory"); }
    }
    __device__ __forceinline__ void operator()(f32x4 (&acc)[2][2][4][2], const Unit& u, int wr, int wc, int fr, int fq) const {
        const int row0 = u.pm * 256 + wr * 64 + fr, pn = u.pn;
        if (pn >= 51) { store_act<3>(acc, Gt, NG, row0, (pn - 51) * 256 + wc * 32 + 8 * fq); }
        else if (pn >= 12 && pn < 16) {
            const int colb = (pn - 12) * 256 + wc * 32 + 8 * fq;
#pragma unroll
            for (int bj = 0; bj < 2; ++bj) { const f32x4 l0 = *(const f32x4*)(LB + colb + bj * 128), l1 = *(const f32x4*)(LB + colb + bj * 128 + 4);
#pragma unroll
                for (int ai = 0; ai < 2; ++ai)
#pragma unroll
                    for (int m = 0; m < 4; ++m) { const size_t r = (size_t)(row0 + ai * 128 + m * 16);
                        f32x4 v0 = acc[ai][bj][m][0], v1 = acc[ai][bj][m][1], g0, g1, k0, k1;
#pragma unroll
                        for (int j = 0; j < 4; ++j) { { const float e = __expf(-fabsf(v0[j])), r = 1.f / (1.f + e), sm = e * r, sg = v0[j] >= 0.f ? r : sm, sn = v0[j] >= 0.f ? sm : r; g0[j] = __logf(l0[j] + (1.f - l0[j]) * sg); k0[j] = (1.f - l0[j]) * sn; }
                                                      { const float e = __expf(-fabsf(v1[j])), r = 1.f / (1.f + e), sm = e * r, sg = v1[j] >= 0.f ? r : sm, sn = v1[j] >= 0.f ? sm : r; g1[j] = __logf(l1[j] + (1.f - l1[j]) * sg); k1[j] = (1.f - l1[j]) * sn; } }
                        *(f32x4*)(HF + r * 1024 + colb + bj * 128) = g0; *(f32x4*)(HF + r * 1024 + colb + bj * 128 + 4) = g1;
                        pg8::u32x4 w; w.x = cvt_pk_bf16(k0[0], k0[1]); w.y = cvt_pk_bf16(k0[2], k0[3]); w.z = cvt_pk_bf16(k1[0], k1[1]); w.w = cvt_pk_bf16(k1[2], k1[3]);
                        *(pg8::u32x4*)(P + r * NP + C_HF + colb + bj * 128) = w; asm volatile("" ::: "memory"); } }
        } else if (pn == 34) {
            if (wc == 0 && fq < 2) {
#pragma unroll
                for (int ai = 0; ai < 2; ++ai)
#pragma unroll
                    for (int m = 0; m < 4; ++m) { float* rowp = DT + (size_t)(row0 + ai * 128 + m * 16) * 16 + 8 * fq;
                        *(f32x4*)(rowp) = acc[ai][0][m][0]; *(f32x4*)(rowp + 4) = acc[ai][0][m][1]; }
            }
        } else {
            const int colb = pn * 256 + wc * 32 + 8 * fq;
            if (pn >= 4 && pn < 8) store_act<1>(acc, P, NP, row0, colb);
            else if ((pn >= 8 && pn < 12) || (pn >= 20 && pn < 28) || pn >= 47) store_act<2>(acc, P, NP, row0, colb);
            else store_act<0>(acc, P, NP, row0, colb);
        }
    }
};

struct EpiB {
    static constexpr bool PERM = true;
    bf16* O; int ldc;
    __device__ __forceinline__ bool keep(const Unit&) const { return false; }
    __device__ __forceinline__ void operator()(f32x4 (&acc)[2][2][4][2], const Unit& u, int wr, int wc, int fr, int fq) const {
        const int row0 = u.pm * 256 + wr * 64 + fr, colb = u.pn * 256 + wc * 32 + 8 * fq;
#pragma unroll
        for (int ai = 0; ai < 2; ++ai)
#pragma unroll
            for (int m = 0; m < 4; ++m) { bf16* rowp = O + (size_t)(row0 + ai * 128 + m * 16) * ldc + colb;
#pragma unroll
                for (int bj = 0; bj < 2; ++bj) { const f32x4 v0 = acc[ai][bj][m][0], v1 = acc[ai][bj][m][1]; pg8::u32x4 w;
                    w.x = cvt_pk_bf16(v0[0], v0[1]); w.y = cvt_pk_bf16(v0[2], v0[3]); w.z = cvt_pk_bf16(v1[0], v1[1]); w.w = cvt_pk_bf16(v1[2], v1[3]);
                    *(pg8::u32x4*)(rowp + bj * 128) = w; } }
    }
};

struct EpiBr {
    static constexpr bool PERM = true;
    const bf16* Gt; bf16* O;
    __device__ __forceinline__ bool keep(const Unit& u) const { return u.kz < 3; }
    __device__ __forceinline__ void operator()(f32x4 (&acc)[2][2][4][2], const Unit& u, int wr, int wc, int fr, int fq) const {
        const int row0 = u.pm * 256 + wr * 64 + fr, colb = u.pn * 256 + wc * 32 + 8 * fq, kz = u.kz;
#pragma unroll
        for (int ai = 0; ai < 2; ++ai)
#pragma unroll
            for (int m = 0; m < 4; ++m) { const size_t r = (size_t)(row0 + ai * 128 + m * 16);
#pragma unroll
                for (int bj = 0; bj < 2; ++bj) {
                    const pg8::u32x4 ga = *(const pg8::u32x4*)(Gt + r * NG + kz * 2048 + colb + bj * 128);
                    float s[8] = {bflo(ga.x), bfhi(ga.x), bflo(ga.y), bfhi(ga.y), bflo(ga.z), bfhi(ga.z), bflo(ga.w), bfhi(ga.w)};
                    if (kz < 3) {
                        const pg8::u32x4 gb = *(const pg8::u32x4*)(Gt + r * NG + (kz + 1) * 2048 + colb + bj * 128);
                        const float d[8] = {bflo(gb.x), bfhi(gb.x), bflo(gb.y), bfhi(gb.y), bflo(gb.z), bfhi(gb.z), bflo(gb.w), bfhi(gb.w)};
#pragma unroll
                        for (int j = 0; j < 8; ++j) s[j] = s[j] * __builtin_amdgcn_rcpf(fmaxf(d[j], 1e-20f));
                    }
                    f32x4 v0 = acc[ai][bj][m][0], v1 = acc[ai][bj][m][1];
                    v0[0] *= s[0]; v0[1] *= s[1]; v0[2] *= s[2]; v0[3] *= s[3]; v1[0] *= s[4]; v1[1] *= s[5]; v1[2] *= s[6]; v1[3] *= s[7];
                    acc[ai][bj][m][0] = v0; acc[ai][bj][m][1] = v1;
                    if (kz == 3) { pg8::u32x4 w; w.x = cvt_pk_bf16(v0[0], v0[1]); w.y = cvt_pk_bf16(v0[2], v0[3]); w.z = cvt_pk_bf16(v1[0], v1[1]); w.w = cvt_pk_bf16(v1[2], v1[3]);
                        *(pg8::u32x4*)(O + r * DM + colb + bj * 128) = w; }
                }
                asm volatile("" ::: "memory"); }
    }
};

struct EpiRes {
    static constexpr bool PERM = false;
    const float* Xc; float* Xn;
    __device__ __forceinline__ bool keep(const Unit&) const { return false; }
    __device__ __forceinline__ void operator()(f32x4 (&acc)[2][2][4][2], const Unit& u, int wr, int wc, int fr, int fq) const {
        const int row0 = u.pm * 256 + wr * 64 + fr, col0 = u.pn * 256 + wc * 32 + 4 * fq;
#pragma unroll
        for (int ai = 0; ai < 2; ++ai)
#pragma unroll
            for (int m = 0; m < 4; ++m) { const size_t off = (size_t)(row0 + ai * 128 + m * 16) * DM + col0;
#pragma unroll
                for (int bj = 0; bj < 2; ++bj)
#pragma unroll
                    for (int n = 0; n < 2; ++n) { const f32x4 b = *(const f32x4*)(Xc + off + bj * 128 + n * 16); *(f32x4*)(Xn + off + bj * 128 + n * 16) = b + acc[ai][bj][m][n]; }
                asm volatile("" ::: "memory"); }
    }
};

__device__ __forceinline__ void tr_item(const float* W, int K, int N, bf16* WT, int ldt, int mode, int roff, LAS float* scr, int item, int lane) {
    const int nblk = (N + 31) >> 5, kb = item / nblk, nb = item - kb * nblk, k0 = 64 * kb, n0 = 32 * nb;
    const int nn = n0 + (lane & 31); const bool okn = nn < N;
#pragma unroll 8
    for (int i = 0; i < 32; ++i) { const int kk = 2 * i + (lane >> 5); scr[kk * 33 + (lane & 31)] = okn ? W[(size_t)(k0 + kk) * N + nn] : 0.f; }
    LDS_WAIT(); asm volatile("" ::: "memory");
    const int c = lane & 7;
#pragma unroll
    for (int j = 0; j < 4; ++j) { const int n = (lane >> 3) + 8 * j, gn = n0 + n; const LAS float* s = scr + (8 * c) * 33 + n;
        v4u o; o.x = pk2(s[0 * 33], s[1 * 33]); o.y = pk2(s[2 * 33], s[3 * 33]); o.z = pk2(s[4 * 33], s[5 * 33]); o.w = pk2(s[6 * 33], s[7 * 33]);
        if (gn < N) { const int dr = (mode == 1) ? (gn < SRC_SPLIT ? gn : gn + 240) : gn + roff; *(v4u*)(WT + (size_t)dr * ldt + k0 + 8 * c) = o; } }
    LDS_WAIT(); asm volatile("" ::: "memory");
}

__device__ __forceinline__ void phase_prologue(const Frame& F0) {
    Frame F = launder(F0);
    LAS float* scr = (LAS float*)(F.lds + F.wave * 8704);
    const int gw = F.c * NWAVES + F.wave, NGW = F.G * NWAVES;
    constexpr int I_IN = (DM / 64) * ((NIN + 31) / 32), I_GT = (DM / 64) * (NG / 32), I_BR = (BW / 64) * (DM / 32), I_OUT = (DM / 64) * (DM / 32), I_UP = (DM / 64) * (DFF / 32), I_DN = (DFF / 64) * (DM / 32);
    constexpr int I_LAYER = I_IN + I_GT + 4 * I_BR + I_OUT + 2 * I_UP + I_DN;
    for (int it = gw; it < NLAYER * I_LAYER; it += NGW) {
        const int l = it / I_LAYER; int r = it - l * I_LAYER;
        bf16* W1 = WSP(bf16, WS_W1 + l * SZ_W1);
        if (r < I_IN) { tr_item(F.in[I_WIN] + (size_t)l * DM * NIN, DM, NIN, W1, DM, 1, 0, scr, r, F.lane); continue; } r -= I_IN;
        if (r < I_GT) { tr_item(F.in[I_WGATE] + (size_t)l * DM * NG, DM, NG, W1, DM, 0, NP, scr, r, F.lane); continue; } r -= I_GT;
        if (r < 4 * I_BR) { const int k = r / I_BR; tr_item(F.in[I_WBR] + ((size_t)l * 4 + k) * BW * DM, BW, DM, WSP(bf16, WS_WB + l * SZ_WB) + (size_t)k * DM * BW, BW, 0, 0, scr, r - k * I_BR, F.lane); continue; } r -= 4 * I_BR;
        if (r < I_OUT) { tr_item(F.in[I_WOUT] + (size_t)l * DM * DM, DM, DM, WSP(bf16, WS_WO + l * SZ_WO), DM, 0, 0, scr, r, F.lane); continue; } r -= I_OUT;
        if (r < I_UP) { tr_item(F.in[I_WUP] + (size_t)l * DM * DFF, DM, DFF, WSP(bf16, WS_WUV + l * SZ_WUV), DM, 0, 0, scr, r, F.lane); continue; } r -= I_UP;
        if (r < I_UP) { tr_item(F.in[I_WVAL] + (size_t)l * DM * DFF, DM, DFF, WSP(bf16, WS_WUV + l * SZ_WUV), DM, 0, DFF, scr, r, F.lane); continue; } r -= I_UP;
        tr_item(F.in[I_WDOWN] + (size_t)l * DFF * DM, DFF, DM, WSP(bf16, WS_WD + l * SZ_WD), DFF, 0, 0, scr, r, F.lane);
    }
    const int gt = F.c * NTHR + F.tid, NGT = F.G * NTHR;
    for (int i = gt; i < NLAYER * 240 * (DM / 8); i += NGT) { const int l = i / (240 * (DM / 8)), r = i - l * (240 * (DM / 8));
        *(v4u*)(WSP(bf16, WS_W1 + l * SZ_W1) + (size_t)(SRC_SPLIT + r / (DM / 8)) * DM + (r % (DM / 8)) * 8) = (v4u){0u, 0u, 0u, 0u}; }
    for (int i = gt; i < NLAYER * 1024; i += NGT) { const int l = i >> 10, c = i & 1023; WSP(float, WS_LB)[i] = l == 0 ? 0.f : sigm(F.in[I_HGLB][1024 + c] - F.in[I_HGLB][c]); }
    for (int i = gt; i < 2049 * 64; i += NGT) { const int p = i >> 6, j = i & 63; const float pos = p < 2048 ? (float)p : 16384.f;
        const float fr = powf(10000.f, -(float)j / 64.f); const float ang = pos * fr; WSP(f32x2, WS_ROPE)[i] = (f32x2){cosf(ang), sinf(ang)}; }
    for (int i = gt; i < M * (DM / 4); i += NGT) { const int row = i / (DM / 4), c4 = i - row * (DM / 4);
        f32x4 v = (f32x4){0.f, 0.f, 0.f, 0.f};
        if (row < MP) v = ((const f32x4*)F.in[I_XP])[(size_t)row * (DM / 4) + c4]; else if (row < MR) v = ((const f32x4*)F.in[I_XS])[(size_t)(row - MP) * (DM / 4) + c4];
        WSP(f32x4, WS_X0)[i] = v; }
}

__device__ __forceinline__ float wave_sum(float v) {
#pragma unroll
    for (int o = 1; o < 64; o <<= 1) v += __shfl_xor(v, o);
    return v;
}
__device__ __forceinline__ void phase_norm(const Frame& F0, const float* X, const float* g, bf16* H) {
    Frame F = launder(F0);
    const int gw = F.c * NWAVES + F.wave, NGW = F.G * NWAVES;
    for (int row = gw; row < M; row += NGW) {
        v2u* o8 = (v2u*)(H + (size_t)row * DM) + F.lane;
        if (row >= MR) {
#pragma unroll
            for (int j = 0; j < 8; ++j) o8[64 * j] = (v2u){0u, 0u};
            continue; }
        const f32x4* xr = (const f32x4*)(X + (size_t)row * DM) + F.lane;
        f32x4 v[8]; float s = 0.f;
#pragma unroll
        for (int j = 0; j < 8; ++j) { v[j] = xr[64 * j]; s += (v[j].x * v[j].x + v[j].y * v[j].y) + (v[j].z * v[j].z + v[j].w * v[j].w); }
        const float rstd = rsqrtf(wave_sum(s) * (1.f / DM) + EPS);
#pragma unroll
        for (int j = 0; j < 8; ++j) { const f32x4 gv = ((const f32x4*)g)[F.lane + 64 * j];
            o8[64 * j] = (v2u){pk2(v[j].x * rstd * gv.x, v[j].y * rstd * gv.y), pk2(v[j].z * rstd * gv.z, v[j].w * rstd * gv.w)}; }
    }
}
__device__ __forceinline__ void phase_final(const Frame& F0, const float* X, const float* g) {
    Frame F = launder(F0);
    const int gw = F.c * NWAVES + F.wave, NGW = F.G * NWAVES;
    for (int row = gw; row < MR; row += NGW) {
        const f32x4* xr = (const f32x4*)(X + (size_t)row * DM) + F.lane;
        f32x4* o = (f32x4*)(F.out + (row < MP ? O_YP + (size_t)row * DM : O_YS + (size_t)(row - MP) * DM)) + F.lane;
        f32x4 v[8]; float s = 0.f;
#pragma unroll
        for (int j = 0; j < 8; ++j) { v[j] = xr[64 * j]; s += (v[j].x * v[j].x + v[j].y * v[j].y) + (v[j].z * v[j].z + v[j].w * v[j].w); }
        const float rstd = rsqrtf(wave_sum(s) * (1.f / DM) + EPS);
#pragma unroll
        for (int j = 0; j < 8; ++j) { const f32x4 gv = ((const f32x4*)g)[F.lane + 64 * j]; o[64 * j] = v[j] * rstd * gv; }
    }
}

constexpr int LW_STR = 136;
constexpr int L_WT = 0, L_XC = 256 * LW_STR * 2, L_XCF = L_XC + 64 * LW_STR * 2, LXF_STR = 132;
static_assert(L_XCF + 64 * LXF_STR * 4 <= RING_BYTES, "lru lds");
__device__ __forceinline__ void lru_stage_w(const Frame& F0, int l, int n) {
    Frame F = launder(F0);
    LAS bf16* WT = (LAS bf16*)(F.lds + L_WT);
    const float* wa = F.in[I_LWA] + ((size_t)l * 8 + n) * 16384; const float* wx = F.in[I_LWX] + ((size_t)l * 8 + n) * 16384;
    for (int i = F.tid; i < 16384; i += NTHR) { const int c = i >> 7, d = i & 127;
        WT[d * LW_STR + c] = (bf16)f2bf(wa[i]); WT[(128 + d) * LW_STR + c] = (bf16)f2bf(wx[i]); }
}
__device__ __forceinline__ void lru_tile(const Frame& F0, int l, int n, int tt) {
    Frame F = launder(F0);
    LAS bf16* WT = (LAS bf16*)(F.lds + L_WT); LAS bf16* XC = (LAS bf16*)(F.lds + L_XC); LAS float* XCF = (LAS float*)(F.lds + L_XCF);
    const bf16* P = WSP(bf16, WS_P);
    const float* cw = F.in[I_LCW] + (size_t)l * 4 * 1024; const float* cb = F.in[I_LCB] + (size_t)l * 1024;
    {
        const int tk = F.tid >> 3, c0 = (F.tid & 7) * 16, row = tt * 64 + tk, ch0 = n * 128 + c0;
        float acc[16];
#pragma unroll
        for (int j = 0; j < 16; ++j) acc[j] = cb[ch0 + j];
        if (row < MP) {
            const int t = row & (SEQ - 1);
#pragma unroll
            for (int jj = 0; jj < 4; ++jj) { if (t - 3 + jj >= 0) { const v4u* src = (const v4u*)(P + (size_t)(row - 3 + jj) * NP + C_XA + ch0); const v4u a = src[0], b = src[1];
                const unsigned w[8] = {a.x, a.y, a.z, a.w, b.x, b.y, b.z, b.w}; const float* wj = cw + jj * 1024 + ch0;
#pragma unroll
                for (int q = 0; q < 8; ++q) { acc[2 * q] += wj[2 * q] * bflo(w[q]); acc[2 * q + 1] += wj[2 * q + 1] * bfhi(w[q]); } } }
        } else if (row < MR) {
            const int s = row - MP; const float* st = F.in[I_SLC] + ((size_t)l * 128 + s) * 3 * 1024 + ch0;
#pragma unroll
            for (int jj = 0; jj < 3; ++jj) { const float* wj = cw + jj * 1024 + ch0;
#pragma unroll
                for (int q = 0; q < 16; ++q) acc[q] += wj[q] * st[jj * 1024 + q]; }
            const v4u* src = (const v4u*)(P + (size_t)row * NP + C_XA + ch0); const v4u a = src[0], b = src[1];
            const unsigned w[8] = {a.x, a.y, a.z, a.w, b.x, b.y, b.z, b.w}; const float* wj = cw + 3 * 1024 + ch0;
#pragma unroll
            for (int q = 0; q < 8; ++q) { acc[2 * q] += wj[2 * q] * bflo(w[q]); acc[2 * q + 1] += wj[2 * q + 1] * bfhi(w[q]); }
        }
#pragma unroll
        for (int q = 0; q < 16; ++q) { XCF[tk * LXF_STR + c0 + q] = acc[q]; }
#pragma unroll
        for (int q = 0; q < 8; ++q) *(LAS unsigned*)(XC + tk * LW_STR + c0 + 2 * q) = pk2(acc[2 * q], acc[2 * q + 1]);
    }
    __syncthreads();
    const int w = F.wave, lane = F.lane, fr = lane & 15, g = lane >> 4;
    f32x4 ar[4], ai_[4];
#pragma unroll
    for (int rt = 0; rt < 4; ++rt) { ar[rt] = (f32x4){0.f, 0.f, 0.f, 0.f}; ai_[rt] = (f32x4){0.f, 0.f, 0.f, 0.f}; }
#pragma unroll
    for (int ks = 0; ks < 4; ++ks) {
        const bf16x8 br = *(const LAS bf16x8*)(WT + (16 * w + fr) * LW_STR + 32 * ks + 8 * g);
        const bf16x8 bi = *(const LAS bf16x8*)(WT + (128 + 16 * w + fr) * LW_STR + 32 * ks + 8 * g);
#pragma unroll
        for (int rt = 0; rt < 4; ++rt) { const bf16x8 a = *(const LAS bf16x8*)(XC + (16 * rt + fr) * LW_STR + 32 * ks + 8 * g);
            ar[rt] = __builtin_amdgcn_mfma_f32_16x16x32_bf16(a, br, ar[rt], 0, 0, 0); ai_[rt] = __builtin_amdgcn_mfma_f32_16x16x32_bf16(a, bi, ai_[rt], 0, 0, 0); }
    }
    const int d = 16 * w + fr, ch = n * 128 + d;
    const float ba = F.in[I_LBA][(size_t)l * 1024 + ch], bx = F.in[I_LBX][(size_t)l * 1024 + ch], sp = softplusf(-F.in[I_LLAM][(size_t)l * 1024 + ch]);
    float* LA = WSP(float, WS_X1); float* LU = LA + (size_t)M * 1024;
    const bool scan = (tt < 128);
    float CA = 1.f, CU = 0.f;
#pragma unroll
    for (int rt = 0; rt < 4; ++rt) {
        float A[4], U[4];
#pragma unroll
        for (int reg = 0; reg < 4; ++reg) { const int tk = 16 * rt + 4 * g + reg;
            const float r = sigm(ar[rt][reg] + ba), iv = sigm(ai_[rt][reg] + bx), la = -8.f * r * sp, a = __expf(la), xc = XCF[tk * LXF_STR + d];
            A[reg] = a; U[reg] = sqrtf(fmaxf(-expm1f(2.f * la), 0.f)) * (iv * xc); }
        if (scan) {
#pragma unroll
            for (int reg = 1; reg < 4; ++reg) { U[reg] = A[reg] * U[reg - 1] + U[reg]; A[reg] = A[reg] * A[reg - 1]; }
            float PA = 1.f, PU = 0.f, TA = 1.f, TU = 0.f;
#pragma unroll
            for (int src = 0; src < 4; ++src) { const float sa = __shfl(A[3], fr + 16 * src), su = __shfl(U[3], fr + 16 * src);
                if (src < g) { PU = sa * PU + su; PA = sa * PA; }
                TU = sa * TU + su; TA = sa * TA; }
            const float GA = PA * CA, GU = PA * CU + PU;
#pragma unroll
            for (int reg = 0; reg < 4; ++reg) { U[reg] = A[reg] * GU + U[reg]; A[reg] = A[reg] * GA; }
            CU = TA * CU + TU; CA = TA * CA;
        }
#pragma unroll
        for (int reg = 0; reg < 4; ++reg) { const size_t row = (size_t)tt * 64 + 16 * rt + 4 * g + reg; LA[row * 1024 + ch] = A[reg]; LU[row * 1024 + ch] = U[reg]; }
    }
    __syncthreads();
}
__device__ __forceinline__ void phase_conv(const Frame& F00, int l) {
    Frame F0 = launder(F00);
    { const int n = F0.c & 7; bool staged = false;
      for (int tt = F0.c >> 3; tt < 130; tt += (F0.G >> 3)) { if (!staged) { lru_stage_w(F0, l, n); __syncthreads(); staged = true; } lru_tile(F0, l, n, tt); } }
    Frame F = launder(F0);
    const bf16* P = WSP(bf16, WS_P);
    const int gt = F.c * NTHR + F.tid, NGT = F.G * NTHR;
    { const float* cw = F.in[I_SCW] + (size_t)l * 4 * SSD_CD; const float* cb = F.in[I_SCB] + (size_t)l * SSD_CD; bf16* XBC = WSP(bf16, WS_XBC);
      for (int i = gt; i < MR * (SSD_CD / 8); i += NGT) { const int row = i / (SSD_CD / 8), c = (i - row * (SSD_CD / 8)) * 8;
          float acc[8];
#pragma unroll
          for (int q = 0; q < 8; ++q) acc[q] = cb[c + q];
          if (row < MP) { const int t = row & (SEQ - 1);
#pragma unroll
              for (int jj = 0; jj < 4; ++jj) if (t - 3 + jj >= 0) { const v4u a = *(const v4u*)(P + (size_t)(row - 3 + jj) * NP + C_SX + c); const unsigned w[4] = {a.x, a.y, a.z, a.w}; const float* wj = cw + jj * SSD_CD + c;
#pragma unroll
                  for (int q = 0; q < 4; ++q) { acc[2 * q] += wj[2 * q] * bflo(w[q]); acc[2 * q + 1] += wj[2 * q + 1] * bfhi(w[q]); } }
          } else { const int s = row - MP; const float* st = F.in[I_SSC] + ((size_t)l * 128 + s) * 3 * SSD_CD + c;
#pragma unroll
              for (int jj = 0; jj < 3; ++jj) { const float* wj = cw + jj * SSD_CD + c;
#pragma unroll
                  for (int q = 0; q < 8; ++q) acc[q] += wj[q] * st[jj * SSD_CD + q]; }
              const v4u a = *(const v4u*)(P + (size_t)row * NP + C_SX + c); const unsigned w[4] = {a.x, a.y, a.z, a.w}; const float* wj = cw + 3 * SSD_CD + c;
#pragma unroll
              for (int q = 0; q < 4; ++q) { acc[2 * q] += wj[2 * q] * bflo(w[q]); acc[2 * q + 1] += wj[2 * q + 1] * bfhi(w[q]); } }
          v4u o; o.x = pk2(siluf(acc[0]), siluf(acc[1])); o.y = pk2(siluf(acc[2]), siluf(acc[3])); o.z = pk2(siluf(acc[4]), siluf(acc[5])); o.w = pk2(siluf(acc[6]), siluf(acc[7]));
          *(v4u*)(XBC + (size_t)row * SSD_CD + c) = o; } }
    { float* DT = WSP(float, WS_DT); for (int i = gt; i < MR * 16; i += NGT) DT[i] = softplusf(DT[i] + F.in[I_SDTB][l * 16 + (i & 15)]); }
    for (int i = gt; i < NBATCH * 3 * 1024; i += NGT) { const int b = i / 3072, r = i - b * 3072, j = r >> 10, c = r & 1023;
        F.out[O_LC_P + (size_t)l * NBATCH * 3072 + i] = bf2f(P[((size_t)b * SEQ + SEQ - 3 + j) * NP + C_XA + c]); }
    for (int i = gt; i < MS * 3 * 1024; i += NGT) { const int s = i / 3072, r = i - s * 3072, j = r >> 10, c = r & 1023;
        F.out[O_LC_S + (size_t)l * MS * 3072 + i] = j < 2 ? F.in[I_SLC][(size_t)l * MS * 3072 + (size_t)s * 3072 + (j + 1) * 1024 + c] : bf2f(P[((size_t)MP + s) * NP + C_XA + c]); }
    for (int i = gt; i < NBATCH * 3 * SSD_CD; i += NGT) { const int b = i / (3 * SSD_CD), r = i - b * 3 * SSD_CD, j = r / SSD_CD, c = r - j * SSD_CD;
        F.out[O_SC_P + (size_t)l * NBATCH * 3 * SSD_CD + i] = bf2f(P[((size_t)b * SEQ + SEQ - 3 + j) * NP + C_SX + c]); }
    for (int i = gt; i < MS * 3 * SSD_CD; i += NGT) { const int s = i / (3 * SSD_CD), r = i - s * 3 * SSD_CD, j = r / SSD_CD, c = r - j * SSD_CD;
        F.out[O_SC_S + (size_t)l * MS * 3 * SSD_CD + i] = j < 2 ? F.in[I_SSC][(size_t)l * MS * 3 * SSD_CD + (size_t)s * 3 * SSD_CD + (j + 1) * SSD_CD + c] : bf2f(P[((size_t)MP + s) * NP + C_SX + c]); }
}

constexpr int TB = 16;
constexpr int R_DEC = 0, R_KK = TB * 128 * 4, R_Q = 2 * TB * 128 * 4, R_VV = 3 * TB * 128 * 4, R_XS = R_VV + TB * 64 * 4, R_DSC = R_XS + TB * 64 * 4;
template <int MODE>
__device__ __forceinline__ void rec_unit(const Frame& F0, int l, int unit) {
    Frame F = launder(F0);
    constexpr int V = (MODE == 2) ? 64 : 128, NH = (MODE == 2) ? 16 : 8;
    int b, h, vbase;
    if (MODE == 2) { b = unit >> 4; h = unit & 15; vbase = 0; } else { b = unit >> 4; h = (unit >> 1) & 7; vbase = (unit & 1) * 64; }
    LAS float* DEC = (LAS float*)(F.lds + R_DEC); LAS float* KK = (LAS float*)(F.lds + R_KK); LAS float* Q = (LAS float*)(F.lds + R_Q);
    LAS float* VV = (LAS float*)(F.lds + R_VV); LAS float* XS = (LAS float*)(F.lds + R_XS); LAS float* DSC = (LAS float*)(F.lds + R_DSC);
    const bf16* P = WSP(bf16, WS_P); const bf16* XBC = WSP(bf16, WS_XBC);
    const int lane = F.lane, kq = lane & 15, vg = lane >> 4, vl = 8 * F.wave + 2 * vg;
    float S[8][2];
#pragma unroll
    for (int i = 0; i < 8; ++i) { S[i][0] = 0.f; S[i][1] = 0.f; }
    float* OUT = (MODE == 0) ? WSP(float, WS_OB) : (MODE == 1 ? WSP(float, WS_OB + 2 * SZ_O) : WSP(float, WS_OB + SZ_O));
    const float ret_gamma = 1.f - exp2f(-5.f - (float)h);
    float ssd_A = 0.f, ssd_D = 0.f;
    if (MODE == 2) { ssd_A = -__expf(F.in[I_SALOG][l * 16 + h]); ssd_D = F.in[I_SD][l * 16 + h]; }
    for (int blk = 0; blk < SEQ / TB; ++blk) {
        const int t0 = blk * TB, row0 = b * SEQ + t0;
        if (MODE == 0) {
#pragma unroll
            for (int r = 0; r < 4; ++r) { const int i = F.tid + NTHR * r, tok = i >> 7, k = i & 127; const size_t row = row0 + tok;
                DEC[tok * 128 + k] = __expf(WSP(float, WS_HF)[row * 1024 + h * 128 + k]); KK[tok * 128 + k] = bf2f(P[row * NP + C_HF + h * 128 + k]); Q[tok * 128 + k] = bf2f(P[row * NP + C_HQ + h * 128 + k]); }
#pragma unroll
            for (int r = 0; r < 2; ++r) { const int i = F.tid + NTHR * r, tok = i >> 6, vv = i & 63; VV[tok * 64 + vv] = bf2f(P[(size_t)(row0 + tok) * NP + C_HI + h * 128 + vbase + vv]); }
        } else if (MODE == 1) {
#pragma unroll
            for (int r = 0; r < 2; ++r) { const int i = F.tid + NTHR * r, tok = i >> 6, j = i & 63; const size_t row = row0 + tok;
                const float q1 = bf2f(P[row * NP + C_RQ + h * 128 + j]), q2 = bf2f(P[row * NP + C_RQ + h * 128 + 64 + j]);
                const float k1 = bf2f(P[row * NP + C_RK + h * 128 + j]), k2 = bf2f(P[row * NP + C_RK + h * 128 + 64 + j]);
                const f32x2 cs = WSP(f32x2, WS_ROPE)[(t0 + tok) * 64 + j];
                Q[tok * 128 + j] = q1 * cs.x - q2 * cs.y; Q[tok * 128 + 64 + j] = q1 * cs.y + q2 * cs.x;
                KK[tok * 128 + j] = (k1 * cs.x - k2 * cs.y) * 0.08838834764831845f; KK[tok * 128 + 64 + j] = (k1 * cs.y + k2 * cs.x) * 0.08838834764831845f;
                VV[tok * 64 + j] = bf2f(P[row * NP + C_RV + h * 128 + vbase + j]); }
        } else {
            const int grp = h >> 3;
#pragma unroll 2
            for (int r = 0; r < 10; ++r) { const int i = F.tid + NTHR * r, tok = i / 320, ch = i - tok * 320; const size_t row = row0 + tok;
                const int cidx = ch < 64 ? h * 64 + ch : (ch < 192 ? 1024 + grp * 128 + (ch - 64) : 1280 + grp * 128 + (ch - 192));
                const float val = bf2f(XBC[row * SSD_CD + cidx]);
                if (ch < 64) { const float dtv = WSP(float, WS_DT)[row * 16 + h]; XS[tok * 64 + ch] = val; VV[tok * 64 + ch] = val * dtv; if (ch == 0) DSC[tok] = __expf(dtv * ssd_A); }
                else if (ch < 192) KK[tok * 128 + ch - 64] = val; else Q[tok * 128 + ch - 192] = val; }
        }
        __syncthreads();
#pragma unroll 2
        for (int tt = 0; tt < TB; ++tt) {
            float dec[8], kk[8], q[8];
            { const f32x4 a = *(const LAS f32x4*)(KK + tt * 128 + 8 * kq), c = *(const LAS f32x4*)(KK + tt * 128 + 8 * kq + 4); kk[0] = a.x; kk[1] = a.y; kk[2] = a.z; kk[3] = a.w; kk[4] = c.x; kk[5] = c.y; kk[6] = c.z; kk[7] = c.w; }
            { const f32x4 a = *(const LAS f32x4*)(Q + tt * 128 + 8 * kq), c = *(const LAS f32x4*)(Q + tt * 128 + 8 * kq + 4); q[0] = a.x; q[1] = a.y; q[2] = a.z; q[3] = a.w; q[4] = c.x; q[5] = c.y; q[6] = c.z; q[7] = c.w; }
            if (MODE == 0) { const f32x4 a = *(const LAS f32x4*)(DEC + tt * 128 + 8 * kq), c = *(const LAS f32x4*)(DEC + tt * 128 + 8 * kq + 4); dec[0] = a.x; dec[1] = a.y; dec[2] = a.z; dec[3] = a.w; dec[4] = c.x; dec[5] = c.y; dec[6] = c.z; dec[7] = c.w; }
            else { const float dsc = (MODE == 1) ? ret_gamma : DSC[tt];
#pragma unroll
                for (int i = 0; i < 8; ++i) dec[i] = dsc; }
            const f32x2 vv = *(const LAS f32x2*)(VV + tt * 64 + vl);
            float o0 = 0.f, o1 = 0.f;
#pragma unroll
            for (int i = 0; i < 8; ++i) { S[i][0] = dec[i] * S[i][0] + kk[i] * vv.x; S[i][1] = dec[i] * S[i][1] + kk[i] * vv.y; o0 += q[i] * S[i][0]; o1 += q[i] * S[i][1]; }
#pragma unroll
            for (int o = 1; o < 16; o <<= 1) { o0 += __shfl_xor(o0, o); o1 += __shfl_xor(o1, o); }
            if (kq == 0) { if (MODE == 2) { const f32x2 xs = *(const LAS f32x2*)(XS + tt * 64 + vl); o0 += ssd_D * xs.x; o1 += ssd_D * xs.y; }
                *(f32x2*)(OUT + (size_t)(row0 + tt) * 1024 + h * V + vbase + vl) = (f32x2){o0, o1}; }
        }
        __syncthreads();
    }
    float* so = F.out + (MODE == 0 ? O_HG_P : (MODE == 1 ? O_RET_P : O_SSD_P)) + (((size_t)l * NBATCH + b) * NH + h) * (128 * V);
#pragma unroll
    for (int i = 0; i < 8; ++i) *(f32x2*)(so + (size_t)(8 * kq + i) * V + vbase + vl) = (f32x2){S[i][0], S[i][1]};
}

template <int MODE>
__device__ __forceinline__ void samp_unit(const Frame& F0, int l, int pair) {
    Frame F = launder(F0);
    constexpr int V = (MODE == 2) ? 64 : 128, NH = (MODE == 2) ? 16 : 8, NKR = (MODE == 2) ? 32 : 16, NJ = 128 / NKR;
    const int s = pair / NH, h = pair - s * NH; const size_t row = MP + s;
    LAS float* DEC = (LAS float*)(F.lds + R_DEC); LAS float* KK = (LAS float*)(F.lds + R_KK); LAS float* Q = (LAS float*)(F.lds + R_Q);
    LAS float* VV = (LAS float*)(F.lds + R_VV); LAS float* XS = (LAS float*)(F.lds + R_XS); LAS float* DSC = (LAS float*)(F.lds + R_DSC);
    LAS float* RED = (LAS float*)(F.lds + 65536);
    const bf16* P = WSP(bf16, WS_P); const bf16* XBC = WSP(bf16, WS_XBC);
    const int tid = F.tid;
    if (MODE == 0) {
        if (tid < 128) { const int k = tid; DEC[k] = __expf(WSP(float, WS_HF)[row * 1024 + h * 128 + k]); KK[k] = bf2f(P[row * NP + C_HF + h * 128 + k]); Q[k] = bf2f(P[row * NP + C_HQ + h * 128 + k]);
            VV[k] = bf2f(P[row * NP + C_HI + h * 128 + k]); }
    } else if (MODE == 1) {
        if (tid < 64) { const int j = tid;
            const float q1 = bf2f(P[row * NP + C_RQ + h * 128 + j]), q2 = bf2f(P[row * NP + C_RQ + h * 128 + 64 + j]);
            const float k1 = bf2f(P[row * NP + C_RK + h * 128 + j]), k2 = bf2f(P[row * NP + C_RK + h * 128 + 64 + j]);
            const f32x2 cs = WSP(f32x2, WS_ROPE)[2048 * 64 + j];
            Q[j] = q1 * cs.x - q2 * cs.y; Q[64 + j] = q1 * cs.y + q2 * cs.x;
            KK[j] = (k1 * cs.x - k2 * cs.y) * 0.08838834764831845f; KK[64 + j] = (k1 * cs.y + k2 * cs.x) * 0.08838834764831845f; }
        else if (tid < 192) { const int v = tid - 64; VV[v] = bf2f(P[row * NP + C_RV + h * 128 + v]); DEC[v] = 1.f - exp2f(-5.f - (float)h); }
    } else {
        if (tid < 320) { const int ch = tid, grp = h >> 3;
            const int cidx = ch < 64 ? h * 64 + ch : (ch < 192 ? 1024 + grp * 128 + (ch - 64) : 1280 + grp * 128 + (ch - 192));
            const float val = bf2f(XBC[row * SSD_CD + cidx]);
            if (ch < 64) { const float dtv = WSP(float, WS_DT)[row * 16 + h]; XS[ch] = val; VV[ch] = val * dtv;
                if (ch == 0) DSC[0] = __expf(dtv * (-__expf(F.in[I_SALOG][l * 16 + h]))); }
            else if (ch < 192) KK[ch - 64] = val; else Q[ch - 192] = val; }
    }
    __syncthreads();
    const int v4 = (MODE == 2) ? (tid & 15) : (tid & 31), kr = (MODE == 2) ? (tid >> 4) : (tid >> 5);
    const float* sin_ = F.in[MODE == 0 ? I_SHG : (MODE == 1 ? I_SRET : I_SSSD)] + (((size_t)l * 128 + s) * NH + h) * (128 * V);
    float* sout = F.out + (MODE == 0 ? O_HG_S : (MODE == 1 ? O_RET_S : O_SSD_S)) + (((size_t)l * 128 + s) * NH + h) * (128 * V);
    const f32x4 vv = *(const LAS f32x4*)(VV + 4 * v4);
    f32x4 sv[NJ];
#pragma unroll
    for (int j = 0; j < NJ; ++j) sv[j] = *(const f32x4*)(sin_ + (size_t)(kr + NKR * j) * V + 4 * v4);
    f32x4 po = (f32x4){0.f, 0.f, 0.f, 0.f};
#pragma unroll
    for (int j = 0; j < NJ; ++j) { const int k = kr + NKR * j; const float dec = (MODE == 2) ? DSC[0] : DEC[k]; const float kk = KK[k], q = Q[k];
        const f32x4 sn = sv[j] * dec + vv * kk; *(f32x4*)(sout + (size_t)k * V + 4 * v4) = sn; po += sn * q; }
    *(LAS f32x4*)(RED + kr * V + 4 * v4) = po;
    __syncthreads();
    if (tid < V) { float o = 0.f;
#pragma unroll
        for (int r = 0; r < NKR; ++r) o += RED[r * V + tid];
        if (MODE == 2) o += F.in[I_SD][l * 16 + h] * XS[tid];
        float* OUT = (MODE == 0) ? WSP(float, WS_OB) : (MODE == 1 ? WSP(float, WS_OB + 2 * SZ_O) : WSP(float, WS_OB + SZ_O));
        OUT[row * 1024 + h * V + tid] = o; }
    __syncthreads();
}

__device__ __forceinline__ void phase_mix(const Frame& F0, int l) {
    Frame F = launder(F0);
    { const int w = F.c;
        if (w < 64) rec_unit<0>(F, l, w);
        else if (w < 128) rec_unit<1>(F, l, w - 64);
        else if (w < 192) rec_unit<2>(F, l, w - 128);
        else {
            const int ww = w - 192;
            for (int p = ww; p < 1024; p += 64) samp_unit<0>(F, l, p);
            for (int p = ww; p < 1024; p += 64) samp_unit<1>(F, l, p);
            for (int p = ww; p < 2048; p += 64) samp_unit<2>(F, l, p);
        }
    }
}

__device__ __forceinline__ void phase_post(const Frame& F0, int l) {
    Frame F = launder(F0);
    const bf16* P = WSP(bf16, WS_P);
    const float* LA = WSP(float, WS_X1); const float* LU = LA + (size_t)M * 1024;
    bf16* BR = WSP(bf16, WS_BR);
    const int gt = F.c * NTHR + F.tid, NGT = F.G * NTHR, gw = F.c * NWAVES + F.wave, NGW = F.G * NWAVES, lane = F.lane;
    for (int task = gw; task < NBATCH * 16 * 4; task += NGW) {
        const int b = task >> 6, cg = (task >> 2) & 15, tq = task & 3, ch = cg * 64 + lane;
        float h = 0.f;
        for (int j = 0; j < 8 * tq; ++j) { const size_t row = (size_t)b * SEQ + 64 * j + 63; h = LA[row * 1024 + ch] * h + LU[row * 1024 + ch]; }
        for (int j = 8 * tq; j < 8 * tq + 8; ++j) {
            float hv = 0.f;
            for (int t0 = 0; t0 < 64; t0 += 8) {
                float a[8], u[8], y[8];
#pragma unroll
                for (int q = 0; q < 8; ++q) { const size_t row = (size_t)b * SEQ + 64 * j + t0 + q; a[q] = LA[row * 1024 + ch]; u[q] = LU[row * 1024 + ch]; y[q] = bf2f(P[row * NP + C_YA + ch]); }
#pragma unroll
                for (int q = 0; q < 8; ++q) { const size_t row = (size_t)b * SEQ + 64 * j + t0 + q; hv = a[q] * h + u[q]; BR[row * BW + ch] = (bf16)f2bf(hv * y[q]); }
            }
            h = hv;
        }
        if (tq == 3) F.out[O_LH_P + ((size_t)l * NBATCH + b) * 1024 + ch] = h;
    }
    for (int i = gt; i < MS * 1024; i += NGT) { const int s = i >> 10, ch = i & 1023; const size_t row = MP + s;
        const float hp = F.in[I_SLH][((size_t)l * 128 + s) * 1024 + ch]; const float h = LA[row * 1024 + ch] * hp + LU[row * 1024 + ch];
        F.out[O_LH_S + ((size_t)l * 128 + s) * 1024 + ch] = h; BR[row * BW + ch] = (bf16)f2bf(h * bf2f(P[row * NP + C_YA + ch])); }
    for (int task = gw; task < MR * 3; task += NGW) {
        const int row = task / 3, br = task - row * 3;
        const f32x4* src = (const f32x4*)(WSP(float, WS_OB + (size_t)br * SZ_O) + (size_t)row * 1024 + 16 * lane);
        float x[16];
#pragma unroll
        for (int j = 0; j < 4; ++j) { const f32x4 v = src[j]; x[4 * j] = v.x; x[4 * j + 1] = v.y; x[4 * j + 2] = v.z; x[4 * j + 3] = v.w; }
        const int gcol = (br == 0) ? C_HGG : (br == 1 ? C_SZ : C_RG);
        const v4u* gp = (const v4u*)(P + (size_t)row * NP + gcol + 16 * lane); const v4u ga = gp[0], gb = gp[1];
        const unsigned gw_[8] = {ga.x, ga.y, ga.z, ga.w, gb.x, gb.y, gb.z, gb.w};
        float gt_[16];
#pragma unroll
        for (int q = 0; q < 8; ++q) { gt_[2 * q] = bflo(gw_[q]); gt_[2 * q + 1] = bfhi(gw_[q]); }
        float o[16];
        if (br == 1) {
            float ss = 0.f;
#pragma unroll
            for (int j = 0; j < 16; ++j) { x[j] *= gt_[j]; ss += x[j] * x[j]; }
#pragma unroll
            for (int m = 1; m < 32; m <<= 1) ss += __shfl_xor(ss, m);
            const float rs = rsqrtf(ss * (1.f / 512.f) + EPS); const float* nw = F.in[I_SNW] + (size_t)l * 1024 + 16 * lane;
#pragma unroll
            for (int j = 0; j < 16; ++j) o[j] = x[j] * rs * nw[j];
        } else {
            float ss = 0.f;
#pragma unroll
            for (int j = 0; j < 16; ++j) ss += x[j] * x[j];
#pragma unroll
            for (int m = 1; m < 8; m <<= 1) ss += __shfl_xor(ss, m);
            const float rs = rsqrtf(ss * (1.f / 128.f) + EPS);
            if (br == 0) { const float* nw = F.in[I_HGNW] + (size_t)l * 128 + ((16 * lane) & 127);
#pragma unroll
                for (int j = 0; j < 16; ++j) o[j] = x[j] * rs * nw[j] * gt_[j]; }
            else {
#pragma unroll
                for (int j = 0; j < 16; ++j) o[j] = x[j] * rs * gt_[j]; }
        }
        v4u w0, w1; w0.x = pk2(o[0], o[1]); w0.y = pk2(o[2], o[3]); w0.z = pk2(o[4], o[5]); w0.w = pk2(o[6], o[7]); w1.x = pk2(o[8], o[9]); w1.y = pk2(o[10], o[11]); w1.z = pk2(o[12], o[13]); w1.w = pk2(o[14], o[15]);
        v4u* dst = (v4u*)(BR + (size_t)(br + 1) * M * BW + (size_t)row * BW + 16 * lane); dst[0] = w0; dst[1] = w1;
    }
}

__device__ __forceinline__ void phase_act(const Frame& F0, int l) {
    Frame F = launder(F0);
    const bf16* UV = WSP(bf16, WS_P); bf16* A2 = WSP(bf16, WS_G);
    const float* cw = F.in[I_FCW] + (size_t)l * 3 * DFF; const float* cb = F.in[I_FCB] + (size_t)l * DFF;
    const int gt = F.c * NTHR + F.tid, NGT = F.G * NTHR;
    constexpr int C8 = DFF / 8;
    for (int i = gt; i < M * C8; i += NGT) {
        const int row = i / C8, c = (i - row * C8) * 8;
        v4u outw = (v4u){0u, 0u, 0u, 0u};
        if (row < MR) {
            const v4u uw = *(const v4u*)(UV + (size_t)row * NUV + c), vw = *(const v4u*)(UV + (size_t)row * NUV + DFF + c);
            float u0[8] = {bflo(uw.x), bfhi(uw.x), bflo(uw.y), bfhi(uw.y), bflo(uw.z), bfhi(uw.z), bflo(uw.w), bfhi(uw.w)};
            const float vv[8] = {bflo(vw.x), bfhi(vw.x), bflo(vw.y), bfhi(vw.y), bflo(vw.z), bfhi(vw.z), bflo(vw.w), bfhi(vw.w)};
            float u1[8], u2[8];
#pragma unroll
            for (int j = 0; j < 8; ++j) { u1[j] = 0.f; u2[j] = 0.f; }
            if (row < MP) { const int t = row & (SEQ - 1);
                if (t >= 1) { const v4u w = *(const v4u*)(UV + (size_t)(row - 1) * NUV + c); u1[0] = bflo(w.x); u1[1] = bfhi(w.x); u1[2] = bflo(w.y); u1[3] = bfhi(w.y); u1[4] = bflo(w.z); u1[5] = bfhi(w.z); u1[6] = bflo(w.w); u1[7] = bfhi(w.w); }
                if (t >= 2) { const v4u w = *(const v4u*)(UV + (size_t)(row - 2) * NUV + c); u2[0] = bflo(w.x); u2[1] = bfhi(w.x); u2[2] = bflo(w.y); u2[3] = bfhi(w.y); u2[4] = bflo(w.z); u2[5] = bfhi(w.z); u2[6] = bflo(w.w); u2[7] = bfhi(w.w); }
                if (t >= SEQ - 2) { float* so = F.out + O_FC_P + (((size_t)l * NBATCH + (row >> 11)) * 2 + (t - (SEQ - 2))) * DFF + c;
#pragma unroll
                    for (int j = 0; j < 8; ++j) so[j] = u0[j]; }
            } else { const int s = row - MP; const float* st = F.in[I_SFC] + ((size_t)l * MS + s) * 2 * DFF + c; float* so = F.out + O_FC_S + ((size_t)l * MS + s) * 2 * DFF + c;
#pragma unroll
                for (int j = 0; j < 8; ++j) { u2[j] = st[j]; u1[j] = st[DFF + j]; so[j] = st[DFF + j]; so[DFF + j] = u0[j]; } }
            float a[8];
#pragma unroll
            for (int j = 0; j < 8; ++j) { const float y = cb[c + j] + cw[c + j] * u2[j] + cw[DFF + c + j] * u1[j] + cw[2 * DFF + c + j] * u0[j]; a[j] = geluf(y) * vv[j]; }
            outw.x = pk2(a[0], a[1]); outw.y = pk2(a[2], a[3]); outw.z = pk2(a[4], a[5]); outw.w = pk2(a[6], a[7]);
        }
        *(v4u*)(A2 + (size_t)row * DFF + c) = outw;
    }
}

constexpr int PH_PER_LAYER = 11, NPHASE = 1 + NLAYER * PH_PER_LAYER + 1;
__global__ void __launch_bounds__(NTHR, 2) mk_fwd(Args args) {
    extern __shared__ __attribute__((aligned(16))) unsigned char lds_raw[];
    Frame F;
    F.lds = (LAS unsigned char*)lds_raw;
    F.tid = threadIdx.x; F.lane = F.tid & 63; F.wave = __builtin_amdgcn_readfirstlane(F.tid >> 6);
    F.G = gridDim.x; F.c = blockIdx.x;
    F.in = args.in; F.out = args.out; F.ws = args.ws;
    volatile LAS unsigned* MISC = (volatile LAS unsigned*)(F.lds + LDSCTL_OFF);
    if (F.tid < 64) MISC[F.tid] = 0u;
    __syncthreads();
    unsigned* barw = (unsigned*)(F.ws + WS_CTL) + 4096;
    XcdBarrier bar; bar.bar = barw; bar.x = 0; bar.st = nullptr;
    if (!MK_SPLIT) bar = xcd_barrier_post(barw, MISC + 8);
    const int lo = args.ph_lo, hi = args.ph_hi;
#define IN(k) (lo <= (k) && (k) < hi)
#define SEAM(k) do { if (IN(k) && IN((k) + 1)) xcd_barrier(bar); } while (0)
#define X0 WSP(float, WS_X0)
#define X1 WSP(float, WS_X1)
#define H WSP(bf16, WS_H)
#define GEMM_RUN(EPI) do { pg8::gemm_phase<EPI, pg8::TileOrder>(F.lds, g, S, E); if (REP_G > 1) { Frame F1 = launder(F); pg8::gemm_phase<EPI, pg8::TileOrder>(F1.lds, g, S, E); } } while (0)

    if (IN(0) && !(SKMASK & 1)) { phase_prologue(F); } SEAM(0);

    for (int l = 0; l < NLAYER; ++l) {
        const int pb = 1 + l * PH_PER_LAYER;
        if (IN(pb + 0) && !(SKMASK & 2)) { phase_norm(F, X0, F.in[I_GMIX] + (size_t)l * DM, H); } SEAM(pb + 0);
        if (IN(pb + 1) && !(SKMASK & 4)) { const Frame F0 = F; Frame F = launder(F0);
            pg8::Gemm g{H, WSP(bf16, WS_W1 + l * SZ_W1), DM, DM, DM, 0, 0}; pg8::TileOrder S; S.init(M, N1, F.G, F.c, 1);
            Epi1 E{WSP(bf16, WS_P), WSP(float, WS_HF), WSP(float, WS_DT), WSP(bf16, WS_G), WSP(float, WS_LB) + l * 1024};
            GEMM_RUN(Epi1);
        } SEAM(pb + 1);
        if (IN(pb + 2) && !(SKMASK & 8)) { phase_conv(F, l); if (REP_CONV > 1) phase_conv(F, l); } SEAM(pb + 2);
        if (IN(pb + 3) && !(SKMASK & 16)) { phase_mix(F, l); if (REP_MIX > 1) phase_mix(F, l); } SEAM(pb + 3);
        if (IN(pb + 4) && !(SKMASK & 32)) { phase_post(F, l); if (REP_POST > 1) phase_post(F, l); } SEAM(pb + 4);
        if (IN(pb + 5) && !(SKMASK & 64)) { const Frame F0 = F; Frame F = launder(F0);
            pg8::Gemm g{WSP(bf16, WS_BR), WSP(bf16, WS_WB + l * SZ_WB), BW, BW, BW, (size_t)M * BW, (size_t)DM * BW}; pg8::TileOrder S; S.init(M, DM, F.G, F.c, 4);
            EpiBr E{WSP(bf16, WS_G), WSP(bf16, WS_MG)};
            GEMM_RUN(EpiBr);
        } SEAM(pb + 5);
        if (IN(pb + 6) && !(SKMASK & 128)) { const Frame F0 = F; Frame F = launder(F0);
            pg8::Gemm g{WSP(bf16, WS_MG), WSP(bf16, WS_WO + l * SZ_WO), DM, DM, DM, 0, 0}; pg8::TileOrder S; S.init(M, DM, F.G, F.c, 1);
            EpiRes E{X0, X1};
            GEMM_RUN(EpiRes);
        } SEAM(pb + 6);
        if (IN(pb + 7) && !(SKMASK & 256)) { phase_norm(F, X1, F.in[I_GFFN] + (size_t)l * DM, H); } SEAM(pb + 7);
        if (IN(pb + 8) && !(SKMASK & 512)) { const Frame F0 = F; Frame F = launder(F0);
            pg8::Gemm g{H, WSP(bf16, WS_WUV + l * SZ_WUV), DM, DM, DM, 0, 0}; pg8::TileOrder S; S.init(M, NUV, F.G, F.c, 1);
            EpiB E{WSP(bf16, WS_P), NUV};
            GEMM_RUN(EpiB);
        } SEAM(pb + 8);
        if (IN(pb + 9) && !(SKMASK & 1024)) { phase_act(F, l); } SEAM(pb + 9);
        if (IN(pb + 10) && !(SKMASK & 2048)) { const Frame F0 = F; Frame F = launder(F0);
            pg8::Gemm g{WSP(bf16, WS_G), WSP(bf16, WS_WD + l * SZ_WD), DFF, DFF, DFF, 0, 0}; pg8::TileOrder S; S.init(M, DM, F.G, F.c, 1);
            EpiRes E{X1, X0};
            GEMM_RUN(EpiRes);
        } SEAM(pb + 10);
    }
    if (IN(NPHASE - 1) && !(SKMASK & 4096)) { phase_final(F, WSP(float, WS_X0), F.in[I_GFIN]); }
#undef IN
#undef SEAM
#undef X0
#undef X1
#undef H
#undef GEMM_RUN
}

extern "C" void kernel_launch(void* const* d_in, const int* in_sizes, int n_in, void* d_out, int out_size, void* d_ws, size_t ws_size, hipStream_t stream) {
    static int grid = 0;
    if (grid == 0) {
        if (n_in != N_INPUTS || (size_t)out_size != O_END || ws_size < WS_END) { fprintf(stderr, "kernel_launch: unexpected shapes: n_in %d out %d ws %zu (need %zu)\n", n_in, out_size, ws_size, (size_t)WS_END); grid = -1; return; }
        int dev = 0, cus = 0, per_cu = 0;
        if (hipGetDevice(&dev) != hipSuccess || hipDeviceGetAttribute(&cus, hipDeviceAttributeMultiprocessorCount, dev) != hipSuccess) { grid = -1; return; }
        if (hipFuncSetAttribute((const void*)mk_fwd, hipFuncAttributeMaxDynamicSharedMemorySize, LDS_BYTES) != hipSuccess) { fprintf(stderr, "kernel_launch: hipFuncSetAttribute failed\n"); grid = -1; return; }
        if (hipOccupancyMaxActiveBlocksPerMultiprocessor(&per_cu, (const void*)mk_fwd, NTHR, LDS_BYTES) != hipSuccess || per_cu < 1) { fprintf(stderr, "kernel_launch: occupancy query says %d\n", per_cu); }
        (void)hipGetLastError();
        grid = cus;
    }
    if (grid < 0) return;
    (void)hipMemsetAsync((char*)d_ws + WS_CTL, 0, CTL_BYTES, stream);
    Args a{};
    for (int i = 0; i < N_INPUTS; ++i) a.in[i] = (const float*)d_in[i];
    a.out = (float*)d_out; a.ws = (unsigned char*)d_ws;
#if MK_SPLIT
    for (int p = 0; p < NPHASE; ++p) { a.ph_lo = p; a.ph_hi = p + 1; hipLaunchKernelGGL(mk_fwd, dim3(grid), dim3(NTHR), LDS_BYTES, stream, a); }
#else
    a.ph_lo = 0; a.ph_hi = NPHASE;
    hipLaunchKernelGGL(mk_fwd, dim3(grid), dim3(NTHR), LDS_BYTES, stream, a);
#endif
}
```

```cpp
#include <hip/hip_runtime.h>
#include <cstdio>
#include <cstdint>

#ifndef REP_G
#define REP_G 1
#endif
#ifndef REP_CONV
#define REP_CONV 1
#endif
#ifndef REP_MIX
#define REP_MIX 1
#endif
#ifndef REP_POST
#define REP_POST 1
#endif
#ifndef SKMASK
#define SKMASK 0
#endif
#ifndef MK_SPLIT
#define MK_SPLIT 0
#endif

namespace pg8 {
#define PG8_LAS __attribute__((address_space(3)))
typedef unsigned short bf16_t;
typedef short bf16x8 __attribute__((ext_vector_type(8)));
typedef float f32x4 __attribute__((ext_vector_type(4)));
typedef unsigned u32x4 __attribute__((ext_vector_type(4)));
constexpr int BM = 256, BK = 64, HALF = 128, HTB = HALF * BK * 2, STAGE_BYTES = 8 * HTB, NXCD = 8, WGM = 8;

__host__ __device__ __forceinline__ int lds_byte(int r, int c) { const int st = (r >> 4) * 2 + (c >> 5), rr = r & 15, cc = c & 31, ob = rr * 64 + cc * 2; return st * 1024 + (ob ^ (((ob >> 9) & 1) << 5)); }
__host__ __device__ __forceinline__ void stage_rc(int b, int& R, int& C) { const int st = b / 1024, sb = b % 1024, swz = sb ^ (((sb >> 9) & 1) << 5); R = (st >> 1) * 16 + swz / 64; C = (st & 1) * 32 + (swz % 64) / 2; }
__host__ __device__ __forceinline__ int perm32(int rho) { const int n = rho >> 4, i = rho & 15; return 8 * (i >> 2) + 4 * n + (i & 3); }

struct Unit { int pm, pn, kz; };
struct Gemm { const bf16_t* A; const bf16_t* Bt; int lda, ldb, K; size_t azs, bzs; };

struct TileOrder {
    int nM, nN, nwg, G, c, nkz;
    __device__ void init(int M, int N, int G_, int c_, int nkz_) { nM = M / BM; nN = N / BM; nwg = nM * nN; G = G_; c = c_; nkz = nkz_; }
    __device__ bool next(int i, Unit& u) const {
        const int ti = i / nkz; u.kz = i - ti * nkz;
        const long L = (long)ti * G + c; if (L >= nwg) return false;
        int wgid = (int)L; { const int q = nwg / NXCD, r = nwg % NXCD, xcd = wgid % NXCD, off = wgid / NXCD; wgid = (xcd < r ? xcd * (q + 1) : r * (q + 1) + (xcd - r) * q) + off; }
        const int nig = WGM * nN, gid = wgid / nig, fm = gid * WGM, gsz = (nM - fm) < WGM ? (nM - fm) : WGM;
        u.pm = fm + ((wgid % nig) % gsz); u.pn = (wgid % nig) / gsz; return true;
    }
};

__device__ __forceinline__ unsigned cvt_pk_bf16(float lo, float hi) { unsigned r; asm volatile("v_cvt_pk_bf16_f32 %0, %1, %2" : "=v"(r) : "v"(lo), "v"(hi)); return r; }

template <class Epi, class Sched, bool ALIGN_EPI = true>
__device__ __forceinline__ void gemm_phase(PG8_LAS unsigned char* lds, const Gemm g, const Sched& S, const Epi& E) {
    int tid = threadIdx.x; asm volatile("" : "+v"(tid));
    const int wid = __builtin_amdgcn_readfirstlane(tid >> 6), lane = tid & 63, wr = wid >> 2, wc = wid & 3, fr = lane & 15, fq = lane >> 4;
    const int K = g.K, nt = K / BK;
    unsigned voffA[2], voffB[2];
#pragma unroll
    for (int i = 0; i < 2; ++i) { int R, C; stage_rc(tid * 16 + i * 8192, R, C); const int Rb = Epi::PERM ? ((R & ~31) + perm32(R & 31)) : R;
        voffA[i] = (unsigned)(R * g.lda + C) * 2u; voffB[i] = (unsigned)(Rb * g.ldb + C) * 2u; }
    const size_t kstep = (size_t)(BK * 2);
    const size_t hstepA = (size_t)HALF * g.lda * 2, hstepB = (size_t)HALF * g.ldb * 2;
    const size_t tstepA = 2 * hstepA, tstepB = 2 * hstepB;
    const unsigned ldsw = (unsigned)wid * 1024u;
    const int aoff = lds_byte(wr * 64 + fr, fq * 8), boff = lds_byte(wc * 32 + fr, fq * 8);
#define PG8_SA(b, h) (((b) * 2 + (h)) * HTB)
#define PG8_SB(b, h) ((4 + (b) * 2 + (h)) * HTB)
#define PG8_STAGE(bufoff, gbase, voff) do { _Pragma("unroll") for (int _i = 0; _i < 2; ++_i) \
        __builtin_amdgcn_global_load_lds((const unsigned*)((const char*)(gbase) + (voff)[_i]), (PG8_LAS unsigned*)(lds + (bufoff) + ldsw + _i * 8192), 16, 0, 0); } while (0)
#define PG8_LDA(dst, b, h) do { _Pragma("unroll") for (int m = 0; m < 4; ++m) _Pragma("unroll") for (int k = 0; k < 2; ++k) dst[m][k] = *(const PG8_LAS bf16x8*)(lds + PG8_SA(b, h) + aoff + m * 2048 + k * 1024); } while (0)
#define PG8_LDB(dst, b, h) do { _Pragma("unroll") for (int n = 0; n < 2; ++n) _Pragma("unroll") for (int k = 0; k < 2; ++k) dst[n][k] = *(const PG8_LAS bf16x8*)(lds + PG8_SB(b, h) + boff + n * 2048 + k * 1024); } while (0)
#define PG8_MMA(ai, bj, At, Bt) do { __builtin_amdgcn_s_setprio(1); _Pragma("unroll") for (int m = 0; m < 4; ++m) _Pragma("unroll") for (int n = 0; n < 2; ++n) _Pragma("unroll") for (int k = 0; k < 2; ++k) \
        acc[ai][bj][m][n] = __builtin_amdgcn_mfma_f32_16x16x32_bf16(Bt[n][k], At[m][k], acc[ai][bj][m][n], 0, 0, 0); __builtin_amdgcn_s_setprio(0); } while (0)
#define PG8_WAIT_V(n) asm volatile("s_waitcnt vmcnt(" #n ")" ::: "memory")
#define PG8_WAIT_L(n) asm volatile("s_waitcnt lgkmcnt(" #n ")" ::: "memory")
#define PG8_BAR __builtin_amdgcn_s_barrier()
#define PG8_SCHED __builtin_amdgcn_sched_barrier(0)
    Unit cur, nxt; int ui = 0;
    if (!S.next(0, cur)) return;
    f32x4 acc[2][2][4][2];
#pragma unroll
    for (int a = 0; a < 2; ++a)
#pragma unroll
        for (int b = 0; b < 2; ++b)
#pragma unroll
            for (int m = 0; m < 4; ++m)
#pragma unroll
                for (int n = 0; n < 2; ++n) acc[a][b][m][n] = (f32x4){0.f, 0.f, 0.f, 0.f};
    bf16x8 At[4][2], B0[2][2], B1[2][2];
    const char* cA = (const char*)g.A + (size_t)cur.kz * g.azs * 2 + (size_t)cur.pm * tstepA;
    const char* cB = (const char*)g.Bt + (size_t)cur.kz * g.bzs * 2 + (size_t)cur.pn * tstepB;
    PG8_STAGE(PG8_SB(0, 0), cB, voffB); PG8_STAGE(PG8_SB(0, 1), cB + hstepB, voffB); PG8_STAGE(PG8_SA(0, 0), cA, voffA); PG8_STAGE(PG8_SA(0, 1), cA + hstepA, voffA);
    if (wr == 1) PG8_BAR;
    PG8_WAIT_V(2); PG8_BAR;
    PG8_STAGE(PG8_SB(1, 0), cB + kstep, voffB); PG8_STAGE(PG8_SA(1, 0), cA + kstep, voffA); PG8_STAGE(PG8_SB(1, 1), cB + hstepB + kstep, voffB);
    PG8_WAIT_V(6); PG8_BAR;
    for (;;) {
        const bool has_next = S.next(ui + 1, nxt);
        const char* nA = has_next ? (const char*)g.A + (size_t)nxt.kz * g.azs * 2 + (size_t)nxt.pm * tstepA : cA;
        const char* nB = has_next ? (const char*)g.Bt + (size_t)nxt.kz * g.bzs * 2 + (size_t)nxt.pn * tstepB : cB;
        for (int t = 0; t < nt; t += 2) {
            const bool last = (t == nt - 2);
            const char* a1 = cA + (size_t)(t + 1) * kstep;
            const char* a2 = last ? nA : cA + (size_t)(t + 2) * kstep; const char* b2 = last ? nB : cB + (size_t)(t + 2) * kstep;
            const char* a3 = a2 + kstep; const char* b3 = b2 + kstep;
            PG8_LDB(B0, 0, 0); PG8_LDB(B1, 0, 1); PG8_SCHED; PG8_LDA(At, 0, 0); PG8_STAGE(PG8_SA(1, 1), a1 + hstepA, voffA);
            PG8_WAIT_V(8); PG8_WAIT_L(0); PG8_BAR; PG8_MMA(0, 0, At, B0); PG8_MMA(0, 1, At, B1); PG8_BAR; PG8_SCHED;
            PG8_LDA(At, 0, 1); PG8_STAGE(PG8_SB(0, 0), b2, voffB); PG8_STAGE(PG8_SB(0, 1), b2 + hstepB, voffB); PG8_STAGE(PG8_SA(0, 0), a2, voffA);
            PG8_WAIT_V(8); PG8_WAIT_L(0); PG8_BAR; PG8_MMA(1, 0, At, B0); PG8_MMA(1, 1, At, B1); PG8_BAR; PG8_SCHED;
            PG8_LDB(B0, 1, 0); PG8_LDB(B1, 1, 1); PG8_SCHED; PG8_LDA(At, 1, 0); PG8_STAGE(PG8_SA(0, 1), a2 + hstepA, voffA);
            PG8_WAIT_V(8); PG8_WAIT_L(0); PG8_BAR; PG8_MMA(0, 0, At, B0); PG8_MMA(0, 1, At, B1); PG8_BAR; PG8_SCHED;
            PG8_LDA(At, 1, 1); PG8_STAGE(PG8_SB(1, 0), b3, voffB); PG8_STAGE(PG8_SB(1, 1), b3 + hstepB, voffB); PG8_STAGE(PG8_SA(1, 0), a3, voffA);
            PG8_WAIT_V(8); PG8_WAIT_L(0); PG8_BAR; PG8_MMA(1, 0, At, B0); PG8_MMA(1, 1, At, B1); PG8_BAR; PG8_SCHED;
        }
        if constexpr (ALIGN_EPI) { if (wr == 0) PG8_BAR; }
        E(acc, cur, wr, wc, fr, fq);
        if (!has_next) break;
        if (!E.keep(cur)) {
#pragma unroll
            for (int a = 0; a < 2; ++a)
#pragma unroll
                for (int b = 0; b < 2; ++b)
#pragma unroll
                    for (int m = 0; m < 4; ++m)
#pragma unroll
                        for (int n = 0; n < 2; ++n) acc[a][b][m][n] = (f32x4){0.f, 0.f, 0.f, 0.f};
        }
        cur = nxt; cA = nA; cB = nB; ++ui;
        if constexpr (ALIGN_EPI) { if (wr == 1) PG8_BAR; }
    }
    PG8_WAIT_V(0);
    if constexpr (!ALIGN_EPI) { if (wr == 0) PG8_BAR; }
    PG8_BAR;
#undef PG8_SA
#undef PG8_SB
#undef PG8_STAGE
#undef PG8_LDA
#undef PG8_LDB
#undef PG8_MMA
#undef PG8_WAIT_V
#undef PG8_WAIT_L
#undef PG8_BAR
#undef PG8_SCHED
}
}

constexpr int NWAVES = 8, NTHR = 512;
constexpr int DM = 2048, NBATCH = 4, SEQ = 2048, MP = NBATCH * SEQ, MS = 128, MR = MP + MS, M = 8448;
constexpr int NLAYER = 2;
constexpr int NIN = 12816, NP = 13056, NG = 8192, N1 = NP + NG;
constexpr int DFF = 5632, NUV = 2 * DFF;
constexpr int BW = 1024;
constexpr float EPS = 1e-6f;
constexpr int C_XA = 0, C_YA = 1024, C_HQ = 2048, C_HF = 3072, C_HI = 4096, C_HGG = 5120, C_SZ = 6144, C_SX = 7168, C_SDT = 8704, C_RQ = 8960, C_RK = 9984, C_RV = 11008, C_RG = 12032;
constexpr int SRC_SPLIT = 8720;
constexpr int SSD_CD = 1536;

enum { I_XP = 0, I_XS, I_SLH, I_SLC, I_SHG, I_SSSD, I_SSC, I_SRET, I_SFC, I_GMIX, I_GFFN, I_WIN, I_LCW, I_LCB, I_LWA, I_LBA, I_LWX, I_LBX, I_LLAM, I_HGLB, I_HGNW,
       I_SCW, I_SCB, I_SDTB, I_SALOG, I_SD, I_SNW, I_WBR, I_WGATE, I_WOUT, I_WUP, I_WVAL, I_FCW, I_FCB, I_WDOWN, I_GFIN, N_INPUTS };

constexpr size_t O_YP = 0, O_YS = O_YP + (size_t)MP * DM, O_LH_P = O_YS + (size_t)MS * DM, O_LH_S = O_LH_P + 2 * 4 * 1024, O_LC_P = O_LH_S + 2 * 128 * 1024,
    O_LC_S = O_LC_P + 2 * 4 * 3 * 1024, O_HG_P = O_LC_S + 2 * 128 * 3 * 1024, O_HG_S = O_HG_P + (size_t)2 * 4 * 8 * 16384, O_SSD_P = O_HG_S + (size_t)2 * 128 * 8 * 16384,
    O_SSD_S = O_SSD_P + (size_t)2 * 4 * 16 * 8192, O_SC_P = O_SSD_S + (size_t)2 * 128 * 16 * 8192, O_SC_S = O_SC_P + 2 * 4 * 3 * 1536, O_RET_P = O_SC_S + 2 * 128 * 3 * 1536,
    O_RET_S = O_RET_P + (size_t)2 * 4 * 8 * 16384, O_FC_P = O_RET_S + (size_t)2 * 128 * 8 * 16384, O_FC_S = O_FC_P + 2 * 4 * 2 * 5632, O_END = O_FC_S + (size_t)2 * 128 * 2 * 5632;
static_assert(O_END == 126119936ull, "output size");

constexpr size_t AL(size_t x) { return (x + 4095) & ~(size_t)4095; }
constexpr size_t WS_CTL = 0, CTL_BYTES = 1u << 20;
constexpr size_t SZ_W1 = (size_t)N1 * DM * 2, SZ_WB = (size_t)4 * DM * BW * 2, SZ_WO = (size_t)DM * DM * 2, SZ_WUV = (size_t)NUV * DM * 2, SZ_WD = (size_t)DM * DFF * 2;
constexpr size_t WS_W1 = CTL_BYTES, WS_WB = WS_W1 + 2 * SZ_W1, WS_WO = WS_WB + 2 * SZ_WB, WS_WUV = WS_WO + 2 * SZ_WO, WS_WD = WS_WUV + 2 * SZ_WUV;
constexpr size_t WS_ROPE = WS_WD + 2 * SZ_WD, SZ_ROPE = AL((size_t)2049 * 64 * 8);
constexpr size_t SZ_X = (size_t)M * DM * 4;
constexpr size_t WS_X0 = WS_ROPE + SZ_ROPE, WS_X1 = WS_X0 + SZ_X;
constexpr size_t WS_H = WS_X1 + SZ_X, SZ_H = (size_t)M * DM * 2;
constexpr size_t WS_P = WS_H + SZ_H, SZ_P = (size_t)M * NP * 2;
constexpr size_t WS_G = WS_P + SZ_P, SZ_G = (size_t)M * NG * 2;
constexpr size_t WS_HF = WS_G + SZ_G, SZ_HF = (size_t)M * 1024 * 4;
constexpr size_t WS_DT = WS_HF + SZ_HF, SZ_DT = AL((size_t)M * 16 * 4);
constexpr size_t WS_OB = WS_DT + SZ_DT, SZ_O = (size_t)M * 1024 * 4;
constexpr size_t WS_BR = WS_OB + 3 * SZ_O, SZ_BR = (size_t)4 * M * BW * 2;
constexpr size_t WS_MG = WS_BR + SZ_BR, SZ_MG = (size_t)M * DM * 2;
constexpr size_t WS_XBC = WS_MG + SZ_MG, SZ_XBC = (size_t)M * SSD_CD * 2;
constexpr size_t WS_LB = WS_XBC + SZ_XBC, SZ_LB = AL((size_t)NLAYER * 1024 * 4);
constexpr size_t WS_END = WS_LB + SZ_LB;
static_assert((size_t)M * NUV * 2 <= SZ_P && (size_t)M * DFF * 2 <= SZ_G && 2 * SZ_O <= SZ_X, "overlays");

constexpr int RING_BYTES = 131072, LDSCTL_OFF = RING_BYTES, LDS_BYTES = 147456;

#define GAS __attribute__((address_space(1)))
#define LAS __attribute__((address_space(3)))
typedef unsigned short bf16;
typedef unsigned v4u __attribute__((ext_vector_type(4)));
typedef unsigned v2u __attribute__((ext_vector_type(2)));
typedef float f32x4 __attribute__((ext_vector_type(4)));
typedef float f32x2 __attribute__((ext_vector_type(2)));
typedef short bf16x8 __attribute__((ext_vector_type(8)));
#define LDS_WAIT() asm volatile("s_waitcnt lgkmcnt(0)" ::: "memory")
__device__ __forceinline__ unsigned f2bf(float f) { unsigned u = __builtin_bit_cast(unsigned, f); return (u + 0x7fffu + ((u >> 16) & 1u)) >> 16; }
__device__ __forceinline__ unsigned pk2(float lo, float hi) { return f2bf(lo) | (f2bf(hi) << 16); }
__device__ __forceinline__ float bf2f(unsigned short b) { return __uint_as_float(((unsigned)b) << 16); }
__device__ __forceinline__ float bflo(unsigned w) { return __uint_as_float(w << 16); }
__device__ __forceinline__ float bfhi(unsigned w) { return __uint_as_float(w & 0xffff0000u); }
__device__ __forceinline__ float sigm(float x) { return 1.f / (1.f + __expf(-x)); }
__device__ __forceinline__ float siluf(float x) { return x * sigm(x); }
__device__ __forceinline__ float geluf(float x) { return x * sigm(1.5957691216057308f * (x + 0.044715f * x * x * x)); }
__device__ __forceinline__ float softplusf(float x) { return x > 20.f ? x : log1pf(__expf(x)); }

#define XB_TMO      128
#define XB_XCNT(j)  (256  + 64 * (j))
#define XB_XSUB(j)  (1280 + 64 * (j))
#define XB_XGEN(j)  (2304 + 64 * (j))
#define XB_TOP      3328
#define XB_TOPGEN   3392
#define XCD_BAR_WORDS 3456
#define XB_SPIN_CAP (1u << 19)
__device__ __forceinline__ unsigned xb_ld(unsigned* p)              { return __hip_atomic_load(p, __ATOMIC_RELAXED, __HIP_MEMORY_SCOPE_AGENT); }
__device__ __forceinline__ unsigned xb_add(unsigned* p, unsigned v) { return __hip_atomic_fetch_add(p, v, __ATOMIC_RELAXED, __HIP_MEMORY_SCOPE_AGENT); }
__device__ __forceinline__ unsigned xb_xcc_id() { return (unsigned)__builtin_amdgcn_s_getreg((3 << 11) | 20) & 0xFu; }
#define XB_SPIN(cond, bar) do { unsigned _sp = 0; while (cond) { __builtin_amdgcn_s_sleep(1); \
    if ((++_sp & 255u) == 0u) { if (xb_ld(&(bar)[XB_TMO])) break; if (_sp > XB_SPIN_CAP) { atomicAdd(&(bar)[XB_TMO], 1u); break; } } } } while (0)
struct XcdBarrier { unsigned* bar; unsigned x; volatile LAS unsigned* st; };
__device__ __forceinline__ XcdBarrier xcd_barrier_post(unsigned* bar, volatile LAS unsigned* st) {
    XcdBarrier b; b.bar = bar; b.x = xb_xcc_id(); b.st = st;
    if (threadIdx.x == 0) (void)xb_add(&bar[XB_XCNT(b.x)], 1u);
    return b;
}
__device__ __forceinline__ void xcd_barrier_complete(unsigned* bar, unsigned x, unsigned& nloc, unsigned& nx) {
    const unsigned G = gridDim.x * gridDim.y * gridDim.z;
    unsigned sum, cnt, mine, sp = 0u;
    for (;;) {
        sum = 0u; cnt = 0u; mine = 0u;
#pragma unroll
        for (unsigned j = 0; j < 16; ++j) { const unsigned c = xb_ld(&bar[XB_XCNT(j)]); sum += c; cnt += (c > 0u) ? 1u : 0u; mine = (j == x) ? c : mine; }
        if (sum == G) break;
        __builtin_amdgcn_s_sleep(1);
        if ((++sp & 255u) == 0u) { if (xb_ld(&bar[XB_TMO])) break; if (sp > XB_SPIN_CAP) { atomicAdd(&bar[XB_TMO], 1u); break; } }
    }
    nloc = mine > 0u ? mine : 1u; nx = cnt > 0u ? cnt : 1u;
}
__device__ __forceinline__ void xcd_barrier(const XcdBarrier& b) {
    asm volatile("s_waitcnt vmcnt(0)" ::: "memory");
    __syncthreads();
    if (threadIdx.x == 0) {
        unsigned* bar = b.bar;
        __builtin_amdgcn_s_waitcnt(0);
        unsigned nloc = b.st[0], nx = b.st[1];
        if (nloc == 0u) { xcd_barrier_complete(bar, b.x, nloc, nx); b.st[0] = nloc; b.st[1] = nx; }
        const unsigned old = xb_add(&bar[XB_XSUB(b.x)], 1u);
        const unsigned gen = old / nloc;
        if (old + 1u == (gen + 1u) * nloc) {
            __builtin_amdgcn_fence(__ATOMIC_RELEASE, "agent");
            asm volatile("s_waitcnt vmcnt(0)" ::: "memory");
            const unsigned og = xb_add(&bar[XB_TOP], 1u);
            const unsigned tg = og / nx;
            if (og + 1u == (tg + 1u) * nx) xb_add(&bar[XB_TOPGEN], 1u);
            else XB_SPIN(xb_ld(&bar[XB_TOPGEN]) == tg, bar);
            __builtin_amdgcn_fence(__ATOMIC_ACQUIRE, "agent");
            xb_add(&bar[XB_XGEN(b.x)], 1u);
            asm volatile("s_waitcnt vmcnt(0)" ::: "memory");
        } else {
            XB_SPIN(xb_ld(&bar[XB_XGEN(b.x)]) == gen, bar);
            __builtin_amdgcn_fence(__ATOMIC_ACQUIRE, "agent");
            asm volatile("s_waitcnt vmcnt(0)" ::: "memory");
        }
    }
    __syncthreads();
}

struct Args { const float* in[N_INPUTS]; float* out; unsigned char* ws; int ph_lo, ph_hi; };

struct Frame {
    LAS unsigned char* lds;
    int tid, lane, wave, G, c;
    const float* const* in;
    float* out;
    unsigned char* ws;
};
#define WSP(T, off) ((T*)(F.ws + (off)))
__device__ __forceinline__ Frame launder(const Frame& F0) {
    Frame F = F0;
    asm volatile("" : "+v"(F.tid), "+v"(F.lane));
    asm volatile("" : "+s"(F.wave), "+s"(F.G), "+s"(F.c));
    { int z = 0; asm volatile("" : "+s"(z)); F.in += z; F.out += z; F.ws += z; }
    asm volatile("" : "+s"(F.lds));
    return F;
}

using pg8::f32x4;
using pg8::Unit;
using pg8::cvt_pk_bf16;

struct Epi1 {
    static constexpr bool PERM = true;
    bf16* P; float* HF; float* DT; bf16* Gt; const float* LB;
    __device__ __forceinline__ bool keep(const Unit&) const { return false; }
    template <int ACT> __device__ __forceinline__ void store_act(f32x4 (&acc)[2][2][4][2], bf16* base, int ld, int row0, int colb) const {
#pragma unroll
        for (int ai = 0; ai < 2; ++ai)
#pragma unroll
            for (int m = 0; m < 4; ++m) { bf16* rowp = base + (size_t)(row0 + ai * 128 + m * 16) * ld + colb;
#pragma unroll
                for (int bj = 0; bj < 2; ++bj) { f32x4 v0 = acc[ai][bj][m][0], v1 = acc[ai][bj][m][1];
#pragma unroll
                    for (int j = 0; j < 4; ++j) { if (ACT == 1) { v0[j] = geluf(v0[j]); v1[j] = geluf(v1[j]); } if (ACT == 2) { v0[j] = siluf(v0[j]); v1[j] = siluf(v1[j]); } if (ACT == 3) { v0[j] = sigm(v0[j]); v1[j] = sigm(v1[j]); } }
                    pg8::u32x4 w; w.x = cvt_pk_bf16(v0[0], v0[1]); w.y = cvt_pk_bf16(v0[2], v0[3]); w.z = cvt_pk_bf16(v1[0], v1[1]); w.w = cvt_pk_bf16(v1[2], v1[3]);
                    *(pg8::u32x4*)(rowp + bj * 128) = w; }
                asm volatile("" ::: "memory"); }
    }
    __device__ __forceinline__ void operator()(f32x4 (&acc)[2][2][4][2], const Unit& u, int wr, int wc, int fr, int fq) const {
        const int row0 = u.pm * 256 + wr * 64 + fr, pn = u.pn;
        if (pn >= 51) { store_act<3>(acc, Gt, NG, row0, (pn - 51) * 256 + wc * 32 + 8 * fq); }
        else if (pn >= 12 && pn < 16) {
            const int colb = (pn - 12) * 256 + wc * 32 + 8 * fq;
#pragma unroll
            for (int bj = 0; bj < 2; ++bj) { const f32x4 l0 = *(const f32x4*)(LB + colb + bj * 128), l1 = *(const f32x4*)(LB + colb + bj * 128 + 4);
#pragma unroll
                for (int ai = 0; ai < 2; ++ai)
#pragma unroll
                    for (int m = 0; m < 4; ++m) { const size_t r = (size_t)(row0 + ai * 128 + m * 16);
                        f32x4 v0 = acc[ai][bj][m][0], v1 = acc[ai][bj][m][1], g0, g1, k0, k1;
#pragma unroll
                        for (int j = 0; j < 4; ++j) { { const float e = __expf(-fabsf(v0[j])), r = 1.f / (1.f + e), sm = e * r, sg = v0[j] >= 0.f ? r : sm, sn = v0[j] >= 0.f ? sm : r; g0[j] = __logf(l0[j] + (1.f - l0[j]) * sg); k0[j] = (1.f - l0[j]) * sn; }
                                                      { const float e = __expf(-fabsf(v1[j])), r = 1.f / (1.f + e), sm = e * r, sg = v1[j] >= 0.f ? r : sm, sn = v1[j] >= 0.f ? sm : r; g1[j] = __logf(l1[j] + (1.f - l1[j]) * sg); k1[j] = (1.f - l1[j]) * sn; } }
                        *(f32x4*)(HF + r * 1024 + colb + bj * 128) = g0; *(f32x4*)(HF + r * 1024 + colb + bj * 128 + 4) = g1;
                        pg8::u32x4 w; w.x = cvt_pk_bf16(k0[0], k0[1]); w.y = cvt_pk_bf16(k0[2], k0[3]); w.z = cvt_pk_bf16(k1[0], k1[1]); w.w = cvt_pk_bf16(k1[2], k1[3]);
                        *(pg8::u32x4*)(P + r * NP + C_HF + colb + bj * 128) = w; asm volatile("" ::: "memory"); } }
        } else if (pn == 34) {
            if (wc == 0 && fq < 2) {
#pragma unroll
                for (int ai = 0; ai < 2; ++ai)
#pragma unroll
                    for (int m = 0; m < 4; ++m) { float* rowp = DT + (size_t)(row0 + ai * 128 + m * 16) * 16 + 8 * fq;
                        *(f32x4*)(rowp) = acc[ai][0][m][0]; *(f32x4*)(rowp + 4) = acc[ai][0][m][1]; }
            }
        } else {
            const int colb = pn * 256 + wc * 32 + 8 * fq;
            if (pn >= 4 && pn < 8) store_act<1>(acc, P, NP, row0, colb);
            else if ((pn >= 8 && pn < 12) || (pn >= 20 && pn < 28) || pn >= 47) store_act<2>(acc, P, NP, row0, colb);
            else store_act<0>(acc, P, NP, row0, colb);
        }
    }
};

struct EpiB {
    static constexpr bool PERM = true;
    bf16* O; int ldc;
    __device__ __forceinline__ bool keep(const Unit&) const { return false; }
    __device__ __forceinline__ void operator()(f32x4 (&acc)[2][2][4][2], const Unit& u, int wr, int wc, int fr, int fq) const {
        const int row0 = u.pm * 256 + wr * 64 + fr, colb = u.pn * 256 + wc * 32 + 8 * fq;
#pragma unroll
        for (int ai = 0; ai < 2; ++ai)
#pragma unroll
            for (int m = 0; m < 4; ++m) { bf16* rowp = O + (size_t)(row0 + ai * 128 + m * 16) * ldc + colb;
#pragma unroll
                for (int bj = 0; bj < 2; ++bj) { const f32x4 v0 = acc[ai][bj][m][0], v1 = acc[ai][bj][m][1]; pg8::u32x4 w;
                    w.x = cvt_pk_bf16(v0[0], v0[1]); w.y = cvt_pk_bf16(v0[2], v0[3]); w.z = cvt_pk_bf16(v1[0], v1[1]); w.w = cvt_pk_bf16(v1[2], v1[3]);
                    *(pg8::u32x4*)(rowp + bj * 128) = w; } }
    }
};

struct EpiBr {
    static constexpr bool PERM = true;
    const bf16* Gt; bf16* O;
    __device__ __forceinline__ bool keep(const Unit& u) const { return u.kz < 3; }
    __device__ __forceinline__ void operator()(f32x4 (&acc)[2][2][4][2], const Unit& u, int wr, int wc, int fr, int fq) const {
        const int row0 = u.pm * 256 + wr * 64 + fr, colb = u.pn * 256 + wc * 32 + 8 * fq, kz = u.kz;
#pragma unroll
        for (int ai = 0; ai < 2; ++ai)
#pragma unroll
            for (int m = 0; m < 4; ++m) { const size_t r = (size_t)(row0 + ai * 128 + m * 16);
#pragma unroll
                for (int bj = 0; bj < 2; ++bj) {
                    const pg8::u32x4 ga = *(const pg8::u32x4*)(Gt + r * NG + kz * 2048 + colb + bj * 128);
                    float s[8] = {bflo(ga.x), bfhi(ga.x), bflo(ga.y), bfhi(ga.y), bflo(ga.z), bfhi(ga.z), bflo(ga.w), bfhi(ga.w)};
                    if (kz < 3) {
                        const pg8::u32x4 gb = *(const pg8::u32x4*)(Gt + r * NG + (kz + 1) * 2048 + colb + bj * 128);
                        const float d[8] = {bflo(gb.x), bfhi(gb.x), bflo(gb.y), bfhi(gb.y), bflo(gb.z), bfhi(gb.z), bflo(gb.w), bfhi(gb.w)};
#pragma unroll
                        for (int j = 0; j < 8; ++j) s[j] = s[j] * __builtin_amdgcn_rcpf(fmaxf(d[j], 1e-20f));
                    }
                    f32x4 v0 = acc[ai][bj][m][0], v1 = acc[ai][bj][m][1];
                    v0[0] *= s[0]; v0[1] *= s[1]; v0[2] *= s[2]; v0[3] *= s[3]; v1[0] *= s[4]; v1[1] *= s[5]; v1[2] *= s[6]; v1[3] *= s[7];
                    acc[ai][bj][m][0] = v0; acc[ai][bj][m][1] = v1;
                    if (kz == 3) { pg8::u32x4 w; w.x = cvt_pk_bf16(v0[0], v0[1]); w.y = cvt_pk_bf16(v0[2], v0[3]); w.z = cvt_pk_bf16(v1[0], v1[1]); w.w = cvt_pk_bf16(v1[2], v1[3]);
                        *(pg8::u32x4*)(O + r * DM + colb + bj * 128) = w; }
                }
                asm volatile("" ::: "memory"); }
    }
};

struct EpiRes {
    static constexpr bool PERM = false;
    const float* Xc; float* Xn;
    __device__ __forceinline__ bool keep(const Unit&) const { return false; }
    __device__ __forceinline__ void operator()(f32x4 (&acc)[2][2][4][2], const Unit& u, int wr, int wc, int fr, int fq) const {
        const int row0 = u.pm * 256 + wr * 64 + fr, col0 = u.pn * 256 + wc * 32 + 4 * fq;
#pragma unroll
        for (int ai = 0; ai < 2; ++ai)
#pragma unroll
            for (int m = 0; m < 4; ++m) { const size_t off = (size_t)(row0 + ai * 128 + m * 16) * DM + col0;
#pragma unroll
                for (int bj = 0; bj < 2; ++bj)
#pragma unroll
                    for (int n = 0; n < 2; ++n) { const f32x4 b = *(const f32x4*)(Xc + off + bj * 128 + n * 16); *(f32x4*)(Xn + off + bj * 128 + n * 16) = b + acc[ai][bj][m][n]; }
                asm volatile("" ::: "memory"); }
    }
};

__device__ __forceinline__ void tr_item(const float* W, int K, int N, bf16* WT, int ldt, int mode, int roff, LAS float* scr, int item, int lane) {
    const int nblk = (N + 31) >> 5, kb = item / nblk, nb = item - kb * nblk, k0 = 64 * kb, n0 = 32 * nb;
    const int nn = n0 + (lane & 31); const bool okn = nn < N;
#pragma unroll 8
    for (int i = 0; i < 32; ++i) { const int kk = 2 * i + (lane >> 5); scr[kk * 33 + (lane & 31)] = okn ? W[(size_t)(k0 + kk) * N + nn] : 0.f; }
    LDS_WAIT(); asm volatile("" ::: "memory");
    const int c = lane & 7;
#pragma unroll
    for (int j = 0; j < 4; ++j) { const int n = (lane >> 3) + 8 * j, gn = n0 + n; const LAS float* s = scr + (8 * c) * 33 + n;
        v4u o; o.x = pk2(s[0 * 33], s[1 * 33]); o.y = pk2(s[2 * 33], s[3 * 33]); o.z = pk2(s[4 * 33], s[5 * 33]); o.w = pk2(s[6 * 33], s[7 * 33]);
        if (gn < N) { const int dr = (mode == 1) ? (gn < SRC_SPLIT ? gn : gn + 240) : gn + roff; *(v4u*)(WT + (size_t)dr * ldt + k0 + 8 * c) = o; } }
    LDS_WAIT(); asm volatile("" ::: "memory");
}

__device__ __forceinline__ void phase_prologue(const Frame& F0) {
    Frame F = launder(F0);
    LAS float* scr = (LAS float*)(F.lds + F.wave * 8704);
    const int gw = F.c * NWAVES + F.wave, NGW = F.G * NWAVES;
    constexpr int I_IN = (DM / 64) * ((NIN + 31) / 32), I_GT = (DM / 64) * (NG / 32), I_BR = (BW / 64) * (DM / 32), I_OUT = (DM / 64) * (DM / 32), I_UP = (DM / 64) * (DFF / 32), I_DN = (DFF / 64) * (DM / 32);
    constexpr int I_LAYER = I_IN + I_GT + 4 * I_BR + I_OUT + 2 * I_UP + I_DN;
    for (int it = gw; it < NLAYER * I_LAYER; it += NGW) {
        const int l = it / I_LAYER; int r = it - l * I_LAYER;
        bf16* W1 = WSP(bf16, WS_W1 + l * SZ_W1);
        if (r < I_IN) { tr_item(F.in[I_WIN] + (size_t)l * DM * NIN, DM, NIN, W1, DM, 1, 0, scr, r, F.lane); continue; } r -= I_IN;
        if (r < I_GT) { tr_item(F.in[I_WGATE] + (size_t)l * DM * NG, DM, NG, W1, DM, 0, NP, scr, r, F.lane); continue; } r -= I_GT;
        if (r < 4 * I_BR) { const int k = r / I_BR; tr_item(F.in[I_WBR] + ((size_t)l * 4 + k) * BW * DM, BW, DM, WSP(bf16, WS_WB + l * SZ_WB) + (size_t)k * DM * BW, BW, 0, 0, scr, r - k * I_BR, F.lane); continue; } r -= 4 * I_BR;
        if (r < I_OUT) { tr_item(F.in[I_WOUT] + (size_t)l * DM * DM, DM, DM, WSP(bf16, WS_WO + l * SZ_WO), DM, 0, 0, scr, r, F.lane); continue; } r -= I_OUT;
        if (r < I_UP) { tr_item(F.in[I_WUP] + (size_t)l * DM * DFF, DM, DFF, WSP(bf16, WS_WUV + l * SZ_WUV), DM, 0, 0, scr, r, F.lane); continue; } r -= I_UP;
        if (r < I_UP) { tr_item(F.in[I_WVAL] + (size_t)l * DM * DFF, DM, DFF, WSP(bf16, WS_WUV + l * SZ_WUV), DM, 0, DFF, scr, r, F.lane); continue; } r -= I_UP;
        tr_item(F.in[I_WDOWN] + (size_t)l * DFF * DM, DFF, DM, WSP(bf16, WS_WD + l * SZ_WD), DFF, 0, 0, scr, r, F.lane);
    }
    const int gt = F.c * NTHR + F.tid, NGT = F.G * NTHR;
    for (int i = gt; i < NLAYER * 240 * (DM / 8); i += NGT) { const int l = i / (240 * (DM / 8)), r = i - l * (240 * (DM / 8));
        *(v4u*)(WSP(bf16, WS_W1 + l * SZ_W1) + (size_t)(SRC_SPLIT + r / (DM / 8)) * DM + (r % (DM / 8)) * 8) = (v4u){0u, 0u, 0u, 0u}; }
    for (int i = gt; i < NLAYER * 1024; i += NGT) { const int l = i >> 10, c = i & 1023; WSP(float, WS_LB)[i] = l == 0 ? 0.f : sigm(F.in[I_HGLB][1024 + c] - F.in[I_HGLB][c]); }
    for (int i = gt; i < 2049 * 64; i += NGT) { const int p = i >> 6, j = i & 63; const float pos = p < 2048 ? (float)p : 16384.f;
        const float fr = powf(10000.f, -(float)j / 64.f); const float ang = pos * fr; WSP(f32x2, WS_ROPE)[i] = (f32x2){cosf(ang), sinf(ang)}; }
    for (int i = gt; i < M * (DM / 4); i += NGT) { const int row = i / (DM / 4), c4 = i - row * (DM / 4);
        f32x4 v = (f32x4){0.f, 0.f, 0.f, 0.f};
        if (row < MP) v = ((const f32x4*)F.in[I_XP])[(size_t)row * (DM / 4) + c4]; else if (row < MR) v = ((const f32x4*)F.in[I_XS])[(size_t)(row - MP) * (DM / 4) + c4];
        WSP(f32x4, WS_X0)[i] = v; }
}

__device__ __forceinline__ float wave_sum(float v) {
#pragma unroll
    for (int o = 1; o < 64; o <<= 1) v += __shfl_xor(v, o);
    return v;
}
__device__ __forceinline__ void phase_norm(const Frame& F0, const float* X, const float* g, bf16* H) {
    Frame F = launder(F0);
    const int gw = F.c * NWAVES + F.wave, NGW = F.G * NWAVES;
    for (int row = gw; row < M; row += NGW) {
        v2u* o8 = (v2u*)(H + (size_t)row * DM) + F.lane;
        if (row >= MR) {
#pragma unroll
            for (int j = 0; j < 8; ++j) o8[64 * j] = (v2u){0u, 0u};
            continue; }
        const f32x4* xr = (const f32x4*)(X + (size_t)row * DM) + F.lane;
        f32x4 v[8]; float s = 0.f;
#pragma unroll
        for (int j = 0; j < 8; ++j) { v[j] = xr[64 * j]; s += (v[j].x * v[j].x + v[j].y * v[j].y) + (v[j].z * v[j].z + v[j].w * v[j].w); }
        const float rstd = rsqrtf(wave_sum(s) * (1.f / DM) + EPS);
#pragma unroll
        for (int j = 0; j < 8; ++j) { const f32x4 gv = ((const f32x4*)g)[F.lane + 64 * j];
            o8[64 * j] = (v2u){pk2(v[j].x * rstd * gv.x, v[j].y * rstd * gv.y), pk2(v[j].z * rstd * gv.z, v[j].w * rstd * gv.w)}; }
    }
}
__device__ __forceinline__ void phase_final(const Frame& F0, const float* X, const float* g) {
    Frame F = launder(F0);
    const int gw = F.c * NWAVES + F.wave, NGW = F.G * NWAVES;
    for (int row = gw; row < MR; row += NGW) {
        const f32x4* xr = (const f32x4*)(X + (size_t)row * DM) + F.lane;
        f32x4* o = (f32x4*)(F.out + (row < MP ? O_YP + (size_t)row * DM : O_YS + (size_t)(row - MP) * DM)) + F.lane;
        f32x4 v[8]; float s = 0.f;
#pragma unroll
        for (int j = 0; j < 8; ++j) { v[j] = xr[64 * j]; s += (v[j].x * v[j].x + v[j].y * v[j].y) + (v[j].z * v[j].z + v[j].w * v[j].w); }
        const float rstd = rsqrtf(wave_sum(s) * (1.f / DM) + EPS);
#pragma unroll
        for (int j = 0; j < 8; ++j) { const f32x4 gv = ((const f32x4*)g)[F.lane + 64 * j]; o[64 * j] = v[j] * rstd * gv; }
    }
}

constexpr int LW_STR = 136;
constexpr int L_WT = 0, L_XC = 256 * LW_STR * 2, L_XCF = L_XC + 64 * LW_STR * 2, LXF_STR = 132;
static_assert(L_XCF + 64 * LXF_STR * 4 <= RING_BYTES, "lru lds");
__device__ __forceinline__ void lru_stage_w(const Frame& F0, int l, int n) {
    Frame F = launder(F0);
    LAS bf16* WT = (LAS bf16*)(F.lds + L_WT);
    const float* wa = F.in[I_LWA] + ((size_t)l * 8 + n) * 16384; const float* wx = F.in[I_LWX] + ((size_t)l * 8 + n) * 16384;
    for (int i = F.tid; i < 16384; i += NTHR) { const int c = i >> 7, d = i & 127;
        WT[d * LW_STR + c] = (bf16)f2bf(wa[i]); WT[(128 + d) * LW_STR + c] = (bf16)f2bf(wx[i]); }
}
__device__ __forceinline__ void lru_tile(const Frame& F0, int l, int n, int tt) {
    Frame F = launder(F0);
    LAS bf16* WT = (LAS bf16*)(F.lds + L_WT); LAS bf16* XC = (LAS bf16*)(F.lds + L_XC); LAS float* XCF = (LAS float*)(F.lds + L_XCF);
    const bf16* P = WSP(bf16, WS_P);
    const float* cw = F.in[I_LCW] + (size_t)l * 4 * 1024; const float* cb = F.in[I_LCB] + (size_t)l * 1024;
    {
        const int tk = F.tid >> 3, c0 = (F.tid & 7) * 16, row = tt * 64 + tk, ch0 = n * 128 + c0;
        float acc[16];
#pragma unroll
        for (int j = 0; j < 16; ++j) acc[j] = cb[ch0 + j];
        if (row < MP) {
            const int t = row & (SEQ - 1);
#pragma unroll
            for (int jj = 0; jj < 4; ++jj) { if (t - 3 + jj >= 0) { const v4u* src = (const v4u*)(P + (size_t)(row - 3 + jj) * NP + C_XA + ch0); const v4u a = src[0], b = src[1];
                const unsigned w[8] = {a.x, a.y, a.z, a.w, b.x, b.y, b.z, b.w}; const float* wj = cw + jj * 1024 + ch0;
#pragma unroll
                for (int q = 0; q < 8; ++q) { acc[2 * q] += wj[2 * q] * bflo(w[q]); acc[2 * q + 1] += wj[2 * q + 1] * bfhi(w[q]); } } }
        } else if (row < MR) {
            const int s = row - MP; const float* st = F.in[I_SLC] + ((size_t)l * 128 + s) * 3 * 1024 + ch0;
#pragma unroll
            for (int jj = 0; jj < 3; ++jj) { const float* wj = cw + jj * 1024 + ch0;
#pragma unroll
                for (int q = 0; q < 16; ++q) acc[q] += wj[q] * st[jj * 1024 + q]; }
            const v4u* src = (const v4u*)(P + (size_t)row * NP + C_XA + ch0); const v4u a = src[0], b = src[1];
            const unsigned w[8] = {a.x, a.y, a.z, a.w, b.x, b.y, b.z, b.w}; const float* wj = cw + 3 * 1024 + ch0;
#pragma unroll
            for (int q = 0; q < 8; ++q) { acc[2 * q] += wj[2 * q] * bflo(w[q]); acc[2 * q + 1] += wj[2 * q + 1] * bfhi(w[q]); }
        }
#pragma unroll
        for (int q = 0; q < 16; ++q) { XCF[tk * LXF_STR + c0 + q] = acc[q]; }
#pragma unroll
        for (int q = 0; q < 8; ++q) *(LAS unsigned*)(XC + tk * LW_STR + c0 + 2 * q) = pk2(acc[2 * q], acc[2 * q + 1]);
    }
    __syncthreads();
    const int w = F.wave, lane = F.lane, fr = lane & 15, g = lane >> 4;
    f32x4 ar[4], ai_[4];
#pragma unroll
    for (int rt = 0; rt < 4; ++rt) { ar[rt] = (f32x4){0.f, 0.f, 0.f, 0.f}; ai_[rt] = (f32x4){0.f, 0.f, 0.f, 0.f}; }
#pragma unroll
    for (int ks = 0; ks < 4; ++ks) {
        const bf16x8 br = *(const LAS bf16x8*)(WT + (16 * w + fr) * LW_STR + 32 * ks + 8 * g);
        const bf16x8 bi = *(const LAS bf16x8*)(WT + (128 + 16 * w + fr) * LW_STR + 32 * ks + 8 * g);
#pragma unroll
        for (int rt = 0; rt < 4; ++rt) { const bf16x8 a = *(const LAS bf16x8*)(XC + (16 * rt + fr) * LW_STR + 32 * ks + 8 * g);
            ar[rt] = __builtin_amdgcn_mfma_f32_16x16x32_bf16(a, br, ar[rt], 0, 0, 0); ai_[rt] = __builtin_amdgcn_mfma_f32_16x16x32_bf16(a, bi, ai_[rt], 0, 0, 0); }
    }
    const int d = 16 * w + fr, ch = n * 128 + d;
    const float ba = F.in[I_LBA][(size_t)l * 1024 + ch], bx = F.in[I_LBX][(size_t)l * 1024 + ch], sp = softplusf(-F.in[I_LLAM][(size_t)l * 1024 + ch]);
    float* LA = WSP(float, WS_X1); float* LU = LA + (size_t)M * 1024;
    const bool scan = (tt < 128);
    float CA = 1.f, CU = 0.f;
#pragma unroll
    for (int rt = 0; rt < 4; ++rt) {
        float A[4], U[4];
#pragma unroll
        for (int reg = 0; reg < 4; ++reg) { const int tk = 16 * rt + 4 * g + reg;
            const float r = sigm(ar[rt][reg] + ba), iv = sigm(ai_[rt][reg] + bx), la = -8.f * r * sp, a = __expf(la), xc = XCF[tk * LXF_STR + d];
            A[reg] = a; U[reg] = sqrtf(fmaxf(-expm1f(2.f * la), 0.f)) * (iv * xc); }
        if (scan) {
#pragma unroll
            for (int reg = 1; reg < 4; ++reg) { U[reg] = A[reg] * U[reg - 1] + U[reg]; A[reg] = A[reg] * A[reg - 1]; }
            float PA = 1.f, PU = 0.f, TA = 1.f, TU = 0.f;
#pragma unroll
            for (int src = 0; src < 4; ++src) { const float sa = __shfl(A[3], fr + 16 * src), su = __shfl(U[3], fr + 16 * src);
                if (src < g) { PU = sa * PU + su; PA = sa * PA; }
                TU = sa * TU + su; TA = sa * TA; }
            const float GA = PA * CA, GU = PA * CU + PU;
#pragma unroll
            for (int reg = 0; reg < 4; ++reg) { U[reg] = A[reg] * GU + U[reg]; A[reg] = A[reg] * GA; }
            CU = TA * CU + TU; CA = TA * CA;
        }
#pragma unroll
        for (int reg = 0; reg < 4; ++reg) { const size_t row = (size_t)tt * 64 + 16 * rt + 4 * g + reg; LA[row * 1024 + ch] = A[reg]; LU[row * 1024 + ch] = U[reg]; }
    }
    __syncthreads();
}
__device__ __forceinline__ void phase_conv(const Frame& F00, int l) {
    Frame F0 = launder(F00);
    { const int n = F0.c & 7; bool staged = false;
      for (int tt = F0.c >> 3; tt < 130; tt += (F0.G >> 3)) { if (!staged) { lru_stage_w(F0, l, n); __syncthreads(); staged = true; } lru_tile(F0, l, n, tt); } }
    Frame F = launder(F0);
    const bf16* P = WSP(bf16, WS_P);
    const int gt = F.c * NTHR + F.tid, NGT = F.G * NTHR;
    { const float* cw = F.in[I_SCW] + (size_t)l * 4 * SSD_CD; const float* cb = F.in[I_SCB] + (size_t)l * SSD_CD; bf16* XBC = WSP(bf16, WS_XBC);
      for (int i = gt; i < MR * (SSD_CD / 8); i += NGT) { const int row = i / (SSD_CD / 8), c = (i - row * (SSD_CD / 8)) * 8;
          float acc[8];
#pragma unroll
          for (int q = 0; q < 8; ++q) acc[q] = cb[c + q];
          if (row < MP) { const int t = row & (SEQ - 1);
#pragma unroll
              for (int jj = 0; jj < 4; ++jj) if (t - 3 + jj >= 0) { const v4u a = *(const v4u*)(P + (size_t)(row - 3 + jj) * NP + C_SX + c); const unsigned w[4] = {a.x, a.y, a.z, a.w}; const float* wj = cw + jj * SSD_CD + c;
#pragma unroll
                  for (int q = 0; q < 4; ++q) { acc[2 * q] += wj[2 * q] * bflo(w[q]); acc[2 * q + 1] += wj[2 * q + 1] * bfhi(w[q]); } }
          } else { const int s = row - MP; const float* st = F.in[I_SSC] + ((size_t)l * 128 + s) * 3 * SSD_CD + c;
#pragma unroll
              for (int jj = 0; jj < 3; ++jj) { const float* wj = cw + jj * SSD_CD + c;
#pragma unroll
                  for (int q = 0; q < 8; ++q) acc[q] += wj[q] * st[jj * SSD_CD + q]; }
              const v4u a = *(const v4u*)(P + (size_t)row * NP + C_SX + c); const unsigned w[4] = {a.x, a.y, a.z, a.w}; const float* wj = cw + 3 * SSD_CD + c;
#pragma unroll
              for (int q = 0; q < 4; ++q) { acc[2 * q] += wj[2 * q] * bflo(w[q]); acc[2 * q + 1] += wj[2 * q + 1] * bfhi(w[q]); } }
          v4u o; o.x = pk2(siluf(acc[0]), siluf(acc[1])); o.y = pk2(siluf(acc[2]), siluf(acc[3])); o.z = pk2(siluf(acc[4]), siluf(acc[5])); o.w = pk2(siluf(acc[6]), siluf(acc[7]));
          *(v4u*)(XBC + (size_t)row * SSD_CD + c) = o; } }
    { float* DT = WSP(float, WS_DT); for (int i = gt; i < MR * 16; i += NGT) DT[i] = softplusf(DT[i] + F.in[I_SDTB][l * 16 + (i & 15)]); }
    for (int i = gt; i < NBATCH * 3 * 1024; i += NGT) { const int b = i / 3072, r = i - b * 3072, j = r >> 10, c = r & 1023;
        F.out[O_LC_P + (size_t)l * NBATCH * 3072 + i] = bf2f(P[((size_t)b * SEQ + SEQ - 3 + j) * NP + C_XA + c]); }
    for (int i = gt; i < MS * 3 * 1024; i += NGT) { const int s = i / 3072, r = i - s * 3072, j = r >> 10, c = r & 1023;
        F.out[O_LC_S + (size_t)l * MS * 3072 + i] = j < 2 ? F.in[I_SLC][(size_t)l * MS * 3072 + (size_t)s * 3072 + (j + 1) * 1024 + c] : bf2f(P[((size_t)MP + s) * NP + C_XA + c]); }
    for (int i = gt; i < NBATCH * 3 * SSD_CD; i += NGT) { const int b = i / (3 * SSD_CD), r = i - b * 3 * SSD_CD, j = r / SSD_CD, c = r - j * SSD_CD;
        F.out[O_SC_P + (size_t)l * NBATCH * 3 * SSD_CD + i] = bf2f(P[((size_t)b * SEQ + SEQ - 3 + j) * NP + C_SX + c]); }
    for (int i = gt; i < MS * 3 * SSD_CD; i += NGT) { const int s = i / (3 * SSD_CD), r = i - s * 3 * SSD_CD, j = r / SSD_CD, c = r - j * SSD_CD;
        F.out[O_SC_S + (size_t)l * MS * 3 * SSD_CD + i] = j < 2 ? F.in[I_SSC][(size_t)l * MS * 3 * SSD_CD + (size_t)s * 3 * SSD_CD + (j + 1) * SSD_CD + c] : bf2f(P[((size_t)MP + s) * NP + C_SX + c]); }
}

constexpr int QS_STR = 136, KT_STR = 72;
template <int MODE> struct CK {
    static constexpr int V = (MODE == 2) ? 64 : 128, NVT = V / 16, NVW = NVT / 2, NH = (MODE == 2) ? 16 : 8;
    static constexpr int O_QS = 0, O_QH = O_QS + 64 * QS_STR * 2, O_KS = O_QH + (MODE == 0 ? 64 * QS_STR * 2 : 0), O_KT = O_KS + 64 * QS_STR * 2, O_VT = O_KT + 128 * KT_STR * 2,
        O_VD = O_VT + V * KT_STR * 2, O_XT = O_VD + (MODE == 0 ? 0 : V * KT_STR * 2), O_S0T = O_XT + (MODE == 2 ? 64 * KT_STR * 2 : 0), O_F32 = O_S0T + V * QS_STR * 2, O_END = O_F32 + 4096;
    static_assert(O_END <= RING_BYTES, "chunk unit LDS");
};
__device__ __forceinline__ bf16x8 mk_frag(v2u lo, v2u hi) { v4u t; t.x = lo.x; t.y = lo.y; t.z = hi.x; t.w = hi.y; return __builtin_bit_cast(bf16x8, t); }
template <int MODE>
__device__ __forceinline__ void chunk_unit(const Frame& F0, int l, int unit) {
    Frame F = launder(F0);
    typedef CK<MODE> C; constexpr int V = C::V, NVT = C::NVT, NVW = C::NVW, NH = C::NH;
    const int b = unit / NH, h = unit - b * NH;
    LAS bf16* QS = (LAS bf16*)(F.lds + C::O_QS); LAS bf16* QH = (LAS bf16*)(F.lds + C::O_QH); LAS bf16* KS = (LAS bf16*)(F.lds + C::O_KS); LAS bf16* KT = (LAS bf16*)(F.lds + C::O_KT);
    LAS bf16* VT = (LAS bf16*)(F.lds + C::O_VT); LAS bf16* VD = (LAS bf16*)(F.lds + C::O_VD); LAS bf16* XT = (LAS bf16*)(F.lds + C::O_XT); LAS bf16* S0T = (LAS bf16*)(F.lds + C::O_S0T);
    LAS float* FA = (LAS float*)(F.lds + C::O_F32);
    const bf16* P = WSP(bf16, WS_P); const bf16* XBC = WSP(bf16, WS_XBC); const float* LOGF = WSP(float, WS_HF); const float* DT = WSP(float, WS_DT);
    float* OUT = (MODE == 0) ? WSP(float, WS_OB) : (MODE == 1 ? WSP(float, WS_OB + 2 * SZ_O) : WSP(float, WS_OB + SZ_O));
    const int tid = F.tid, lane = F.lane, w = F.wave, fr = lane & 15, g = lane >> 4, tt = w & 3, vh = w >> 2;
    const float lg = (MODE == 1) ? log1pf(-exp2f(-5.f - (float)h)) : 0.f;
    float ssd_A = 0.f, ssd_D = 0.f;
    if (MODE == 2) { ssd_A = -__expf(F.in[I_SALOG][l * 16 + h]); ssd_D = F.in[I_SD][l * 16 + h]; }
    const int grp = h >> 3;
    for (int i = tid; i < V * QS_STR / 2; i += NTHR) ((LAS unsigned*)S0T)[i] = 0u;
    f32x4 S[NVT];
#pragma unroll
    for (int i = 0; i < NVT; ++i) S[i] = (f32x4){0.f, 0.f, 0.f, 0.f};
    float lf[16]; unsigned short qv[16], kv[16];
    v4u ra[10]; float rdt = 0.f;
    const int kd = tid & 127, seg = tid >> 7, stok = tid >> 3, sg = tid & 7;
    auto load_chunk = [&](int c) {
        const size_t rowb = (size_t)b * SEQ + 64 * c;
        if (MODE == 0) {
#pragma unroll
            for (int j = 0; j < 16; ++j) { const size_t row = rowb + 16 * seg + j; lf[j] = LOGF[row * 1024 + h * 128 + kd]; qv[j] = P[row * NP + C_HQ + h * 128 + kd]; kv[j] = P[row * NP + C_HF + h * 128 + kd]; }
            const bf16* vp = P + (rowb + stok) * NP + C_HI + h * 128 + 16 * sg; ra[0] = *(const v4u*)vp; ra[1] = *(const v4u*)(vp + 8);
        } else if (MODE == 1) {
            const bf16* rp = P + (rowb + stok) * NP + h * 128;
            ra[0] = *(const v4u*)(rp + C_RQ + 8 * sg); ra[1] = *(const v4u*)(rp + C_RQ + 64 + 8 * sg); ra[2] = *(const v4u*)(rp + C_RK + 8 * sg); ra[3] = *(const v4u*)(rp + C_RK + 64 + 8 * sg);
            const v4u* cp = (const v4u*)(WSP(f32x2, WS_ROPE) + (size_t)(64 * c + stok) * 64 + 8 * sg); ra[4] = cp[0]; ra[5] = cp[1]; ra[6] = cp[2]; ra[7] = cp[3];
            ra[8] = *(const v4u*)(rp + C_RV + 16 * sg); ra[9] = *(const v4u*)(rp + C_RV + 16 * sg + 8);
        } else {
            const bf16* xp = XBC + (rowb + stok) * SSD_CD;
            ra[0] = *(const v4u*)(xp + 1024 + grp * 128 + 16 * sg); ra[1] = *(const v4u*)(xp + 1024 + grp * 128 + 16 * sg + 8);
            ra[2] = *(const v4u*)(xp + 1280 + grp * 128 + 16 * sg); ra[3] = *(const v4u*)(xp + 1280 + grp * 128 + 16 * sg + 8);
            ra[4] = *(const v4u*)(xp + h * 64 + 8 * sg);
            rdt = DT[(rowb + lane) * 16 + h];
        }
    };
    auto stage_chunk = [&]() {
        if (MODE == 0) {
            float cs[16]; cs[0] = lf[0];
#pragma unroll
            for (int j = 1; j < 16; ++j) cs[j] = cs[j - 1] + lf[j];
            FA[seg * 128 + kd] = cs[15];
            __syncthreads();
            const float s0 = FA[kd], s1 = FA[128 + kd], s2 = FA[256 + kd], s3 = FA[384 + kd];
            const float off = (seg > 0 ? s0 : 0.f) + (seg > 1 ? s1 : 0.f) + (seg > 2 ? s2 : 0.f), beta = s0 + s1, bC = (s0 + s1) + (s2 + s3);
            unsigned ktp[8];
#pragma unroll
            for (int j = 0; j < 16; ++j) { const float bt = off + cs[j], q = bf2f(qv[j]), k = bf2f(kv[j]); const int t = 16 * seg + j;
                const unsigned qs = f2bf(q * __expf(fminf(bt - beta, 80.f))), qh = f2bf(q * __expf(bt)), kt = f2bf(k * __expf(fminf(beta - bt, 80.f)));
                QS[t * QS_STR + kd] = (bf16)qs; QH[t * QS_STR + kd] = (bf16)qh; KS[t * QS_STR + kd] = (bf16)kt;
                if (j & 1) ktp[j >> 1] |= kt << 16; else ktp[j >> 1] = kt; }
            *(LAS v4u*)(KT + kd * KT_STR + 16 * seg) = (v4u){ktp[0], ktp[1], ktp[2], ktp[3]}; *(LAS v4u*)(KT + kd * KT_STR + 16 * seg + 8) = (v4u){ktp[4], ktp[5], ktp[6], ktp[7]};
            if (seg == 0) { FA[512 + kd] = __expf(bC); FA[640 + kd] = __expf(bC - beta); }
            const unsigned vw[8] = {ra[0].x, ra[0].y, ra[0].z, ra[0].w, ra[1].x, ra[1].y, ra[1].z, ra[1].w};
#pragma unroll
            for (int i = 0; i < 8; ++i) { VT[(16 * sg + 2 * i) * KT_STR + stok] = (bf16)(vw[i] & 0xffffu); VT[(16 * sg + 2 * i + 1) * KT_STR + stok] = (bf16)(vw[i] >> 16); }
        } else if (MODE == 1) {
            const unsigned q1[4] = {ra[0].x, ra[0].y, ra[0].z, ra[0].w}, q2[4] = {ra[1].x, ra[1].y, ra[1].z, ra[1].w}, k1[4] = {ra[2].x, ra[2].y, ra[2].z, ra[2].w}, k2[4] = {ra[3].x, ra[3].y, ra[3].z, ra[3].w};
            const unsigned csw[16] = {ra[4].x, ra[4].y, ra[4].z, ra[4].w, ra[5].x, ra[5].y, ra[5].z, ra[5].w, ra[6].x, ra[6].y, ra[6].z, ra[6].w, ra[7].x, ra[7].y, ra[7].z, ra[7].w};
            unsigned qa[4], qb[4], ka[4], kb[4];
            const float ksc = 0.08838834764831845f;
#pragma unroll
            for (int i = 0; i < 4; ++i) {
                const float c0 = __uint_as_float(csw[4 * i]), s0 = __uint_as_float(csw[4 * i + 1]), c1 = __uint_as_float(csw[4 * i + 2]), s1 = __uint_as_float(csw[4 * i + 3]);
                const float a0 = bflo(q1[i]), a1 = bfhi(q1[i]), b0 = bflo(q2[i]), b1 = bfhi(q2[i]);
                const float qa0 = a0 * c0 - b0 * s0, qa1 = a1 * c1 - b1 * s1, qb0 = a0 * s0 + b0 * c0, qb1 = a1 * s1 + b1 * c1;
                const float e0 = bflo(k1[i]), e1 = bfhi(k1[i]), f0 = bflo(k2[i]), f1 = bfhi(k2[i]);
                const float ka0 = (e0 * c0 - f0 * s0) * ksc, ka1 = (e1 * c1 - f1 * s1) * ksc, kb0 = (e0 * s0 + f0 * c0) * ksc, kb1 = (e1 * s1 + f1 * c1) * ksc;
                qa[i] = pk2(qa0, qa1); qb[i] = pk2(qb0, qb1); ka[i] = pk2(ka0, ka1); kb[i] = pk2(kb0, kb1); }
            *(LAS v4u*)(QS + stok * QS_STR + 8 * sg) = (v4u){qa[0], qa[1], qa[2], qa[3]}; *(LAS v4u*)(QS + stok * QS_STR + 64 + 8 * sg) = (v4u){qb[0], qb[1], qb[2], qb[3]};
            *(LAS v4u*)(KS + stok * QS_STR + 8 * sg) = (v4u){ka[0], ka[1], ka[2], ka[3]}; *(LAS v4u*)(KS + stok * QS_STR + 64 + 8 * sg) = (v4u){kb[0], kb[1], kb[2], kb[3]};
#pragma unroll
            for (int i = 0; i < 4; ++i) { KT[(8 * sg + 2 * i) * KT_STR + stok] = (bf16)(ka[i] & 0xffffu); KT[(8 * sg + 2 * i + 1) * KT_STR + stok] = (bf16)(ka[i] >> 16);
                KT[(64 + 8 * sg + 2 * i) * KT_STR + stok] = (bf16)(kb[i] & 0xffffu); KT[(64 + 8 * sg + 2 * i + 1) * KT_STR + stok] = (bf16)(kb[i] >> 16); }
            const float ws = __expf(lg * (float)(63 - stok));
            const unsigned vw[8] = {ra[8].x, ra[8].y, ra[8].z, ra[8].w, ra[9].x, ra[9].y, ra[9].z, ra[9].w};
#pragma unroll
            for (int i = 0; i < 8; ++i) { const float v0 = bflo(vw[i]), v1 = bfhi(vw[i]);
                VT[(16 * sg + 2 * i) * KT_STR + stok] = (bf16)(vw[i] & 0xffffu); VT[(16 * sg + 2 * i + 1) * KT_STR + stok] = (bf16)(vw[i] >> 16);
                VD[(16 * sg + 2 * i) * KT_STR + stok] = (bf16)f2bf(v0 * ws); VD[(16 * sg + 2 * i + 1) * KT_STR + stok] = (bf16)f2bf(v1 * ws); }
        } else {
            float bs = rdt * ssd_A;
#pragma unroll
            for (int o = 1; o < 64; o <<= 1) { const float up = __shfl_up(bs, o); if (lane >= o) bs += up; }
            const float bC = __shfl(bs, 63), bmy = __shfl(bs, stok), dtm = __shfl(rdt, stok);
            if (w == 0) { FA[lane] = bs; FA[64 + lane] = __expf(bs); }
            *(LAS v4u*)(KS + stok * QS_STR + 16 * sg) = ra[0]; *(LAS v4u*)(KS + stok * QS_STR + 16 * sg + 8) = ra[1];
            *(LAS v4u*)(QS + stok * QS_STR + 16 * sg) = ra[2]; *(LAS v4u*)(QS + stok * QS_STR + 16 * sg + 8) = ra[3];
            const unsigned bw[8] = {ra[0].x, ra[0].y, ra[0].z, ra[0].w, ra[1].x, ra[1].y, ra[1].z, ra[1].w};
#pragma unroll
            for (int i = 0; i < 8; ++i) { KT[(16 * sg + 2 * i) * KT_STR + stok] = (bf16)(bw[i] & 0xffffu); KT[(16 * sg + 2 * i + 1) * KT_STR + stok] = (bf16)(bw[i] >> 16); }
            const float ws = __expf(bC - bmy);
            const unsigned xw[4] = {ra[4].x, ra[4].y, ra[4].z, ra[4].w};
#pragma unroll
            for (int i = 0; i < 4; ++i) { const float x0 = bflo(xw[i]), x1 = bfhi(xw[i]);
                XT[(8 * sg + 2 * i) * KT_STR + stok] = (bf16)(xw[i] & 0xffffu); XT[(8 * sg + 2 * i + 1) * KT_STR + stok] = (bf16)(xw[i] >> 16);
                VT[(8 * sg + 2 * i) * KT_STR + stok] = (bf16)f2bf(x0 * dtm); VT[(8 * sg + 2 * i + 1) * KT_STR + stok] = (bf16)f2bf(x1 * dtm);
                VD[(8 * sg + 2 * i) * KT_STR + stok] = (bf16)f2bf(x0 * dtm * ws); VD[(8 * sg + 2 * i + 1) * KT_STR + stok] = (bf16)f2bf(x1 * dtm * ws); }
        }
    };
    load_chunk(0);
    stage_chunk();
    __syncthreads();
    for (int c = 0; c < SEQ / 64; ++c) {
        if (c + 1 < SEQ / 64) load_chunk(c + 1);
        const size_t row0 = (size_t)b * SEQ + 64 * c;
        f32x4 sc[4];
#pragma unroll
        for (int st = 0; st < 4; ++st) { sc[st] = (f32x4){0.f, 0.f, 0.f, 0.f};
            if (st <= tt) {
#pragma unroll
                for (int ks = 0; ks < 4; ++ks) { const bf16x8 a = *(const LAS bf16x8*)(KS + (16 * st + fr) * QS_STR + 32 * ks + 8 * g), bq = *(const LAS bf16x8*)(QS + (16 * tt + fr) * QS_STR + 32 * ks + 8 * g);
                    sc[st] = __builtin_amdgcn_mfma_f32_16x16x32_bf16(a, bq, sc[st], 0, 0, 0); } } }
        const int tloc = 16 * tt + fr;
        float btt = 0.f; if (MODE == 2) btt = FA[tloc];
        unsigned pw[8];
#pragma unroll
        for (int st = 0; st < 4; ++st) { float vals[4];
#pragma unroll
            for (int reg = 0; reg < 4; ++reg) { const int s = 16 * st + 4 * g + reg; float x = sc[st][reg];
                if (MODE == 1) x *= __expf(lg * (float)(tloc - s));
                if (MODE == 2) x *= __expf(fminf(btt - FA[s], 0.f));
                vals[reg] = (st <= tt && s <= tloc) ? x : 0.f; }
            pw[2 * st] = pk2(vals[0], vals[1]); pw[2 * st + 1] = pk2(vals[2], vals[3]); }
        const bf16x8 pf0 = __builtin_bit_cast(bf16x8, ((v4u){pw[0], pw[1], pw[2], pw[3]})), pf1 = __builtin_bit_cast(bf16x8, ((v4u){pw[4], pw[5], pw[6], pw[7]}));
        LAS bf16* QX = (MODE == 0) ? QH : QS;
#pragma unroll
        for (int vi = 0; vi < NVW; ++vi) { const int vt = vh * NVW + vi; const LAS bf16* vrow = VT + (16 * vt + fr) * KT_STR;
            f32x4 o = (f32x4){0.f, 0.f, 0.f, 0.f}, oi = (f32x4){0.f, 0.f, 0.f, 0.f};
            { const bf16x8 bv = mk_frag(*(const LAS v2u*)(vrow + 4 * g), *(const LAS v2u*)(vrow + 16 + 4 * g)); o = __builtin_amdgcn_mfma_f32_16x16x32_bf16(pf0, bv, o, 0, 0, 0); }
            if (tt >= 2) { const bf16x8 bv = mk_frag(*(const LAS v2u*)(vrow + 32 + 4 * g), *(const LAS v2u*)(vrow + 48 + 4 * g)); o = __builtin_amdgcn_mfma_f32_16x16x32_bf16(pf1, bv, o, 0, 0, 0); }
#pragma unroll
            for (int ks = 0; ks < 4; ++ks) { const bf16x8 a = *(const LAS bf16x8*)(QX + (16 * tt + fr) * QS_STR + 32 * ks + 8 * g), bs = *(const LAS bf16x8*)(S0T + (16 * vt + fr) * QS_STR + 32 * ks + 8 * g);
                oi = __builtin_amdgcn_mfma_f32_16x16x32_bf16(a, bs, oi, 0, 0, 0); }
#pragma unroll
            for (int reg = 0; reg < 4; ++reg) { const int t = 16 * tt + 4 * g + reg; float val;
                if (MODE == 0) val = o[reg] + oi[reg];
                else if (MODE == 1) val = o[reg] + __expf(lg * (float)(t + 1)) * oi[reg];
                else val = o[reg] + FA[64 + t] * oi[reg] + ssd_D * bf2f(XT[(16 * vt + fr) * KT_STR + t]);
                OUT[(row0 + t) * 1024 + h * V + 16 * vt + fr] = val; } }
        { const LAS bf16* VX = (MODE == 0) ? VT : VD;
          float e1[4], e2[4];
#pragma unroll
          for (int reg = 0; reg < 4; ++reg) { if (MODE == 0) { e1[reg] = FA[512 + 16 * w + 4 * g + reg]; e2[reg] = FA[640 + 16 * w + 4 * g + reg]; } else if (MODE == 1) { e1[reg] = __expf(lg * 64.f); e2[reg] = 1.f; } else { e1[reg] = FA[64 + 63]; e2[reg] = 1.f; } }
          const bf16x8 ka0 = *(const LAS bf16x8*)(KT + (16 * w + fr) * KT_STR + 8 * g), ka1 = *(const LAS bf16x8*)(KT + (16 * w + fr) * KT_STR + 32 + 8 * g);
#pragma unroll
          for (int vt = 0; vt < NVT; ++vt) { f32x4 d = (f32x4){0.f, 0.f, 0.f, 0.f};
              const bf16x8 b0 = *(const LAS bf16x8*)(VX + (16 * vt + fr) * KT_STR + 8 * g), b1 = *(const LAS bf16x8*)(VX + (16 * vt + fr) * KT_STR + 32 + 8 * g);
              d = __builtin_amdgcn_mfma_f32_16x16x32_bf16(ka0, b0, d, 0, 0, 0); d = __builtin_amdgcn_mfma_f32_16x16x32_bf16(ka1, b1, d, 0, 0, 0);
#pragma unroll
              for (int reg = 0; reg < 4; ++reg) S[vt][reg] = e1[reg] * S[vt][reg] + e2[reg] * d[reg]; } }
        __syncthreads();
#pragma unroll
        for (int vt = 0; vt < NVT; ++vt) *(LAS v2u*)(S0T + (16 * vt + fr) * QS_STR + 16 * w + 4 * g) = (v2u){pk2(S[vt][0], S[vt][1]), pk2(S[vt][2], S[vt][3])};
        if (c + 1 < SEQ / 64) stage_chunk();
        __syncthreads();
    }
    float* so = F.out + (MODE == 0 ? O_HG_P : (MODE == 1 ? O_RET_P : O_SSD_P)) + (((size_t)l * NBATCH + b) * NH + h) * (128 * V);
#pragma unroll
    for (int vt = 0; vt < NVT; ++vt)
#pragma unroll
        for (int reg = 0; reg < 4; ++reg) so[(size_t)(16 * w + 4 * g + reg) * V + 16 * vt + fr] = S[vt][reg];
}

constexpr int TB = 16;
constexpr int R_DEC = 0, R_KK = TB * 128 * 4, R_Q = 2 * TB * 128 * 4, R_VV = 3 * TB * 128 * 4, R_XS = R_VV + TB * 64 * 4, R_DSC = R_XS + TB * 64 * 4;
template <int MODE>
__device__ __forceinline__ void samp_unit(const Frame& F0, int l, int pair) {
    Frame F = launder(F0);
    constexpr int V = (MODE == 2) ? 64 : 128, NH = (MODE == 2) ? 16 : 8, NKR = (MODE == 2) ? 32 : 16, NJ = 128 / NKR;
    const int s = pair / NH, h = pair - s * NH; const size_t row = MP + s;
    LAS float* DEC = (LAS float*)(F.lds + R_DEC); LAS float* KK = (LAS float*)(F.lds + R_KK); LAS float* Q = (LAS float*)(F.lds + R_Q);
    LAS float* VV = (LAS float*)(F.lds + R_VV); LAS float* XS = (LAS float*)(F.lds + R_XS); LAS float* DSC = (LAS float*)(F.lds + R_DSC);
    LAS float* RED = (LAS float*)(F.lds + 65536);
    const bf16* P = WSP(bf16, WS_P); const bf16* XBC = WSP(bf16, WS_XBC);
    const int tid = F.tid;
    if (MODE == 0) {
        if (tid < 128) { const int k = tid; DEC[k] = __expf(WSP(float, WS_HF)[row * 1024 + h * 128 + k]); KK[k] = bf2f(P[row * NP + C_HF + h * 128 + k]); Q[k] = bf2f(P[row * NP + C_HQ + h * 128 + k]);
            VV[k] = bf2f(P[row * NP + C_HI + h * 128 + k]); }
    } else if (MODE == 1) {
        if (tid < 64) { const int j = tid;
            const float q1 = bf2f(P[row * NP + C_RQ + h * 128 + j]), q2 = bf2f(P[row * NP + C_RQ + h * 128 + 64 + j]);
            const float k1 = bf2f(P[row * NP + C_RK + h * 128 + j]), k2 = bf2f(P[row * NP + C_RK + h * 128 + 64 + j]);
            const f32x2 cs = WSP(f32x2, WS_ROPE)[2048 * 64 + j];
            Q[j] = q1 * cs.x - q2 * cs.y; Q[64 + j] = q1 * cs.y + q2 * cs.x;
            KK[j] = (k1 * cs.x - k2 * cs.y) * 0.08838834764831845f; KK[64 + j] = (k1 * cs.y + k2 * cs.x) * 0.08838834764831845f; }
        else if (tid < 192) { const int v = tid - 64; VV[v] = bf2f(P[row * NP + C_RV + h * 128 + v]); DEC[v] = 1.f - exp2f(-5.f - (float)h); }
    } else {
        if (tid < 320) { const int ch = tid, grp = h >> 3;
            const int cidx = ch < 64 ? h * 64 + ch : (ch < 192 ? 1024 + grp * 128 + (ch - 64) : 1280 + grp * 128 + (ch - 192));
            const float val = bf2f(XBC[row * SSD_CD + cidx]);
            if (ch < 64) { const float dtv = WSP(float, WS_DT)[row * 16 + h]; XS[ch] = val; VV[ch] = val * dtv;
                if (ch == 0) DSC[0] = __expf(dtv * (-__expf(F.in[I_SALOG][l * 16 + h]))); }
            else if (ch < 192) KK[ch - 64] = val; else Q[ch - 192] = val; }
    }
    __syncthreads();
    const int v4 = (MODE == 2) ? (tid & 15) : (tid & 31), kr = (MODE == 2) ? (tid >> 4) : (tid >> 5);
    const float* sin_ = F.in[MODE == 0 ? I_SHG : (MODE == 1 ? I_SRET : I_SSSD)] + (((size_t)l * 128 + s) * NH + h) * (128 * V);
    float* sout = F.out + (MODE == 0 ? O_HG_S : (MODE == 1 ? O_RET_S : O_SSD_S)) + (((size_t)l * 128 + s) * NH + h) * (128 * V);
    const f32x4 vv = *(const LAS f32x4*)(VV + 4 * v4);
    f32x4 sv[NJ];
#pragma unroll
    for (int j = 0; j < NJ; ++j) sv[j] = *(const f32x4*)(sin_ + (size_t)(kr + NKR * j) * V + 4 * v4);
    f32x4 po = (f32x4){0.f, 0.f, 0.f, 0.f};
#pragma unroll
    for (int j = 0; j < NJ; ++j) { const int k = kr + NKR * j; const float dec = (MODE == 2) ? DSC[0] : DEC[k]; const float kk = KK[k], q = Q[k];
        const f32x4 sn = sv[j] * dec + vv * kk; *(f32x4*)(sout + (size_t)k * V + 4 * v4) = sn; po += sn * q; }
    *(LAS f32x4*)(RED + kr * V + 4 * v4) = po;
    __syncthreads();
    if (tid < V) { float o = 0.f;
#pragma unroll
        for (int r = 0; r < NKR; ++r) o += RED[r * V + tid];
        if (MODE == 2) o += F.in[I_SD][l * 16 + h] * XS[tid];
        float* OUT = (MODE == 0) ? WSP(float, WS_OB) : (MODE == 1 ? WSP(float, WS_OB + 2 * SZ_O) : WSP(float, WS_OB + SZ_O));
        OUT[row * 1024 + h * V + tid] = o; }
    __syncthreads();
}

constexpr int CW_QUEUE = 8192;
__device__ __forceinline__ void phase_mix(const Frame& F0, int l) {
    Frame F = launder(F0);
    { const int w = F.c;
        if (w < 32) chunk_unit<0>(F, l, w);
        else if (w < 64) chunk_unit<1>(F, l, w - 32);
        else if (w < 128) chunk_unit<2>(F, l, w - 64);
    }
    __syncthreads();
    volatile LAS unsigned* QW = (volatile LAS unsigned*)(F.lds + LDSCTL_OFF) + 16;
    unsigned* qhead = (unsigned*)(F.ws + WS_CTL) + CW_QUEUE + 64 * l;
    for (;;) {
        if (F.tid == 0) QW[0] = __hip_atomic_fetch_add(qhead, 1u, __ATOMIC_RELAXED, __HIP_MEMORY_SCOPE_AGENT);
        __syncthreads();
        const int p = (int)QW[0];
        __syncthreads();
        if (p >= 4096) break;
        if (p < 1024) samp_unit<0>(F, l, p); else if (p < 2048) samp_unit<1>(F, l, p - 1024); else samp_unit<2>(F, l, p - 2048);
    }
}

__device__ __forceinline__ void phase_post(const Frame& F0, int l) {
    Frame F = launder(F0);
    const bf16* P = WSP(bf16, WS_P);
    const float* LA = WSP(float, WS_X1); const float* LU = LA + (size_t)M * 1024;
    bf16* BR = WSP(bf16, WS_BR);
    const int gt = F.c * NTHR + F.tid, NGT = F.G * NTHR, gw = F.c * NWAVES + F.wave, NGW = F.G * NWAVES, lane = F.lane;
    for (int task = gw; task < NBATCH * 16 * 32; task += NGW) {
        const int b = task >> 9, cg = (task >> 5) & 15, j = task & 31, ch = cg * 64 + lane;
        float h = 0.f;
        for (int jj = 0; jj < j; ++jj) { const size_t row = (size_t)b * SEQ + 64 * jj + 63; h = LA[row * 1024 + ch] * h + LU[row * 1024 + ch]; }
        float hv = 0.f;
        for (int t0 = 0; t0 < 64; t0 += 16) {
            float a[16], u[16], y[16];
#pragma unroll
            for (int q = 0; q < 16; ++q) { const size_t row = (size_t)b * SEQ + 64 * j + t0 + q; a[q] = LA[row * 1024 + ch]; u[q] = LU[row * 1024 + ch]; y[q] = bf2f(P[row * NP + C_YA + ch]); }
#pragma unroll
            for (int q = 0; q < 16; ++q) { const size_t row = (size_t)b * SEQ + 64 * j + t0 + q; hv = a[q] * h + u[q]; BR[row * BW + ch] = (bf16)f2bf(hv * y[q]); }
        }
        if (j == 31) F.out[O_LH_P + ((size_t)l * NBATCH + b) * 1024 + ch] = hv;
    }
    for (int i = gt; i < MS * 1024; i += NGT) { const int s = i >> 10, ch = i & 1023; const size_t row = MP + s;
        const float hp = F.in[I_SLH][((size_t)l * 128 + s) * 1024 + ch]; const float h = LA[row * 1024 + ch] * hp + LU[row * 1024 + ch];
        F.out[O_LH_S + ((size_t)l * 128 + s) * 1024 + ch] = h; BR[row * BW + ch] = (bf16)f2bf(h * bf2f(P[row * NP + C_YA + ch])); }
    for (int task = gw; task < MR * 3; task += NGW) {
        const int row = task / 3, br = task - row * 3;
        const f32x4* src = (const f32x4*)(WSP(float, WS_OB + (size_t)br * SZ_O) + (size_t)row * 1024 + 16 * lane);
        float x[16];
#pragma unroll
        for (int j = 0; j < 4; ++j) { const f32x4 v = src[j]; x[4 * j] = v.x; x[4 * j + 1] = v.y; x[4 * j + 2] = v.z; x[4 * j + 3] = v.w; }
        const int gcol = (br == 0) ? C_HGG : (br == 1 ? C_SZ : C_RG);
        const v4u* gp = (const v4u*)(P + (size_t)row * NP + gcol + 16 * lane); const v4u ga = gp[0], gb = gp[1];
        const unsigned gw_[8] = {ga.x, ga.y, ga.z, ga.w, gb.x, gb.y, gb.z, gb.w};
        float gt_[16];
#pragma unroll
        for (int q = 0; q < 8; ++q) { gt_[2 * q] = bflo(gw_[q]); gt_[2 * q + 1] = bfhi(gw_[q]); }
        float o[16];
        if (br == 1) {
            float ss = 0.f;
#pragma unroll
            for (int j = 0; j < 16; ++j) { x[j] *= gt_[j]; ss += x[j] * x[j]; }
#pragma unroll
            for (int m = 1; m < 32; m <<= 1) ss += __shfl_xor(ss, m);
            const float rs = rsqrtf(ss * (1.f / 512.f) + EPS); const float* nw = F.in[I_SNW] + (size_t)l * 1024 + 16 * lane;
#pragma unroll
            for (int j = 0; j < 16; ++j) o[j] = x[j] * rs * nw[j];
        } else {
            float ss = 0.f;
#pragma unroll
            for (int j = 0; j < 16; ++j) ss += x[j] * x[j];
#pragma unroll
            for (int m = 1; m < 8; m <<= 1) ss += __shfl_xor(ss, m);
            const float rs = rsqrtf(ss * (1.f / 128.f) + EPS);
            if (br == 0) { const float* nw = F.in[I_HGNW] + (size_t)l * 128 + ((16 * lane) & 127);
#pragma unroll
                for (int j = 0; j < 16; ++j) o[j] = x[j] * rs * nw[j] * gt_[j]; }
            else {
#pragma unroll
                for (int j = 0; j < 16; ++j) o[j] = x[j] * rs * gt_[j]; }
        }
        v4u w0, w1; w0.x = pk2(o[0], o[1]); w0.y = pk2(o[2], o[3]); w0.z = pk2(o[4], o[5]); w0.w = pk2(o[6], o[7]); w1.x = pk2(o[8], o[9]); w1.y = pk2(o[10], o[11]); w1.z = pk2(o[12], o[13]); w1.w = pk2(o[14], o[15]);
        v4u* dst = (v4u*)(BR + (size_t)(br + 1) * M * BW + (size_t)row * BW + 16 * lane); dst[0] = w0; dst[1] = w1;
    }
}

__device__ __forceinline__ void phase_act(const Frame& F0, int l) {
    Frame F = launder(F0);
    const bf16* UV = WSP(bf16, WS_P); bf16* A2 = WSP(bf16, WS_G);
    const float* cw = F.in[I_FCW] + (size_t)l * 3 * DFF; const float* cb = F.in[I_FCB] + (size_t)l * DFF;
    const int gt = F.c * NTHR + F.tid, NGT = F.G * NTHR;
    constexpr int C8 = DFF / 8;
    for (int i = gt; i < M * C8; i += NGT) {
        const int row = i / C8, c = (i - row * C8) * 8;
        v4u outw = (v4u){0u, 0u, 0u, 0u};
        if (row < MR) {
            const v4u uw = *(const v4u*)(UV + (size_t)row * NUV + c), vw = *(const v4u*)(UV + (size_t)row * NUV + DFF + c);
            float u0[8] = {bflo(uw.x), bfhi(uw.x), bflo(uw.y), bfhi(uw.y), bflo(uw.z), bfhi(uw.z), bflo(uw.w), bfhi(uw.w)};
            const float vv[8] = {bflo(vw.x), bfhi(vw.x), bflo(vw.y), bfhi(vw.y), bflo(vw.z), bfhi(vw.z), bflo(vw.w), bfhi(vw.w)};
            float u1[8], u2[8];
#pragma unroll
            for (int j = 0; j < 8; ++j) { u1[j] = 0.f; u2[j] = 0.f; }
            if (row < MP) { const int t = row & (SEQ - 1);
                if (t >= 1) { const v4u w = *(const v4u*)(UV + (size_t)(row - 1) * NUV + c); u1[0] = bflo(w.x); u1[1] = bfhi(w.x); u1[2] = bflo(w.y); u1[3] = bfhi(w.y); u1[4] = bflo(w.z); u1[5] = bfhi(w.z); u1[6] = bflo(w.w); u1[7] = bfhi(w.w); }
                if (t >= 2) { const v4u w = *(const v4u*)(UV + (size_t)(row - 2) * NUV + c); u2[0] = bflo(w.x); u2[1] = bfhi(w.x); u2[2] = bflo(w.y); u2[3] = bfhi(w.y); u2[4] = bflo(w.z); u2[5] = bfhi(w.z); u2[6] = bflo(w.w); u2[7] = bfhi(w.w); }
                if (t >= SEQ - 2) { float* so = F.out + O_FC_P + (((size_t)l * NBATCH + (row >> 11)) * 2 + (t - (SEQ - 2))) * DFF + c;
#pragma unroll
                    for (int j = 0; j < 8; ++j) so[j] = u0[j]; }
            } else { const int s = row - MP; const float* st = F.in[I_SFC] + ((size_t)l * MS + s) * 2 * DFF + c; float* so = F.out + O_FC_S + ((size_t)l * MS + s) * 2 * DFF + c;
#pragma unroll
                for (int j = 0; j < 8; ++j) { u2[j] = st[j]; u1[j] = st[DFF + j]; so[j] = st[DFF + j]; so[DFF + j] = u0[j]; } }
            float a[8];
#pragma unroll
            for (int j = 0; j < 8; ++j) { const float y = cb[c + j] + cw[c + j] * u2[j] + cw[DFF + c + j] * u1[j] + cw[2 * DFF + c + j] * u0[j]; a[j] = geluf(y) * vv[j]; }
            outw.x = pk2(a[0], a[1]); outw.y = pk2(a[2], a[3]); outw.z = pk2(a[4], a[5]); outw.w = pk2(a[6], a[7]);
        }
        *(v4u*)(A2 + (size_t)row * DFF + c) = outw;
    }
}

constexpr int PH_PER_LAYER = 11, NPHASE = 1 + NLAYER * PH_PER_LAYER + 1;
__global__ void __launch_bounds__(NTHR, 2) mk_fwd(Args args) {
    extern __shared__ __attribute__((aligned(16))) unsigned char lds_raw[];
    Frame F;
    F.lds = (LAS unsigned char*)lds_raw;
    F.tid = threadIdx.x; F.lane = F.tid & 63; F.wave = __builtin_amdgcn_readfirstlane(F.tid >> 6);
    F.G = gridDim.x; F.c = blockIdx.x;
    F.in = args.in; F.out = args.out; F.ws = args.ws;
    volatile LAS unsigned* MISC = (volatile LAS unsigned*)(F.lds + LDSCTL_OFF);
    if (F.tid < 64) MISC[F.tid] = 0u;
    __syncthreads();
    unsigned* barw = (unsigned*)(F.ws + WS_CTL) + 4096;
    XcdBarrier bar; bar.bar = barw; bar.x = 0; bar.st = nullptr;
    if (!MK_SPLIT) bar = xcd_barrier_post(barw, MISC + 8);
    const int lo = args.ph_lo, hi = args.ph_hi;
#define IN(k) (lo <= (k) && (k) < hi)
#define SEAM(k) do { if (IN(k) && IN((k) + 1)) xcd_barrier(bar); } while (0)
#define X0 WSP(float, WS_X0)
#define X1 WSP(float, WS_X1)
#define H WSP(bf16, WS_H)
#define GEMM_RUN(EPI) do { pg8::gemm_phase<EPI, pg8::TileOrder>(F.lds, g, S, E); if (REP_G > 1) { Frame F1 = launder(F); pg8::gemm_phase<EPI, pg8::TileOrder>(F1.lds, g, S, E); } } while (0)

    if (IN(0) && !(SKMASK & 1)) { phase_prologue(F); } SEAM(0);

    for (int l = 0; l < NLAYER; ++l) {
        const int pb = 1 + l * PH_PER_LAYER;
        if (IN(pb + 0) && !(SKMASK & 2)) { phase_norm(F, X0, F.in[I_GMIX] + (size_t)l * DM, H); } SEAM(pb + 0);
        if (IN(pb + 1) && !(SKMASK & 4)) { const Frame F0 = F; Frame F = launder(F0);
            pg8::Gemm g{H, WSP(bf16, WS_W1 + l * SZ_W1), DM, DM, DM, 0, 0}; pg8::TileOrder S; S.init(M, N1, F.G, F.c, 1);
            Epi1 E{WSP(bf16, WS_P), WSP(float, WS_HF), WSP(float, WS_DT), WSP(bf16, WS_G), WSP(float, WS_LB) + l * 1024};
            GEMM_RUN(Epi1);
        } SEAM(pb + 1);
        if (IN(pb + 2) && !(SKMASK & 8)) { phase_conv(F, l); if (REP_CONV > 1) phase_conv(F, l); } SEAM(pb + 2);
        if (IN(pb + 3) && !(SKMASK & 16)) { phase_mix(F, l); if (REP_MIX > 1) phase_mix(F, l); } SEAM(pb + 3);
        if (IN(pb + 4) && !(SKMASK & 32)) { phase_post(F, l); if (REP_POST > 1) phase_post(F, l); } SEAM(pb + 4);
        if (IN(pb + 5) && !(SKMASK & 64)) { const Frame F0 = F; Frame F = launder(F0);
            pg8::Gemm g{WSP(bf16, WS_BR), WSP(bf16, WS_WB + l * SZ_WB), BW, BW, BW, (size_t)M * BW, (size_t)DM * BW}; pg8::TileOrder S; S.init(M, DM, F.G, F.c, 4);
            EpiBr E{WSP(bf16, WS_G), WSP(bf16, WS_MG)};
            GEMM_RUN(EpiBr);
        } SEAM(pb + 5);
        if (IN(pb + 6) && !(SKMASK & 128)) { const Frame F0 = F; Frame F = launder(F0);
            pg8::Gemm g{WSP(bf16, WS_MG), WSP(bf16, WS_WO + l * SZ_WO), DM, DM, DM, 0, 0}; pg8::TileOrder S; S.init(M, DM, F.G, F.c, 1);
            EpiRes E{X0, X1};
            GEMM_RUN(EpiRes);
        } SEAM(pb + 6);
        if (IN(pb + 7) && !(SKMASK & 256)) { phase_norm(F, X1, F.in[I_GFFN] + (size_t)l * DM, H); } SEAM(pb + 7);
        if (IN(pb + 8) && !(SKMASK & 512)) { const Frame F0 = F; Frame F = launder(F0);
            pg8::Gemm g{H, WSP(bf16, WS_WUV + l * SZ_WUV), DM, DM, DM, 0, 0}; pg8::TileOrder S; S.init(M, NUV, F.G, F.c, 1);
            EpiB E{WSP(bf16, WS_P), NUV};
            GEMM_RUN(EpiB);
        } SEAM(pb + 8);
        if (IN(pb + 9) && !(SKMASK & 1024)) { phase_act(F, l); } SEAM(pb + 9);
        if (IN(pb + 10) && !(SKMASK & 2048)) { const Frame F0 = F; Frame F = launder(F0);
            pg8::Gemm g{WSP(bf16, WS_G), WSP(bf16, WS_WD + l * SZ_WD), DFF, DFF, DFF, 0, 0}; pg8::TileOrder S; S.init(M, DM, F.G, F.c, 1);
            EpiRes E{X1, X0};
            GEMM_RUN(EpiRes);
        } SEAM(pb + 10);
    }
    if (IN(NPHASE - 1) && !(SKMASK & 4096)) { phase_final(F, WSP(float, WS_X0), F.in[I_GFIN]); }
#undef IN
#undef SEAM
#undef X0
#undef X1
#undef H
#undef GEMM_RUN
}

extern "C" void kernel_launch(void* const* d_in, const int* in_sizes, int n_in, void* d_out, int out_size, void* d_ws, size_t ws_size, hipStream_t stream) {
    static int grid = 0;
    if (grid == 0) {
        if (n_in != N_INPUTS || (size_t)out_size != O_END || ws_size < WS_END) { fprintf(stderr, "kernel_launch: unexpected shapes: n_in %d out %d ws %zu (need %zu)\n", n_in, out_size, ws_size, (size_t)WS_END); grid = -1; return; }
        int dev = 0, cus = 0, per_cu = 0;
        if (hipGetDevice(&dev) != hipSuccess || hipDeviceGetAttribute(&cus, hipDeviceAttributeMultiprocessorCount, dev) != hipSuccess) { grid = -1; return; }
        if (hipFuncSetAttribute((const void*)mk_fwd, hipFuncAttributeMaxDynamicSharedMemorySize, LDS_BYTES) != hipSuccess) { fprintf(stderr, "kernel_launch: hipFuncSetAttribute failed\n"); grid = -1; return; }
        if (hipOccupancyMaxActiveBlocksPerMultiprocessor(&per_cu, (const void*)mk_fwd, NTHR, LDS_BYTES) != hipSuccess || per_cu < 1) { fprintf(stderr, "kernel_launch: occupancy query says %d\n", per_cu); }
        (void)hipGetLastError();
        grid = cus;
    }
    if (grid < 0) return;
    (void)hipMemsetAsync((char*)d_ws + WS_CTL, 0, CTL_BYTES, stream);
    Args a{};
    for (int i = 0; i < N_INPUTS; ++i) a.in[i] = (const float*)d_in[i];
    a.out = (float*)d_out; a.ws = (unsigned char*)d_ws;
#if MK_SPLIT
    for (int p = 0; p < NPHASE; ++p) { a.ph_lo = p; a.ph_hi = p + 1; hipLaunchKernelGGL(mk_fwd, dim3(grid), dim3(NTHR), LDS_BYTES, stream, a); }
#else
    a.ph_lo = 0; a.ph_hi = NPHASE;
    hipLaunchKernelGGL(mk_fwd, dim3(grid), dim3(NTHR), LDS_BYTES, stream, a);
#endif
}
```

```cpp
#include <hip/hip_runtime.h>
#include <cstdio>
#include <cstdint>

#ifndef REP_G
#define REP_G 1
#endif
#ifndef REP_CONV
#define REP_CONV 1
#endif
#ifndef REP_MIX
#define REP_MIX 1
#endif
#ifndef REP_POST
#define REP_POST 1
#endif
#ifndef SKMASK
#define SKMASK 0
#endif
#ifndef MK_SPLIT
#define MK_SPLIT 0
#endif

namespace pg8 {
#define PG8_LAS __attribute__((address_space(3)))
typedef unsigned short bf16_t;
typedef short bf16x8 __attribute__((ext_vector_type(8)));
typedef float f32x4 __attribute__((ext_vector_type(4)));
typedef unsigned u32x4 __attribute__((ext_vector_type(4)));
constexpr int BM = 256, BK = 64, HALF = 128, HTB = HALF * BK * 2, STAGE_BYTES = 8 * HTB, NXCD = 8, WGM = 8;

__host__ __device__ __forceinline__ int lds_byte(int r, int c) { const int st = (r >> 4) * 2 + (c >> 5), rr = r & 15, cc = c & 31, ob = rr * 64 + cc * 2; return st * 1024 + (ob ^ (((ob >> 9) & 1) << 5)); }
__host__ __device__ __forceinline__ void stage_rc(int b, int& R, int& C) { const int st = b / 1024, sb = b % 1024, swz = sb ^ (((sb >> 9) & 1) << 5); R = (st >> 1) * 16 + swz / 64; C = (st & 1) * 32 + (swz % 64) / 2; }
__host__ __device__ __forceinline__ int perm32(int rho) { const int n = rho >> 4, i = rho & 15; return 8 * (i >> 2) + 4 * n + (i & 3); }

struct Unit { int pm, pn, kz; };
struct Gemm { const bf16_t* A; const bf16_t* Bt; int lda, ldb, K; size_t azs, bzs; };

struct TileOrder {
    int nM, nN, nwg, G, c, nkz;
    __device__ void init(int M, int N, int G_, int c_, int nkz_) { nM = M / BM; nN = N / BM; nwg = nM * nN; G = G_; c = c_; nkz = nkz_; }
    __device__ bool next(int i, Unit& u) const {
        const int ti = i / nkz; u.kz = i - ti * nkz;
        const long L = (long)ti * G + c; if (L >= nwg) return false;
        int wgid = (int)L; { const int q = nwg / NXCD, r = nwg % NXCD, xcd = wgid % NXCD, off = wgid / NXCD; wgid = (xcd < r ? xcd * (q + 1) : r * (q + 1) + (xcd - r) * q) + off; }
        const int nig = WGM * nN, gid = wgid / nig, fm = gid * WGM, gsz = (nM - fm) < WGM ? (nM - fm) : WGM;
        u.pm = fm + ((wgid % nig) % gsz); u.pn = (wgid % nig) / gsz; return true;
    }
};

__device__ __forceinline__ unsigned cvt_pk_bf16(float lo, float hi) { unsigned r; asm volatile("v_cvt_pk_bf16_f32 %0, %1, %2" : "=v"(r) : "v"(lo), "v"(hi)); return r; }

template <class Epi, class Sched, bool ALIGN_EPI = true>
__device__ __forceinline__ void gemm_phase(PG8_LAS unsigned char* lds, const Gemm g, const Sched& S, const Epi& E) {
    int tid = threadIdx.x; asm volatile("" : "+v"(tid));
    const int wid = __builtin_amdgcn_readfirstlane(tid >> 6), lane = tid & 63, wr = wid >> 2, wc = wid & 3, fr = lane & 15, fq = lane >> 4;
    const int K = g.K, nt = K / BK;
    unsigned voffA[2], voffB[2];
#pragma unroll
    for (int i = 0; i < 2; ++i) { int R, C; stage_rc(tid * 16 + i * 8192, R, C); const int Rb = Epi::PERM ? ((R & ~31) + perm32(R & 31)) : R;
        voffA[i] = (unsigned)(R * g.lda + C) * 2u; voffB[i] = (unsigned)(Rb * g.ldb + C) * 2u; }
    const size_t kstep = (size_t)(BK * 2);
    const size_t hstepA = (size_t)HALF * g.lda * 2, hstepB = (size_t)HALF * g.ldb * 2;
    const size_t tstepA = 2 * hstepA, tstepB = 2 * hstepB;
    const unsigned ldsw = (unsigned)wid * 1024u;
    const int aoff = lds_byte(wr * 64 + fr, fq * 8), boff = lds_byte(wc * 32 + fr, fq * 8);
#define PG8_SA(b, h) (((b) * 2 + (h)) * HTB)
#define PG8_SB(b, h) ((4 + (b) * 2 + (h)) * HTB)
#define PG8_STAGE(bufoff, gbase, voff) do { _Pragma("unroll") for (int _i = 0; _i < 2; ++_i) \
        __builtin_amdgcn_global_load_lds((const unsigned*)((const char*)(gbase) + (voff)[_i]), (PG8_LAS unsigned*)(lds + (bufoff) + ldsw + _i * 8192), 16, 0, 0); } while (0)
#define PG8_LDA(dst, b, h) do { _Pragma("unroll") for (int m = 0; m < 4; ++m) _Pragma("unroll") for (int k = 0; k < 2; ++k) dst[m][k] = *(const PG8_LAS bf16x8*)(lds + PG8_SA(b, h) + aoff + m * 2048 + k * 1024); } while (0)
#define PG8_LDB(dst, b, h) do { _Pragma("unroll") for (int n = 0; n < 2; ++n) _Pragma("unroll") for (int k = 0; k < 2; ++k) dst[n][k] = *(const PG8_LAS bf16x8*)(lds + PG8_SB(b, h) + boff + n * 2048 + k * 1024); } while (0)
#define PG8_MMA(ai, bj, At, Bt) do { __builtin_amdgcn_s_setprio(1); _Pragma("unroll") for (int m = 0; m < 4; ++m) _Pragma("unroll") for (int n = 0; n < 2; ++n) _Pragma("unroll") for (int k = 0; k < 2; ++k) \
        acc[ai][bj][m][n] = __builtin_amdgcn_mfma_f32_16x16x32_bf16(Bt[n][k], At[m][k], acc[ai][bj][m][n], 0, 0, 0); __builtin_amdgcn_s_setprio(0); } while (0)
#define PG8_WAIT_V(n) asm volatile("s_waitcnt vmcnt(" #n ")" ::: "memory")
#define PG8_WAIT_L(n) asm volatile("s_waitcnt lgkmcnt(" #n ")" ::: "memory")
#define PG8_BAR __builtin_amdgcn_s_barrier()
#define PG8_SCHED __builtin_amdgcn_sched_barrier(0)
    Unit cur, nxt; int ui = 0;
    if (!S.next(0, cur)) return;
    f32x4 acc[2][2][4][2];
#pragma unroll
    for (int a = 0; a < 2; ++a)
#pragma unroll
        for (int b = 0; b < 2; ++b)
#pragma unroll
            for (int m = 0; m < 4; ++m)
#pragma unroll
                for (int n = 0; n < 2; ++n) acc[a][b][m][n] = (f32x4){0.f, 0.f, 0.f, 0.f};
    bf16x8 At[4][2], B0[2][2], B1[2][2];
    const char* cA = (const char*)g.A + (size_t)cur.kz * g.azs * 2 + (size_t)cur.pm * tstepA;
    const char* cB = (const char*)g.Bt + (size_t)cur.kz * g.bzs * 2 + (size_t)cur.pn * tstepB;
    PG8_STAGE(PG8_SB(0, 0), cB, voffB); PG8_STAGE(PG8_SB(0, 1), cB + hstepB, voffB); PG8_STAGE(PG8_SA(0, 0), cA, voffA); PG8_STAGE(PG8_SA(0, 1), cA + hstepA, voffA);
    if (wr == 1) PG8_BAR;
    PG8_WAIT_V(2); PG8_BAR;
    PG8_STAGE(PG8_SB(1, 0), cB + kstep, voffB); PG8_STAGE(PG8_SA(1, 0), cA + kstep, voffA); PG8_STAGE(PG8_SB(1, 1), cB + hstepB + kstep, voffB);
    PG8_WAIT_V(6); PG8_BAR;
    for (;;) {
        const bool has_next = S.next(ui + 1, nxt);
        const char* nA = has_next ? (const char*)g.A + (size_t)nxt.kz * g.azs * 2 + (size_t)nxt.pm * tstepA : cA;
        const char* nB = has_next ? (const char*)g.Bt + (size_t)nxt.kz * g.bzs * 2 + (size_t)nxt.pn * tstepB : cB;
        for (int t = 0; t < nt; t += 2) {
            const bool last = (t == nt - 2);
            const char* a1 = cA + (size_t)(t + 1) * kstep;
            const char* a2 = last ? nA : cA + (size_t)(t + 2) * kstep; const char* b2 = last ? nB : cB + (size_t)(t + 2) * kstep;
            const char* a3 = a2 + kstep; const char* b3 = b2 + kstep;
            PG8_LDB(B0, 0, 0); PG8_LDB(B1, 0, 1); PG8_SCHED; PG8_LDA(At, 0, 0); PG8_STAGE(PG8_SA(1, 1), a1 + hstepA, voffA);
            PG8_WAIT_V(8); PG8_WAIT_L(0); PG8_BAR; PG8_MMA(0, 0, At, B0); PG8_MMA(0, 1, At, B1); PG8_BAR; PG8_SCHED;
            PG8_LDA(At, 0, 1); PG8_STAGE(PG8_SB(0, 0), b2, voffB); PG8_STAGE(PG8_SB(0, 1), b2 + hstepB, voffB); PG8_STAGE(PG8_SA(0, 0), a2, voffA);
            PG8_WAIT_V(8); PG8_WAIT_L(0); PG8_BAR; PG8_MMA(1, 0, At, B0); PG8_MMA(1, 1, At, B1); PG8_BAR; PG8_SCHED;
            PG8_LDB(B0, 1, 0); PG8_LDB(B1, 1, 1); PG8_SCHED; PG8_LDA(At, 1, 0); PG8_STAGE(PG8_SA(0, 1), a2 + hstepA, voffA);
            PG8_WAIT_V(8); PG8_WAIT_L(0); PG8_BAR; PG8_MMA(0, 0, At, B0); PG8_MMA(0, 1, At, B1); PG8_BAR; PG8_SCHED;
            PG8_LDA(At, 1, 1); PG8_STAGE(PG8_SB(1, 0), b3, voffB); PG8_STAGE(PG8_SB(1, 1), b3 + hstepB, voffB); PG8_STAGE(PG8_SA(1, 0), a3, voffA);
            PG8_WAIT_V(8); PG8_WAIT_L(0); PG8_BAR; PG8_MMA(1, 0, At, B0); PG8_MMA(1, 1, At, B1); PG8_BAR; PG8_SCHED;
        }
        if constexpr (ALIGN_EPI) { if (wr == 0) PG8_BAR; }
        E(acc, cur, wr, wc, fr, fq);
        if (!has_next) break;
        if (!E.keep(cur)) {
#pragma unroll
            for (int a = 0; a < 2; ++a)
#pragma unroll
                for (int b = 0; b < 2; ++b)
#pragma unroll
                    for (int m = 0; m < 4; ++m)
#pragma unroll
                        for (int n = 0; n < 2; ++n) acc[a][b][m][n] = (f32x4){0.f, 0.f, 0.f, 0.f};
        }
        cur = nxt; cA = nA; cB = nB; ++ui;
        if constexpr (ALIGN_EPI) { if (wr == 1) PG8_BAR; }
    }
    PG8_WAIT_V(0);
    if constexpr (!ALIGN_EPI) { if (wr == 0) PG8_BAR; }
    PG8_BAR;
#undef PG8_SA
#undef PG8_SB
#undef PG8_STAGE
#undef PG8_LDA
#undef PG8_LDB
#undef PG8_MMA
#undef PG8_WAIT_V
#undef PG8_WAIT_L
#undef PG8_BAR
#undef PG8_SCHED
}
}

constexpr int NWAVES = 8, NTHR = 512;
constexpr int DM = 2048, NBATCH = 4, SEQ = 2048, MP = NBATCH * SEQ, MS = 128, MR = MP + MS, M = 8448;
constexpr int NLAYER = 2;
constexpr int NIN = 12816, NP = 13056, NG = 8192, N1 = NP + NG;
constexpr int DFF = 5632, NUV = 2 * DFF;
constexpr int BW = 1024;
constexpr float EPS = 1e-6f;
constexpr int C_XA = 0, C_YA = 1024, C_HQ = 2048, C_HF = 3072, C_HI = 4096, C_HGG = 5120, C_SZ = 6144, C_SX = 7168, C_SDT = 8704, C_RQ = 8960, C_RK = 9984, C_RV = 11008, C_RG = 12032;
constexpr int SRC_SPLIT = 8720;
constexpr int SSD_CD = 1536;

enum { I_XP = 0, I_XS, I_SLH, I_SLC, I_SHG, I_SSSD, I_SSC, I_SRET, I_SFC, I_GMIX, I_GFFN, I_WIN, I_LCW, I_LCB, I_LWA, I_LBA, I_LWX, I_LBX, I_LLAM, I_HGLB, I_HGNW,
       I_SCW, I_SCB, I_SDTB, I_SALOG, I_SD, I_SNW, I_WBR, I_WGATE, I_WOUT, I_WUP, I_WVAL, I_FCW, I_FCB, I_WDOWN, I_GFIN, N_INPUTS };

constexpr size_t O_YP = 0, O_YS = O_YP + (size_t)MP * DM, O_LH_P = O_YS + (size_t)MS * DM, O_LH_S = O_LH_P + 2 * 4 * 1024, O_LC_P = O_LH_S + 2 * 128 * 1024,
    O_LC_S = O_LC_P + 2 * 4 * 3 * 1024, O_HG_P = O_LC_S + 2 * 128 * 3 * 1024, O_HG_S = O_HG_P + (size_t)2 * 4 * 8 * 16384, O_SSD_P = O_HG_S + (size_t)2 * 128 * 8 * 16384,
    O_SSD_S = O_SSD_P + (size_t)2 * 4 * 16 * 8192, O_SC_P = O_SSD_S + (size_t)2 * 128 * 16 * 8192, O_SC_S = O_SC_P + 2 * 4 * 3 * 1536, O_RET_P = O_SC_S + 2 * 128 * 3 * 1536,
    O_RET_S = O_RET_P + (size_t)2 * 4 * 8 * 16384, O_FC_P = O_RET_S + (size_t)2 * 128 * 8 * 16384, O_FC_S = O_FC_P + 2 * 4 * 2 * 5632, O_END = O_FC_S + (size_t)2 * 128 * 2 * 5632;
static_assert(O_END == 126119936ull, "output size");

constexpr size_t AL(size_t x) { return (x + 4095) & ~(size_t)4095; }
constexpr size_t WS_CTL = 0, CTL_BYTES = 1u << 20;
constexpr size_t SZ_W1 = (size_t)N1 * DM * 2, SZ_WB = (size_t)4 * DM * BW * 2, SZ_WO = (size_t)DM * DM * 2, SZ_WUV = (size_t)NUV * DM * 2, SZ_WD = (size_t)DM * DFF * 2;
constexpr size_t WS_W1 = CTL_BYTES, WS_WB = WS_W1 + 2 * SZ_W1, WS_WO = WS_WB + 2 * SZ_WB, WS_WUV = WS_WO + 2 * SZ_WO, WS_WD = WS_WUV + 2 * SZ_WUV;
constexpr size_t WS_ROPE = WS_WD + 2 * SZ_WD, SZ_ROPE = AL((size_t)2049 * 64 * 8);
constexpr size_t SZ_X = (size_t)M * DM * 4;
constexpr size_t WS_X0 = WS_ROPE + SZ_ROPE, WS_X1 = WS_X0 + SZ_X;
constexpr size_t WS_H = WS_X1 + SZ_X, SZ_H = (size_t)M * DM * 2;
constexpr size_t WS_P = WS_H + SZ_H, SZ_P = (size_t)M * NP * 2;
constexpr size_t WS_G = WS_P + SZ_P, SZ_G = (size_t)M * NG * 2;
constexpr size_t WS_HF = WS_G + SZ_G, SZ_HF = (size_t)M * 1024 * 4;
constexpr size_t WS_DT = WS_HF + SZ_HF, SZ_DT = AL((size_t)M * 16 * 4);
constexpr size_t WS_OB = WS_DT + SZ_DT, SZ_O = (size_t)M * 1024 * 4;
constexpr size_t WS_BR = WS_OB + 3 * SZ_O, SZ_BR = (size_t)4 * M * BW * 2;
constexpr size_t WS_MG = WS_BR + SZ_BR, SZ_MG = (size_t)M * DM * 2;
constexpr size_t WS_XBC = WS_MG + SZ_MG, SZ_XBC = (size_t)M * SSD_CD * 2;
constexpr size_t WS_LB = WS_XBC + SZ_XBC, SZ_LB = AL((size_t)NLAYER * 1024 * 4);
constexpr size_t WS_END = WS_LB + SZ_LB;
static_assert((size_t)M * NUV * 2 <= SZ_P && (size_t)M * DFF * 2 <= SZ_G && 2 * SZ_O <= SZ_X, "overlays");

constexpr int RING_BYTES = 131072, LDSCTL_OFF = RING_BYTES, LDS_BYTES = 147456;

#define GAS __attribute__((address_space(1)))
#define LAS __attribute__((address_space(3)))
typedef unsigned short bf16;
typedef unsigned v4u __attribute__((ext_vector_type(4)));
typedef unsigned v2u __attribute__((ext_vector_type(2)));
typedef float f32x4 __attribute__((ext_vector_type(4)));
typedef float f32x2 __attribute__((ext_vector_type(2)));
typedef short bf16x8 __attribute__((ext_vector_type(8)));
#define LDS_WAIT() asm volatile("s_waitcnt lgkmcnt(0)" ::: "memory")
__device__ __forceinline__ unsigned f2bf(float f) { unsigned u = __builtin_bit_cast(unsigned, f); return (u + 0x7fffu + ((u >> 16) & 1u)) >> 16; }
__device__ __forceinline__ unsigned pk2(float lo, float hi) { return f2bf(lo) | (f2bf(hi) << 16); }
__device__ __forceinline__ float bf2f(unsigned short b) { return __uint_as_float(((unsigned)b) << 16); }
__device__ __forceinline__ float bflo(unsigned w) { return __uint_as_float(w << 16); }
__device__ __forceinline__ float bfhi(unsigned w) { return __uint_as_float(w & 0xffff0000u); }
__device__ __forceinline__ float sigm(float x) { return 1.f / (1.f + __expf(-x)); }
__device__ __forceinline__ float siluf(float x) { return x * sigm(x); }
__device__ __forceinline__ float geluf(float x) { return x * sigm(1.5957691216057308f * (x + 0.044715f * x * x * x)); }
__device__ __forceinline__ float softplusf(float x) { return x > 20.f ? x : log1pf(__expf(x)); }

#define XB_TMO      128
#define XB_XCNT(j)  (256  + 64 * (j))
#define XB_XSUB(j)  (1280 + 64 * (j))
#define XB_XGEN(j)  (2304 + 64 * (j))
#define XB_TOP      3328
#define XB_TOPGEN   3392
#define XCD_BAR_WORDS 3456
#define XB_SPIN_CAP (1u << 19)
__device__ __forceinline__ unsigned xb_ld(unsigned* p)              { return __hip_atomic_load(p, __ATOMIC_RELAXED, __HIP_MEMORY_SCOPE_AGENT); }
__device__ __forceinline__ unsigned xb_add(unsigned* p, unsigned v) { return __hip_atomic_fetch_add(p, v, __ATOMIC_RELAXED, __HIP_MEMORY_SCOPE_AGENT); }
__device__ __forceinline__ unsigned xb_xcc_id() { return (unsigned)__builtin_amdgcn_s_getreg((3 << 11) | 20) & 0xFu; }
#define XB_SPIN(cond, bar) do { unsigned _sp = 0; while (cond) { __builtin_amdgcn_s_sleep(1); \
    if ((++_sp & 255u) == 0u) { if (xb_ld(&(bar)[XB_TMO])) break; if (_sp > XB_SPIN_CAP) { atomicAdd(&(bar)[XB_TMO], 1u); break; } } } } while (0)
struct XcdBarrier { unsigned* bar; unsigned x; volatile LAS unsigned* st; };
__device__ __forceinline__ XcdBarrier xcd_barrier_post(unsigned* bar, volatile LAS unsigned* st) {
    XcdBarrier b; b.bar = bar; b.x = xb_xcc_id(); b.st = st;
    if (threadIdx.x == 0) (void)xb_add(&bar[XB_XCNT(b.x)], 1u);
    return b;
}
__device__ __forceinline__ void xcd_barrier_complete(unsigned* bar, unsigned x, unsigned& nloc, unsigned& nx) {
    const unsigned G = gridDim.x * gridDim.y * gridDim.z;
    unsigned sum, cnt, mine, sp = 0u;
    for (;;) {
        sum = 0u; cnt = 0u; mine = 0u;
#pragma unroll
        for (unsigned j = 0; j < 16; ++j) { const unsigned c = xb_ld(&bar[XB_XCNT(j)]); sum += c; cnt += (c > 0u) ? 1u : 0u; mine = (j == x) ? c : mine; }
        if (sum == G) break;
        __builtin_amdgcn_s_sleep(1);
        if ((++sp & 255u) == 0u) { if (xb_ld(&bar[XB_TMO])) break; if (sp > XB_SPIN_CAP) { atomicAdd(&bar[XB_TMO], 1u); break; } }
    }
    nloc = mine > 0u ? mine : 1u; nx = cnt > 0u ? cnt : 1u;
}
__device__ __forceinline__ void xcd_barrier(const XcdBarrier& b) {
    asm volatile("s_waitcnt vmcnt(0)" ::: "memory");
    __syncthreads();
    if (threadIdx.x == 0) {
        unsigned* bar = b.bar;
        __builtin_amdgcn_s_waitcnt(0);
        unsigned nloc = b.st[0], nx = b.st[1];
        if (nloc == 0u) { xcd_barrier_complete(bar, b.x, nloc, nx); b.st[0] = nloc; b.st[1] = nx; }
        const unsigned old = xb_add(&bar[XB_XSUB(b.x)], 1u);
        const unsigned gen = old / nloc;
        if (old + 1u == (gen + 1u) * nloc) {
            __builtin_amdgcn_fence(__ATOMIC_RELEASE, "agent");
            asm volatile("s_waitcnt vmcnt(0)" ::: "memory");
            const unsigned og = xb_add(&bar[XB_TOP], 1u);
            const unsigned tg = og / nx;
            if (og + 1u == (tg + 1u) * nx) xb_add(&bar[XB_TOPGEN], 1u);
            else XB_SPIN(xb_ld(&bar[XB_TOPGEN]) == tg, bar);
            __builtin_amdgcn_fence(__ATOMIC_ACQUIRE, "agent");
            xb_add(&bar[XB_XGEN(b.x)], 1u);
            asm volatile("s_waitcnt vmcnt(0)" ::: "memory");
        } else {
            XB_SPIN(xb_ld(&bar[XB_XGEN(b.x)]) == gen, bar);
            __builtin_amdgcn_fence(__ATOMIC_ACQUIRE, "agent");
            asm volatile("s_waitcnt vmcnt(0)" ::: "memory");
        }
    }
    __syncthreads();
}

struct Args { const float* in[N_INPUTS]; float* out; unsigned char* ws; int ph_lo, ph_hi; };

struct Frame {
    LAS unsigned char* lds;
    int tid, lane, wave, G, c;
    const float* const* in;
    float* out;
    unsigned char* ws;
};
#define WSP(T, off) ((T*)(F.ws + (off)))
__device__ __forceinline__ Frame launder(const Frame& F0) {
    Frame F = F0;
    asm volatile("" : "+v"(F.tid), "+v"(F.lane));
    asm volatile("" : "+s"(F.wave), "+s"(F.G), "+s"(F.c));
    { int z = 0; asm volatile("" : "+s"(z)); F.in += z; F.out += z; F.ws += z; }
    asm volatile("" : "+s"(F.lds));
    return F;
}

using pg8::f32x4;
using pg8::Unit;
using pg8::cvt_pk_bf16;

struct Epi1 {
    static constexpr bool PERM = true;
    bf16* P; float* HF; float* DT; bf16* Gt; const float* LB;
    __device__ __forceinline__ bool keep(const Unit&) const { return false; }
    template <int ACT> __device__ __forceinline__ void store_act(f32x4 (&acc)[2][2][4][2], bf16* base, int ld, int row0, int colb) const {
#pragma unroll
        for (int ai = 0; ai < 2; ++ai)
#pragma unroll
            for (int m = 0; m < 4; ++m) { bf16* rowp = base + (size_t)(row0 + ai * 128 + m * 16) * ld + colb;
#pragma unroll
                for (int bj = 0; bj < 2; ++bj) { f32x4 v0 = acc[ai][bj][m][0], v1 = acc[ai][bj][m][1];
#pragma unroll
                    for (int j = 0; j < 4; ++j) { if (ACT == 1) { v0[j] = geluf(v0[j]); v1[j] = geluf(v1[j]); } if (ACT == 2) { v0[j] = siluf(v0[j]); v1[j] = siluf(v1[j]); } if (ACT == 3) { v0[j] = sigm(v0[j]); v1[j] = sigm(v1[j]); } }
                    pg8::u32x4 w; w.x = cvt_pk_bf16(v0[0], v0[1]); w.y = cvt_pk_bf16(v0[2], v0[3]); w.z = cvt_pk_bf16(v1[0], v1[1]); w.w = cvt_pk_bf16(v1[2], v1[3]);
                    *(pg8::u32x4*)(rowp + bj * 128) = w; }
                asm volatile("" ::: "memory"); }
    }
    __device__ __forceinline__ void operator()(f32x4 (&acc)[2][2][4][2], const Unit& u, int wr, int wc, int fr, int fq) const {
        const int row0 = u.pm * 256 + wr * 64 + fr, pn = u.pn;
        if (pn >= 51) { store_act<3>(acc, Gt, NG, row0, (pn - 51) * 256 + wc * 32 + 8 * fq); }
        else if (pn >= 12 && pn < 16) {
            const int colb = (pn - 12) * 256 + wc * 32 + 8 * fq;
#pragma unroll
            for (int bj = 0; bj < 2; ++bj) { const f32x4 l0 = *(const f32x4*)(LB + colb + bj * 128), l1 = *(const f32x4*)(LB + colb + bj * 128 + 4);
#pragma unroll
                for (int ai = 0; ai < 2; ++ai)
#pragma unroll
                    for (int m = 0; m < 4; ++m) { const size_t r = (size_t)(row0 + ai * 128 + m * 16);
                        f32x4 v0 = acc[ai][bj][m][0], v1 = acc[ai][bj][m][1], g0, g1, k0, k1;
#pragma unroll
                        for (int j = 0; j < 4; ++j) { { const float e = __expf(-fabsf(v0[j])), r = 1.f / (1.f + e), sm = e * r, sg = v0[j] >= 0.f ? r : sm, sn = v0[j] >= 0.f ? sm : r; g0[j] = __logf(l0[j] + (1.f - l0[j]) * sg); k0[j] = (1.f - l0[j]) * sn; }
                                                      { const float e = __expf(-fabsf(v1[j])), r = 1.f / (1.f + e), sm = e * r, sg = v1[j] >= 0.f ? r : sm, sn = v1[j] >= 0.f ? sm : r; g1[j] = __logf(l1[j] + (1.f - l1[j]) * sg); k1[j] = (1.f - l1[j]) * sn; } }
                        *(f32x4*)(HF + r * 1024 + colb + bj * 128) = g0; *(f32x4*)(HF + r * 1024 + colb + bj * 128 + 4) = g1;
                        pg8::u32x4 w; w.x = cvt_pk_bf16(k0[0], k0[1]); w.y = cvt_pk_bf16(k0[2], k0[3]); w.z = cvt_pk_bf16(k1[0], k1[1]); w.w = cvt_pk_bf16(k1[2], k1[3]);
                        *(pg8::u32x4*)(P + r * NP + C_HF + colb + bj * 128) = w; asm volatile("" ::: "memory"); } }
        } else if (pn == 34) {
            if (wc == 0 && fq < 2) {
#pragma unroll
                for (int ai = 0; ai < 2; ++ai)
#pragma unroll
                    for (int m = 0; m < 4; ++m) { float* rowp = DT + (size_t)(row0 + ai * 128 + m * 16) * 16 + 8 * fq;
                        *(f32x4*)(rowp) = acc[ai][0][m][0]; *(f32x4*)(rowp + 4) = acc[ai][0][m][1]; }
            }
        } else {
            const int colb = pn * 256 + wc * 32 + 8 * fq;
            if (pn >= 4 && pn < 8) store_act<1>(acc, P, NP, row0, colb);
            else if ((pn >= 8 && pn < 12) || (pn >= 20 && pn < 28) || pn >= 47) store_act<2>(acc, P, NP, row0, colb);
            else store_act<0>(acc, P, NP, row0, colb);
        }
    }
};

struct EpiB {
    static constexpr bool PERM = true;
    bf16* O; int ldc;
    __device__ __forceinline__ bool keep(const Unit&) const { return false; }
    __device__ __forceinline__ void operator()(f32x4 (&acc)[2][2][4][2], const Unit& u, int wr, int wc, int fr, int fq) const {
        const int row0 = u.pm * 256 + wr * 64 + fr, colb = u.pn * 256 + wc * 32 + 8 * fq;
#pragma unroll
        for (int ai = 0; ai < 2; ++ai)
#pragma unroll
            for (int m = 0; m < 4; ++m) { bf16* rowp = O + (size_t)(row0 + ai * 128 + m * 16) * ldc + colb;
#pragma unroll
                for (int bj = 0; bj < 2; ++bj) { const f32x4 v0 = acc[ai][bj][m][0], v1 = acc[ai][bj][m][1]; pg8::u32x4 w;
                    w.x = cvt_pk_bf16(v0[0], v0[1]); w.y = cvt_pk_bf16(v0[2], v0[3]); w.z = cvt_pk_bf16(v1[0], v1[1]); w.w = cvt_pk_bf16(v1[2], v1[3]);
                    *(pg8::u32x4*)(rowp + bj * 128) = w; } }
    }
};

struct EpiBr {
    static constexpr bool PERM = true;
    const bf16* Gt; bf16* O;
    __device__ __forceinline__ bool keep(const Unit& u) const { return u.kz < 3; }
    __device__ __forceinline__ void operator()(f32x4 (&acc)[2][2][4][2], const Unit& u, int wr, int wc, int fr, int fq) const {
        const int row0 = u.pm * 256 + wr * 64 + fr, colb = u.pn * 256 + wc * 32 + 8 * fq, kz = u.kz;
#pragma unroll
        for (int ai = 0; ai < 2; ++ai)
#pragma unroll
            for (int m = 0; m < 4; ++m) { const size_t r = (size_t)(row0 + ai * 128 + m * 16);
#pragma unroll
                for (int bj = 0; bj < 2; ++bj) {
                    const pg8::u32x4 ga = *(const pg8::u32x4*)(Gt + r * NG + kz * 2048 + colb + bj * 128);
                    float s[8] = {bflo(ga.x), bfhi(ga.x), bflo(ga.y), bfhi(ga.y), bflo(ga.z), bfhi(ga.z), bflo(ga.w), bfhi(ga.w)};
                    if (kz < 3) {
                        const pg8::u32x4 gb = *(const pg8::u32x4*)(Gt + r * NG + (kz + 1) * 2048 + colb + bj * 128);
                        const float d[8] = {bflo(gb.x), bfhi(gb.x), bflo(gb.y), bfhi(gb.y), bflo(gb.z), bfhi(gb.z), bflo(gb.w), bfhi(gb.w)};
#pragma unroll
                        for (int j = 0; j < 8; ++j) s[j] = s[j] * __builtin_amdgcn_rcpf(fmaxf(d[j], 1e-20f));
                    }
                    f32x4 v0 = acc[ai][bj][m][0], v1 = acc[ai][bj][m][1];
                    v0[0] *= s[0]; v0[1] *= s[1]; v0[2] *= s[2]; v0[3] *= s[3]; v1[0] *= s[4]; v1[1] *= s[5]; v1[2] *= s[6]; v1[3] *= s[7];
                    acc[ai][bj][m][0] = v0; acc[ai][bj][m][1] = v1;
                    if (kz == 3) { pg8::u32x4 w; w.x = cvt_pk_bf16(v0[0], v0[1]); w.y = cvt_pk_bf16(v0[2], v0[3]); w.z = cvt_pk_bf16(v1[0], v1[1]); w.w = cvt_pk_bf16(v1[2], v1[3]);
                        *(pg8::u32x4*)(O + r * DM + colb + bj * 128) = w; }
                }
                asm volatile("" ::: "memory"); }
    }
};

struct EpiRes {
    static constexpr bool PERM = false;
    const float* Xc; float* Xn;
    __device__ __forceinline__ bool keep(const Unit&) const { return false; }
    __device__ __forceinline__ void operator()(f32x4 (&acc)[2][2][4][2], const Unit& u, int wr, int wc, int fr, int fq) const {
        const int row0 = u.pm * 256 + wr * 64 + fr, col0 = u.pn * 256 + wc * 32 + 4 * fq;
#pragma unroll
        for (int ai = 0; ai < 2; ++ai)
#pragma unroll
            for (int m = 0; m < 4; ++m) { const size_t off = (size_t)(row0 + ai * 128 + m * 16) * DM + col0;
#pragma unroll
                for (int bj = 0; bj < 2; ++bj)
#pragma unroll
                    for (int n = 0; n < 2; ++n) { const f32x4 b = *(const f32x4*)(Xc + off + bj * 128 + n * 16); *(f32x4*)(Xn + off + bj * 128 + n * 16) = b + acc[ai][bj][m][n]; }
                asm volatile("" ::: "memory"); }
    }
};

struct TrJob { const float* W; bf16* WT; int K, N, ldt, mode, roff, item; };
__device__ __forceinline__ void tr_load(const TrJob& j, int lane, float (&v)[32]) {
    const int nblk = (j.N + 31) >> 5, kb = j.item / nblk, nb = j.item - kb * nblk, k0 = 64 * kb, n0 = 32 * nb;
    int nn = n0 + (lane & 31); nn = nn < j.N ? nn : j.N - 1;
    const float* p = j.W + (size_t)(k0 + (lane >> 5)) * j.N + nn;
#pragma unroll
    for (int i = 0; i < 32; ++i) v[i] = p[(size_t)(2 * i) * j.N];
}
__device__ __forceinline__ void tr_store(const TrJob& j, int lane, LAS float* scr, const float (&v)[32]) {
    const int nblk = (j.N + 31) >> 5, kb = j.item / nblk, nb = j.item - kb * nblk, k0 = 64 * kb, n0 = 32 * nb;
#pragma unroll
    for (int i = 0; i < 32; ++i) scr[(2 * i + (lane >> 5)) * 33 + (lane & 31)] = v[i];
    LDS_WAIT(); asm volatile("" ::: "memory");
    const int c = lane & 7;
#pragma unroll
    for (int jj = 0; jj < 4; ++jj) { const int n = (lane >> 3) + 8 * jj, gn = n0 + n; const LAS float* s = scr + (8 * c) * 33 + n;
        v4u o; o.x = pk2(s[0 * 33], s[1 * 33]); o.y = pk2(s[2 * 33], s[3 * 33]); o.z = pk2(s[4 * 33], s[5 * 33]); o.w = pk2(s[6 * 33], s[7 * 33]);
        if (gn < j.N) { const int dr = (j.mode == 1) ? (gn < SRC_SPLIT ? gn : gn + 240) : gn + j.roff; *(v4u*)(j.WT + (size_t)dr * j.ldt + k0 + 8 * c) = o; } }
    LDS_WAIT(); asm volatile("" ::: "memory");
}
constexpr int I_IN = (DM / 64) * ((NIN + 31) / 32), I_GT = (DM / 64) * (NG / 32), I_BR = (BW / 64) * (DM / 32), I_OUT = (DM / 64) * (DM / 32), I_UP = (DM / 64) * (DFF / 32), I_DN = (DFF / 64) * (DM / 32);
constexpr int I_LAYER = I_IN + I_GT + 4 * I_BR + I_OUT + 2 * I_UP + I_DN;
__device__ __forceinline__ TrJob tr_decode(const Frame& F, int it) {
    const int l = it / I_LAYER; int r = it - l * I_LAYER; TrJob j;
    bf16* W1 = WSP(bf16, WS_W1 + l * SZ_W1);
    if (r < I_IN) { j = TrJob{F.in[I_WIN] + (size_t)l * DM * NIN, W1, DM, NIN, DM, 1, 0, r}; return j; } r -= I_IN;
    if (r < I_GT) { j = TrJob{F.in[I_WGATE] + (size_t)l * DM * NG, W1, DM, NG, DM, 0, NP, r}; return j; } r -= I_GT;
    if (r < 4 * I_BR) { const int k = r / I_BR; j = TrJob{F.in[I_WBR] + ((size_t)l * 4 + k) * BW * DM, WSP(bf16, WS_WB + l * SZ_WB) + (size_t)k * DM * BW, BW, DM, BW, 0, 0, r - k * I_BR}; return j; } r -= 4 * I_BR;
    if (r < I_OUT) { j = TrJob{F.in[I_WOUT] + (size_t)l * DM * DM, WSP(bf16, WS_WO + l * SZ_WO), DM, DM, DM, 0, 0, r}; return j; } r -= I_OUT;
    if (r < I_UP) { j = TrJob{F.in[I_WUP] + (size_t)l * DM * DFF, WSP(bf16, WS_WUV + l * SZ_WUV), DM, DFF, DM, 0, 0, r}; return j; } r -= I_UP;
    if (r < I_UP) { j = TrJob{F.in[I_WVAL] + (size_t)l * DM * DFF, WSP(bf16, WS_WUV + l * SZ_WUV), DM, DFF, DM, 0, DFF, r}; return j; } r -= I_UP;
    j = TrJob{F.in[I_WDOWN] + (size_t)l * DFF * DM, WSP(bf16, WS_WD + l * SZ_WD), DFF, DM, DFF, 0, 0, r}; return j;
}

__device__ __forceinline__ void phase_prologue(const Frame& F0) {
    Frame F = launder(F0);
    LAS float* scr = (LAS float*)(F.lds + F.wave * 8704);
    const int gw = F.c * NWAVES + F.wave, NGW = F.G * NWAVES;
    {
        constexpr int NIT = NLAYER * I_LAYER;
        int it = gw; TrJob jc; float cur[32];
        if (it < NIT) { jc = tr_decode(F, it); tr_load(jc, F.lane, cur); }
        while (it < NIT) {
            const int itn = it + NGW; const bool hn = itn < NIT; TrJob jn = jc; float nx[32];
            if (hn) { jn = tr_decode(F, itn); tr_load(jn, F.lane, nx); }
            tr_store(jc, F.lane, scr, cur);
            if (hn) {
#pragma unroll
                for (int i = 0; i < 32; ++i) cur[i] = nx[i];
            }
            jc = jn; it = itn;
        }
    }
    const int gt = F.c * NTHR + F.tid, NGT = F.G * NTHR;
    for (int i = gt; i < NLAYER * 240 * (DM / 8); i += NGT) { const int l = i / (240 * (DM / 8)), r = i - l * (240 * (DM / 8));
        *(v4u*)(WSP(bf16, WS_W1 + l * SZ_W1) + (size_t)(SRC_SPLIT + r / (DM / 8)) * DM + (r % (DM / 8)) * 8) = (v4u){0u, 0u, 0u, 0u}; }
    for (int i = gt; i < NLAYER * 1024; i += NGT) { const int l = i >> 10, c = i & 1023; WSP(float, WS_LB)[i] = l == 0 ? 0.f : sigm(F.in[I_HGLB][1024 + c] - F.in[I_HGLB][c]); }
    for (int i = gt; i < 2049 * 64; i += NGT) { const int p = i >> 6, j = i & 63; const float pos = p < 2048 ? (float)p : 16384.f;
        const float fr = powf(10000.f, -(float)j / 64.f); const float ang = pos * fr; WSP(f32x2, WS_ROPE)[i] = (f32x2){cosf(ang), sinf(ang)}; }
    for (int i = gt; i < M * (DM / 4); i += NGT) { const int row = i / (DM / 4), c4 = i - row * (DM / 4);
        f32x4 v = (f32x4){0.f, 0.f, 0.f, 0.f};
        if (row < MP) v = ((const f32x4*)F.in[I_XP])[(size_t)row * (DM / 4) + c4]; else if (row < MR) v = ((const f32x4*)F.in[I_XS])[(size_t)(row - MP) * (DM / 4) + c4];
        WSP(f32x4, WS_X0)[i] = v; }
}

__device__ __forceinline__ float wave_sum(float v) {
#pragma unroll
    for (int o = 1; o < 64; o <<= 1) v += __shfl_xor(v, o);
    return v;
}
__device__ __forceinline__ void phase_norm(const Frame& F0, const float* X, const float* g, bf16* H) {
    Frame F = launder(F0);
    const int gw = F.c * NWAVES + F.wave, NGW = F.G * NWAVES;
    for (int row = gw; row < M; row += NGW) {
        v2u* o8 = (v2u*)(H + (size_t)row * DM) + F.lane;
        if (row >= MR) {
#pragma unroll
            for (int j = 0; j < 8; ++j) o8[64 * j] = (v2u){0u, 0u};
            continue; }
        const f32x4* xr = (const f32x4*)(X + (size_t)row * DM) + F.lane;
        f32x4 v[8]; float s = 0.f;
#pragma unroll
        for (int j = 0; j < 8; ++j) { v[j] = xr[64 * j]; s += (v[j].x * v[j].x + v[j].y * v[j].y) + (v[j].z * v[j].z + v[j].w * v[j].w); }
        const float rstd = rsqrtf(wave_sum(s) * (1.f / DM) + EPS);
#pragma unroll
        for (int j = 0; j < 8; ++j) { const f32x4 gv = ((const f32x4*)g)[F.lane + 64 * j];
            o8[64 * j] = (v2u){pk2(v[j].x * rstd * gv.x, v[j].y * rstd * gv.y), pk2(v[j].z * rstd * gv.z, v[j].w * rstd * gv.w)}; }
    }
}
__device__ __forceinline__ void phase_final(const Frame& F0, const float* X, const float* g) {
    Frame F = launder(F0);
    const int gw = F.c * NWAVES + F.wave, NGW = F.G * NWAVES;
    for (int row = gw; row < MR; row += NGW) {
        const f32x4* xr = (const f32x4*)(X + (size_t)row * DM) + F.lane;
        f32x4* o = (f32x4*)(F.out + (row < MP ? O_YP + (size_t)row * DM : O_YS + (size_t)(row - MP) * DM)) + F.lane;
        f32x4 v[8]; float s = 0.f;
#pragma unroll
        for (int j = 0; j < 8; ++j) { v[j] = xr[64 * j]; s += (v[j].x * v[j].x + v[j].y * v[j].y) + (v[j].z * v[j].z + v[j].w * v[j].w); }
        const float rstd = rsqrtf(wave_sum(s) * (1.f / DM) + EPS);
#pragma unroll
        for (int j = 0; j < 8; ++j) { const f32x4 gv = ((const f32x4*)g)[F.lane + 64 * j]; o[64 * j] = v[j] * rstd * gv; }
    }
}

constexpr int LW_STR = 136;
constexpr int L_WT = 0, L_XC = 256 * LW_STR * 2, L_XCF = L_XC + 64 * LW_STR * 2, LXF_STR = 132;
static_assert(L_XCF + 64 * LXF_STR * 4 <= RING_BYTES, "lru lds");
__device__ __forceinline__ void lru_stage_w(const Frame& F0, int l, int n) {
    Frame F = launder(F0);
    LAS bf16* WT = (LAS bf16*)(F.lds + L_WT);
    const float* wa = F.in[I_LWA] + ((size_t)l * 8 + n) * 16384; const float* wx = F.in[I_LWX] + ((size_t)l * 8 + n) * 16384;
    for (int i = F.tid; i < 16384; i += NTHR) { const int c = i >> 7, d = i & 127;
        WT[d * LW_STR + c] = (bf16)f2bf(wa[i]); WT[(128 + d) * LW_STR + c] = (bf16)f2bf(wx[i]); }
}
__device__ __forceinline__ void lru_tile(const Frame& F0, int l, int n, int tt) {
    Frame F = launder(F0);
    LAS bf16* WT = (LAS bf16*)(F.lds + L_WT); LAS bf16* XC = (LAS bf16*)(F.lds + L_XC); LAS float* XCF = (LAS float*)(F.lds + L_XCF);
    const bf16* P = WSP(bf16, WS_P);
    const float* cw = F.in[I_LCW] + (size_t)l * 4 * 1024; const float* cb = F.in[I_LCB] + (size_t)l * 1024;
    {
        const int tk = F.tid >> 3, c0 = (F.tid & 7) * 16, row = tt * 64 + tk, ch0 = n * 128 + c0;
        float acc[16];
#pragma unroll
        for (int j = 0; j < 16; ++j) acc[j] = cb[ch0 + j];
        if (row < MP) {
            const int t = row & (SEQ - 1);
#pragma unroll
            for (int jj = 0; jj < 4; ++jj) { if (t - 3 + jj >= 0) { const v4u* src = (const v4u*)(P + (size_t)(row - 3 + jj) * NP + C_XA + ch0); const v4u a = src[0], b = src[1];
                const unsigned w[8] = {a.x, a.y, a.z, a.w, b.x, b.y, b.z, b.w}; const float* wj = cw + jj * 1024 + ch0;
#pragma unroll
                for (int q = 0; q < 8; ++q) { acc[2 * q] += wj[2 * q] * bflo(w[q]); acc[2 * q + 1] += wj[2 * q + 1] * bfhi(w[q]); } } }
        } else if (row < MR) {
            const int s = row - MP; const float* st = F.in[I_SLC] + ((size_t)l * 128 + s) * 3 * 1024 + ch0;
#pragma unroll
            for (int jj = 0; jj < 3; ++jj) { const float* wj = cw + jj * 1024 + ch0;
#pragma unroll
                for (int q = 0; q < 16; ++q) acc[q] += wj[q] * st[jj * 1024 + q]; }
            const v4u* src = (const v4u*)(P + (size_t)row * NP + C_XA + ch0); const v4u a = src[0], b = src[1];
            const unsigned w[8] = {a.x, a.y, a.z, a.w, b.x, b.y, b.z, b.w}; const float* wj = cw + 3 * 1024 + ch0;
#pragma unroll
            for (int q = 0; q < 8; ++q) { acc[2 * q] += wj[2 * q] * bflo(w[q]); acc[2 * q + 1] += wj[2 * q + 1] * bfhi(w[q]); }
        }
#pragma unroll
        for (int q = 0; q < 16; ++q) { XCF[tk * LXF_STR + c0 + q] = acc[q]; }
#pragma unroll
        for (int q = 0; q < 8; ++q) *(LAS unsigned*)(XC + tk * LW_STR + c0 + 2 * q) = pk2(acc[2 * q], acc[2 * q + 1]);
    }
    __syncthreads();
    const int w = F.wave, lane = F.lane, fr = lane & 15, g = lane >> 4;
    f32x4 ar[4], ai_[4];
#pragma unroll
    for (int rt = 0; rt < 4; ++rt) { ar[rt] = (f32x4){0.f, 0.f, 0.f, 0.f}; ai_[rt] = (f32x4){0.f, 0.f, 0.f, 0.f}; }
#pragma unroll
    for (int ks = 0; ks < 4; ++ks) {
        const bf16x8 br = *(const LAS bf16x8*)(WT + (16 * w + fr) * LW_STR + 32 * ks + 8 * g);
        const bf16x8 bi = *(const LAS bf16x8*)(WT + (128 + 16 * w + fr) * LW_STR + 32 * ks + 8 * g);
#pragma unroll
        for (int rt = 0; rt < 4; ++rt) { const bf16x8 a = *(const LAS bf16x8*)(XC + (16 * rt + fr) * LW_STR + 32 * ks + 8 * g);
            ar[rt] = __builtin_amdgcn_mfma_f32_16x16x32_bf16(a, br, ar[rt], 0, 0, 0); ai_[rt] = __builtin_amdgcn_mfma_f32_16x16x32_bf16(a, bi, ai_[rt], 0, 0, 0); }
    }
    const int d = 16 * w + fr, ch = n * 128 + d;
    const float ba = F.in[I_LBA][(size_t)l * 1024 + ch], bx = F.in[I_LBX][(size_t)l * 1024 + ch], sp = softplusf(-F.in[I_LLAM][(size_t)l * 1024 + ch]);
    float* LA = WSP(float, WS_X1); float* LU = LA + (size_t)M * 1024;
    const bool scan = (tt < 128);
    float CA = 1.f, CU = 0.f;
#pragma unroll
    for (int rt = 0; rt < 4; ++rt) {
        float A[4], U[4];
#pragma unroll
        for (int reg = 0; reg < 4; ++reg) { const int tk = 16 * rt + 4 * g + reg;
            const float r = sigm(ar[rt][reg] + ba), iv = sigm(ai_[rt][reg] + bx), la = -8.f * r * sp, a = __expf(la), xc = XCF[tk * LXF_STR + d];
            A[reg] = a; U[reg] = sqrtf(fmaxf(-expm1f(2.f * la), 0.f)) * (iv * xc); }
        if (scan) {
#pragma unroll
            for (int reg = 1; reg < 4; ++reg) { U[reg] = A[reg] * U[reg - 1] + U[reg]; A[reg] = A[reg] * A[reg - 1]; }
            float PA = 1.f, PU = 0.f, TA = 1.f, TU = 0.f;
#pragma unroll
            for (int src = 0; src < 4; ++src) { const float sa = __shfl(A[3], fr + 16 * src), su = __shfl(U[3], fr + 16 * src);
                if (src < g) { PU = sa * PU + su; PA = sa * PA; }
                TU = sa * TU + su; TA = sa * TA; }
            const float GA = PA * CA, GU = PA * CU + PU;
#pragma unroll
            for (int reg = 0; reg < 4; ++reg) { U[reg] = A[reg] * GU + U[reg]; A[reg] = A[reg] * GA; }
            CU = TA * CU + TU; CA = TA * CA;
        }
#pragma unroll
        for (int reg = 0; reg < 4; ++reg) { const size_t row = (size_t)tt * 64 + 16 * rt + 4 * g + reg; LA[row * 1024 + ch] = A[reg]; LU[row * 1024 + ch] = U[reg]; }
    }
    __syncthreads();
}
__device__ __forceinline__ void phase_conv(const Frame& F00, int l) {
    Frame F0 = launder(F00);
    { const int n = F0.c & 7; bool staged = false;
      for (int tt = F0.c >> 3; tt < 130; tt += (F0.G >> 3)) { if (!staged) { lru_stage_w(F0, l, n); __syncthreads(); staged = true; } lru_tile(F0, l, n, tt); } }
    Frame F = launder(F0);
    const bf16* P = WSP(bf16, WS_P);
    const int gt = F.c * NTHR + F.tid, NGT = F.G * NTHR;
    { const float* cw = F.in[I_SCW] + (size_t)l * 4 * SSD_CD; const float* cb = F.in[I_SCB] + (size_t)l * SSD_CD; bf16* XBC = WSP(bf16, WS_XBC);
      for (int i = gt; i < MR * (SSD_CD / 8); i += NGT) { const int row = i / (SSD_CD / 8), c = (i - row * (SSD_CD / 8)) * 8;
          float acc[8];
#pragma unroll
          for (int q = 0; q < 8; ++q) acc[q] = cb[c + q];
          if (row < MP) { const int t = row & (SEQ - 1);
#pragma unroll
              for (int jj = 0; jj < 4; ++jj) if (t - 3 + jj >= 0) { const v4u a = *(const v4u*)(P + (size_t)(row - 3 + jj) * NP + C_SX + c); const unsigned w[4] = {a.x, a.y, a.z, a.w}; const float* wj = cw + jj * SSD_CD + c;
#pragma unroll
                  for (int q = 0; q < 4; ++q) { acc[2 * q] += wj[2 * q] * bflo(w[q]); acc[2 * q + 1] += wj[2 * q + 1] * bfhi(w[q]); } }
          } else { const int s = row - MP; const float* st = F.in[I_SSC] + ((size_t)l * 128 + s) * 3 * SSD_CD + c;
#pragma unroll
              for (int jj = 0; jj < 3; ++jj) { const float* wj = cw + jj * SSD_CD + c;
#pragma unroll
                  for (int q = 0; q < 8; ++q) acc[q] += wj[q] * st[jj * SSD_CD + q]; }
              const v4u a = *(const v4u*)(P + (size_t)row * NP + C_SX + c); const unsigned w[4] = {a.x, a.y, a.z, a.w}; const float* wj = cw + 3 * SSD_CD + c;
#pragma unroll
              for (int q = 0; q < 4; ++q) { acc[2 * q] += wj[2 * q] * bflo(w[q]); acc[2 * q + 1] += wj[2 * q + 1] * bfhi(w[q]); } }
          v4u o; o.x = pk2(siluf(acc[0]), siluf(acc[1])); o.y = pk2(siluf(acc[2]), siluf(acc[3])); o.z = pk2(siluf(acc[4]), siluf(acc[5])); o.w = pk2(siluf(acc[6]), siluf(acc[7]));
          *(v4u*)(XBC + (size_t)row * SSD_CD + c) = o; } }
    { float* DT = WSP(float, WS_DT); for (int i = gt; i < MR * 16; i += NGT) DT[i] = softplusf(DT[i] + F.in[I_SDTB][l * 16 + (i & 15)]); }
    for (int i = gt; i < NBATCH * 3 * 1024; i += NGT) { const int b = i / 3072, r = i - b * 3072, j = r >> 10, c = r & 1023;
        F.out[O_LC_P + (size_t)l * NBATCH * 3072 + i] = bf2f(P[((size_t)b * SEQ + SEQ - 3 + j) * NP + C_XA + c]); }
    for (int i = gt; i < MS * 3 * 1024; i += NGT) { const int s = i / 3072, r = i - s * 3072, j = r >> 10, c = r & 1023;
        F.out[O_LC_S + (size_t)l * MS * 3072 + i] = j < 2 ? F.in[I_SLC][(size_t)l * MS * 3072 + (size_t)s * 3072 + (j + 1) * 1024 + c] : bf2f(P[((size_t)MP + s) * NP + C_XA + c]); }
    for (int i = gt; i < NBATCH * 3 * SSD_CD; i += NGT) { const int b = i / (3 * SSD_CD), r = i - b * 3 * SSD_CD, j = r / SSD_CD, c = r - j * SSD_CD;
        F.out[O_SC_P + (size_t)l * NBATCH * 3 * SSD_CD + i] = bf2f(P[((size_t)b * SEQ + SEQ - 3 + j) * NP + C_SX + c]); }
    for (int i = gt; i < MS * 3 * SSD_CD; i += NGT) { const int s = i / (3 * SSD_CD), r = i - s * 3 * SSD_CD, j = r / SSD_CD, c = r - j * SSD_CD;
        F.out[O_SC_S + (size_t)l * MS * 3 * SSD_CD + i] = j < 2 ? F.in[I_SSC][(size_t)l * MS * 3 * SSD_CD + (size_t)s * 3 * SSD_CD + (j + 1) * SSD_CD + c] : bf2f(P[((size_t)MP + s) * NP + C_SX + c]); }
}

constexpr int QS_STR = 136, KT_STR = 72;
template <int MODE> struct CK {
    static constexpr int V = (MODE == 2) ? 64 : 128, NVT = V / 16, NVW = NVT / 2, NH = (MODE == 2) ? 16 : 8;
    static constexpr int O_QS = 0, O_QH = O_QS + 64 * QS_STR * 2, O_KS = O_QH + (MODE == 0 ? 64 * QS_STR * 2 : 0), O_KT = O_KS + 64 * QS_STR * 2, O_VT = O_KT + 128 * KT_STR * 2,
        O_VD = O_VT + V * KT_STR * 2, O_XT = O_VD + (MODE == 0 ? 0 : V * KT_STR * 2), O_S0T = O_XT + (MODE == 2 ? 64 * KT_STR * 2 : 0), O_F32 = O_S0T + V * QS_STR * 2, O_END = O_F32 + 4096;
    static_assert(O_END <= RING_BYTES, "chunk unit LDS");
};
__device__ __forceinline__ bf16x8 mk_frag(v2u lo, v2u hi) { v4u t; t.x = lo.x; t.y = lo.y; t.z = hi.x; t.w = hi.y; return __builtin_bit_cast(bf16x8, t); }
template <int MODE>
__device__ __forceinline__ void chunk_unit(const Frame& F0, int l, int unit) {
    Frame F = launder(F0);
    typedef CK<MODE> C; constexpr int V = C::V, NVT = C::NVT, NVW = C::NVW, NH = C::NH;
    const int b = unit / NH, h = unit - b * NH;
    LAS bf16* QS = (LAS bf16*)(F.lds + C::O_QS); LAS bf16* QH = (LAS bf16*)(F.lds + C::O_QH); LAS bf16* KS = (LAS bf16*)(F.lds + C::O_KS); LAS bf16* KT = (LAS bf16*)(F.lds + C::O_KT);
    LAS bf16* VT = (LAS bf16*)(F.lds + C::O_VT); LAS bf16* VD = (LAS bf16*)(F.lds + C::O_VD); LAS bf16* XT = (LAS bf16*)(F.lds + C::O_XT); LAS bf16* S0T = (LAS bf16*)(F.lds + C::O_S0T);
    LAS float* FA = (LAS float*)(F.lds + C::O_F32);
    const bf16* P = WSP(bf16, WS_P); const bf16* XBC = WSP(bf16, WS_XBC); const float* LOGF = WSP(float, WS_HF); const float* DT = WSP(float, WS_DT);
    float* OUT = (MODE == 0) ? WSP(float, WS_OB) : (MODE == 1 ? WSP(float, WS_OB + 2 * SZ_O) : WSP(float, WS_OB + SZ_O));
    const int tid = F.tid, lane = F.lane, w = F.wave, fr = lane & 15, g = lane >> 4, tt = w & 3, vh = w >> 2;
    const float lg = (MODE == 1) ? log1pf(-exp2f(-5.f - (float)h)) : 0.f;
    float ssd_A = 0.f, ssd_D = 0.f;
    if (MODE == 2) { ssd_A = -__expf(F.in[I_SALOG][l * 16 + h]); ssd_D = F.in[I_SD][l * 16 + h]; }
    const int grp = h >> 3;
    for (int i = tid; i < V * QS_STR / 2; i += NTHR) ((LAS unsigned*)S0T)[i] = 0u;
    f32x4 S[NVT];
#pragma unroll
    for (int i = 0; i < NVT; ++i) S[i] = (f32x4){0.f, 0.f, 0.f, 0.f};
    float lf[16]; unsigned short qv[16], kv[16];
    v4u ra[10]; float rdt = 0.f;
    const int kd = tid & 127, seg = tid >> 7, stok = tid >> 3, sg = tid & 7;
    auto load_chunk = [&](int c) {
        const size_t rowb = (size_t)b * SEQ + 64 * c;
        if (MODE == 0) {
#pragma unroll
            for (int j = 0; j < 16; ++j) { const size_t row = rowb + 16 * seg + j; lf[j] = LOGF[row * 1024 + h * 128 + kd]; qv[j] = P[row * NP + C_HQ + h * 128 + kd]; kv[j] = P[row * NP + C_HF + h * 128 + kd]; }
            const bf16* vp = P + (rowb + stok) * NP + C_HI + h * 128 + 16 * sg; ra[0] = *(const v4u*)vp; ra[1] = *(const v4u*)(vp + 8);
        } else if (MODE == 1) {
            const bf16* rp = P + (rowb + stok) * NP + h * 128;
            ra[0] = *(const v4u*)(rp + C_RQ + 8 * sg); ra[1] = *(const v4u*)(rp + C_RQ + 64 + 8 * sg); ra[2] = *(const v4u*)(rp + C_RK + 8 * sg); ra[3] = *(const v4u*)(rp + C_RK + 64 + 8 * sg);
            const v4u* cp = (const v4u*)(WSP(f32x2, WS_ROPE) + (size_t)(64 * c + stok) * 64 + 8 * sg); ra[4] = cp[0]; ra[5] = cp[1]; ra[6] = cp[2]; ra[7] = cp[3];
            ra[8] = *(const v4u*)(rp + C_RV + 16 * sg); ra[9] = *(const v4u*)(rp + C_RV + 16 * sg + 8);
        } else {
            const bf16* xp = XBC + (rowb + stok) * SSD_CD;
            ra[0] = *(const v4u*)(xp + 1024 + grp * 128 + 16 * sg); ra[1] = *(const v4u*)(xp + 1024 + grp * 128 + 16 * sg + 8);
            ra[2] = *(const v4u*)(xp + 1280 + grp * 128 + 16 * sg); ra[3] = *(const v4u*)(xp + 1280 + grp * 128 + 16 * sg + 8);
            ra[4] = *(const v4u*)(xp + h * 64 + 8 * sg);
            rdt = DT[(rowb + lane) * 16 + h];
        }
    };
    auto stage_chunk = [&]() {
        if (MODE == 0) {
            float cs[16]; cs[0] = lf[0];
#pragma unroll
            for (int j = 1; j < 16; ++j) cs[j] = cs[j - 1] + lf[j];
            FA[seg * 128 + kd] = cs[15];
            __syncthreads();
            const float s0 = FA[kd], s1 = FA[128 + kd], s2 = FA[256 + kd], s3 = FA[384 + kd];
            const float off = (seg > 0 ? s0 : 0.f) + (seg > 1 ? s1 : 0.f) + (seg > 2 ? s2 : 0.f), beta = s0 + s1, bC = (s0 + s1) + (s2 + s3);
            unsigned ktp[8];
#pragma unroll
            for (int j = 0; j < 16; ++j) { const float bt = off + cs[j], q = bf2f(qv[j]), k = bf2f(kv[j]); const int t = 16 * seg + j;
                const unsigned qs = f2bf(q * __expf(fminf(bt - beta, 80.f))), qh = f2bf(q * __expf(bt)), kt = f2bf(k * __expf(fminf(beta - bt, 80.f)));
                QS[t * QS_STR + kd] = (bf16)qs; QH[t * QS_STR + kd] = (bf16)qh; KS[t * QS_STR + kd] = (bf16)kt;
                if (j & 1) ktp[j >> 1] |= kt << 16; else ktp[j >> 1] = kt; }
            *(LAS v4u*)(KT + kd * KT_STR + 16 * seg) = (v4u){ktp[0], ktp[1], ktp[2], ktp[3]}; *(LAS v4u*)(KT + kd * KT_STR + 16 * seg + 8) = (v4u){ktp[4], ktp[5], ktp[6], ktp[7]};
            if (seg == 0) { FA[512 + kd] = __expf(bC); FA[640 + kd] = __expf(bC - beta); }
            const unsigned vw[8] = {ra[0].x, ra[0].y, ra[0].z, ra[0].w, ra[1].x, ra[1].y, ra[1].z, ra[1].w};
#pragma unroll
            for (int i = 0; i < 8; ++i) { VT[(16 * sg + 2 * i) * KT_STR + stok] = (bf16)(vw[i] & 0xffffu); VT[(16 * sg + 2 * i + 1) * KT_STR + stok] = (bf16)(vw[i] >> 16); }
        } else if (MODE == 1) {
            const unsigned q1[4] = {ra[0].x, ra[0].y, ra[0].z, ra[0].w}, q2[4] = {ra[1].x, ra[1].y, ra[1].z, ra[1].w}, k1[4] = {ra[2].x, ra[2].y, ra[2].z, ra[2].w}, k2[4] = {ra[3].x, ra[3].y, ra[3].z, ra[3].w};
            const unsigned csw[16] = {ra[4].x, ra[4].y, ra[4].z, ra[4].w, ra[5].x, ra[5].y, ra[5].z, ra[5].w, ra[6].x, ra[6].y, ra[6].z, ra[6].w, ra[7].x, ra[7].y, ra[7].z, ra[7].w};
            unsigned qa[4], qb[4], ka[4], kb[4];
            const float ksc = 0.08838834764831845f;
#pragma unroll
            for (int i = 0; i < 4; ++i) {
                const float c0 = __uint_as_float(csw[4 * i]), s0 = __uint_as_float(csw[4 * i + 1]), c1 = __uint_as_float(csw[4 * i + 2]), s1 = __uint_as_float(csw[4 * i + 3]);
                const float a0 = bflo(q1[i]), a1 = bfhi(q1[i]), b0 = bflo(q2[i]), b1 = bfhi(q2[i]);
                const float qa0 = a0 * c0 - b0 * s0, qa1 = a1 * c1 - b1 * s1, qb0 = a0 * s0 + b0 * c0, qb1 = a1 * s1 + b1 * c1;
                const float e0 = bflo(k1[i]), e1 = bfhi(k1[i]), f0 = bflo(k2[i]), f1 = bfhi(k2[i]);
                const float ka0 = (e0 * c0 - f0 * s0) * ksc, ka1 = (e1 * c1 - f1 * s1) * ksc, kb0 = (e0 * s0 + f0 * c0) * ksc, kb1 = (e1 * s1 + f1 * c1) * ksc;
                qa[i] = pk2(qa0, qa1); qb[i] = pk2(qb0, qb1); ka[i] = pk2(ka0, ka1); kb[i] = pk2(kb0, kb1); }
            *(LAS v4u*)(QS + stok * QS_STR + 8 * sg) = (v4u){qa[0], qa[1], qa[2], qa[3]}; *(LAS v4u*)(QS + stok * QS_STR + 64 + 8 * sg) = (v4u){qb[0], qb[1], qb[2], qb[3]};
            *(LAS v4u*)(KS + stok * QS_STR + 8 * sg) = (v4u){ka[0], ka[1], ka[2], ka[3]}; *(LAS v4u*)(KS + stok * QS_STR + 64 + 8 * sg) = (v4u){kb[0], kb[1], kb[2], kb[3]};
#pragma unroll
            for (int i = 0; i < 4; ++i) { KT[(8 * sg + 2 * i) * KT_STR + stok] = (bf16)(ka[i] & 0xffffu); KT[(8 * sg + 2 * i + 1) * KT_STR + stok] = (bf16)(ka[i] >> 16);
                KT[(64 + 8 * sg + 2 * i) * KT_STR + stok] = (bf16)(kb[i] & 0xffffu); KT[(64 + 8 * sg + 2 * i + 1) * KT_STR + stok] = (bf16)(kb[i] >> 16); }
            const float ws = __expf(lg * (float)(63 - stok));
            const unsigned vw[8] = {ra[8].x, ra[8].y, ra[8].z, ra[8].w, ra[9].x, ra[9].y, ra[9].z, ra[9].w};
#pragma unroll
            for (int i = 0; i < 8; ++i) { const float v0 = bflo(vw[i]), v1 = bfhi(vw[i]);
                VT[(16 * sg + 2 * i) * KT_STR + stok] = (bf16)(vw[i] & 0xffffu); VT[(16 * sg + 2 * i + 1) * KT_STR + stok] = (bf16)(vw[i] >> 16);
                VD[(16 * sg + 2 * i) * KT_STR + stok] = (bf16)f2bf(v0 * ws); VD[(16 * sg + 2 * i + 1) * KT_STR + stok] = (bf16)f2bf(v1 * ws); }
        } else {
            float bs = rdt * ssd_A;
#pragma unroll
            for (int o = 1; o < 64; o <<= 1) { const float up = __shfl_up(bs, o); if (lane >= o) bs += up; }
            const float bC = __shfl(bs, 63), bmy = __shfl(bs, stok), dtm = __shfl(rdt, stok);
            if (w == 0) { FA[lane] = bs; FA[64 + lane] = __expf(bs); }
            *(LAS v4u*)(KS + stok * QS_STR + 16 * sg) = ra[0]; *(LAS v4u*)(KS + stok * QS_STR + 16 * sg + 8) = ra[1];
            *(LAS v4u*)(QS + stok * QS_STR + 16 * sg) = ra[2]; *(LAS v4u*)(QS + stok * QS_STR + 16 * sg + 8) = ra[3];
            const unsigned bw[8] = {ra[0].x, ra[0].y, ra[0].z, ra[0].w, ra[1].x, ra[1].y, ra[1].z, ra[1].w};
#pragma unroll
            for (int i = 0; i < 8; ++i) { KT[(16 * sg + 2 * i) * KT_STR + stok] = (bf16)(bw[i] & 0xffffu); KT[(16 * sg + 2 * i + 1) * KT_STR + stok] = (bf16)(bw[i] >> 16); }
            const float ws = __expf(bC - bmy);
            const unsigned xw[4] = {ra[4].x, ra[4].y, ra[4].z, ra[4].w};
#pragma unroll
            for (int i = 0; i < 4; ++i) { const float x0 = bflo(xw[i]), x1 = bfhi(xw[i]);
                XT[(8 * sg + 2 * i) * KT_STR + stok] = (bf16)(xw[i] & 0xffffu); XT[(8 * sg + 2 * i + 1) * KT_STR + stok] = (bf16)(xw[i] >> 16);
                VT[(8 * sg + 2 * i) * KT_STR + stok] = (bf16)f2bf(x0 * dtm); VT[(8 * sg + 2 * i + 1) * KT_STR + stok] = (bf16)f2bf(x1 * dtm);
                VD[(8 * sg + 2 * i) * KT_STR + stok] = (bf16)f2bf(x0 * dtm * ws); VD[(8 * sg + 2 * i + 1) * KT_STR + stok] = (bf16)f2bf(x1 * dtm * ws); }
        }
    };
    load_chunk(0);
    stage_chunk();
    __syncthreads();
    for (int c = 0; c < SEQ / 64; ++c) {
        if (c + 1 < SEQ / 64) load_chunk(c + 1);
        const size_t row0 = (size_t)b * SEQ + 64 * c;
        f32x4 sc[4];
#pragma unroll
        for (int st = 0; st < 4; ++st) { sc[st] = (f32x4){0.f, 0.f, 0.f, 0.f};
            if (st <= tt) {
#pragma unroll
                for (int ks = 0; ks < 4; ++ks) { const bf16x8 a = *(const LAS bf16x8*)(KS + (16 * st + fr) * QS_STR + 32 * ks + 8 * g), bq = *(const LAS bf16x8*)(QS + (16 * tt + fr) * QS_STR + 32 * ks + 8 * g);
                    sc[st] = __builtin_amdgcn_mfma_f32_16x16x32_bf16(a, bq, sc[st], 0, 0, 0); } } }
        const int tloc = 16 * tt + fr;
        float btt = 0.f; if (MODE == 2) btt = FA[tloc];
        unsigned pw[8];
#pragma unroll
        for (int st = 0; st < 4; ++st) { float vals[4];
#pragma unroll
            for (int reg = 0; reg < 4; ++reg) { const int s = 16 * st + 4 * g + reg; float x = sc[st][reg];
                if (MODE == 1) x *= __expf(lg * (float)(tloc - s));
                if (MODE == 2) x *= __expf(fminf(btt - FA[s], 0.f));
                vals[reg] = (st <= tt && s <= tloc) ? x : 0.f; }
            pw[2 * st] = pk2(vals[0], vals[1]); pw[2 * st + 1] = pk2(vals[2], vals[3]); }
        const bf16x8 pf0 = __builtin_bit_cast(bf16x8, ((v4u){pw[0], pw[1], pw[2], pw[3]})), pf1 = __builtin_bit_cast(bf16x8, ((v4u){pw[4], pw[5], pw[6], pw[7]}));
        LAS bf16* QX = (MODE == 0) ? QH : QS;
#pragma unroll
        for (int vi = 0; vi < NVW; ++vi) { const int vt = vh * NVW + vi; const LAS bf16* vrow = VT + (16 * vt + fr) * KT_STR;
            f32x4 o = (f32x4){0.f, 0.f, 0.f, 0.f}, oi = (f32x4){0.f, 0.f, 0.f, 0.f};
            { const bf16x8 bv = mk_frag(*(const LAS v2u*)(vrow + 4 * g), *(const LAS v2u*)(vrow + 16 + 4 * g)); o = __builtin_amdgcn_mfma_f32_16x16x32_bf16(pf0, bv, o, 0, 0, 0); }
            if (tt >= 2) { const bf16x8 bv = mk_frag(*(const LAS v2u*)(vrow + 32 + 4 * g), *(const LAS v2u*)(vrow + 48 + 4 * g)); o = __builtin_amdgcn_mfma_f32_16x16x32_bf16(pf1, bv, o, 0, 0, 0); }
#pragma unroll
            for (int ks = 0; ks < 4; ++ks) { const bf16x8 a = *(const LAS bf16x8*)(QX + (16 * tt + fr) * QS_STR + 32 * ks + 8 * g), bs = *(const LAS bf16x8*)(S0T + (16 * vt + fr) * QS_STR + 32 * ks + 8 * g);
                oi = __builtin_amdgcn_mfma_f32_16x16x32_bf16(a, bs, oi, 0, 0, 0); }
#pragma unroll
            for (int reg = 0; reg < 4; ++reg) { const int t = 16 * tt + 4 * g + reg; float val;
                if (MODE == 0) val = o[reg] + oi[reg];
                else if (MODE == 1) val = o[reg] + __expf(lg * (float)(t + 1)) * oi[reg];
                else val = o[reg] + FA[64 + t] * oi[reg] + ssd_D * bf2f(XT[(16 * vt + fr) * KT_STR + t]);
                OUT[(row0 + t) * 1024 + h * V + 16 * vt + fr] = val; } }
        { const LAS bf16* VX = (MODE == 0) ? VT : VD;
          float e1[4], e2[4];
#pragma unroll
          for (int reg = 0; reg < 4; ++reg) { if (MODE == 0) { e1[reg] = FA[512 + 16 * w + 4 * g + reg]; e2[reg] = FA[640 + 16 * w + 4 * g + reg]; } else if (MODE == 1) { e1[reg] = __expf(lg * 64.f); e2[reg] = 1.f; } else { e1[reg] = FA[64 + 63]; e2[reg] = 1.f; } }
          const bf16x8 ka0 = *(const LAS bf16x8*)(KT + (16 * w + fr) * KT_STR + 8 * g), ka1 = *(const LAS bf16x8*)(KT + (16 * w + fr) * KT_STR + 32 + 8 * g);
#pragma unroll
          for (int vt = 0; vt < NVT; ++vt) { f32x4 d = (f32x4){0.f, 0.f, 0.f, 0.f};
              const bf16x8 b0 = *(const LAS bf16x8*)(VX + (16 * vt + fr) * KT_STR + 8 * g), b1 = *(const LAS bf16x8*)(VX + (16 * vt + fr) * KT_STR + 32 + 8 * g);
              d = __builtin_amdgcn_mfma_f32_16x16x32_bf16(ka0, b0, d, 0, 0, 0); d = __builtin_amdgcn_mfma_f32_16x16x32_bf16(ka1, b1, d, 0, 0, 0);
#pragma unroll
              for (int reg = 0; reg < 4; ++reg) S[vt][reg] = e1[reg] * S[vt][reg] + e2[reg] * d[reg]; } }
        __syncthreads();
#pragma unroll
        for (int vt = 0; vt < NVT; ++vt) *(LAS v2u*)(S0T + (16 * vt + fr) * QS_STR + 16 * w + 4 * g) = (v2u){pk2(S[vt][0], S[vt][1]), pk2(S[vt][2], S[vt][3])};
        if (c + 1 < SEQ / 64) stage_chunk();
        __syncthreads();
    }
    float* so = F.out + (MODE == 0 ? O_HG_P : (MODE == 1 ? O_RET_P : O_SSD_P)) + (((size_t)l * NBATCH + b) * NH + h) * (128 * V);
#pragma unroll
    for (int vt = 0; vt < NVT; ++vt)
#pragma unroll
        for (int reg = 0; reg < 4; ++reg) so[(size_t)(16 * w + 4 * g + reg) * V + 16 * vt + fr] = S[vt][reg];
}

constexpr int TB = 16;
constexpr int R_DEC = 0, R_KK = TB * 128 * 4, R_Q = 2 * TB * 128 * 4, R_VV = 3 * TB * 128 * 4, R_XS = R_VV + TB * 64 * 4, R_DSC = R_XS + TB * 64 * 4;
template <int MODE>
__device__ __forceinline__ void samp_unit(const Frame& F0, int l, int pair) {
    Frame F = launder(F0);
    constexpr int V = (MODE == 2) ? 64 : 128, NH = (MODE == 2) ? 16 : 8, NKR = (MODE == 2) ? 32 : 16, NJ = 128 / NKR;
    const int s = pair / NH, h = pair - s * NH; const size_t row = MP + s;
    LAS float* DEC = (LAS float*)(F.lds + R_DEC); LAS float* KK = (LAS float*)(F.lds + R_KK); LAS float* Q = (LAS float*)(F.lds + R_Q);
    LAS float* VV = (LAS float*)(F.lds + R_VV); LAS float* XS = (LAS float*)(F.lds + R_XS); LAS float* DSC = (LAS float*)(F.lds + R_DSC);
    LAS float* RED = (LAS float*)(F.lds + 65536);
    const bf16* P = WSP(bf16, WS_P); const bf16* XBC = WSP(bf16, WS_XBC);
    const int tid = F.tid;
    if (MODE == 0) {
        if (tid < 128) { const int k = tid; DEC[k] = __expf(WSP(float, WS_HF)[row * 1024 + h * 128 + k]); KK[k] = bf2f(P[row * NP + C_HF + h * 128 + k]); Q[k] = bf2f(P[row * NP + C_HQ + h * 128 + k]);
            VV[k] = bf2f(P[row * NP + C_HI + h * 128 + k]); }
    } else if (MODE == 1) {
        if (tid < 64) { const int j = tid;
            const float q1 = bf2f(P[row * NP + C_RQ + h * 128 + j]), q2 = bf2f(P[row * NP + C_RQ + h * 128 + 64 + j]);
            const float k1 = bf2f(P[row * NP + C_RK + h * 128 + j]), k2 = bf2f(P[row * NP + C_RK + h * 128 + 64 + j]);
            const f32x2 cs = WSP(f32x2, WS_ROPE)[2048 * 64 + j];
            Q[j] = q1 * cs.x - q2 * cs.y; Q[64 + j] = q1 * cs.y + q2 * cs.x;
            KK[j] = (k1 * cs.x - k2 * cs.y) * 0.08838834764831845f; KK[64 + j] = (k1 * cs.y + k2 * cs.x) * 0.08838834764831845f; }
        else if (tid < 192) { const int v = tid - 64; VV[v] = bf2f(P[row * NP + C_RV + h * 128 + v]); DEC[v] = 1.f - exp2f(-5.f - (float)h); }
    } else {
        if (tid < 320) { const int ch = tid, grp = h >> 3;
            const int cidx = ch < 64 ? h * 64 + ch : (ch < 192 ? 1024 + grp * 128 + (ch - 64) : 1280 + grp * 128 + (ch - 192));
            const float val = bf2f(XBC[row * SSD_CD + cidx]);
            if (ch < 64) { const float dtv = WSP(float, WS_DT)[row * 16 + h]; XS[ch] = val; VV[ch] = val * dtv;
                if (ch == 0) DSC[0] = __expf(dtv * (-__expf(F.in[I_SALOG][l * 16 + h]))); }
            else if (ch < 192) KK[ch - 64] = val; else Q[ch - 192] = val; }
    }
    __syncthreads();
    const int v4 = (MODE == 2) ? (tid & 15) : (tid & 31), kr = (MODE == 2) ? (tid >> 4) : (tid >> 5);
    const float* sin_ = F.in[MODE == 0 ? I_SHG : (MODE == 1 ? I_SRET : I_SSSD)] + (((size_t)l * 128 + s) * NH + h) * (128 * V);
    float* sout = F.out + (MODE == 0 ? O_HG_S : (MODE == 1 ? O_RET_S : O_SSD_S)) + (((size_t)l * 128 + s) * NH + h) * (128 * V);
    const f32x4 vv = *(const LAS f32x4*)(VV + 4 * v4);
    f32x4 sv[NJ];
#pragma unroll
    for (int j = 0; j < NJ; ++j) sv[j] = *(const f32x4*)(sin_ + (size_t)(kr + NKR * j) * V + 4 * v4);
    f32x4 po = (f32x4){0.f, 0.f, 0.f, 0.f};
#pragma unroll
    for (int j = 0; j < NJ; ++j) { const int k = kr + NKR * j; const float dec = (MODE == 2) ? DSC[0] : DEC[k]; const float kk = KK[k], q = Q[k];
        const f32x4 sn = sv[j] * dec + vv * kk; *(f32x4*)(sout + (size_t)k * V + 4 * v4) = sn; po += sn * q; }
    *(LAS f32x4*)(RED + kr * V + 4 * v4) = po;
    __syncthreads();
    if (tid < V) { float o = 0.f;
#pragma unroll
        for (int r = 0; r < NKR; ++r) o += RED[r * V + tid];
        if (MODE == 2) o += F.in[I_SD][l * 16 + h] * XS[tid];
        float* OUT = (MODE == 0) ? WSP(float, WS_OB) : (MODE == 1 ? WSP(float, WS_OB + 2 * SZ_O) : WSP(float, WS_OB + SZ_O));
        OUT[row * 1024 + h * V + tid] = o; }
    __syncthreads();
}

constexpr int CW_QUEUE = 8192;
__device__ __forceinline__ void phase_mix(const Frame& F0, int l) {
    Frame F = launder(F0);
    { const int w = F.c;
        if (w < 32) chunk_unit<0>(F, l, w);
        else if (w < 64) chunk_unit<1>(F, l, w - 32);
        else if (w < 128) chunk_unit<2>(F, l, w - 64);
    }
    __syncthreads();
    volatile LAS unsigned* QW = (volatile LAS unsigned*)(F.lds + LDSCTL_OFF) + 16;
    unsigned* qhead = (unsigned*)(F.ws + WS_CTL) + CW_QUEUE + 64 * l;
    for (;;) {
        if (F.tid == 0) QW[0] = __hip_atomic_fetch_add(qhead, 1u, __ATOMIC_RELAXED, __HIP_MEMORY_SCOPE_AGENT);
        __syncthreads();
        const int p = (int)QW[0];
        __syncthreads();
        if (p >= 4096) break;
        if (p < 1024) samp_unit<0>(F, l, p); else if (p < 2048) samp_unit<1>(F, l, p - 1024); else samp_unit<2>(F, l, p - 2048);
    }
}

__device__ __forceinline__ void phase_post(const Frame& F0, int l) {
    Frame F = launder(F0);
    const bf16* P = WSP(bf16, WS_P);
    const float* LA = WSP(float, WS_X1); const float* LU = LA + (size_t)M * 1024;
    bf16* BR = WSP(bf16, WS_BR);
    const int gt = F.c * NTHR + F.tid, NGT = F.G * NTHR, gw = F.c * NWAVES + F.wave, NGW = F.G * NWAVES, lane = F.lane;
    for (int task = gw; task < NBATCH * 16 * 32; task += NGW) {
        const int b = task >> 9, cg = (task >> 5) & 15, j = task & 31, ch = cg * 64 + lane;
        float h = 0.f;
        for (int jj = 0; jj < j; ++jj) { const size_t row = (size_t)b * SEQ + 64 * jj + 63; h = LA[row * 1024 + ch] * h + LU[row * 1024 + ch]; }
        float hv = 0.f;
        for (int t0 = 0; t0 < 64; t0 += 16) {
            float a[16], u[16], y[16];
#pragma unroll
            for (int q = 0; q < 16; ++q) { const size_t row = (size_t)b * SEQ + 64 * j + t0 + q; a[q] = LA[row * 1024 + ch]; u[q] = LU[row * 1024 + ch]; y[q] = bf2f(P[row * NP + C_YA + ch]); }
#pragma unroll
            for (int q = 0; q < 16; ++q) { const size_t row = (size_t)b * SEQ + 64 * j + t0 + q; hv = a[q] * h + u[q]; BR[row * BW + ch] = (bf16)f2bf(hv * y[q]); }
        }
        if (j == 31) F.out[O_LH_P + ((size_t)l * NBATCH + b) * 1024 + ch] = hv;
    }
    for (int i = gt; i < MS * 1024; i += NGT) { const int s = i >> 10, ch = i & 1023; const size_t row = MP + s;
        const float hp = F.in[I_SLH][((size_t)l * 128 + s) * 1024 + ch]; const float h = LA[row * 1024 + ch] * hp + LU[row * 1024 + ch];
        F.out[O_LH_S + ((size_t)l * 128 + s) * 1024 + ch] = h; BR[row * BW + ch] = (bf16)f2bf(h * bf2f(P[row * NP + C_YA + ch])); }
    for (int task = gw; task < MR * 3; task += NGW) {
        const int row = task / 3, br = task - row * 3;
        const f32x4* src = (const f32x4*)(WSP(float, WS_OB + (size_t)br * SZ_O) + (size_t)row * 1024 + 16 * lane);
        float x[16];
#pragma unroll
        for (int j = 0; j < 4; ++j) { const f32x4 v = src[j]; x[4 * j] = v.x; x[4 * j + 1] = v.y; x[4 * j + 2] = v.z; x[4 * j + 3] = v.w; }
        const int gcol = (br == 0) ? C_HGG : (br == 1 ? C_SZ : C_RG);
        const v4u* gp = (const v4u*)(P + (size_t)row * NP + gcol + 16 * lane); const v4u ga = gp[0], gb = gp[1];
        const unsigned gw_[8] = {ga.x, ga.y, ga.z, ga.w, gb.x, gb.y, gb.z, gb.w};
        float gt_[16];
#pragma unroll
        for (int q = 0; q < 8; ++q) { gt_[2 * q] = bflo(gw_[q]); gt_[2 * q + 1] = bfhi(gw_[q]); }
        float o[16];
        if (br == 1) {
            float ss = 0.f;
#pragma unroll
            for (int j = 0; j < 16; ++j) { x[j] *= gt_[j]; ss += x[j] * x[j]; }
#pragma unroll
            for (int m = 1; m < 32; m <<= 1) ss += __shfl_xor(ss, m);
            const float rs = rsqrtf(ss * (1.f / 512.f) + EPS); const float* nw = F.in[I_SNW] + (size_t)l * 1024 + 16 * lane;
#pragma unroll
            for (int j = 0; j < 16; ++j) o[j] = x[j] * rs * nw[j];
        } else {
            float ss = 0.f;
#pragma unroll
            for (int j = 0; j < 16; ++j) ss += x[j] * x[j];
#pragma unroll
            for (int m = 1; m < 8; m <<= 1) ss += __shfl_xor(ss, m);
            const float rs = rsqrtf(ss * (1.f / 128.f) + EPS);
            if (br == 0) { const float* nw = F.in[I_HGNW] + (size_t)l * 128 + ((16 * lane) & 127);
#pragma unroll
                for (int j = 0; j < 16; ++j) o[j] = x[j] * rs * nw[j] * gt_[j]; }
            else {
#pragma unroll
                for (int j = 0; j < 16; ++j) o[j] = x[j] * rs * gt_[j]; }
        }
        v4u w0, w1; w0.x = pk2(o[0], o[1]); w0.y = pk2(o[2], o[3]); w0.z = pk2(o[4], o[5]); w0.w = pk2(o[6], o[7]); w1.x = pk2(o[8], o[9]); w1.y = pk2(o[10], o[11]); w1.z = pk2(o[12], o[13]); w1.w = pk2(o[14], o[15]);
        v4u* dst = (v4u*)(BR + (size_t)(br + 1) * M * BW + (size_t)row * BW + 16 * lane); dst[0] = w0; dst[1] = w1;
    }
}

__device__ __forceinline__ void phase_act(const Frame& F0, int l) {
    Frame F = launder(F0);
    const bf16* UV = WSP(bf16, WS_P); bf16* A2 = WSP(bf16, WS_G);
    const float* cw = F.in[I_FCW] + (size_t)l * 3 * DFF; const float* cb = F.in[I_FCB] + (size_t)l * DFF;
    const int gt = F.c * NTHR + F.tid, NGT = F.G * NTHR;
    constexpr int C8 = DFF / 8;
    for (int i = gt; i < M * C8; i += NGT) {
        const int row = i / C8, c = (i - row * C8) * 8;
        v4u outw = (v4u){0u, 0u, 0u, 0u};
        if (row < MR) {
            const v4u uw = *(const v4u*)(UV + (size_t)row * NUV + c), vw = *(const v4u*)(UV + (size_t)row * NUV + DFF + c);
            float u0[8] = {bflo(uw.x), bfhi(uw.x), bflo(uw.y), bfhi(uw.y), bflo(uw.z), bfhi(uw.z), bflo(uw.w), bfhi(uw.w)};
            const float vv[8] = {bflo(vw.x), bfhi(vw.x), bflo(vw.y), bfhi(vw.y), bflo(vw.z), bfhi(vw.z), bflo(vw.w), bfhi(vw.w)};
            float u1[8], u2[8];
#pragma unroll
            for (int j = 0; j < 8; ++j) { u1[j] = 0.f; u2[j] = 0.f; }
            if (row < MP) { const int t = row & (SEQ - 1);
                if (t >= 1) { const v4u w = *(const v4u*)(UV + (size_t)(row - 1) * NUV + c); u1[0] = bflo(w.x); u1[1] = bfhi(w.x); u1[2] = bflo(w.y); u1[3] = bfhi(w.y); u1[4] = bflo(w.z); u1[5] = bfhi(w.z); u1[6] = bflo(w.w); u1[7] = bfhi(w.w); }
                if (t >= 2) { const v4u w = *(const v4u*)(UV + (size_t)(row - 2) * NUV + c); u2[0] = bflo(w.x); u2[1] = bfhi(w.x); u2[2] = bflo(w.y); u2[3] = bfhi(w.y); u2[4] = bflo(w.z); u2[5] = bfhi(w.z); u2[6] = bflo(w.w); u2[7] = bfhi(w.w); }
                if (t >= SEQ - 2) { float* so = F.out + O_FC_P + (((size_t)l * NBATCH + (row >> 11)) * 2 + (t - (SEQ - 2))) * DFF + c;
#pragma unroll
                    for (int j = 0; j < 8; ++j) so[j] = u0[j]; }
            } else { const int s = row - MP; const float* st = F.in[I_SFC] + ((size_t)l * MS + s) * 2 * DFF + c; float* so = F.out + O_FC_S + ((size_t)l * MS + s) * 2 * DFF + c;
#pragma unroll
                for (int j = 0; j < 8; ++j) { u2[j] = st[j]; u1[j] = st[DFF + j]; so[j] = st[DFF + j]; so[DFF + j] = u0[j]; } }
            float a[8];
#pragma unroll
            for (int j = 0; j < 8; ++j) { const float y = cb[c + j] + cw[c + j] * u2[j] + cw[DFF + c + j] * u1[j] + cw[2 * DFF + c + j] * u0[j]; a[j] = geluf(y) * vv[j]; }
            outw.x = pk2(a[0], a[1]); outw.y = pk2(a[2], a[3]); outw.z = pk2(a[4], a[5]); outw.w = pk2(a[6], a[7]);
        }
        *(v4u*)(A2 + (size_t)row * DFF + c) = outw;
    }
}

constexpr int PH_PER_LAYER = 11, NPHASE = 1 + NLAYER * PH_PER_LAYER + 1;
__global__ void __launch_bounds__(NTHR, 2) mk_fwd(Args args) {
    extern __shared__ __attribute__((aligned(16))) unsigned char lds_raw[];
    Frame F;
    F.lds = (LAS unsigned char*)lds_raw;
    F.tid = threadIdx.x; F.lane = F.tid & 63; F.wave = __builtin_amdgcn_readfirstlane(F.tid >> 6);
    F.G = gridDim.x; F.c = blockIdx.x;
    F.in = args.in; F.out = args.out; F.ws = args.ws;
    volatile LAS unsigned* MISC = (volatile LAS unsigned*)(F.lds + LDSCTL_OFF);
    if (F.tid < 64) MISC[F.tid] = 0u;
    __syncthreads();
    unsigned* barw = (unsigned*)(F.ws + WS_CTL) + 4096;
    XcdBarrier bar; bar.bar = barw; bar.x = 0; bar.st = nullptr;
    if (!MK_SPLIT) bar = xcd_barrier_post(barw, MISC + 8);
    const int lo = args.ph_lo, hi = args.ph_hi;
#define IN(k) (lo <= (k) && (k) < hi)
#define SEAM(k) do { if (IN(k) && IN((k) + 1)) xcd_barrier(bar); } while (0)
#define X0 WSP(float, WS_X0)
#define X1 WSP(float, WS_X1)
#define H WSP(bf16, WS_H)
#define GEMM_RUN(EPI) do { pg8::gemm_phase<EPI, pg8::TileOrder>(F.lds, g, S, E); if (REP_G > 1) { Frame F1 = launder(F); pg8::gemm_phase<EPI, pg8::TileOrder>(F1.lds, g, S, E); } } while (0)

    if (IN(0) && !(SKMASK & 1)) { phase_prologue(F); } SEAM(0);

    for (int l = 0; l < NLAYER; ++l) {
        const int pb = 1 + l * PH_PER_LAYER;
        if (IN(pb + 0) && !(SKMASK & 2)) { phase_norm(F, X0, F.in[I_GMIX] + (size_t)l * DM, H); } SEAM(pb + 0);
        if (IN(pb + 1) && !(SKMASK & 4)) { const Frame F0 = F; Frame F = launder(F0);
            pg8::Gemm g{H, WSP(bf16, WS_W1 + l * SZ_W1), DM, DM, DM, 0, 0}; pg8::TileOrder S; S.init(M, N1, F.G, F.c, 1);
            Epi1 E{WSP(bf16, WS_P), WSP(float, WS_HF), WSP(float, WS_DT), WSP(bf16, WS_G), WSP(float, WS_LB) + l * 1024};
            GEMM_RUN(Epi1);
        } SEAM(pb + 1);
        if (IN(pb + 2) && !(SKMASK & 8)) { phase_conv(F, l); if (REP_CONV > 1) phase_conv(F, l); } SEAM(pb + 2);
        if (IN(pb + 3) && !(SKMASK & 16)) { phase_mix(F, l); if (REP_MIX > 1) phase_mix(F, l); } SEAM(pb + 3);
        if (IN(pb + 4) && !(SKMASK & 32)) { phase_post(F, l); if (REP_POST > 1) phase_post(F, l); } SEAM(pb + 4);
        if (IN(pb + 5) && !(SKMASK & 64)) { const Frame F0 = F; Frame F = launder(F0);
            pg8::Gemm g{WSP(bf16, WS_BR), WSP(bf16, WS_WB + l * SZ_WB), BW, BW, BW, (size_t)M * BW, (size_t)DM * BW}; pg8::TileOrder S; S.init(M, DM, F.G, F.c, 4);
            EpiBr E{WSP(bf16, WS_G), WSP(bf16, WS_MG)};
            GEMM_RUN(EpiBr);
        } SEAM(pb + 5);
        if (IN(pb + 6) && !(SKMASK & 128)) { const Frame F0 = F; Frame F = launder(F0);
            pg8::Gemm g{WSP(bf16, WS_MG), WSP(bf16, WS_WO + l * SZ_WO), DM, DM, DM, 0, 0}; pg8::TileOrder S; S.init(M, DM, F.G, F.c, 1);
            EpiRes E{X0, X1};
            GEMM_RUN(EpiRes);
        } SEAM(pb + 6);
        if (IN(pb + 7) && !(SKMASK & 256)) { phase_norm(F, X1, F.in[I_GFFN] + (size_t)l * DM, H); } SEAM(pb + 7);
        if (IN(pb + 8) && !(SKMASK & 512)) { const Frame F0 = F; Frame F = launder(F0);
            pg8::Gemm g{H, WSP(bf16, WS_WUV + l * SZ_WUV), DM, DM, DM, 0, 0}; pg8::TileOrder S; S.init(M, NUV, F.G, F.c, 1);
            EpiB E{WSP(bf16, WS_P), NUV};
            GEMM_RUN(EpiB);
        } SEAM(pb + 8);
        if (IN(pb + 9) && !(SKMASK & 1024)) { phase_act(F, l); } SEAM(pb + 9);
        if (IN(pb + 10) && !(SKMASK & 2048)) { const Frame F0 = F; Frame F = launder(F0);
            pg8::Gemm g{WSP(bf16, WS_G), WSP(bf16, WS_WD + l * SZ_WD), DFF, DFF, DFF, 0, 0}; pg8::TileOrder S; S.init(M, DM, F.G, F.c, 1);
            EpiRes E{X1, X0};
            GEMM_RUN(EpiRes);
        } SEAM(pb + 10);
    }
    if (IN(NPHASE - 1) && !(SKMASK & 4096)) { phase_final(F, WSP(float, WS_X0), F.in[I_GFIN]); }
#undef IN
#undef SEAM
#undef X0
#undef X1
#undef H
#undef GEMM_RUN
}

extern "C" void kernel_launch(void* const* d_in, const int* in_sizes, int n_in, void* d_out, int out_size, void* d_ws, size_t ws_size, hipStream_t stream) {
    static int grid = 0;
    if (grid == 0) {
        if (n_in != N_INPUTS || (size_t)out_size != O_END || ws_size < WS_END) { fprintf(stderr, "kernel_launch: unexpected shapes: n_in %d out %d ws %zu (need %zu)\n", n_in, out_size, ws_size, (size_t)WS_END); grid = -1; return; }
        int dev = 0, cus = 0, per_cu = 0;
        if (hipGetDevice(&dev) != hipSuccess || hipDeviceGetAttribute(&cus, hipDeviceAttributeMultiprocessorCount, dev) != hipSuccess) { grid = -1; return; }
        if (hipFuncSetAttribute((const void*)mk_fwd, hipFuncAttributeMaxDynamicSharedMemorySize, LDS_BYTES) != hipSuccess) { fprintf(stderr, "kernel_launch: hipFuncSetAttribute failed\n"); grid = -1; return; }
        if (hipOccupancyMaxActiveBlocksPerMultiprocessor(&per_cu, (const void*)mk_fwd, NTHR, LDS_BYTES) != hipSuccess || per_cu < 1) { fprintf(stderr, "kernel_launch: occupancy query says %d\n", per_cu); }
        (void)hipGetLastError();
        grid = cus;
    }
    if (grid < 0) return;
    (void)hipMemsetAsync((char*)d_ws + WS_CTL, 0, CTL_BYTES, stream);
    Args a{};
    for (int i = 0; i < N_INPUTS; ++i) a.in[i] = (const float*)d_in[i];
    a.out = (float*)d_out; a.ws = (unsigned char*)d_ws;
#if MK_SPLIT
    for (int p = 0; p < NPHASE; ++p) { a.ph_lo = p; a.ph_hi = p + 1; hipLaunchKernelGGL(mk_fwd, dim3(grid), dim3(NTHR), LDS_BYTES, stream, a); }
#else
    a.ph_lo = 0; a.ph_hi = NPHASE;
    hipLaunchKernelGGL(mk_fwd, dim3(grid), dim3(NTHR), LDS_BYTES, stream, a);
#endif
}
```

```cpp
#include <hip/hip_runtime.h>
#include <cstdio>
#include <cstdint>

#ifndef REP_G
#define REP_G 1
#endif
#ifndef REP_CONV
#define REP_CONV 1
#endif
#ifndef REP_MIX
#define REP_MIX 1
#endif
#ifndef REP_POST
#define REP_POST 1
#endif
#ifndef SKMASK
#define SKMASK 0
#endif
#ifndef MK_SPLIT
#define MK_SPLIT 0
#endif

namespace pg8 {
#define PG8_LAS __attribute__((address_space(3)))
typedef unsigned short bf16_t;
typedef short bf16x8 __attribute__((ext_vector_type(8)));
typedef float f32x4 __attribute__((ext_vector_type(4)));
typedef unsigned u32x4 __attribute__((ext_vector_type(4)));
constexpr int BM = 256, BK = 64, HALF = 128, HTB = HALF * BK * 2, STAGE_BYTES = 8 * HTB, NXCD = 8, WGM = 8;

__host__ __device__ __forceinline__ int lds_byte(int r, int c) { const int st = (r >> 4) * 2 + (c >> 5), rr = r & 15, cc = c & 31, ob = rr * 64 + cc * 2; return st * 1024 + (ob ^ (((ob >> 9) & 1) << 5)); }
__host__ __device__ __forceinline__ void stage_rc(int b, int& R, int& C) { const int st = b / 1024, sb = b % 1024, swz = sb ^ (((sb >> 9) & 1) << 5); R = (st >> 1) * 16 + swz / 64; C = (st & 1) * 32 + (swz % 64) / 2; }
__host__ __device__ __forceinline__ int perm32(int rho) { const int n = rho >> 4, i = rho & 15; return 8 * (i >> 2) + 4 * n + (i & 3); }

struct Unit { int pm, pn, kz; };
struct Gemm { const bf16_t* A; const bf16_t* Bt; int lda, ldb, K; size_t azs, bzs; };

struct TileOrder {
    int nM, nN, nwg, G, c, nkz;
    __device__ void init(int M, int N, int G_, int c_, int nkz_) { nM = M / BM; nN = N / BM; nwg = nM * nN; G = G_; c = c_; nkz = nkz_; }
    __device__ bool next(int i, Unit& u) const {
        const int ti = i / nkz; u.kz = i - ti * nkz;
        const long L = (long)ti * G + c; if (L >= nwg) return false;
        int wgid = (int)L; { const int q = nwg / NXCD, r = nwg % NXCD, xcd = wgid % NXCD, off = wgid / NXCD; wgid = (xcd < r ? xcd * (q + 1) : r * (q + 1) + (xcd - r) * q) + off; }
        const int nig = WGM * nN, gid = wgid / nig, fm = gid * WGM, gsz = (nM - fm) < WGM ? (nM - fm) : WGM;
        u.pm = fm + ((wgid % nig) % gsz); u.pn = (wgid % nig) / gsz; return true;
    }
};

__device__ __forceinline__ unsigned cvt_pk_bf16(float lo, float hi) { unsigned r; asm volatile("v_cvt_pk_bf16_f32 %0, %1, %2" : "=v"(r) : "v"(lo), "v"(hi)); return r; }

template <class Epi, class Sched, bool ALIGN_EPI = true>
__device__ __forceinline__ void gemm_phase(PG8_LAS unsigned char* lds, const Gemm g, const Sched& S, const Epi& E) {
    int tid = threadIdx.x; asm volatile("" : "+v"(tid));
    const int wid = __builtin_amdgcn_readfirstlane(tid >> 6), lane = tid & 63, wr = wid >> 2, wc = wid & 3, fr = lane & 15, fq = lane >> 4;
    const int K = g.K, nt = K / BK;
    unsigned voffA[2], voffB[2];
#pragma unroll
    for (int i = 0; i < 2; ++i) { int R, C; stage_rc(tid * 16 + i * 8192, R, C); const int Rb = Epi::PERM ? ((R & ~31) + perm32(R & 31)) : R;
        voffA[i] = (unsigned)(R * g.lda + C) * 2u; voffB[i] = (unsigned)(Rb * g.ldb + C) * 2u; }
    const size_t kstep = (size_t)(BK * 2);
    const size_t hstepA = (size_t)HALF * g.lda * 2, hstepB = (size_t)HALF * g.ldb * 2;
    const size_t tstepA = 2 * hstepA, tstepB = 2 * hstepB;
    const unsigned ldsw = (unsigned)wid * 1024u;
    const int aoff = lds_byte(wr * 64 + fr, fq * 8), boff = lds_byte(wc * 32 + fr, fq * 8);
#define PG8_SA(b, h) (((b) * 2 + (h)) * HTB)
#define PG8_SB(b, h) ((4 + (b) * 2 + (h)) * HTB)
#define PG8_STAGE(bufoff, gbase, voff) do { _Pragma("unroll") for (int _i = 0; _i < 2; ++_i) \
        __builtin_amdgcn_global_load_lds((const unsigned*)((const char*)(gbase) + (voff)[_i]), (PG8_LAS unsigned*)(lds + (bufoff) + ldsw + _i * 8192), 16, 0, 0); } while (0)
#define PG8_LDA(dst, b, h) do { _Pragma("unroll") for (int m = 0; m < 4; ++m) _Pragma("unroll") for (int k = 0; k < 2; ++k) dst[m][k] = *(const PG8_LAS bf16x8*)(lds + PG8_SA(b, h) + aoff + m * 2048 + k * 1024); } while (0)
#define PG8_LDB(dst, b, h) do { _Pragma("unroll") for (int n = 0; n < 2; ++n) _Pragma("unroll") for (int k = 0; k < 2; ++k) dst[n][k] = *(const PG8_LAS bf16x8*)(lds + PG8_SB(b, h) + boff + n * 2048 + k * 1024); } while (0)
#define PG8_MMA(ai, bj, At, Bt) do { __builtin_amdgcn_s_setprio(1); _Pragma("unroll") for (int m = 0; m < 4; ++m) _Pragma("unroll") for (int n = 0; n < 2; ++n) _Pragma("unroll") for (int k = 0; k < 2; ++k) \
        acc[ai][bj][m][n] = __builtin_amdgcn_mfma_f32_16x16x32_bf16(Bt[n][k], At[m][k], acc[ai][bj][m][n], 0, 0, 0); __builtin_amdgcn_s_setprio(0); } while (0)
#define PG8_WAIT_V(n) asm volatile("s_waitcnt vmcnt(" #n ")" ::: "memory")
#define PG8_WAIT_L(n) asm volatile("s_waitcnt lgkmcnt(" #n ")" ::: "memory")
#define PG8_BAR __builtin_amdgcn_s_barrier()
#define PG8_SCHED __builtin_amdgcn_sched_barrier(0)
    Unit cur, nxt; int ui = 0;
    if (!S.next(0, cur)) return;
    f32x4 acc[2][2][4][2];
#pragma unroll
    for (int a = 0; a < 2; ++a)
#pragma unroll
        for (int b = 0; b < 2; ++b)
#pragma unroll
            for (int m = 0; m < 4; ++m)
#pragma unroll
                for (int n = 0; n < 2; ++n) acc[a][b][m][n] = (f32x4){0.f, 0.f, 0.f, 0.f};
    bf16x8 At[4][2], B0[2][2], B1[2][2];
    const char* cA = (const char*)g.A + (size_t)cur.kz * g.azs * 2 + (size_t)cur.pm * tstepA;
    const char* cB = (const char*)g.Bt + (size_t)cur.kz * g.bzs * 2 + (size_t)cur.pn * tstepB;
    PG8_STAGE(PG8_SB(0, 0), cB, voffB); PG8_STAGE(PG8_SB(0, 1), cB + hstepB, voffB); PG8_STAGE(PG8_SA(0, 0), cA, voffA); PG8_STAGE(PG8_SA(0, 1), cA + hstepA, voffA);
    if (wr == 1) PG8_BAR;
    PG8_WAIT_V(2); PG8_BAR;
    PG8_STAGE(PG8_SB(1, 0), cB + kstep, voffB); PG8_STAGE(PG8_SA(1, 0), cA + kstep, voffA); PG8_STAGE(PG8_SB(1, 1), cB + hstepB + kstep, voffB);
    PG8_WAIT_V(6); PG8_BAR;
    for (;;) {
        const bool has_next = S.next(ui + 1, nxt);
        const char* nA = has_next ? (const char*)g.A + (size_t)nxt.kz * g.azs * 2 + (size_t)nxt.pm * tstepA : cA;
        const char* nB = has_next ? (const char*)g.Bt + (size_t)nxt.kz * g.bzs * 2 + (size_t)nxt.pn * tstepB : cB;
        for (int t = 0; t < nt; t += 2) {
            const bool last = (t == nt - 2);
            const char* a1 = cA + (size_t)(t + 1) * kstep;
            const char* a2 = last ? nA : cA + (size_t)(t + 2) * kstep; const char* b2 = last ? nB : cB + (size_t)(t + 2) * kstep;
            const char* a3 = a2 + kstep; const char* b3 = b2 + kstep;
            PG8_LDB(B0, 0, 0); PG8_LDB(B1, 0, 1); PG8_SCHED; PG8_LDA(At, 0, 0); PG8_STAGE(PG8_SA(1, 1), a1 + hstepA, voffA);
            PG8_WAIT_V(8); PG8_WAIT_L(0); PG8_BAR; PG8_MMA(0, 0, At, B0); PG8_MMA(0, 1, At, B1); PG8_BAR; PG8_SCHED;
            PG8_LDA(At, 0, 1); PG8_STAGE(PG8_SB(0, 0), b2, voffB); PG8_STAGE(PG8_SB(0, 1), b2 + hstepB, voffB); PG8_STAGE(PG8_SA(0, 0), a2, voffA);
            PG8_WAIT_V(8); PG8_WAIT_L(0); PG8_BAR; PG8_MMA(1, 0, At, B0); PG8_MMA(1, 1, At, B1); PG8_BAR; PG8_SCHED;
            PG8_LDB(B0, 1, 0); PG8_LDB(B1, 1, 1); PG8_SCHED; PG8_LDA(At, 1, 0); PG8_STAGE(PG8_SA(0, 1), a2 + hstepA, voffA);
            PG8_WAIT_V(8); PG8_WAIT_L(0); PG8_BAR; PG8_MMA(0, 0, At, B0); PG8_MMA(0, 1, At, B1); PG8_BAR; PG8_SCHED;
            PG8_LDA(At, 1, 1); PG8_STAGE(PG8_SB(1, 0), b3, voffB); PG8_STAGE(PG8_SB(1, 1), b3 + hstepB, voffB); PG8_STAGE(PG8_SA(1, 0), a3, voffA);
            PG8_WAIT_V(8); PG8_WAIT_L(0); PG8_BAR; PG8_MMA(1, 0, At, B0); PG8_MMA(1, 1, At, B1); PG8_BAR; PG8_SCHED;
        }
        if constexpr (ALIGN_EPI) { if (wr == 0) PG8_BAR; }
        E(acc, cur, wr, wc, fr, fq);
        if (!has_next) break;
        if (!E.keep(cur)) {
#pragma unroll
            for (int a = 0; a < 2; ++a)
#pragma unroll
                for (int b = 0; b < 2; ++b)
#pragma unroll
                    for (int m = 0; m < 4; ++m)
#pragma unroll
                        for (int n = 0; n < 2; ++n) acc[a][b][m][n] = (f32x4){0.f, 0.f, 0.f, 0.f};
        }
        cur = nxt; cA = nA; cB = nB; ++ui;
        if constexpr (ALIGN_EPI) { if (wr == 1) PG8_BAR; }
    }
    PG8_WAIT_V(0);
    if constexpr (!ALIGN_EPI) { if (wr == 0) PG8_BAR; }
    PG8_BAR;
#undef PG8_SA
#undef PG8_SB
#undef PG8_STAGE
#undef PG8_LDA
#undef PG8_LDB
#undef PG8_MMA
#undef PG8_WAIT_V
#undef PG8_WAIT_L
#undef PG8_BAR
#undef PG8_SCHED
}
}

constexpr int NWAVES = 8, NTHR = 512;
constexpr int DM = 2048, NBATCH = 4, SEQ = 2048, MP = NBATCH * SEQ, MS = 128, MR = MP + MS, M = 8448;
constexpr int NLAYER = 2;
constexpr int NIN = 12816, NP = 13056, NG = 8192, N1 = NP + NG;
constexpr int DFF = 5632, NUV = 2 * DFF;
constexpr int BW = 1024;
constexpr float EPS = 1e-6f;
constexpr int C_XA = 0, C_YA = 1024, C_HQ = 2048, C_HF = 3072, C_HI = 4096, C_HGG = 5120, C_SZ = 6144, C_SX = 7168, C_SDT = 8704, C_RQ = 8960, C_RK = 9984, C_RV = 11008, C_RG = 12032;
constexpr int SRC_SPLIT = 8720;
constexpr int SSD_CD = 1536;

enum { I_XP = 0, I_XS, I_SLH, I_SLC, I_SHG, I_SSSD, I_SSC, I_SRET, I_SFC, I_GMIX, I_GFFN, I_WIN, I_LCW, I_LCB, I_LWA, I_LBA, I_LWX, I_LBX, I_LLAM, I_HGLB, I_HGNW,
       I_SCW, I_SCB, I_SDTB, I_SALOG, I_SD, I_SNW, I_WBR, I_WGATE, I_WOUT, I_WUP, I_WVAL, I_FCW, I_FCB, I_WDOWN, I_GFIN, N_INPUTS };

constexpr size_t O_YP = 0, O_YS = O_YP + (size_t)MP * DM, O_LH_P = O_YS + (size_t)MS * DM, O_LH_S = O_LH_P + 2 * 4 * 1024, O_LC_P = O_LH_S + 2 * 128 * 1024,
    O_LC_S = O_LC_P + 2 * 4 * 3 * 1024, O_HG_P = O_LC_S + 2 * 128 * 3 * 1024, O_HG_S = O_HG_P + (size_t)2 * 4 * 8 * 16384, O_SSD_P = O_HG_S + (size_t)2 * 128 * 8 * 16384,
    O_SSD_S = O_SSD_P + (size_t)2 * 4 * 16 * 8192, O_SC_P = O_SSD_S + (size_t)2 * 128 * 16 * 8192, O_SC_S = O_SC_P + 2 * 4 * 3 * 1536, O_RET_P = O_SC_S + 2 * 128 * 3 * 1536,
    O_RET_S = O_RET_P + (size_t)2 * 4 * 8 * 16384, O_FC_P = O_RET_S + (size_t)2 * 128 * 8 * 16384, O_FC_S = O_FC_P + 2 * 4 * 2 * 5632, O_END = O_FC_S + (size_t)2 * 128 * 2 * 5632;
static_assert(O_END == 126119936ull, "output size");

constexpr size_t AL(size_t x) { return (x + 4095) & ~(size_t)4095; }
constexpr size_t WS_CTL = 0, CTL_BYTES = 1u << 20;
constexpr size_t SZ_W1 = (size_t)N1 * DM * 2, SZ_WB = (size_t)4 * DM * BW * 2, SZ_WO = (size_t)DM * DM * 2, SZ_WUV = (size_t)NUV * DM * 2, SZ_WD = (size_t)DM * DFF * 2;
constexpr size_t WS_W1 = CTL_BYTES, WS_WB = WS_W1 + 2 * SZ_W1, WS_WO = WS_WB + 2 * SZ_WB, WS_WUV = WS_WO + 2 * SZ_WO, WS_WD = WS_WUV + 2 * SZ_WUV;
constexpr size_t WS_ROPE = WS_WD + 2 * SZ_WD, SZ_ROPE = AL((size_t)2049 * 64 * 8);
constexpr size_t SZ_X = (size_t)M * DM * 4;
constexpr size_t WS_X0 = WS_ROPE + SZ_ROPE, WS_X1 = WS_X0 + SZ_X;
constexpr size_t WS_H = WS_X1 + SZ_X, SZ_H = (size_t)M * DM * 2;
constexpr size_t WS_P = WS_H + SZ_H, SZ_P = (size_t)M * NP * 2;
constexpr size_t WS_G = WS_P + SZ_P, SZ_G = (size_t)M * NG * 2;
constexpr size_t WS_HF = WS_G + SZ_G, SZ_HF = (size_t)M * 1024 * 4;
constexpr size_t WS_DT = WS_HF + SZ_HF, SZ_DT = AL((size_t)M * 16 * 4);
constexpr size_t WS_OB = WS_DT + SZ_DT, SZ_O = (size_t)M * 1024 * 4;
constexpr size_t WS_BR = WS_OB + 3 * SZ_O, SZ_BR = (size_t)4 * M * BW * 2;
constexpr size_t WS_MG = WS_BR + SZ_BR, SZ_MG = (size_t)M * DM * 2;
constexpr size_t WS_XBC = WS_MG + SZ_MG, SZ_XBC = (size_t)M * SSD_CD * 2;
constexpr size_t WS_LB = WS_XBC + SZ_XBC, SZ_LB = AL((size_t)NLAYER * 1024 * 4);
constexpr size_t WS_END = WS_LB + SZ_LB;
static_assert((size_t)M * NUV * 2 <= SZ_P && (size_t)M * DFF * 2 <= SZ_G && 2 * SZ_O <= SZ_X, "overlays");

constexpr int RING_BYTES = 131072, LDSCTL_OFF = RING_BYTES, LDS_BYTES = 147456;

#define GAS __attribute__((address_space(1)))
#define LAS __attribute__((address_space(3)))
typedef unsigned short bf16;
typedef unsigned v4u __attribute__((ext_vector_type(4)));
typedef unsigned v2u __attribute__((ext_vector_type(2)));
typedef float f32x4 __attribute__((ext_vector_type(4)));
typedef float f32x2 __attribute__((ext_vector_type(2)));
typedef short bf16x8 __attribute__((ext_vector_type(8)));
#define LDS_WAIT() asm volatile("s_waitcnt lgkmcnt(0)" ::: "memory")
__device__ __forceinline__ unsigned f2bf(float f) { unsigned u = __builtin_bit_cast(unsigned, f); return (u + 0x7fffu + ((u >> 16) & 1u)) >> 16; }
__device__ __forceinline__ unsigned pk2(float lo, float hi) { return f2bf(lo) | (f2bf(hi) << 16); }
__device__ __forceinline__ float bf2f(unsigned short b) { return __uint_as_float(((unsigned)b) << 16); }
__device__ __forceinline__ float bflo(unsigned w) { return __uint_as_float(w << 16); }
__device__ __forceinline__ float bfhi(unsigned w) { return __uint_as_float(w & 0xffff0000u); }
__device__ __forceinline__ float sigm(float x) { return 1.f / (1.f + __expf(-x)); }
__device__ __forceinline__ float siluf(float x) { return x * sigm(x); }
__device__ __forceinline__ float geluf(float x) { return x * sigm(1.5957691216057308f * (x + 0.044715f * x * x * x)); }
__device__ __forceinline__ float softplusf(float x) { return x > 20.f ? x : log1pf(__expf(x)); }

#define XB_TMO      128
#define XB_XCNT(j)  (256  + 64 * (j))
#define XB_XSUB(j)  (1280 + 64 * (j))
#define XB_XGEN(j)  (2304 + 64 * (j))
#define XB_TOP      3328
#define XB_TOPGEN   3392
#define XCD_BAR_WORDS 3456
#define XB_SPIN_CAP (1u << 19)
__device__ __forceinline__ unsigned xb_ld(unsigned* p)              { return __hip_atomic_load(p, __ATOMIC_RELAXED, __HIP_MEMORY_SCOPE_AGENT); }
__device__ __forceinline__ unsigned xb_add(unsigned* p, unsigned v) { return __hip_atomic_fetch_add(p, v, __ATOMIC_RELAXED, __HIP_MEMORY_SCOPE_AGENT); }
__device__ __forceinline__ unsigned xb_xcc_id() { return (unsigned)__builtin_amdgcn_s_getreg((3 << 11) | 20) & 0xFu; }
#define XB_SPIN(cond, bar) do { unsigned _sp = 0; while (cond) { __builtin_amdgcn_s_sleep(1); \
    if ((++_sp & 255u) == 0u) { if (xb_ld(&(bar)[XB_TMO])) break; if (_sp > XB_SPIN_CAP) { atomicAdd(&(bar)[XB_TMO], 1u); break; } } } } while (0)
struct XcdBarrier { unsigned* bar; unsigned x; volatile LAS unsigned* st; };
__device__ __forceinline__ XcdBarrier xcd_barrier_post(unsigned* bar, volatile LAS unsigned* st) {
    XcdBarrier b; b.bar = bar; b.x = xb_xcc_id(); b.st = st;
    if (threadIdx.x == 0) (void)xb_add(&bar[XB_XCNT(b.x)], 1u);
    return b;
}
__device__ __forceinline__ void xcd_barrier_complete(unsigned* bar, unsigned x, unsigned& nloc, unsigned& nx) {
    const unsigned G = gridDim.x * gridDim.y * gridDim.z;
    unsigned sum, cnt, mine, sp = 0u;
    for (;;) {
        sum = 0u; cnt = 0u; mine = 0u;
#pragma unroll
        for (unsigned j = 0; j < 16; ++j) { const unsigned c = xb_ld(&bar[XB_XCNT(j)]); sum += c; cnt += (c > 0u) ? 1u : 0u; mine = (j == x) ? c : mine; }
        if (sum == G) break;
        __builtin_amdgcn_s_sleep(1);
        if ((++sp & 255u) == 0u) { if (xb_ld(&bar[XB_TMO])) break; if (sp > XB_SPIN_CAP) { atomicAdd(&bar[XB_TMO], 1u); break; } }
    }
    nloc = mine > 0u ? mine : 1u; nx = cnt > 0u ? cnt : 1u;
}
__device__ __forceinline__ void xcd_barrier(const XcdBarrier& b) {
    asm volatile("s_waitcnt vmcnt(0)" ::: "memory");
    __syncthreads();
    if (threadIdx.x == 0) {
        unsigned* bar = b.bar;
        __builtin_amdgcn_s_waitcnt(0);
        unsigned nloc = b.st[0], nx = b.st[1];
        if (nloc == 0u) { xcd_barrier_complete(bar, b.x, nloc, nx); b.st[0] = nloc; b.st[1] = nx; }
        const unsigned old = xb_add(&bar[XB_XSUB(b.x)], 1u);
        const unsigned gen = old / nloc;
        if (old + 1u == (gen + 1u) * nloc) {
            __builtin_amdgcn_fence(__ATOMIC_RELEASE, "agent");
            asm volatile("s_waitcnt vmcnt(0)" ::: "memory");
            const unsigned og = xb_add(&bar[XB_TOP], 1u);
            const unsigned tg = og / nx;
            if (og + 1u == (tg + 1u) * nx) xb_add(&bar[XB_TOPGEN], 1u);
            else XB_SPIN(xb_ld(&bar[XB_TOPGEN]) == tg, bar);
            __builtin_amdgcn_fence(__ATOMIC_ACQUIRE, "agent");
            xb_add(&bar[XB_XGEN(b.x)], 1u);
            asm volatile("s_waitcnt vmcnt(0)" ::: "memory");
        } else {
            XB_SPIN(xb_ld(&bar[XB_XGEN(b.x)]) == gen, bar);
            __builtin_amdgcn_fence(__ATOMIC_ACQUIRE, "agent");
            asm volatile("s_waitcnt vmcnt(0)" ::: "memory");
        }
    }
    __syncthreads();
}

struct Args { const float* in[N_INPUTS]; float* out; unsigned char* ws; int ph_lo, ph_hi; };

struct Frame {
    LAS unsigned char* lds;
    int tid, lane, wave, G, c;
    const float* const* in;
    float* out;
    unsigned char* ws;
};
#define WSP(T, off) ((T*)(F.ws + (off)))
__device__ __forceinline__ Frame launder(const Frame& F0) {
    Frame F = F0;
    asm volatile("" : "+v"(F.tid), "+v"(F.lane));
    asm volatile("" : "+s"(F.wave), "+s"(F.G), "+s"(F.c));
    { int z = 0; asm volatile("" : "+s"(z)); F.in += z; F.out += z; F.ws += z; }
    asm volatile("" : "+s"(F.lds));
    return F;
}

using pg8::f32x4;
using pg8::Unit;
using pg8::cvt_pk_bf16;

struct Epi1 {
    static constexpr bool PERM = true;
    bf16* P; float* HF; float* DT; bf16* Gt; const float* LB;
    __device__ __forceinline__ bool keep(const Unit&) const { return false; }
    template <int ACT> __device__ __forceinline__ void store_act(f32x4 (&acc)[2][2][4][2], bf16* base, int ld, int row0, int colb) const {
#pragma unroll
        for (int ai = 0; ai < 2; ++ai)
#pragma unroll
            for (int m = 0; m < 4; ++m) { bf16* rowp = base + (size_t)(row0 + ai * 128 + m * 16) * ld + colb;
#pragma unroll
                for (int bj = 0; bj < 2; ++bj) { f32x4 v0 = acc[ai][bj][m][0], v1 = acc[ai][bj][m][1];
#pragma unroll
                    for (int j = 0; j < 4; ++j) { if (ACT == 1) { v0[j] = geluf(v0[j]); v1[j] = geluf(v1[j]); } if (ACT == 2) { v0[j] = siluf(v0[j]); v1[j] = siluf(v1[j]); } if (ACT == 3) { v0[j] = sigm(v0[j]); v1[j] = sigm(v1[j]); } }
                    pg8::u32x4 w; w.x = cvt_pk_bf16(v0[0], v0[1]); w.y = cvt_pk_bf16(v0[2], v0[3]); w.z = cvt_pk_bf16(v1[0], v1[1]); w.w = cvt_pk_bf16(v1[2], v1[3]);
                    *(pg8::u32x4*)(rowp + bj * 128) = w; }
                asm volatile("" ::: "memory"); }
    }
    __device__ __forceinline__ void operator()(f32x4 (&acc)[2][2][4][2], const Unit& u, int wr, int wc, int fr, int fq) const {
        const int row0 = u.pm * 256 + wr * 64 + fr, pn = u.pn;
        if (pn >= 51) { store_act<3>(acc, Gt, NG, row0, (pn - 51) * 256 + wc * 32 + 8 * fq); }
        else if (pn >= 12 && pn < 16) {
            const int colb = (pn - 12) * 256 + wc * 32 + 8 * fq;
#pragma unroll
            for (int bj = 0; bj < 2; ++bj) { const f32x4 l0 = *(const f32x4*)(LB + colb + bj * 128), l1 = *(const f32x4*)(LB + colb + bj * 128 + 4);
#pragma unroll
                for (int ai = 0; ai < 2; ++ai)
#pragma unroll
                    for (int m = 0; m < 4; ++m) { const size_t r = (size_t)(row0 + ai * 128 + m * 16);
                        f32x4 v0 = acc[ai][bj][m][0], v1 = acc[ai][bj][m][1], g0, g1, k0, k1;
#pragma unroll
                        for (int j = 0; j < 4; ++j) { { const float e = __expf(-fabsf(v0[j])), r = 1.f / (1.f + e), sm = e * r, sg = v0[j] >= 0.f ? r : sm, sn = v0[j] >= 0.f ? sm : r; g0[j] = __logf(l0[j] + (1.f - l0[j]) * sg); k0[j] = (1.f - l0[j]) * sn; }
                                                      { const float e = __expf(-fabsf(v1[j])), r = 1.f / (1.f + e), sm = e * r, sg = v1[j] >= 0.f ? r : sm, sn = v1[j] >= 0.f ? sm : r; g1[j] = __logf(l1[j] + (1.f - l1[j]) * sg); k1[j] = (1.f - l1[j]) * sn; } }
                        *(f32x4*)(HF + r * 1024 + colb + bj * 128) = g0; *(f32x4*)(HF + r * 1024 + colb + bj * 128 + 4) = g1;
                        pg8::u32x4 w; w.x = cvt_pk_bf16(k0[0], k0[1]); w.y = cvt_pk_bf16(k0[2], k0[3]); w.z = cvt_pk_bf16(k1[0], k1[1]); w.w = cvt_pk_bf16(k1[2], k1[3]);
                        *(pg8::u32x4*)(P + r * NP + C_HF + colb + bj * 128) = w; asm volatile("" ::: "memory"); } }
        } else if (pn == 34) {
            if (wc == 0 && fq < 2) {
#pragma unroll
                for (int ai = 0; ai < 2; ++ai)
#pragma unroll
                    for (int m = 0; m < 4; ++m) { float* rowp = DT + (size_t)(row0 + ai * 128 + m * 16) * 16 + 8 * fq;
                        *(f32x4*)(rowp) = acc[ai][0][m][0]; *(f32x4*)(rowp + 4) = acc[ai][0][m][1]; }
            }
        } else {
            const int colb = pn * 256 + wc * 32 + 8 * fq;
            if (pn >= 4 && pn < 8) store_act<1>(acc, P, NP, row0, colb);
            else if ((pn >= 8 && pn < 12) || (pn >= 20 && pn < 28) || pn >= 47) store_act<2>(acc, P, NP, row0, colb);
            else store_act<0>(acc, P, NP, row0, colb);
        }
    }
};

struct EpiB {
    static constexpr bool PERM = true;
    bf16* O; int ldc;
    __device__ __forceinline__ bool keep(const Unit&) const { return false; }
    __device__ __forceinline__ void operator()(f32x4 (&acc)[2][2][4][2], const Unit& u, int wr, int wc, int fr, int fq) const {
        const int row0 = u.pm * 256 + wr * 64 + fr, colb = u.pn * 256 + wc * 32 + 8 * fq;
#pragma unroll
        for (int ai = 0; ai < 2; ++ai)
#pragma unroll
            for (int m = 0; m < 4; ++m) { bf16* rowp = O + (size_t)(row0 + ai * 128 + m * 16) * ldc + colb;
#pragma unroll
                for (int bj = 0; bj < 2; ++bj) { const f32x4 v0 = acc[ai][bj][m][0], v1 = acc[ai][bj][m][1]; pg8::u32x4 w;
                    w.x = cvt_pk_bf16(v0[0], v0[1]); w.y = cvt_pk_bf16(v0[2], v0[3]); w.z = cvt_pk_bf16(v1[0], v1[1]); w.w = cvt_pk_bf16(v1[2], v1[3]);
                    *(pg8::u32x4*)(rowp + bj * 128) = w; } }
    }
};

struct EpiBr {
    static constexpr bool PERM = true;
    const bf16* Gt; bf16* O;
    __device__ __forceinline__ bool keep(const Unit& u) const { return u.kz < 3; }
    __device__ __forceinline__ void operator()(f32x4 (&acc)[2][2][4][2], const Unit& u, int wr, int wc, int fr, int fq) const {
        const int row0 = u.pm * 256 + wr * 64 + fr, colb = u.pn * 256 + wc * 32 + 8 * fq, kz = u.kz;
#pragma unroll
        for (int ai = 0; ai < 2; ++ai)
#pragma unroll
            for (int m = 0; m < 4; ++m) { const size_t r = (size_t)(row0 + ai * 128 + m * 16);
#pragma unroll
                for (int bj = 0; bj < 2; ++bj) {
                    const pg8::u32x4 ga = *(const pg8::u32x4*)(Gt + r * NG + kz * 2048 + colb + bj * 128);
                    float s[8] = {bflo(ga.x), bfhi(ga.x), bflo(ga.y), bfhi(ga.y), bflo(ga.z), bfhi(ga.z), bflo(ga.w), bfhi(ga.w)};
                    if (kz < 3) {
                        const pg8::u32x4 gb = *(const pg8::u32x4*)(Gt + r * NG + (kz + 1) * 2048 + colb + bj * 128);
                        const float d[8] = {bflo(gb.x), bfhi(gb.x), bflo(gb.y), bfhi(gb.y), bflo(gb.z), bfhi(gb.z), bflo(gb.w), bfhi(gb.w)};
#pragma unroll
                        for (int j = 0; j < 8; ++j) s[j] = s[j] * __builtin_amdgcn_rcpf(fmaxf(d[j], 1e-20f));
                    }
                    f32x4 v0 = acc[ai][bj][m][0], v1 = acc[ai][bj][m][1];
                    v0[0] *= s[0]; v0[1] *= s[1]; v0[2] *= s[2]; v0[3] *= s[3]; v1[0] *= s[4]; v1[1] *= s[5]; v1[2] *= s[6]; v1[3] *= s[7];
                    acc[ai][bj][m][0] = v0; acc[ai][bj][m][1] = v1;
                    if (kz == 3) { pg8::u32x4 w; w.x = cvt_pk_bf16(v0[0], v0[1]); w.y = cvt_pk_bf16(v0[2], v0[3]); w.z = cvt_pk_bf16(v1[0], v1[1]); w.w = cvt_pk_bf16(v1[2], v1[3]);
                        *(pg8::u32x4*)(O + r * DM + colb + bj * 128) = w; }
                }
                asm volatile("" ::: "memory"); }
    }
};

struct EpiRes {
    static constexpr bool PERM = false;
    const float* Xc; float* Xn;
    __device__ __forceinline__ bool keep(const Unit&) const { return false; }
    __device__ __forceinline__ void operator()(f32x4 (&acc)[2][2][4][2], const Unit& u, int wr, int wc, int fr, int fq) const {
        const int row0 = u.pm * 256 + wr * 64 + fr, col0 = u.pn * 256 + wc * 32 + 4 * fq;
#pragma unroll
        for (int ai = 0; ai < 2; ++ai)
#pragma unroll
            for (int m = 0; m < 4; ++m) { const size_t off = (size_t)(row0 + ai * 128 + m * 16) * DM + col0;
#pragma unroll
                for (int bj = 0; bj < 2; ++bj)
#pragma unroll
                    for (int n = 0; n < 2; ++n) { const f32x4 b = *(const f32x4*)(Xc + off + bj * 128 + n * 16); *(f32x4*)(Xn + off + bj * 128 + n * 16) = b + acc[ai][bj][m][n]; }
                asm volatile("" ::: "memory"); }
    }
};

struct TrJob { const float* W; bf16* WT; int K, N, ldt, mode, roff, item; };
__device__ __forceinline__ void tr_load(const TrJob& j, int lane, float (&v)[32]) {
    const int nblk = (j.N + 31) >> 5, kb = j.item / nblk, nb = j.item - kb * nblk, k0 = 64 * kb, n0 = 32 * nb;
    int nn = n0 + (lane & 31); nn = nn < j.N ? nn : j.N - 1;
    const float* p = j.W + (size_t)(k0 + (lane >> 5)) * j.N + nn;
#pragma unroll
    for (int i = 0; i < 32; ++i) v[i] = p[(size_t)(2 * i) * j.N];
}
__device__ __forceinline__ void tr_store(const TrJob& j, int lane, LAS float* scr, const float (&v)[32]) {
    const int nblk = (j.N + 31) >> 5, kb = j.item / nblk, nb = j.item - kb * nblk, k0 = 64 * kb, n0 = 32 * nb;
#pragma unroll
    for (int i = 0; i < 32; ++i) scr[(2 * i + (lane >> 5)) * 33 + (lane & 31)] = v[i];
    LDS_WAIT(); asm volatile("" ::: "memory");
    const int c = lane & 7;
#pragma unroll
    for (int jj = 0; jj < 4; ++jj) { const int n = (lane >> 3) + 8 * jj, gn = n0 + n; const LAS float* s = scr + (8 * c) * 33 + n;
        v4u o; o.x = pk2(s[0 * 33], s[1 * 33]); o.y = pk2(s[2 * 33], s[3 * 33]); o.z = pk2(s[4 * 33], s[5 * 33]); o.w = pk2(s[6 * 33], s[7 * 33]);
        if (gn < j.N) { const int dr = (j.mode == 1) ? (gn < SRC_SPLIT ? gn : gn + 240) : gn + j.roff; *(v4u*)(j.WT + (size_t)dr * j.ldt + k0 + 8 * c) = o; } }
    LDS_WAIT(); asm volatile("" ::: "memory");
}
constexpr int I_IN = (DM / 64) * ((NIN + 31) / 32), I_GT = (DM / 64) * (NG / 32), I_BR = (BW / 64) * (DM / 32), I_OUT = (DM / 64) * (DM / 32), I_UP = (DM / 64) * (DFF / 32), I_DN = (DFF / 64) * (DM / 32);
constexpr int I_LAYER = I_IN + I_GT + 4 * I_BR + I_OUT + 2 * I_UP + I_DN;
__device__ __forceinline__ TrJob tr_decode(const Frame& F, int it) {
    const int l = it / I_LAYER; int r = it - l * I_LAYER; TrJob j;
    bf16* W1 = WSP(bf16, WS_W1 + l * SZ_W1);
    if (r < I_IN) { j = TrJob{F.in[I_WIN] + (size_t)l * DM * NIN, W1, DM, NIN, DM, 1, 0, r}; return j; } r -= I_IN;
    if (r < I_GT) { j = TrJob{F.in[I_WGATE] + (size_t)l * DM * NG, W1, DM, NG, DM, 0, NP, r}; return j; } r -= I_GT;
    if (r < 4 * I_BR) { const int k = r / I_BR; j = TrJob{F.in[I_WBR] + ((size_t)l * 4 + k) * BW * DM, WSP(bf16, WS_WB + l * SZ_WB) + (size_t)k * DM * BW, BW, DM, BW, 0, 0, r - k * I_BR}; return j; } r -= 4 * I_BR;
    if (r < I_OUT) { j = TrJob{F.in[I_WOUT] + (size_t)l * DM * DM, WSP(bf16, WS_WO + l * SZ_WO), DM, DM, DM, 0, 0, r}; return j; } r -= I_OUT;
    if (r < I_UP) { j = TrJob{F.in[I_WUP] + (size_t)l * DM * DFF, WSP(bf16, WS_WUV + l * SZ_WUV), DM, DFF, DM, 0, 0, r}; return j; } r -= I_UP;
    if (r < I_UP) { j = TrJob{F.in[I_WVAL] + (size_t)l * DM * DFF, WSP(bf16, WS_WUV + l * SZ_WUV), DM, DFF, DM, 0, DFF, r}; return j; } r -= I_UP;
    j = TrJob{F.in[I_WDOWN] + (size_t)l * DFF * DM, WSP(bf16, WS_WD + l * SZ_WD), DFF, DM, DFF, 0, 0, r}; return j;
}

__device__ __forceinline__ void phase_prologue(const Frame& F0) {
    Frame F = launder(F0);
    LAS float* scr = (LAS float*)(F.lds + F.wave * 8704);
    const int gw = F.c * NWAVES + F.wave, NGW = F.G * NWAVES;
    {
        constexpr int NIT = NLAYER * I_LAYER;
        int it = gw; TrJob jc; float cur[32];
        if (it < NIT) { jc = tr_decode(F, it); tr_load(jc, F.lane, cur); }
        while (it < NIT) {
            const int itn = it + NGW; const bool hn = itn < NIT; TrJob jn = jc; float nx[32];
            if (hn) { jn = tr_decode(F, itn); tr_load(jn, F.lane, nx); }
            tr_store(jc, F.lane, scr, cur);
            if (hn) {
#pragma unroll
                for (int i = 0; i < 32; ++i) cur[i] = nx[i];
            }
            jc = jn; it = itn;
        }
    }
    const int gt = F.c * NTHR + F.tid, NGT = F.G * NTHR;
    for (int i = gt; i < NLAYER * 240 * (DM / 8); i += NGT) { const int l = i / (240 * (DM / 8)), r = i - l * (240 * (DM / 8));
        *(v4u*)(WSP(bf16, WS_W1 + l * SZ_W1) + (size_t)(SRC_SPLIT + r / (DM / 8)) * DM + (r % (DM / 8)) * 8) = (v4u){0u, 0u, 0u, 0u}; }
    for (int i = gt; i < NLAYER * 1024; i += NGT) { const int l = i >> 10, c = i & 1023; WSP(float, WS_LB)[i] = l == 0 ? 0.f : sigm(F.in[I_HGLB][1024 + c] - F.in[I_HGLB][c]); }
    for (int i = gt; i < 2049 * 64; i += NGT) { const int p = i >> 6, j = i & 63; const float pos = p < 2048 ? (float)p : 16384.f;
        const float fr = powf(10000.f, -(float)j / 64.f); const float ang = pos * fr; WSP(f32x2, WS_ROPE)[i] = (f32x2){cosf(ang), sinf(ang)}; }
    for (int i = gt; i < M * (DM / 4); i += NGT) { const int row = i / (DM / 4), c4 = i - row * (DM / 4);
        f32x4 v = (f32x4){0.f, 0.f, 0.f, 0.f};
        if (row < MP) v = ((const f32x4*)F.in[I_XP])[(size_t)row * (DM / 4) + c4]; else if (row < MR) v = ((const f32x4*)F.in[I_XS])[(size_t)(row - MP) * (DM / 4) + c4];
        WSP(f32x4, WS_X0)[i] = v; }
}

__device__ __forceinline__ float wave_sum(float v) {
#pragma unroll
    for (int o = 1; o < 64; o <<= 1) v += __shfl_xor(v, o);
    return v;
}
__device__ __forceinline__ void phase_norm(const Frame& F0, const float* X, const float* g, bf16* H) {
    Frame F = launder(F0);
    const int gw = F.c * NWAVES + F.wave, NGW = F.G * NWAVES;
    for (int row = gw; row < M; row += NGW) {
        v2u* o8 = (v2u*)(H + (size_t)row * DM) + F.lane;
        if (row >= MR) {
#pragma unroll
            for (int j = 0; j < 8; ++j) o8[64 * j] = (v2u){0u, 0u};
            continue; }
        const f32x4* xr = (const f32x4*)(X + (size_t)row * DM) + F.lane;
        f32x4 v[8]; float s = 0.f;
#pragma unroll
        for (int j = 0; j < 8; ++j) { v[j] = xr[64 * j]; s += (v[j].x * v[j].x + v[j].y * v[j].y) + (v[j].z * v[j].z + v[j].w * v[j].w); }
        const float rstd = rsqrtf(wave_sum(s) * (1.f / DM) + EPS);
#pragma unroll
        for (int j = 0; j < 8; ++j) { const f32x4 gv = ((const f32x4*)g)[F.lane + 64 * j];
            o8[64 * j] = (v2u){pk2(v[j].x * rstd * gv.x, v[j].y * rstd * gv.y), pk2(v[j].z * rstd * gv.z, v[j].w * rstd * gv.w)}; }
    }
}
__device__ __forceinline__ void phase_final(const Frame& F0, const float* X, const float* g) {
    Frame F = launder(F0);
    const int gw = F.c * NWAVES + F.wave, NGW = F.G * NWAVES;
    for (int row = gw; row < MR; row += NGW) {
        const f32x4* xr = (const f32x4*)(X + (size_t)row * DM) + F.lane;
        f32x4* o = (f32x4*)(F.out + (row < MP ? O_YP + (size_t)row * DM : O_YS + (size_t)(row - MP) * DM)) + F.lane;
        f32x4 v[8]; float s = 0.f;
#pragma unroll
        for (int j = 0; j < 8; ++j) { v[j] = xr[64 * j]; s += (v[j].x * v[j].x + v[j].y * v[j].y) + (v[j].z * v[j].z + v[j].w * v[j].w); }
        const float rstd = rsqrtf(wave_sum(s) * (1.f / DM) + EPS);
#pragma unroll
        for (int j = 0; j < 8; ++j) { const f32x4 gv = ((const f32x4*)g)[F.lane + 64 * j]; o[64 * j] = v[j] * rstd * gv; }
    }
}

constexpr int LW_STR = 136;
constexpr int L_WT = 0, L_XC = 256 * LW_STR * 2, L_XCF = L_XC + 64 * LW_STR * 2, LXF_STR = 132;
static_assert(L_XCF + 64 * LXF_STR * 4 <= RING_BYTES, "lru lds");
__device__ __forceinline__ void lru_stage_w(const Frame& F0, int l, int n) {
    Frame F = launder(F0);
    LAS bf16* WT = (LAS bf16*)(F.lds + L_WT);
    const float* wa = F.in[I_LWA] + ((size_t)l * 8 + n) * 16384; const float* wx = F.in[I_LWX] + ((size_t)l * 8 + n) * 16384;
    for (int i = F.tid; i < 16384; i += NTHR) { const int c = i >> 7, d = i & 127;
        WT[d * LW_STR + c] = (bf16)f2bf(wa[i]); WT[(128 + d) * LW_STR + c] = (bf16)f2bf(wx[i]); }
}
__device__ __forceinline__ void lru_tile(const Frame& F0, int l, int n, int tt) {
    Frame F = launder(F0);
    LAS bf16* WT = (LAS bf16*)(F.lds + L_WT); LAS bf16* XC = (LAS bf16*)(F.lds + L_XC); LAS float* XCF = (LAS float*)(F.lds + L_XCF);
    const bf16* P = WSP(bf16, WS_P);
    const float* cw = F.in[I_LCW] + (size_t)l * 4 * 1024; const float* cb = F.in[I_LCB] + (size_t)l * 1024;
    {
        const int tk = F.tid >> 3, c0 = (F.tid & 7) * 16, row = tt * 64 + tk, ch0 = n * 128 + c0;
        float acc[16];
#pragma unroll
        for (int j = 0; j < 16; ++j) acc[j] = cb[ch0 + j];
        if (row < MP) {
            const int t = row & (SEQ - 1);
#pragma unroll
            for (int jj = 0; jj < 4; ++jj) { if (t - 3 + jj >= 0) { const v4u* src = (const v4u*)(P + (size_t)(row - 3 + jj) * NP + C_XA + ch0); const v4u a = src[0], b = src[1];
                const unsigned w[8] = {a.x, a.y, a.z, a.w, b.x, b.y, b.z, b.w}; const float* wj = cw + jj * 1024 + ch0;
#pragma unroll
                for (int q = 0; q < 8; ++q) { acc[2 * q] += wj[2 * q] * bflo(w[q]); acc[2 * q + 1] += wj[2 * q + 1] * bfhi(w[q]); } } }
        } else if (row < MR) {
            const int s = row - MP; const float* st = F.in[I_SLC] + ((size_t)l * 128 + s) * 3 * 1024 + ch0;
#pragma unroll
            for (int jj = 0; jj < 3; ++jj) { const float* wj = cw + jj * 1024 + ch0;
#pragma unroll
                for (int q = 0; q < 16; ++q) acc[q] += wj[q] * st[jj * 1024 + q]; }
            const v4u* src = (const v4u*)(P + (size_t)row * NP + C_XA + ch0); const v4u a = src[0], b = src[1];
            const unsigned w[8] = {a.x, a.y, a.z, a.w, b.x, b.y, b.z, b.w}; const float* wj = cw + 3 * 1024 + ch0;
#pragma unroll
            for (int q = 0; q < 8; ++q) { acc[2 * q] += wj[2 * q] * bflo(w[q]); acc[2 * q + 1] += wj[2 * q + 1] * bfhi(w[q]); }
        }
#pragma unroll
        for (int q = 0; q < 16; ++q) { XCF[tk * LXF_STR + c0 + q] = acc[q]; }
#pragma unroll
        for (int q = 0; q < 8; ++q) *(LAS unsigned*)(XC + tk * LW_STR + c0 + 2 * q) = pk2(acc[2 * q], acc[2 * q + 1]);
    }
    __syncthreads();
    const int w = F.wave, lane = F.lane, fr = lane & 15, g = lane >> 4;
    f32x4 ar[4], ai_[4];
#pragma unroll
    for (int rt = 0; rt < 4; ++rt) { ar[rt] = (f32x4){0.f, 0.f, 0.f, 0.f}; ai_[rt] = (f32x4){0.f, 0.f, 0.f, 0.f}; }
#pragma unroll
    for (int ks = 0; ks < 4; ++ks) {
        const bf16x8 br = *(const LAS bf16x8*)(WT + (16 * w + fr) * LW_STR + 32 * ks + 8 * g);
        const bf16x8 bi = *(const LAS bf16x8*)(WT + (128 + 16 * w + fr) * LW_STR + 32 * ks + 8 * g);
#pragma unroll
        for (int rt = 0; rt < 4; ++rt) { const bf16x8 a = *(const LAS bf16x8*)(XC + (16 * rt + fr) * LW_STR + 32 * ks + 8 * g);
            ar[rt] = __builtin_amdgcn_mfma_f32_16x16x32_bf16(a, br, ar[rt], 0, 0, 0); ai_[rt] = __builtin_amdgcn_mfma_f32_16x16x32_bf16(a, bi, ai_[rt], 0, 0, 0); }
    }
    const int d = 16 * w + fr, ch = n * 128 + d;
    const float ba = F.in[I_LBA][(size_t)l * 1024 + ch], bx = F.in[I_LBX][(size_t)l * 1024 + ch], sp = softplusf(-F.in[I_LLAM][(size_t)l * 1024 + ch]);
    float* LA = WSP(float, WS_X1); float* LU = LA + (size_t)M * 1024;
    const bool scan = (tt < 128);
    float CA = 1.f, CU = 0.f;
#pragma unroll
    for (int rt = 0; rt < 4; ++rt) {
        float A[4], U[4];
#pragma unroll
        for (int reg = 0; reg < 4; ++reg) { const int tk = 16 * rt + 4 * g + reg;
            const float r = sigm(ar[rt][reg] + ba), iv = sigm(ai_[rt][reg] + bx), la = -8.f * r * sp, a = __expf(la), xc = XCF[tk * LXF_STR + d];
            A[reg] = a; U[reg] = sqrtf(fmaxf(-expm1f(2.f * la), 0.f)) * (iv * xc); }
        if (scan) {
#pragma unroll
            for (int reg = 1; reg < 4; ++reg) { U[reg] = A[reg] * U[reg - 1] + U[reg]; A[reg] = A[reg] * A[reg - 1]; }
            float PA = 1.f, PU = 0.f, TA = 1.f, TU = 0.f;
#pragma unroll
            for (int src = 0; src < 4; ++src) { const float sa = __shfl(A[3], fr + 16 * src), su = __shfl(U[3], fr + 16 * src);
                if (src < g) { PU = sa * PU + su; PA = sa * PA; }
                TU = sa * TU + su; TA = sa * TA; }
            const float GA = PA * CA, GU = PA * CU + PU;
#pragma unroll
            for (int reg = 0; reg < 4; ++reg) { U[reg] = A[reg] * GU + U[reg]; A[reg] = A[reg] * GA; }
            CU = TA * CU + TU; CA = TA * CA;
        }
#pragma unroll
        for (int reg = 0; reg < 4; ++reg) { const size_t row = (size_t)tt * 64 + 16 * rt + 4 * g + reg; LA[row * 1024 + ch] = A[reg]; LU[row * 1024 + ch] = U[reg]; }
    }
    __syncthreads();
}
__device__ __forceinline__ void phase_conv(const Frame& F00, int l) {
    Frame F0 = launder(F00);
    { const int n = F0.c & 7; bool staged = false;
      for (int tt = F0.c >> 3; tt < 130; tt += (F0.G >> 3)) { if (!staged) { lru_stage_w(F0, l, n); __syncthreads(); staged = true; } lru_tile(F0, l, n, tt); } }
    Frame F = launder(F0);
    const bf16* P = WSP(bf16, WS_P);
    const int gt = F.c * NTHR + F.tid, NGT = F.G * NTHR;
    { const float* cw = F.in[I_SCW] + (size_t)l * 4 * SSD_CD; const float* cb = F.in[I_SCB] + (size_t)l * SSD_CD; bf16* XBC = WSP(bf16, WS_XBC);
      for (int i = gt; i < MR * (SSD_CD / 8); i += NGT) { const int row = i / (SSD_CD / 8), c = (i - row * (SSD_CD / 8)) * 8;
          float acc[8];
#pragma unroll
          for (int q = 0; q < 8; ++q) acc[q] = cb[c + q];
          if (row < MP) { const int t = row & (SEQ - 1);
#pragma unroll
              for (int jj = 0; jj < 4; ++jj) if (t - 3 + jj >= 0) { const v4u a = *(const v4u*)(P + (size_t)(row - 3 + jj) * NP + C_SX + c); const unsigned w[4] = {a.x, a.y, a.z, a.w}; const float* wj = cw + jj * SSD_CD + c;
#pragma unroll
                  for (int q = 0; q < 4; ++q) { acc[2 * q] += wj[2 * q] * bflo(w[q]); acc[2 * q + 1] += wj[2 * q + 1] * bfhi(w[q]); } }
          } else { const int s = row - MP; const float* st = F.in[I_SSC] + ((size_t)l * 128 + s) * 3 * SSD_CD + c;
#pragma unroll
              for (int jj = 0; jj < 3; ++jj) { const float* wj = cw + jj * SSD_CD + c;
#pragma unroll
                  for (int q = 0; q < 8; ++q) acc[q] += wj[q] * st[jj * SSD_CD + q]; }
              const v4u a = *(const v4u*)(P + (size_t)row * NP + C_SX + c); const unsigned w[4] = {a.x, a.y, a.z, a.w}; const float* wj = cw + 3 * SSD_CD + c;
#pragma unroll
              for (int q = 0; q < 4; ++q) { acc[2 * q] += wj[2 * q] * bflo(w[q]); acc[2 * q + 1] += wj[2 * q + 1] * bfhi(w[q]); } }
          v4u o; o.x = pk2(siluf(acc[0]), siluf(acc[1])); o.y = pk2(siluf(acc[2]), siluf(acc[3])); o.z = pk2(siluf(acc[4]), siluf(acc[5])); o.w = pk2(siluf(acc[6]), siluf(acc[7]));
          *(v4u*)(XBC + (size_t)row * SSD_CD + c) = o; } }
    { float* DT = WSP(float, WS_DT); for (int i = gt; i < MR * 16; i += NGT) DT[i] = softplusf(DT[i] + F.in[I_SDTB][l * 16 + (i & 15)]); }
    for (int i = gt; i < NBATCH * 3 * 1024; i += NGT) { const int b = i / 3072, r = i - b * 3072, j = r >> 10, c = r & 1023;
        F.out[O_LC_P + (size_t)l * NBATCH * 3072 + i] = bf2f(P[((size_t)b * SEQ + SEQ - 3 + j) * NP + C_XA + c]); }
    for (int i = gt; i < MS * 3 * 1024; i += NGT) { const int s = i / 3072, r = i - s * 3072, j = r >> 10, c = r & 1023;
        F.out[O_LC_S + (size_t)l * MS * 3072 + i] = j < 2 ? F.in[I_SLC][(size_t)l * MS * 3072 + (size_t)s * 3072 + (j + 1) * 1024 + c] : bf2f(P[((size_t)MP + s) * NP + C_XA + c]); }
    for (int i = gt; i < NBATCH * 3 * SSD_CD; i += NGT) { const int b = i / (3 * SSD_CD), r = i - b * 3 * SSD_CD, j = r / SSD_CD, c = r - j * SSD_CD;
        F.out[O_SC_P + (size_t)l * NBATCH * 3 * SSD_CD + i] = bf2f(P[((size_t)b * SEQ + SEQ - 3 + j) * NP + C_SX + c]); }
    for (int i = gt; i < MS * 3 * SSD_CD; i += NGT) { const int s = i / (3 * SSD_CD), r = i - s * 3 * SSD_CD, j = r / SSD_CD, c = r - j * SSD_CD;
        F.out[O_SC_S + (size_t)l * MS * 3 * SSD_CD + i] = j < 2 ? F.in[I_SSC][(size_t)l * MS * 3 * SSD_CD + (size_t)s * 3 * SSD_CD + (j + 1) * SSD_CD + c] : bf2f(P[((size_t)MP + s) * NP + C_SX + c]); }
}

constexpr int QS_STR = 136, KT_STR = 72;
template <int MODE> struct CK {
    static constexpr int V = (MODE == 2) ? 64 : 128, NVT = V / 16, NVW = NVT / 2, NH = (MODE == 2) ? 16 : 8;
    static constexpr int O_QS = 0, O_QH = O_QS + 64 * QS_STR * 2, O_KS = O_QH + (MODE == 0 ? 64 * QS_STR * 2 : 0), O_KT = O_KS + 64 * QS_STR * 2, O_VT = O_KT + 128 * KT_STR * 2,
        O_VD = O_VT + V * KT_STR * 2, O_XT = O_VD + (MODE == 0 ? 0 : V * KT_STR * 2), O_S0T = O_XT + (MODE == 2 ? 64 * KT_STR * 2 : 0), O_F32 = O_S0T + V * QS_STR * 2, O_END = O_F32 + 4096;
    static_assert(O_END <= RING_BYTES, "chunk unit LDS");
};
__device__ __forceinline__ bf16x8 mk_frag(v2u lo, v2u hi) { v4u t; t.x = lo.x; t.y = lo.y; t.z = hi.x; t.w = hi.y; return __builtin_bit_cast(bf16x8, t); }
template <int MODE>
__device__ __forceinline__ void chunk_unit(const Frame& F0, int l, int unit) {
    Frame F = launder(F0);
    typedef CK<MODE> C; constexpr int V = C::V, NVT = C::NVT, NVW = C::NVW, NH = C::NH;
    const int b = unit / NH, h = unit - b * NH;
    LAS bf16* QS = (LAS bf16*)(F.lds + C::O_QS); LAS bf16* QH = (LAS bf16*)(F.lds + C::O_QH); LAS bf16* KS = (LAS bf16*)(F.lds + C::O_KS); LAS bf16* KT = (LAS bf16*)(F.lds + C::O_KT);
    LAS bf16* VT = (LAS bf16*)(F.lds + C::O_VT); LAS bf16* VD = (LAS bf16*)(F.lds + C::O_VD); LAS bf16* XT = (LAS bf16*)(F.lds + C::O_XT); LAS bf16* S0T = (LAS bf16*)(F.lds + C::O_S0T);
    LAS float* FA = (LAS float*)(F.lds + C::O_F32);
    const bf16* P = WSP(bf16, WS_P); const bf16* XBC = WSP(bf16, WS_XBC); const float* LOGF = WSP(float, WS_HF); const float* DT = WSP(float, WS_DT);
    float* OUT = (MODE == 0) ? WSP(float, WS_OB) : (MODE == 1 ? WSP(float, WS_OB + 2 * SZ_O) : WSP(float, WS_OB + SZ_O));
    const int tid = F.tid, lane = F.lane, w = F.wave, fr = lane & 15, g = lane >> 4, tt = w & 3, vh = w >> 2;
    const float lg = (MODE == 1) ? log1pf(-exp2f(-5.f - (float)h)) : 0.f;
    float ssd_A = 0.f, ssd_D = 0.f;
    if (MODE == 2) { ssd_A = -__expf(F.in[I_SALOG][l * 16 + h]); ssd_D = F.in[I_SD][l * 16 + h]; }
    const int grp = h >> 3;
    for (int i = tid; i < V * QS_STR / 2; i += NTHR) ((LAS unsigned*)S0T)[i] = 0u;
    f32x4 S[NVT];
#pragma unroll
    for (int i = 0; i < NVT; ++i) S[i] = (f32x4){0.f, 0.f, 0.f, 0.f};
    float lf[16]; unsigned short qv[16], kv[16];
    v4u ra[10]; float rdt = 0.f;
    const int kd = tid & 127, seg = tid >> 7, stok = tid >> 3, sg = tid & 7;
    auto load_chunk = [&](int c) {
        const size_t rowb = (size_t)b * SEQ + 64 * c;
        if (MODE == 0) {
#pragma unroll
            for (int j = 0; j < 16; ++j) { const size_t row = rowb + 16 * seg + j; lf[j] = LOGF[row * 1024 + h * 128 + kd]; qv[j] = P[row * NP + C_HQ + h * 128 + kd]; kv[j] = P[row * NP + C_HF + h * 128 + kd]; }
            const bf16* vp = P + (rowb + stok) * NP + C_HI + h * 128 + 16 * sg; ra[0] = *(const v4u*)vp; ra[1] = *(const v4u*)(vp + 8);
        } else if (MODE == 1) {
            const bf16* rp = P + (rowb + stok) * NP + h * 128;
            ra[0] = *(const v4u*)(rp + C_RQ + 8 * sg); ra[1] = *(const v4u*)(rp + C_RQ + 64 + 8 * sg); ra[2] = *(const v4u*)(rp + C_RK + 8 * sg); ra[3] = *(const v4u*)(rp + C_RK + 64 + 8 * sg);
            const v4u* cp = (const v4u*)(WSP(f32x2, WS_ROPE) + (size_t)(64 * c + stok) * 64 + 8 * sg); ra[4] = cp[0]; ra[5] = cp[1]; ra[6] = cp[2]; ra[7] = cp[3];
            ra[8] = *(const v4u*)(rp + C_RV + 16 * sg); ra[9] = *(const v4u*)(rp + C_RV + 16 * sg + 8);
        } else {
            const bf16* xp = XBC + (rowb + stok) * SSD_CD;
            ra[0] = *(const v4u*)(xp + 1024 + grp * 128 + 16 * sg); ra[1] = *(const v4u*)(xp + 1024 + grp * 128 + 16 * sg + 8);
            ra[2] = *(const v4u*)(xp + 1280 + grp * 128 + 16 * sg); ra[3] = *(const v4u*)(xp + 1280 + grp * 128 + 16 * sg + 8);
            ra[4] = *(const v4u*)(xp + h * 64 + 8 * sg);
            rdt = DT[(rowb + lane) * 16 + h];
        }
    };
    auto stage_chunk = [&]() {
        if (MODE == 0) {
            float cs[16]; cs[0] = lf[0];
#pragma unroll
            for (int j = 1; j < 16; ++j) cs[j] = cs[j - 1] + lf[j];
            FA[seg * 128 + kd] = cs[15];
            __syncthreads();
            const float s0 = FA[kd], s1 = FA[128 + kd], s2 = FA[256 + kd], s3 = FA[384 + kd];
            const float off = (seg > 0 ? s0 : 0.f) + (seg > 1 ? s1 : 0.f) + (seg > 2 ? s2 : 0.f), beta = s0 + s1, bC = (s0 + s1) + (s2 + s3);
            unsigned ktp[8];
#pragma unroll
            for (int j = 0; j < 16; ++j) { const float bt = off + cs[j], q = bf2f(qv[j]), k = bf2f(kv[j]); const int t = 16 * seg + j;
                const unsigned qs = f2bf(q * __expf(fminf(bt - beta, 80.f))), qh = f2bf(q * __expf(bt)), kt = f2bf(k * __expf(fminf(beta - bt, 80.f)));
                QS[t * QS_STR + kd] = (bf16)qs; QH[t * QS_STR + kd] = (bf16)qh; KS[t * QS_STR + kd] = (bf16)kt;
                if (j & 1) ktp[j >> 1] |= kt << 16; else ktp[j >> 1] = kt; }
            *(LAS v4u*)(KT + kd * KT_STR + 16 * seg) = (v4u){ktp[0], ktp[1], ktp[2], ktp[3]}; *(LAS v4u*)(KT + kd * KT_STR + 16 * seg + 8) = (v4u){ktp[4], ktp[5], ktp[6], ktp[7]};
            if (seg == 0) { FA[512 + kd] = __expf(bC); FA[640 + kd] = __expf(bC - beta); }
            const unsigned vw[8] = {ra[0].x, ra[0].y, ra[0].z, ra[0].w, ra[1].x, ra[1].y, ra[1].z, ra[1].w};
#pragma unroll
            for (int i = 0; i < 8; ++i) { VT[(16 * sg + 2 * i) * KT_STR + stok] = (bf16)(vw[i] & 0xffffu); VT[(16 * sg + 2 * i + 1) * KT_STR + stok] = (bf16)(vw[i] >> 16); }
        } else if (MODE == 1) {
            const unsigned q1[4] = {ra[0].x, ra[0].y, ra[0].z, ra[0].w}, q2[4] = {ra[1].x, ra[1].y, ra[1].z, ra[1].w}, k1[4] = {ra[2].x, ra[2].y, ra[2].z, ra[2].w}, k2[4] = {ra[3].x, ra[3].y, ra[3].z, ra[3].w};
            const unsigned csw[16] = {ra[4].x, ra[4].y, ra[4].z, ra[4].w, ra[5].x, ra[5].y, ra[5].z, ra[5].w, ra[6].x, ra[6].y, ra[6].z, ra[6].w, ra[7].x, ra[7].y, ra[7].z, ra[7].w};
            unsigned qa[4], qb[4], ka[4], kb[4];
            const float ksc = 0.08838834764831845f;
#pragma unroll
            for (int i = 0; i < 4; ++i) {
                const float c0 = __uint_as_float(csw[4 * i]), s0 = __uint_as_float(csw[4 * i + 1]), c1 = __uint_as_float(csw[4 * i + 2]), s1 = __uint_as_float(csw[4 * i + 3]);
                const float a0 = bflo(q1[i]), a1 = bfhi(q1[i]), b0 = bflo(q2[i]), b1 = bfhi(q2[i]);
                const float qa0 = a0 * c0 - b0 * s0, qa1 = a1 * c1 - b1 * s1, qb0 = a0 * s0 + b0 * c0, qb1 = a1 * s1 + b1 * c1;
                const float e0 = bflo(k1[i]), e1 = bfhi(k1[i]), f0 = bflo(k2[i]), f1 = bfhi(k2[i]);
                const float ka0 = (e0 * c0 - f0 * s0) * ksc, ka1 = (e1 * c1 - f1 * s1) * ksc, kb0 = (e0 * s0 + f0 * c0) * ksc, kb1 = (e1 * s1 + f1 * c1) * ksc;
                qa[i] = pk2(qa0, qa1); qb[i] = pk2(qb0, qb1); ka[i] = pk2(ka0, ka1); kb[i] = pk2(kb0, kb1); }
            *(LAS v4u*)(QS + stok * QS_STR + 8 * sg) = (v4u){qa[0], qa[1], qa[2], qa[3]}; *(LAS v4u*)(QS + stok * QS_STR + 64 + 8 * sg) = (v4u){qb[0], qb[1], qb[2], qb[3]};
            *(LAS v4u*)(KS + stok * QS_STR + 8 * sg) = (v4u){ka[0], ka[1], ka[2], ka[3]}; *(LAS v4u*)(KS + stok * QS_STR + 64 + 8 * sg) = (v4u){kb[0], kb[1], kb[2], kb[3]};
#pragma unroll
            for (int i = 0; i < 4; ++i) { KT[(8 * sg + 2 * i) * KT_STR + stok] = (bf16)(ka[i] & 0xffffu); KT[(8 * sg + 2 * i + 1) * KT_STR + stok] = (bf16)(ka[i] >> 16);
                KT[(64 + 8 * sg + 2 * i) * KT_STR + stok] = (bf16)(kb[i] & 0xffffu); KT[(64 + 8 * sg + 2 * i + 1) * KT_STR + stok] = (bf16)(kb[i] >> 16); }
            const float ws = __expf(lg * (float)(63 - stok));
            const unsigned vw[8] = {ra[8].x, ra[8].y, ra[8].z, ra[8].w, ra[9].x, ra[9].y, ra[9].z, ra[9].w};
#pragma unroll
            for (int i = 0; i < 8; ++i) { const float v0 = bflo(vw[i]), v1 = bfhi(vw[i]);
                VT[(16 * sg + 2 * i) * KT_STR + stok] = (bf16)(vw[i] & 0xffffu); VT[(16 * sg + 2 * i + 1) * KT_STR + stok] = (bf16)(vw[i] >> 16);
                VD[(16 * sg + 2 * i) * KT_STR + stok] = (bf16)f2bf(v0 * ws); VD[(16 * sg + 2 * i + 1) * KT_STR + stok] = (bf16)f2bf(v1 * ws); }
        } else {
            float bs = rdt * ssd_A;
#pragma unroll
            for (int o = 1; o < 64; o <<= 1) { const float up = __shfl_up(bs, o); if (lane >= o) bs += up; }
            const float bC = __shfl(bs, 63), bmy = __shfl(bs, stok), dtm = __shfl(rdt, stok);
            if (w == 0) { FA[lane] = bs; FA[64 + lane] = __expf(bs); }
            *(LAS v4u*)(KS + stok * QS_STR + 16 * sg) = ra[0]; *(LAS v4u*)(KS + stok * QS_STR + 16 * sg + 8) = ra[1];
            *(LAS v4u*)(QS + stok * QS_STR + 16 * sg) = ra[2]; *(LAS v4u*)(QS + stok * QS_STR + 16 * sg + 8) = ra[3];
            const unsigned bw[8] = {ra[0].x, ra[0].y, ra[0].z, ra[0].w, ra[1].x, ra[1].y, ra[1].z, ra[1].w};
#pragma unroll
            for (int i = 0; i < 8; ++i) { KT[(16 * sg + 2 * i) * KT_STR + stok] = (bf16)(bw[i] & 0xffffu); KT[(16 * sg + 2 * i + 1) * KT_STR + stok] = (bf16)(bw[i] >> 16); }
            const float ws = __expf(bC - bmy);
            const unsigned xw[4] = {ra[4].x, ra[4].y, ra[4].z, ra[4].w};
#pragma unroll
            for (int i = 0; i < 4; ++i) { const float x0 = bflo(xw[i]), x1 = bfhi(xw[i]);
                XT[(8 * sg + 2 * i) * KT_STR + stok] = (bf16)(xw[i] & 0xffffu); XT[(8 * sg + 2 * i + 1) * KT_STR + stok] = (bf16)(xw[i] >> 16);
                VT[(8 * sg + 2 * i) * KT_STR + stok] = (bf16)f2bf(x0 * dtm); VT[(8 * sg + 2 * i + 1) * KT_STR + stok] = (bf16)f2bf(x1 * dtm);
                VD[(8 * sg + 2 * i) * KT_STR + stok] = (bf16)f2bf(x0 * dtm * ws); VD[(8 * sg + 2 * i + 1) * KT_STR + stok] = (bf16)f2bf(x1 * dtm * ws); }
        }
    };
    load_chunk(0);
    stage_chunk();
    __syncthreads();
    for (int c = 0; c < SEQ / 64; ++c) {
        if (c + 1 < SEQ / 64) load_chunk(c + 1);
        const size_t row0 = (size_t)b * SEQ + 64 * c;
        f32x4 sc[4];
#pragma unroll
        for (int st = 0; st < 4; ++st) { sc[st] = (f32x4){0.f, 0.f, 0.f, 0.f};
            if (st <= tt) {
#pragma unroll
                for (int ks = 0; ks < 4; ++ks) { const bf16x8 a = *(const LAS bf16x8*)(KS + (16 * st + fr) * QS_STR + 32 * ks + 8 * g), bq = *(const LAS bf16x8*)(QS + (16 * tt + fr) * QS_STR + 32 * ks + 8 * g);
                    sc[st] = __builtin_amdgcn_mfma_f32_16x16x32_bf16(a, bq, sc[st], 0, 0, 0); } } }
        const int tloc = 16 * tt + fr;
        float btt = 0.f; if (MODE == 2) btt = FA[tloc];
        unsigned pw[8];
#pragma unroll
        for (int st = 0; st < 4; ++st) { float vals[4];
#pragma unroll
            for (int reg = 0; reg < 4; ++reg) { const int s = 16 * st + 4 * g + reg; float x = sc[st][reg];
                if (MODE == 1) x *= __expf(lg * (float)(tloc - s));
                if (MODE == 2) x *= __expf(fminf(btt - FA[s], 0.f));
                vals[reg] = (st <= tt && s <= tloc) ? x : 0.f; }
            pw[2 * st] = pk2(vals[0], vals[1]); pw[2 * st + 1] = pk2(vals[2], vals[3]); }
        const bf16x8 pf0 = __builtin_bit_cast(bf16x8, ((v4u){pw[0], pw[1], pw[2], pw[3]})), pf1 = __builtin_bit_cast(bf16x8, ((v4u){pw[4], pw[5], pw[6], pw[7]}));
        LAS bf16* QX = (MODE == 0) ? QH : QS;
#pragma unroll
        for (int vi = 0; vi < NVW; ++vi) { const int vt = vh * NVW + vi; const LAS bf16* vrow = VT + (16 * vt + fr) * KT_STR;
            f32x4 o = (f32x4){0.f, 0.f, 0.f, 0.f}, oi = (f32x4){0.f, 0.f, 0.f, 0.f};
            { const bf16x8 bv = mk_frag(*(const LAS v2u*)(vrow + 4 * g), *(const LAS v2u*)(vrow + 16 + 4 * g)); o = __builtin_amdgcn_mfma_f32_16x16x32_bf16(pf0, bv, o, 0, 0, 0); }
            if (tt >= 2) { const bf16x8 bv = mk_frag(*(const LAS v2u*)(vrow + 32 + 4 * g), *(const LAS v2u*)(vrow + 48 + 4 * g)); o = __builtin_amdgcn_mfma_f32_16x16x32_bf16(pf1, bv, o, 0, 0, 0); }
#pragma unroll
            for (int ks = 0; ks < 4; ++ks) { const bf16x8 a = *(const LAS bf16x8*)(QX + (16 * tt + fr) * QS_STR + 32 * ks + 8 * g), bs = *(const LAS bf16x8*)(S0T + (16 * vt + fr) * QS_STR + 32 * ks + 8 * g);
                oi = __builtin_amdgcn_mfma_f32_16x16x32_bf16(a, bs, oi, 0, 0, 0); }
#pragma unroll
            for (int reg = 0; reg < 4; ++reg) { const int t = 16 * tt + 4 * g + reg; float val;
                if (MODE == 0) val = o[reg] + oi[reg];
                else if (MODE == 1) val = o[reg] + __expf(lg * (float)(t + 1)) * oi[reg];
                else val = o[reg] + FA[64 + t] * oi[reg] + ssd_D * bf2f(XT[(16 * vt + fr) * KT_STR + t]);
                OUT[(row0 + t) * 1024 + h * V + 16 * vt + fr] = val; } }
        { const LAS bf16* VX = (MODE == 0) ? VT : VD;
          float e1[4], e2[4];
#pragma unroll
          for (int reg = 0; reg < 4; ++reg) { if (MODE == 0) { e1[reg] = FA[512 + 16 * w + 4 * g + reg]; e2[reg] = FA[640 + 16 * w + 4 * g + reg]; } else if (MODE == 1) { e1[reg] = __expf(lg * 64.f); e2[reg] = 1.f; } else { e1[reg] = FA[64 + 63]; e2[reg] = 1.f; } }
          const bf16x8 ka0 = *(const LAS bf16x8*)(KT + (16 * w + fr) * KT_STR + 8 * g), ka1 = *(const LAS bf16x8*)(KT + (16 * w + fr) * KT_STR + 32 + 8 * g);
#pragma unroll
          for (int vt = 0; vt < NVT; ++vt) { f32x4 d = (f32x4){0.f, 0.f, 0.f, 0.f};
              const bf16x8 b0 = *(const LAS bf16x8*)(VX + (16 * vt + fr) * KT_STR + 8 * g), b1 = *(const LAS bf16x8*)(VX + (16 * vt + fr) * KT_STR + 32 + 8 * g);
              d = __builtin_amdgcn_mfma_f32_16x16x32_bf16(ka0, b0, d, 0, 0, 0); d = __builtin_amdgcn_mfma_f32_16x16x32_bf16(ka1, b1, d, 0, 0, 0);
#pragma unroll
              for (int reg = 0; reg < 4; ++reg) S[vt][reg] = e1[reg] * S[vt][reg] + e2[reg] * d[reg]; } }
        __syncthreads();
#pragma unroll
        for (int vt = 0; vt < NVT; ++vt) *(LAS v2u*)(S0T + (16 * vt + fr) * QS_STR + 16 * w + 4 * g) = (v2u){pk2(S[vt][0], S[vt][1]), pk2(S[vt][2], S[vt][3])};
        if (c + 1 < SEQ / 64) stage_chunk();
        __syncthreads();
    }
    float* so = F.out + (MODE == 0 ? O_HG_P : (MODE == 1 ? O_RET_P : O_SSD_P)) + (((size_t)l * NBATCH + b) * NH + h) * (128 * V);
#pragma unroll
    for (int vt = 0; vt < NVT; ++vt)
#pragma unroll
        for (int reg = 0; reg < 4; ++reg) so[(size_t)(16 * w + 4 * g + reg) * V + 16 * vt + fr] = S[vt][reg];
}

constexpr int TB = 16;
constexpr int R_DEC = 0, R_KK = TB * 128 * 4, R_Q = 2 * TB * 128 * 4, R_VV = 3 * TB * 128 * 4, R_XS = R_VV + TB * 64 * 4, R_DSC = R_XS + TB * 64 * 4;
template <int MODE>
__device__ __forceinline__ void samp_unit(const Frame& F0, int l, int pair) {
    Frame F = launder(F0);
    constexpr int V = (MODE == 2) ? 64 : 128, NH = (MODE == 2) ? 16 : 8, NKR = (MODE == 2) ? 32 : 16, NJ = 128 / NKR;
    const int s = pair / NH, h = pair - s * NH; const size_t row = MP + s;
    LAS float* DEC = (LAS float*)(F.lds + R_DEC); LAS float* KK = (LAS float*)(F.lds + R_KK); LAS float* Q = (LAS float*)(F.lds + R_Q);
    LAS float* VV = (LAS float*)(F.lds + R_VV); LAS float* XS = (LAS float*)(F.lds + R_XS); LAS float* DSC = (LAS float*)(F.lds + R_DSC);
    LAS float* RED = (LAS float*)(F.lds + 65536);
    const bf16* P = WSP(bf16, WS_P); const bf16* XBC = WSP(bf16, WS_XBC);
    const int tid = F.tid;
    if (MODE == 0) {
        if (tid < 128) { const int k = tid; DEC[k] = __expf(WSP(float, WS_HF)[row * 1024 + h * 128 + k]); KK[k] = bf2f(P[row * NP + C_HF + h * 128 + k]); Q[k] = bf2f(P[row * NP + C_HQ + h * 128 + k]);
            VV[k] = bf2f(P[row * NP + C_HI + h * 128 + k]); }
    } else if (MODE == 1) {
        if (tid < 64) { const int j = tid;
            const float q1 = bf2f(P[row * NP + C_RQ + h * 128 + j]), q2 = bf2f(P[row * NP + C_RQ + h * 128 + 64 + j]);
            const float k1 = bf2f(P[row * NP + C_RK + h * 128 + j]), k2 = bf2f(P[row * NP + C_RK + h * 128 + 64 + j]);
            const f32x2 cs = WSP(f32x2, WS_ROPE)[2048 * 64 + j];
            Q[j] = q1 * cs.x - q2 * cs.y; Q[64 + j] = q1 * cs.y + q2 * cs.x;
            KK[j] = (k1 * cs.x - k2 * cs.y) * 0.08838834764831845f; KK[64 + j] = (k1 * cs.y + k2 * cs.x) * 0.08838834764831845f; }
        else if (tid < 192) { const int v = tid - 64; VV[v] = bf2f(P[row * NP + C_RV + h * 128 + v]); DEC[v] = 1.f - exp2f(-5.f - (float)h); }
    } else {
        if (tid < 320) { const int ch = tid, grp = h >> 3;
            const int cidx = ch < 64 ? h * 64 + ch : (ch < 192 ? 1024 + grp * 128 + (ch - 64) : 1280 + grp * 128 + (ch - 192));
            const float val = bf2f(XBC[row * SSD_CD + cidx]);
            if (ch < 64) { const float dtv = WSP(float, WS_DT)[row * 16 + h]; XS[ch] = val; VV[ch] = val * dtv;
                if (ch == 0) DSC[0] = __expf(dtv * (-__expf(F.in[I_SALOG][l * 16 + h]))); }
            else if (ch < 192) KK[ch - 64] = val; else Q[ch - 192] = val; }
    }
    __syncthreads();
    const int v4 = (MODE == 2) ? (tid & 15) : (tid & 31), kr = (MODE == 2) ? (tid >> 4) : (tid >> 5);
    const float* sin_ = F.in[MODE == 0 ? I_SHG : (MODE == 1 ? I_SRET : I_SSSD)] + (((size_t)l * 128 + s) * NH + h) * (128 * V);
    float* sout = F.out + (MODE == 0 ? O_HG_S : (MODE == 1 ? O_RET_S : O_SSD_S)) + (((size_t)l * 128 + s) * NH + h) * (128 * V);
    const f32x4 vv = *(const LAS f32x4*)(VV + 4 * v4);
    f32x4 sv[NJ];
#pragma unroll
    for (int j = 0; j < NJ; ++j) sv[j] = *(const f32x4*)(sin_ + (size_t)(kr + NKR * j) * V + 4 * v4);
    f32x4 po = (f32x4){0.f, 0.f, 0.f, 0.f};
#pragma unroll
    for (int j = 0; j < NJ; ++j) { const int k = kr + NKR * j; const float dec = (MODE == 2) ? DSC[0] : DEC[k]; const float kk = KK[k], q = Q[k];
        const f32x4 sn = sv[j] * dec + vv * kk; *(f32x4*)(sout + (size_t)k * V + 4 * v4) = sn; po += sn * q; }
    *(LAS f32x4*)(RED + kr * V + 4 * v4) = po;
    __syncthreads();
    if (tid < V) { float o = 0.f;
#pragma unroll
        for (int r = 0; r < NKR; ++r) o += RED[r * V + tid];
        if (MODE == 2) o += F.in[I_SD][l * 16 + h] * XS[tid];
        float* OUT = (MODE == 0) ? WSP(float, WS_OB) : (MODE == 1 ? WSP(float, WS_OB + 2 * SZ_O) : WSP(float, WS_OB + SZ_O));
        OUT[row * 1024 + h * V + tid] = o; }
    __syncthreads();
}

constexpr int CW_QUEUE = 8192;
__device__ __forceinline__ void phase_mix(const Frame& F0, int l) {
    Frame F = launder(F0);
    { const int w = F.c;
        if (w < 32) chunk_unit<0>(F, l, w);
        else if (w < 64) chunk_unit<1>(F, l, w - 32);
        else if (w < 128) chunk_unit<2>(F, l, w - 64);
    }
    __syncthreads();
    volatile LAS unsigned* QW = (volatile LAS unsigned*)(F.lds + LDSCTL_OFF) + 16;
    unsigned* qhead = (unsigned*)(F.ws + WS_CTL) + CW_QUEUE + 64 * l;
    for (;;) {
        if (F.tid == 0) QW[0] = __hip_atomic_fetch_add(qhead, 1u, __ATOMIC_RELAXED, __HIP_MEMORY_SCOPE_AGENT);
        __syncthreads();
        const int p = (int)QW[0];
        __syncthreads();
        if (p >= 4096) break;
        if (p < 1024) samp_unit<0>(F, l, p); else if (p < 2048) samp_unit<1>(F, l, p - 1024); else samp_unit<2>(F, l, p - 2048);
    }
}

__device__ __forceinline__ void phase_post(const Frame& F0, int l) {
    Frame F = launder(F0);
    const bf16* P = WSP(bf16, WS_P);
    const float* LA = WSP(float, WS_X1); const float* LU = LA + (size_t)M * 1024;
    bf16* BR = WSP(bf16, WS_BR);
    const int gt = F.c * NTHR + F.tid, NGT = F.G * NTHR, gw = F.c * NWAVES + F.wave, NGW = F.G * NWAVES, lane = F.lane;
    for (int task = gw; task < NBATCH * 16 * 32; task += NGW) {
        const int b = task >> 9, cg = (task >> 5) & 15, j = task & 31, ch = cg * 64 + lane;
        float h = 0.f;
        for (int jj = 0; jj < j; ++jj) { const size_t row = (size_t)b * SEQ + 64 * jj + 63; h = LA[row * 1024 + ch] * h + LU[row * 1024 + ch]; }
        float hv = 0.f;
        for (int t0 = 0; t0 < 64; t0 += 16) {
            float a[16], u[16], y[16];
#pragma unroll
            for (int q = 0; q < 16; ++q) { const size_t row = (size_t)b * SEQ + 64 * j + t0 + q; a[q] = LA[row * 1024 + ch]; u[q] = LU[row * 1024 + ch]; y[q] = bf2f(P[row * NP + C_YA + ch]); }
#pragma unroll
            for (int q = 0; q < 16; ++q) { const size_t row = (size_t)b * SEQ + 64 * j + t0 + q; hv = a[q] * h + u[q]; BR[row * BW + ch] = (bf16)f2bf(hv * y[q]); }
        }
        if (j == 31) F.out[O_LH_P + ((size_t)l * NBATCH + b) * 1024 + ch] = hv;
    }
    { float* MGF = (float*)(WSP(bf16, WS_MG) + (size_t)MP * DM); for (int i = gt; i < MS * DM / 4; i += NGT) ((f32x4*)MGF)[i] = (f32x4){0.f, 0.f, 0.f, 0.f}; }
    for (int i = gt; i < MS * 1024; i += NGT) { const int s = i >> 10, ch = i & 1023; const size_t row = MP + s;
        const float hp = F.in[I_SLH][((size_t)l * 128 + s) * 1024 + ch]; const float h = LA[row * 1024 + ch] * hp + LU[row * 1024 + ch];
        F.out[O_LH_S + ((size_t)l * 128 + s) * 1024 + ch] = h; BR[row * BW + ch] = (bf16)f2bf(h * bf2f(P[row * NP + C_YA + ch])); }
    for (int task = gw; task < MR * 3; task += NGW) {
        const int row = task / 3, br = task - row * 3;
        const f32x4* src = (const f32x4*)(WSP(float, WS_OB + (size_t)br * SZ_O) + (size_t)row * 1024 + 16 * lane);
        float x[16];
#pragma unroll
        for (int j = 0; j < 4; ++j) { const f32x4 v = src[j]; x[4 * j] = v.x; x[4 * j + 1] = v.y; x[4 * j + 2] = v.z; x[4 * j + 3] = v.w; }
        const int gcol = (br == 0) ? C_HGG : (br == 1 ? C_SZ : C_RG);
        const v4u* gp = (const v4u*)(P + (size_t)row * NP + gcol + 16 * lane); const v4u ga = gp[0], gb = gp[1];
        const unsigned gw_[8] = {ga.x, ga.y, ga.z, ga.w, gb.x, gb.y, gb.z, gb.w};
        float gt_[16];
#pragma unroll
        for (int q = 0; q < 8; ++q) { gt_[2 * q] = bflo(gw_[q]); gt_[2 * q + 1] = bfhi(gw_[q]); }
        float o[16];
        if (br == 1) {
            float ss = 0.f;
#pragma unroll
            for (int j = 0; j < 16; ++j) { x[j] *= gt_[j]; ss += x[j] * x[j]; }
#pragma unroll
            for (int m = 1; m < 32; m <<= 1) ss += __shfl_xor(ss, m);
            const float rs = rsqrtf(ss * (1.f / 512.f) + EPS); const float* nw = F.in[I_SNW] + (size_t)l * 1024 + 16 * lane;
#pragma unroll
            for (int j = 0; j < 16; ++j) o[j] = x[j] * rs * nw[j];
        } else {
            float ss = 0.f;
#pragma unroll
            for (int j = 0; j < 16; ++j) ss += x[j] * x[j];
#pragma unroll
            for (int m = 1; m < 8; m <<= 1) ss += __shfl_xor(ss, m);
            const float rs = rsqrtf(ss * (1.f / 128.f) + EPS);
            if (br == 0) { const float* nw = F.in[I_HGNW] + (size_t)l * 128 + ((16 * lane) & 127);
#pragma unroll
                for (int j = 0; j < 16; ++j) o[j] = x[j] * rs * nw[j] * gt_[j]; }
            else {
#pragma unroll
                for (int j = 0; j < 16; ++j) o[j] = x[j] * rs * gt_[j]; }
        }
        v4u w0, w1; w0.x = pk2(o[0], o[1]); w0.y = pk2(o[2], o[3]); w0.z = pk2(o[4], o[5]); w0.w = pk2(o[6], o[7]); w1.x = pk2(o[8], o[9]); w1.y = pk2(o[10], o[11]); w1.z = pk2(o[12], o[13]); w1.w = pk2(o[14], o[15]);
        v4u* dst = (v4u*)(BR + (size_t)(br + 1) * M * BW + (size_t)row * BW + 16 * lane); dst[0] = w0; dst[1] = w1;
    }
}

__device__ __forceinline__ void phase_act(const Frame& F0, int l) {
    Frame F = launder(F0);
    const bf16* UV = WSP(bf16, WS_P); bf16* A2 = WSP(bf16, WS_G);
    const float* cw = F.in[I_FCW] + (size_t)l * 3 * DFF; const float* cb = F.in[I_FCB] + (size_t)l * DFF;
    const int gt = F.c * NTHR + F.tid, NGT = F.G * NTHR;
    constexpr int C8 = DFF / 8;
    for (int i = gt; i < MS * DM / 4; i += NGT) ((f32x4*)(WSP(float, WS_X0) + (size_t)MP * DM))[i] = ((const f32x4*)(WSP(float, WS_X1) + (size_t)MP * DM))[i];
    for (int i = gt; i < M * C8; i += NGT) {
        const int row = i / C8, c = (i - row * C8) * 8;
        v4u outw = (v4u){0u, 0u, 0u, 0u};
        if (row < MR) {
            const v4u uw = *(const v4u*)(UV + (size_t)row * NUV + c), vw = *(const v4u*)(UV + (size_t)row * NUV + DFF + c);
            float u0[8] = {bflo(uw.x), bfhi(uw.x), bflo(uw.y), bfhi(uw.y), bflo(uw.z), bfhi(uw.z), bflo(uw.w), bfhi(uw.w)};
            const float vv[8] = {bflo(vw.x), bfhi(vw.x), bflo(vw.y), bfhi(vw.y), bflo(vw.z), bfhi(vw.z), bflo(vw.w), bfhi(vw.w)};
            float u1[8], u2[8];
#pragma unroll
            for (int j = 0; j < 8; ++j) { u1[j] = 0.f; u2[j] = 0.f; }
            if (row < MP) { const int t = row & (SEQ - 1);
                if (t >= 1) { const v4u w = *(const v4u*)(UV + (size_t)(row - 1) * NUV + c); u1[0] = bflo(w.x); u1[1] = bfhi(w.x); u1[2] = bflo(w.y); u1[3] = bfhi(w.y); u1[4] = bflo(w.z); u1[5] = bfhi(w.z); u1[6] = bflo(w.w); u1[7] = bfhi(w.w); }
                if (t >= 2) { const v4u w = *(const v4u*)(UV + (size_t)(row - 2) * NUV + c); u2[0] = bflo(w.x); u2[1] = bfhi(w.x); u2[2] = bflo(w.y); u2[3] = bfhi(w.y); u2[4] = bflo(w.z); u2[5] = bfhi(w.z); u2[6] = bflo(w.w); u2[7] = bfhi(w.w); }
                if (t >= SEQ - 2) { float* so = F.out + O_FC_P + (((size_t)l * NBATCH + (row >> 11)) * 2 + (t - (SEQ - 2))) * DFF + c;
#pragma unroll
                    for (int j = 0; j < 8; ++j) so[j] = u0[j]; }
            } else { const int s = row - MP; const float* st = F.in[I_SFC] + ((size_t)l * MS + s) * 2 * DFF + c; float* so = F.out + O_FC_S + ((size_t)l * MS + s) * 2 * DFF + c;
#pragma unroll
                for (int j = 0; j < 8; ++j) { u2[j] = st[j]; u1[j] = st[DFF + j]; so[j] = st[DFF + j]; so[DFF + j] = u0[j]; } }
            float a[8];
#pragma unroll
            for (int j = 0; j < 8; ++j) { const float y = cb[c + j] + cw[c + j] * u2[j] + cw[DFF + c + j] * u1[j] + cw[2 * DFF + c + j] * u0[j]; a[j] = geluf(y) * vv[j]; }
            outw.x = pk2(a[0], a[1]); outw.y = pk2(a[2], a[3]); outw.z = pk2(a[4], a[5]); outw.w = pk2(a[6], a[7]);
        }
        *(v4u*)(A2 + (size_t)row * DFF + c) = outw;
    }
}

template <int KIND>
__device__ __forceinline__ void samp_gemm(const Frame& F0, int l) {
    Frame F = launder(F0);
    if (F.c >= 256) return;
    const int nb = F.c & 15, ks = F.c >> 4, w = F.wave, fr = F.lane & 15, g = F.lane >> 4;
    constexpr int KS = (KIND == 0) ? 256 : (KIND == 1 ? 128 : 352), NSTEP = KS / 32;
    const bf16* Bt; int ldb; int kb0;
    const bf16* Ab = nullptr; const float* Af = nullptr; int lda;
    float* MGF = (float*)(WSP(bf16, WS_MG) + (size_t)MP * DM);
    if (KIND == 0) { const int k = ks >> 2; Bt = WSP(bf16, WS_WB + l * SZ_WB) + (size_t)k * DM * BW; ldb = BW; kb0 = (ks & 3) * 256; Ab = WSP(bf16, WS_BR) + (size_t)k * M * BW + (size_t)MP * BW; lda = BW; }
    else if (KIND == 1) { Bt = WSP(bf16, WS_WO + l * SZ_WO); ldb = DM; kb0 = ks * 128; Af = MGF; lda = DM; }
    else { Bt = WSP(bf16, WS_WD + l * SZ_WD); ldb = DFF; kb0 = ks * 352; Ab = WSP(bf16, WS_G) + (size_t)MP * DFF; lda = DFF; }
    f32x4 acc[8];
#pragma unroll
    for (int ct = 0; ct < 8; ++ct) acc[ct] = (f32x4){0.f, 0.f, 0.f, 0.f};
    const bf16* bp = Bt + (size_t)(128 * nb + fr) * ldb + kb0 + 8 * g;
#pragma unroll 4
    for (int st = 0; st < NSTEP; ++st) {
        bf16x8 a;
        if (KIND == 1) { const float* ap = Af + (size_t)(16 * w + fr) * lda + kb0 + 32 * st + 8 * g; const f32x4 x0 = *(const f32x4*)ap, x1 = *(const f32x4*)(ap + 4);
            a = __builtin_bit_cast(bf16x8, ((v4u){pk2(x0.x, x0.y), pk2(x0.z, x0.w), pk2(x1.x, x1.y), pk2(x1.z, x1.w)})); }
        else a = *(const bf16x8*)(Ab + (size_t)(16 * w + fr) * lda + kb0 + 32 * st + 8 * g);
#pragma unroll
        for (int ct = 0; ct < 8; ++ct) { const bf16x8 bq = *(const bf16x8*)(bp + (size_t)(16 * ct) * ldb + 32 * st); acc[ct] = __builtin_amdgcn_mfma_f32_16x16x32_bf16(a, bq, acc[ct], 0, 0, 0); }
    }
#pragma unroll
    for (int ct = 0; ct < 8; ++ct)
#pragma unroll
        for (int reg = 0; reg < 4; ++reg) { const int s = 16 * w + 4 * g + reg, d = 128 * nb + 16 * ct + fr; float v = acc[ct][reg]; float* dst;
            if (KIND == 0) { const int k = ks >> 2; v *= bf2f(WSP(bf16, WS_G)[(size_t)(MP + s) * NG + k * 2048 + d]); dst = MGF + (size_t)s * DM + d; }
            else if (KIND == 1) dst = WSP(float, WS_X1) + (size_t)(MP + s) * DM + d;
            else dst = WSP(float, WS_X0) + (size_t)(MP + s) * DM + d;
            (void)__hip_atomic_fetch_add(dst, v, __ATOMIC_RELAXED, __HIP_MEMORY_SCOPE_AGENT); }
}

constexpr int PH_PER_LAYER = 11, NPHASE = 1 + NLAYER * PH_PER_LAYER + 1;
__global__ void __launch_bounds__(NTHR, 2) mk_fwd(Args args) {
    extern __shared__ __attribute__((aligned(16))) unsigned char lds_raw[];
    Frame F;
    F.lds = (LAS unsigned char*)lds_raw;
    F.tid = threadIdx.x; F.lane = F.tid & 63; F.wave = __builtin_amdgcn_readfirstlane(F.tid >> 6);
    F.G = gridDim.x; F.c = blockIdx.x;
    F.in = args.in; F.out = args.out; F.ws = args.ws;
    volatile LAS unsigned* MISC = (volatile LAS unsigned*)(F.lds + LDSCTL_OFF);
    if (F.tid < 64) MISC[F.tid] = 0u;
    __syncthreads();
    unsigned* barw = (unsigned*)(F.ws + WS_CTL) + 4096;
    XcdBarrier bar; bar.bar = barw; bar.x = 0; bar.st = nullptr;
    if (!MK_SPLIT) bar = xcd_barrier_post(barw, MISC + 8);
    const int lo = args.ph_lo, hi = args.ph_hi;
#define IN(k) (lo <= (k) && (k) < hi)
#define SEAM(k) do { if (IN(k) && IN((k) + 1)) xcd_barrier(bar); } while (0)
#define X0 WSP(float, WS_X0)
#define X1 WSP(float, WS_X1)
#define H WSP(bf16, WS_H)
#define GEMM_RUN(EPI) do { pg8::gemm_phase<EPI, pg8::TileOrder>(F.lds, g, S, E); if (REP_G > 1) { Frame F1 = launder(F); pg8::gemm_phase<EPI, pg8::TileOrder>(F1.lds, g, S, E); } } while (0)

    if (IN(0) && !(SKMASK & 1)) { phase_prologue(F); } SEAM(0);

    for (int l = 0; l < NLAYER; ++l) {
        const int pb = 1 + l * PH_PER_LAYER;
        if (IN(pb + 0) && !(SKMASK & 2)) { phase_norm(F, X0, F.in[I_GMIX] + (size_t)l * DM, H); } SEAM(pb + 0);
        if (IN(pb + 1) && !(SKMASK & 4)) { const Frame F0 = F; Frame F = launder(F0);
            pg8::Gemm g{H, WSP(bf16, WS_W1 + l * SZ_W1), DM, DM, DM, 0, 0}; pg8::TileOrder S; S.init(M, N1, F.G, F.c, 1);
            Epi1 E{WSP(bf16, WS_P), WSP(float, WS_HF), WSP(float, WS_DT), WSP(bf16, WS_G), WSP(float, WS_LB) + l * 1024};
            GEMM_RUN(Epi1);
        } SEAM(pb + 1);
        if (IN(pb + 2) && !(SKMASK & 8)) { phase_conv(F, l); if (REP_CONV > 1) phase_conv(F, l); } SEAM(pb + 2);
        if (IN(pb + 3) && !(SKMASK & 16)) { phase_mix(F, l); if (REP_MIX > 1) phase_mix(F, l); } SEAM(pb + 3);
        if (IN(pb + 4) && !(SKMASK & 32)) { phase_post(F, l); if (REP_POST > 1) phase_post(F, l); } SEAM(pb + 4);
        if (IN(pb + 5) && !(SKMASK & 64)) { const Frame F0 = F; Frame F = launder(F0);
            pg8::Gemm g{WSP(bf16, WS_BR), WSP(bf16, WS_WB + l * SZ_WB), BW, BW, BW, (size_t)M * BW, (size_t)DM * BW}; pg8::TileOrder S; S.init(MP, DM, F.G, F.c, 4);
            EpiBr E{WSP(bf16, WS_G), WSP(bf16, WS_MG)};
            GEMM_RUN(EpiBr);
            { const int gt = F.c * NTHR + F.tid, NGT = F.G * NTHR; for (int i = gt; i < MS * DM / 4; i += NGT) ((f32x4*)(X1 + (size_t)MP * DM))[i] = ((const f32x4*)(X0 + (size_t)MP * DM))[i]; }
            samp_gemm<0>(F, l);
        } SEAM(pb + 5);
        if (IN(pb + 6) && !(SKMASK & 128)) { const Frame F0 = F; Frame F = launder(F0);
            pg8::Gemm g{WSP(bf16, WS_MG), WSP(bf16, WS_WO + l * SZ_WO), DM, DM, DM, 0, 0}; pg8::TileOrder S; S.init(MP, DM, F.G, F.c, 1);
            EpiRes E{X0, X1};
            GEMM_RUN(EpiRes);
            samp_gemm<1>(F, l);
        } SEAM(pb + 6);
        if (IN(pb + 7) && !(SKMASK & 256)) { phase_norm(F, X1, F.in[I_GFFN] + (size_t)l * DM, H); } SEAM(pb + 7);
        if (IN(pb + 8) && !(SKMASK & 512)) { const Frame F0 = F; Frame F = launder(F0);
            pg8::Gemm g{H, WSP(bf16, WS_WUV + l * SZ_WUV), DM, DM, DM, 0, 0}; pg8::TileOrder S; S.init(M, NUV, F.G, F.c, 1);
            EpiB E{WSP(bf16, WS_P), NUV};
            GEMM_RUN(EpiB);
        } SEAM(pb + 8);
        if (IN(pb + 9) && !(SKMASK & 1024)) { phase_act(F, l); } SEAM(pb + 9);
        if (IN(pb + 10) && !(SKMASK & 2048)) { const Frame F0 = F; Frame F = launder(F0);
            pg8::Gemm g{WSP(bf16, WS_G), WSP(bf16, WS_WD + l * SZ_WD), DFF, DFF, DFF, 0, 0}; pg8::TileOrder S; S.init(MP, DM, F.G, F.c, 1);
            EpiRes E{X1, X0};
            GEMM_RUN(EpiRes);
            samp_gemm<2>(F, l);
        } SEAM(pb + 10);
    }
    if (IN(NPHASE - 1) && !(SKMASK & 4096)) { phase_final(F, WSP(float, WS_X0), F.in[I_GFIN]); }
#undef IN
#undef SEAM
#undef X0
#undef X1
#undef H
#undef GEMM_RUN
}

extern "C" void kernel_launch(void* const* d_in, const int* in_sizes, int n_in, void* d_out, int out_size, void* d_ws, size_t ws_size, hipStream_t stream) {
    static int grid = 0;
    if (grid == 0) {
        if (n_in != N_INPUTS || (size_t)out_size != O_END || ws_size < WS_END) { fprintf(stderr, "kernel_launch: unexpected shapes: n_in %d out %d ws %zu (need %zu)\n", n_in, out_size, ws_size, (size_t)WS_END); grid = -1; return; }
        int dev = 0, cus = 0, per_cu = 0;
        if (hipGetDevice(&dev) != hipSuccess || hipDeviceGetAttribute(&cus, hipDeviceAttributeMultiprocessorCount, dev) != hipSuccess) { grid = -1; return; }
        if (hipFuncSetAttribute((const void*)mk_fwd, hipFuncAttributeMaxDynamicSharedMemorySize, LDS_BYTES) != hipSuccess) { fprintf(stderr, "kernel_launch: hipFuncSetAttribute failed\n"); grid = -1; return; }
        if (hipOccupancyMaxActiveBlocksPerMultiprocessor(&per_cu, (const void*)mk_fwd, NTHR, LDS_BYTES) != hipSuccess || per_cu < 1) { fprintf(stderr, "kernel_launch: occupancy query says %d\n", per_cu); }
        (void)hipGetLastError();
        grid = cus;
    }
    if (grid < 0) return;
    (void)hipMemsetAsync((char*)d_ws + WS_CTL, 0, CTL_BYTES, stream);
    Args a{};
    for (int i = 0; i < N_INPUTS; ++i) a.in[i] = (const float*)d_in[i];
    a.out = (float*)d_out; a.ws = (unsigned char*)d_ws;
#if MK_SPLIT
    for (int p = 0; p < NPHASE; ++p) { a.ph_lo = p; a.ph_hi = p + 1; hipLaunchKernelGGL(mk_fwd, dim3(grid), dim3(NTHR), LDS_BYTES, stream, a); }
#else
    a.ph_lo = 0; a.ph_hi = NPHASE;
    hipLaunchKernelGGL(mk_fwd, dim3(grid), dim3(NTHR), LDS_BYTES, stream, a);
#endif
}
```

```cpp
#include <hip/hip_runtime.h>
#include <cstdio>
#include <cstdint>

#ifndef REP_G
#define REP_G 1
#endif
#ifndef PROBE_UNIT
#define PROBE_UNIT 0
#endif
#ifndef REP_CONV
#define REP_CONV 1
#endif
#ifndef REP_MIX
#define REP_MIX 1
#endif
#ifndef REP_POST
#define REP_POST 1
#endif
#ifndef SKMASK
#define SKMASK 0
#endif
#ifndef MK_SPLIT
#define MK_SPLIT 0
#endif

namespace pg8 {
#define PG8_LAS __attribute__((address_space(3)))
typedef unsigned short bf16_t;
typedef short bf16x8 __attribute__((ext_vector_type(8)));
typedef float f32x4 __attribute__((ext_vector_type(4)));
typedef unsigned u32x4 __attribute__((ext_vector_type(4)));
constexpr int BM = 256, BK = 64, HALF = 128, HTB = HALF * BK * 2, STAGE_BYTES = 8 * HTB, NXCD = 8, WGM = 8;

__host__ __device__ __forceinline__ int lds_byte(int r, int c) { const int st = (r >> 4) * 2 + (c >> 5), rr = r & 15, cc = c & 31, ob = rr * 64 + cc * 2; return st * 1024 + (ob ^ (((ob >> 9) & 1) << 5)); }
__host__ __device__ __forceinline__ void stage_rc(int b, int& R, int& C) { const int st = b / 1024, sb = b % 1024, swz = sb ^ (((sb >> 9) & 1) << 5); R = (st >> 1) * 16 + swz / 64; C = (st & 1) * 32 + (swz % 64) / 2; }
__host__ __device__ __forceinline__ int perm32(int rho) { const int n = rho >> 4, i = rho & 15; return 8 * (i >> 2) + 4 * n + (i & 3); }

struct Unit { int pm, pn, kz; };
struct Gemm { const bf16_t* A; const bf16_t* Bt; int lda, ldb, K; size_t azs, bzs; };

struct TileOrder {
    int nM, nN, nwg, G, c, nkz;
    __device__ void init(int M, int N, int G_, int c_, int nkz_) { nM = M / BM; nN = N / BM; nwg = nM * nN; G = G_; c = c_; nkz = nkz_; }
    __device__ bool next(int i, Unit& u) const {
        const int ti = i / nkz; u.kz = i - ti * nkz;
        const long L = (long)ti * G + c; if (L >= nwg) return false;
        int wgid = (int)L; { const int q = nwg / NXCD, r = nwg % NXCD, xcd = wgid % NXCD, off = wgid / NXCD; wgid = (xcd < r ? xcd * (q + 1) : r * (q + 1) + (xcd - r) * q) + off; }
        const int nig = WGM * nN, gid = wgid / nig, fm = gid * WGM, gsz = (nM - fm) < WGM ? (nM - fm) : WGM;
        u.pm = fm + ((wgid % nig) % gsz); u.pn = (wgid % nig) / gsz; return true;
    }
};

typedef __bf16 bf16x2_t __attribute__((ext_vector_type(2)));
typedef float f32x2_t __attribute__((ext_vector_type(2)));
__device__ __forceinline__ unsigned cvt_pk_bf16(float lo, float hi) { const bf16x2_t r = __builtin_convertvector((f32x2_t){lo, hi}, bf16x2_t); return __builtin_bit_cast(unsigned, r); }

template <class Epi, class Sched, bool ALIGN_EPI = true>
__device__ __forceinline__ void gemm_phase(PG8_LAS unsigned char* lds, const Gemm g, const Sched& S, const Epi& E) {
    int tid = threadIdx.x; asm volatile("" : "+v"(tid));
    const int wid = __builtin_amdgcn_readfirstlane(tid >> 6), lane = tid & 63, wr = wid >> 2, wc = wid & 3, fr = lane & 15, fq = lane >> 4;
    const int K = g.K, nt = K / BK;
    unsigned voffA[2], voffB[2];
#pragma unroll
    for (int i = 0; i < 2; ++i) { int R, C; stage_rc(tid * 16 + i * 8192, R, C); const int Rb = Epi::PERM ? ((R & ~31) + perm32(R & 31)) : R;
        voffA[i] = (unsigned)(R * g.lda + C) * 2u; voffB[i] = (unsigned)(Rb * g.ldb + C) * 2u; }
    const size_t kstep = (size_t)(BK * 2);
    const size_t hstepA = (size_t)HALF * g.lda * 2, hstepB = (size_t)HALF * g.ldb * 2;
    const size_t tstepA = 2 * hstepA, tstepB = 2 * hstepB;
    const unsigned ldsw = (unsigned)wid * 1024u;
    const int aoff = lds_byte(wr * 64 + fr, fq * 8), boff = lds_byte(wc * 32 + fr, fq * 8);
#define PG8_SA(b, h) (((b) * 2 + (h)) * HTB)
#define PG8_SB(b, h) ((4 + (b) * 2 + (h)) * HTB)
#define PG8_STAGE(bufoff, gbase, voff) do { _Pragma("unroll") for (int _i = 0; _i < 2; ++_i) \
        __builtin_amdgcn_global_load_lds((const unsigned*)((const char*)(gbase) + (voff)[_i]), (PG8_LAS unsigned*)(lds + (bufoff) + ldsw + _i * 8192), 16, 0, 0); } while (0)
#define PG8_LDA(dst, b, h) do { _Pragma("unroll") for (int m = 0; m < 4; ++m) _Pragma("unroll") for (int k = 0; k < 2; ++k) dst[m][k] = *(const PG8_LAS bf16x8*)(lds + PG8_SA(b, h) + aoff + m * 2048 + k * 1024); } while (0)
#define PG8_LDB(dst, b, h) do { _Pragma("unroll") for (int n = 0; n < 2; ++n) _Pragma("unroll") for (int k = 0; k < 2; ++k) dst[n][k] = *(const PG8_LAS bf16x8*)(lds + PG8_SB(b, h) + boff + n * 2048 + k * 1024); } while (0)
#define PG8_MMA(ai, bj, At, Bt) do { __builtin_amdgcn_s_setprio(1); _Pragma("unroll") for (int m = 0; m < 4; ++m) _Pragma("unroll") for (int n = 0; n < 2; ++n) _Pragma("unroll") for (int k = 0; k < 2; ++k) \
        acc[ai][bj][m][n] = __builtin_amdgcn_mfma_f32_16x16x32_bf16(Bt[n][k], At[m][k], acc[ai][bj][m][n], 0, 0, 0); __builtin_amdgcn_s_setprio(0); } while (0)
#define PG8_WAIT_V(n) asm volatile("s_waitcnt vmcnt(" #n ")" ::: "memory")
#define PG8_WAIT_L(n) asm volatile("s_waitcnt lgkmcnt(" #n ")" ::: "memory")
#define PG8_BAR __builtin_amdgcn_s_barrier()
#define PG8_SCHED __builtin_amdgcn_sched_barrier(0)
    Unit cur, nxt; int ui = 0;
    if (!S.next(0, cur)) return;
    f32x4 acc[2][2][4][2];
#pragma unroll
    for (int a = 0; a < 2; ++a)
#pragma unroll
        for (int b = 0; b < 2; ++b)
#pragma unroll
            for (int m = 0; m < 4; ++m)
#pragma unroll
                for (int n = 0; n < 2; ++n) acc[a][b][m][n] = (f32x4){0.f, 0.f, 0.f, 0.f};
    bf16x8 At[4][2], B0[2][2], B1[2][2];
    const char* cA = (const char*)g.A + (size_t)cur.kz * g.azs * 2 + (size_t)cur.pm * tstepA;
    const char* cB = (const char*)g.Bt + (size_t)cur.kz * g.bzs * 2 + (size_t)cur.pn * tstepB;
    PG8_STAGE(PG8_SB(0, 0), cB, voffB); PG8_STAGE(PG8_SB(0, 1), cB + hstepB, voffB); PG8_STAGE(PG8_SA(0, 0), cA, voffA); PG8_STAGE(PG8_SA(0, 1), cA + hstepA, voffA);
    if (wr == 1) PG8_BAR;
    PG8_WAIT_V(2); PG8_BAR;
    PG8_STAGE(PG8_SB(1, 0), cB + kstep, voffB); PG8_STAGE(PG8_SA(1, 0), cA + kstep, voffA); PG8_STAGE(PG8_SB(1, 1), cB + hstepB + kstep, voffB);
    PG8_WAIT_V(6); PG8_BAR;
    for (;;) {
        const bool has_next = S.next(ui + 1, nxt);
        const char* nA = has_next ? (const char*)g.A + (size_t)nxt.kz * g.azs * 2 + (size_t)nxt.pm * tstepA : cA;
        const char* nB = has_next ? (const char*)g.Bt + (size_t)nxt.kz * g.bzs * 2 + (size_t)nxt.pn * tstepB : cB;
        for (int t = 0; t < nt; t += 2) {
            const bool last = (t == nt - 2);
            const char* a1 = cA + (size_t)(t + 1) * kstep;
            const char* a2 = last ? nA : cA + (size_t)(t + 2) * kstep; const char* b2 = last ? nB : cB + (size_t)(t + 2) * kstep;
            const char* a3 = a2 + kstep; const char* b3 = b2 + kstep;
            PG8_LDB(B0, 0, 0); PG8_LDB(B1, 0, 1); PG8_SCHED; PG8_LDA(At, 0, 0); PG8_STAGE(PG8_SA(1, 1), a1 + hstepA, voffA);
            PG8_WAIT_V(8); PG8_WAIT_L(0); PG8_BAR; PG8_MMA(0, 0, At, B0); PG8_MMA(0, 1, At, B1); PG8_BAR; PG8_SCHED;
            PG8_LDA(At, 0, 1); PG8_STAGE(PG8_SB(0, 0), b2, voffB); PG8_STAGE(PG8_SB(0, 1), b2 + hstepB, voffB); PG8_STAGE(PG8_SA(0, 0), a2, voffA);
            PG8_WAIT_V(8); PG8_WAIT_L(0); PG8_BAR; PG8_MMA(1, 0, At, B0); PG8_MMA(1, 1, At, B1); PG8_BAR; PG8_SCHED;
            PG8_LDB(B0, 1, 0); PG8_LDB(B1, 1, 1); PG8_SCHED; PG8_LDA(At, 1, 0); PG8_STAGE(PG8_SA(0, 1), a2 + hstepA, voffA);
            PG8_WAIT_V(8); PG8_WAIT_L(0); PG8_BAR; PG8_MMA(0, 0, At, B0); PG8_MMA(0, 1, At, B1); PG8_BAR; PG8_SCHED;
            PG8_LDA(At, 1, 1); PG8_STAGE(PG8_SB(1, 0), b3, voffB); PG8_STAGE(PG8_SB(1, 1), b3 + hstepB, voffB); PG8_STAGE(PG8_SA(1, 0), a3, voffA);
            PG8_WAIT_V(8); PG8_WAIT_L(0); PG8_BAR; PG8_MMA(1, 0, At, B0); PG8_MMA(1, 1, At, B1); PG8_BAR; PG8_SCHED;
        }
        if constexpr (ALIGN_EPI) { if (wr == 0) PG8_BAR; }
        E(acc, cur, wr, wc, fr, fq);
        if (!has_next) break;
        if (!E.keep(cur)) {
#pragma unroll
            for (int a = 0; a < 2; ++a)
#pragma unroll
                for (int b = 0; b < 2; ++b)
#pragma unroll
                    for (int m = 0; m < 4; ++m)
#pragma unroll
                        for (int n = 0; n < 2; ++n) acc[a][b][m][n] = (f32x4){0.f, 0.f, 0.f, 0.f};
        }
        cur = nxt; cA = nA; cB = nB; ++ui;
        if constexpr (ALIGN_EPI) { if (wr == 1) PG8_BAR; }
    }
    PG8_WAIT_V(0);
    if constexpr (!ALIGN_EPI) { if (wr == 0) PG8_BAR; }
    PG8_BAR;
#undef PG8_SA
#undef PG8_SB
#undef PG8_STAGE
#undef PG8_LDA
#undef PG8_LDB
#undef PG8_MMA
#undef PG8_WAIT_V
#undef PG8_WAIT_L
#undef PG8_BAR
#undef PG8_SCHED
}
}

constexpr int NWAVES = 8, NTHR = 512;
constexpr int DM = 2048, NBATCH = 4, SEQ = 2048, MP = NBATCH * SEQ, MS = 128, MR = MP + MS, M = 8448;
constexpr int NLAYER = 2;
constexpr int NIN = 12816, NP = 13056, NG = 8192, N1 = NP + NG;
constexpr int DFF = 5632, NUV = 2 * DFF;
constexpr int BW = 1024;
constexpr float EPS = 1e-6f;
constexpr int C_XA = 0, C_YA = 1024, C_HQ = 2048, C_HF = 3072, C_HI = 4096, C_HGG = 5120, C_SZ = 6144, C_SX = 7168, C_SDT = 8704, C_RQ = 8960, C_RK = 9984, C_RV = 11008, C_RG = 12032;
constexpr int SRC_SPLIT = 8720;
constexpr int SSD_CD = 1536;

enum { I_XP = 0, I_XS, I_SLH, I_SLC, I_SHG, I_SSSD, I_SSC, I_SRET, I_SFC, I_GMIX, I_GFFN, I_WIN, I_LCW, I_LCB, I_LWA, I_LBA, I_LWX, I_LBX, I_LLAM, I_HGLB, I_HGNW,
       I_SCW, I_SCB, I_SDTB, I_SALOG, I_SD, I_SNW, I_WBR, I_WGATE, I_WOUT, I_WUP, I_WVAL, I_FCW, I_FCB, I_WDOWN, I_GFIN, N_INPUTS };

constexpr size_t O_YP = 0, O_YS = O_YP + (size_t)MP * DM, O_LH_P = O_YS + (size_t)MS * DM, O_LH_S = O_LH_P + 2 * 4 * 1024, O_LC_P = O_LH_S + 2 * 128 * 1024,
    O_LC_S = O_LC_P + 2 * 4 * 3 * 1024, O_HG_P = O_LC_S + 2 * 128 * 3 * 1024, O_HG_S = O_HG_P + (size_t)2 * 4 * 8 * 16384, O_SSD_P = O_HG_S + (size_t)2 * 128 * 8 * 16384,
    O_SSD_S = O_SSD_P + (size_t)2 * 4 * 16 * 8192, O_SC_P = O_SSD_S + (size_t)2 * 128 * 16 * 8192, O_SC_S = O_SC_P + 2 * 4 * 3 * 1536, O_RET_P = O_SC_S + 2 * 128 * 3 * 1536,
    O_RET_S = O_RET_P + (size_t)2 * 4 * 8 * 16384, O_FC_P = O_RET_S + (size_t)2 * 128 * 8 * 16384, O_FC_S = O_FC_P + 2 * 4 * 2 * 5632, O_END = O_FC_S + (size_t)2 * 128 * 2 * 5632;
static_assert(O_END == 126119936ull, "output size");

constexpr size_t AL(size_t x) { return (x + 4095) & ~(size_t)4095; }
constexpr size_t WS_CTL = 0, CTL_BYTES = 1u << 20;
constexpr size_t SZ_W1 = (size_t)N1 * DM * 2, SZ_WB = (size_t)4 * DM * BW * 2, SZ_WO = (size_t)DM * DM * 2, SZ_WUV = (size_t)NUV * DM * 2, SZ_WD = (size_t)DM * DFF * 2;
constexpr size_t WS_W1 = CTL_BYTES, WS_WB = WS_W1 + 2 * SZ_W1, WS_WO = WS_WB + 2 * SZ_WB, WS_WUV = WS_WO + 2 * SZ_WO, WS_WD = WS_WUV + 2 * SZ_WUV;
constexpr size_t WS_ROPE = WS_WD + 2 * SZ_WD, SZ_ROPE = AL((size_t)2049 * 64 * 8);
constexpr size_t SZ_X = (size_t)M * DM * 4;
constexpr size_t WS_X0 = WS_ROPE + SZ_ROPE, WS_X1 = WS_X0 + SZ_X;
constexpr size_t WS_H = WS_X1 + SZ_X, SZ_H = (size_t)M * DM * 2;
constexpr size_t WS_P = WS_H + SZ_H, SZ_P = (size_t)M * NP * 2;
constexpr size_t WS_G = WS_P + SZ_P, SZ_G = (size_t)M * NG * 2;
constexpr size_t WS_HF = WS_G + SZ_G, SZ_HF = (size_t)M * 1024 * 4;
constexpr size_t WS_DT = WS_HF + SZ_HF, SZ_DT = AL((size_t)M * 16 * 4);
constexpr size_t WS_OB = WS_DT + SZ_DT, SZ_O = (size_t)M * 1024 * 4;
constexpr size_t WS_BR = WS_OB + 3 * SZ_O, SZ_BR = (size_t)4 * M * BW * 2;
constexpr size_t WS_MG = WS_BR + SZ_BR, SZ_MG = (size_t)M * DM * 2;
constexpr size_t WS_XBC = WS_MG + SZ_MG, SZ_XBC = (size_t)M * SSD_CD * 2;
constexpr size_t WS_LB = WS_XBC + SZ_XBC, SZ_LB = AL((size_t)NLAYER * 1024 * 4);
constexpr size_t WS_END = WS_LB + SZ_LB;
static_assert((size_t)M * NUV * 2 <= SZ_P && (size_t)M * DFF * 2 <= SZ_G && 2 * SZ_O <= SZ_X, "overlays");

constexpr int RING_BYTES = 131072, LDSCTL_OFF = RING_BYTES, LDS_BYTES = 147456;

#define GAS __attribute__((address_space(1)))
#define LAS __attribute__((address_space(3)))
typedef unsigned short bf16;
typedef unsigned v4u __attribute__((ext_vector_type(4)));
typedef unsigned v2u __attribute__((ext_vector_type(2)));
typedef float f32x4 __attribute__((ext_vector_type(4)));
typedef float f32x2 __attribute__((ext_vector_type(2)));
typedef short bf16x8 __attribute__((ext_vector_type(8)));
#define LDS_WAIT() asm volatile("s_waitcnt lgkmcnt(0)" ::: "memory")
__device__ __forceinline__ unsigned f2bf(float f) { unsigned u = __builtin_bit_cast(unsigned, f); return (u + 0x7fffu + ((u >> 16) & 1u)) >> 16; }
__device__ __forceinline__ unsigned pk2(float lo, float hi) { return pg8::cvt_pk_bf16(lo, hi); }
__device__ __forceinline__ float bf2f(unsigned short b) { return __uint_as_float(((unsigned)b) << 16); }
__device__ __forceinline__ float bflo(unsigned w) { return __uint_as_float(w << 16); }
__device__ __forceinline__ float bfhi(unsigned w) { return __uint_as_float(w & 0xffff0000u); }
__device__ __forceinline__ float sigm(float x) { return __builtin_amdgcn_rcpf(1.f + __builtin_amdgcn_exp2f(-1.4426950408889634f * x)); }
__device__ __forceinline__ float siluf(float x) { return x * sigm(x); }
__device__ __forceinline__ float geluf(float x) { return x * sigm(1.5957691216057308f * (x + 0.044715f * x * x * x)); }
__device__ __forceinline__ float softplusf(float x) { return x > 20.f ? x : log1pf(__expf(x)); }

#define XB_TMO      128
#define XB_XCNT(j)  (256  + 64 * (j))
#define XB_XSUB(j)  (1280 + 64 * (j))
#define XB_XGEN(j)  (2304 + 64 * (j))
#define XB_TOP      3328
#define XB_TOPGEN   3392
#define XCD_BAR_WORDS 3456
#define XB_SPIN_CAP (1u << 19)
__device__ __forceinline__ unsigned xb_ld(unsigned* p)              { return __hip_atomic_load(p, __ATOMIC_RELAXED, __HIP_MEMORY_SCOPE_AGENT); }
__device__ __forceinline__ unsigned xb_add(unsigned* p, unsigned v) { return __hip_atomic_fetch_add(p, v, __ATOMIC_RELAXED, __HIP_MEMORY_SCOPE_AGENT); }
__device__ __forceinline__ unsigned xb_xcc_id() { return (unsigned)__builtin_amdgcn_s_getreg((3 << 11) | 20) & 0xFu; }
#define XB_SPIN(cond, bar) do { unsigned _sp = 0; while (cond) { __builtin_amdgcn_s_sleep(1); \
    if ((++_sp & 255u) == 0u) { if (xb_ld(&(bar)[XB_TMO])) break; if (_sp > XB_SPIN_CAP) { atomicAdd(&(bar)[XB_TMO], 1u); break; } } } } while (0)
struct XcdBarrier { unsigned* bar; unsigned x; volatile LAS unsigned* st; };
__device__ __forceinline__ XcdBarrier xcd_barrier_post(unsigned* bar, volatile LAS unsigned* st) {
    XcdBarrier b; b.bar = bar; b.x = xb_xcc_id(); b.st = st;
    if (threadIdx.x == 0) (void)xb_add(&bar[XB_XCNT(b.x)], 1u);
    return b;
}
__device__ __forceinline__ void xcd_barrier_complete(unsigned* bar, unsigned x, unsigned& nloc, unsigned& nx) {
    const unsigned G = gridDim.x * gridDim.y * gridDim.z;
    unsigned sum, cnt, mine, sp = 0u;
    for (;;) {
        sum = 0u; cnt = 0u; mine = 0u;
#pragma unroll
        for (unsigned j = 0; j < 16; ++j) { const unsigned c = xb_ld(&bar[XB_XCNT(j)]); sum += c; cnt += (c > 0u) ? 1u : 0u; mine = (j == x) ? c : mine; }
        if (sum == G) break;
        __builtin_amdgcn_s_sleep(1);
        if ((++sp & 255u) == 0u) { if (xb_ld(&bar[XB_TMO])) break; if (sp > XB_SPIN_CAP) { atomicAdd(&bar[XB_TMO], 1u); break; } }
    }
    nloc = mine > 0u ? mine : 1u; nx = cnt > 0u ? cnt : 1u;
}
__device__ __forceinline__ void xcd_barrier(const XcdBarrier& b) {
    asm volatile("s_waitcnt vmcnt(0)" ::: "memory");
    __syncthreads();
    if (threadIdx.x == 0) {
        unsigned* bar = b.bar;
        __builtin_amdgcn_s_waitcnt(0);
        unsigned nloc = b.st[0], nx = b.st[1];
        if (nloc == 0u) { xcd_barrier_complete(bar, b.x, nloc, nx); b.st[0] = nloc; b.st[1] = nx; }
        const unsigned old = xb_add(&bar[XB_XSUB(b.x)], 1u);
        const unsigned gen = old / nloc;
        if (old + 1u == (gen + 1u) * nloc) {
            __builtin_amdgcn_fence(__ATOMIC_RELEASE, "agent");
            asm volatile("s_waitcnt vmcnt(0)" ::: "memory");
            const unsigned og = xb_add(&bar[XB_TOP], 1u);
            const unsigned tg = og / nx;
            if (og + 1u == (tg + 1u) * nx) xb_add(&bar[XB_TOPGEN], 1u);
            else XB_SPIN(xb_ld(&bar[XB_TOPGEN]) == tg, bar);
            __builtin_amdgcn_fence(__ATOMIC_ACQUIRE, "agent");
            xb_add(&bar[XB_XGEN(b.x)], 1u);
            asm volatile("s_waitcnt vmcnt(0)" ::: "memory");
        } else {
            XB_SPIN(xb_ld(&bar[XB_XGEN(b.x)]) == gen, bar);
            __builtin_amdgcn_fence(__ATOMIC_ACQUIRE, "agent");
            asm volatile("s_waitcnt vmcnt(0)" ::: "memory");
        }
    }
    __syncthreads();
}

struct Args { const float* in[N_INPUTS]; float* out; unsigned char* ws; int ph_lo, ph_hi; };

struct Frame {
    LAS unsigned char* lds;
    int tid, lane, wave, G, c;
    const float* const* in;
    float* out;
    unsigned char* ws;
};
#define WSP(T, off) ((T*)(F.ws + (off)))
__device__ __forceinline__ Frame launder(const Frame& F0) {
    Frame F = F0;
    asm volatile("" : "+v"(F.tid), "+v"(F.lane));
    asm volatile("" : "+s"(F.wave), "+s"(F.G), "+s"(F.c));
    { int z = 0; asm volatile("" : "+s"(z)); F.in += z; F.out += z; F.ws += z; }
    asm volatile("" : "+s"(F.lds));
    return F;
}

using pg8::f32x4;
using pg8::Unit;
using pg8::cvt_pk_bf16;

struct Epi1 {
    static constexpr bool PERM = true;
    bf16* P; float* HF; float* DT; bf16* Gt; const float* LB;
    __device__ __forceinline__ bool keep(const Unit&) const { return false; }
    template <int ACT> __device__ __forceinline__ void store_act(f32x4 (&acc)[2][2][4][2], bf16* base, int ld, int row0, int colb) const {
#pragma unroll
        for (int ai = 0; ai < 2; ++ai)
#pragma unroll
            for (int m = 0; m < 4; ++m) { bf16* rowp = base + (size_t)(row0 + ai * 128 + m * 16) * ld + colb;
#pragma unroll
                for (int bj = 0; bj < 2; ++bj) { f32x4 v0 = acc[ai][bj][m][0], v1 = acc[ai][bj][m][1];
#pragma unroll
                    for (int j = 0; j < 4; ++j) { if (ACT == 1) { v0[j] = geluf(v0[j]); v1[j] = geluf(v1[j]); } if (ACT == 2) { v0[j] = siluf(v0[j]); v1[j] = siluf(v1[j]); } if (ACT == 3) { v0[j] = sigm(v0[j]); v1[j] = sigm(v1[j]); } }
                    pg8::u32x4 w; w.x = cvt_pk_bf16(v0[0], v0[1]); w.y = cvt_pk_bf16(v0[2], v0[3]); w.z = cvt_pk_bf16(v1[0], v1[1]); w.w = cvt_pk_bf16(v1[2], v1[3]);
                    *(pg8::u32x4*)(rowp + bj * 128) = w; }
                asm volatile("" ::: "memory"); }
    }
    __device__ __forceinline__ void operator()(f32x4 (&acc)[2][2][4][2], const Unit& u, int wr, int wc, int fr, int fq) const {
        asm volatile("" : "+v"(fr), "+v"(fq));
        const int row0 = u.pm * 256 + wr * 64 + fr, pn = u.pn;
        if (pn >= 51) { store_act<3>(acc, Gt, NG, row0, (pn - 51) * 256 + wc * 32 + 8 * fq); }
        else if (pn >= 12 && pn < 16) {
            const int colb = (pn - 12) * 256 + wc * 32 + 8 * fq;
#pragma unroll
            for (int bj = 0; bj < 2; ++bj) { const f32x4 l0 = *(const f32x4*)(LB + colb + bj * 128), l1 = *(const f32x4*)(LB + colb + bj * 128 + 4);
#pragma unroll
                for (int ai = 0; ai < 2; ++ai)
#pragma unroll
                    for (int m = 0; m < 4; ++m) { const size_t r = (size_t)(row0 + ai * 128 + m * 16);
                        f32x4 v0 = acc[ai][bj][m][0], v1 = acc[ai][bj][m][1], g0, g1, k0, k1;
#pragma unroll
                        for (int j = 0; j < 4; ++j) { { const float e = __builtin_amdgcn_exp2f(-1.4426950408889634f * fabsf(v0[j])), r = __builtin_amdgcn_rcpf(1.f + e), sm = e * r, sg = v0[j] >= 0.f ? r : sm, sn = v0[j] >= 0.f ? sm : r; g0[j] = __logf(l0[j] + (1.f - l0[j]) * sg); k0[j] = (1.f - l0[j]) * sn; }
                                                      { const float e = __builtin_amdgcn_exp2f(-1.4426950408889634f * fabsf(v1[j])), r = __builtin_amdgcn_rcpf(1.f + e), sm = e * r, sg = v1[j] >= 0.f ? r : sm, sn = v1[j] >= 0.f ? sm : r; g1[j] = __logf(l1[j] + (1.f - l1[j]) * sg); k1[j] = (1.f - l1[j]) * sn; } }
                        *(f32x4*)(HF + r * 1024 + colb + bj * 128) = g0; *(f32x4*)(HF + r * 1024 + colb + bj * 128 + 4) = g1;
                        pg8::u32x4 w; w.x = cvt_pk_bf16(k0[0], k0[1]); w.y = cvt_pk_bf16(k0[2], k0[3]); w.z = cvt_pk_bf16(k1[0], k1[1]); w.w = cvt_pk_bf16(k1[2], k1[3]);
                        *(pg8::u32x4*)(P + r * NP + C_HF + colb + bj * 128) = w; asm volatile("" ::: "memory"); } }
        } else if (pn == 34) {
            if (wc == 0 && fq < 2) {
#pragma unroll
                for (int ai = 0; ai < 2; ++ai)
#pragma unroll
                    for (int m = 0; m < 4; ++m) { float* rowp = DT + (size_t)(row0 + ai * 128 + m * 16) * 16 + 8 * fq;
                        *(f32x4*)(rowp) = acc[ai][0][m][0]; *(f32x4*)(rowp + 4) = acc[ai][0][m][1]; }
            }
        } else {
            const int colb = pn * 256 + wc * 32 + 8 * fq;
            if (pn >= 4 && pn < 8) store_act<1>(acc, P, NP, row0, colb);
            else if ((pn >= 8 && pn < 12) || (pn >= 20 && pn < 28) || pn >= 47) store_act<2>(acc, P, NP, row0, colb);
            else store_act<0>(acc, P, NP, row0, colb);
        }
    }
};

struct EpiB {
    static constexpr bool PERM = true;
    bf16* O; int ldc;
    __device__ __forceinline__ bool keep(const Unit&) const { return false; }
    __device__ __forceinline__ void operator()(f32x4 (&acc)[2][2][4][2], const Unit& u, int wr, int wc, int fr, int fq) const {
        asm volatile("" : "+v"(fr), "+v"(fq));
        const int row0 = u.pm * 256 + wr * 64 + fr, colb = u.pn * 256 + wc * 32 + 8 * fq;
#pragma unroll
        for (int ai = 0; ai < 2; ++ai)
#pragma unroll
            for (int m = 0; m < 4; ++m) { bf16* rowp = O + (size_t)(row0 + ai * 128 + m * 16) * ldc + colb;
#pragma unroll
                for (int bj = 0; bj < 2; ++bj) { const f32x4 v0 = acc[ai][bj][m][0], v1 = acc[ai][bj][m][1]; pg8::u32x4 w;
                    w.x = cvt_pk_bf16(v0[0], v0[1]); w.y = cvt_pk_bf16(v0[2], v0[3]); w.z = cvt_pk_bf16(v1[0], v1[1]); w.w = cvt_pk_bf16(v1[2], v1[3]);
                    *(pg8::u32x4*)(rowp + bj * 128) = w; } }
    }
};

struct EpiBr {
    static constexpr bool PERM = true;
    const bf16* Gt; bf16* O;
    __device__ __forceinline__ bool keep(const Unit& u) const { return u.kz < 3; }
    __device__ __forceinline__ void operator()(f32x4 (&acc)[2][2][4][2], const Unit& u, int wr, int wc, int fr, int fq) const {
        asm volatile("" : "+v"(fr), "+v"(fq));
        const int row0 = u.pm * 256 + wr * 64 + fr, colb = u.pn * 256 + wc * 32 + 8 * fq, kz = u.kz;
#pragma unroll
        for (int ai = 0; ai < 2; ++ai)
#pragma unroll
            for (int m = 0; m < 4; ++m) { const size_t r = (size_t)(row0 + ai * 128 + m * 16);
#pragma unroll
                for (int bj = 0; bj < 2; ++bj) {
                    const pg8::u32x4 ga = *(const pg8::u32x4*)(Gt + r * NG + kz * 2048 + colb + bj * 128);
                    float s[8] = {bflo(ga.x), bfhi(ga.x), bflo(ga.y), bfhi(ga.y), bflo(ga.z), bfhi(ga.z), bflo(ga.w), bfhi(ga.w)};
                    if (kz < 3) {
                        const pg8::u32x4 gb = *(const pg8::u32x4*)(Gt + r * NG + (kz + 1) * 2048 + colb + bj * 128);
                        const float d[8] = {bflo(gb.x), bfhi(gb.x), bflo(gb.y), bfhi(gb.y), bflo(gb.z), bfhi(gb.z), bflo(gb.w), bfhi(gb.w)};
#pragma unroll
                        for (int j = 0; j < 8; ++j) s[j] = s[j] * __builtin_amdgcn_rcpf(fmaxf(d[j], 1e-20f));
                    }
                    f32x4 v0 = acc[ai][bj][m][0], v1 = acc[ai][bj][m][1];
                    v0[0] *= s[0]; v0[1] *= s[1]; v0[2] *= s[2]; v0[3] *= s[3]; v1[0] *= s[4]; v1[1] *= s[5]; v1[2] *= s[6]; v1[3] *= s[7];
                    acc[ai][bj][m][0] = v0; acc[ai][bj][m][1] = v1;
                    if (kz == 3) { pg8::u32x4 w; w.x = cvt_pk_bf16(v0[0], v0[1]); w.y = cvt_pk_bf16(v0[2], v0[3]); w.z = cvt_pk_bf16(v1[0], v1[1]); w.w = cvt_pk_bf16(v1[2], v1[3]);
                        *(pg8::u32x4*)(O + r * DM + colb + bj * 128) = w; }
                }
                asm volatile("" ::: "memory"); }
    }
};

struct EpiRes {
    static constexpr bool PERM = false;
    const float* Xc; float* Xn;
    __device__ __forceinline__ bool keep(const Unit&) const { return false; }
    __device__ __forceinline__ void operator()(f32x4 (&acc)[2][2][4][2], const Unit& u, int wr, int wc, int fr, int fq) const {
        asm volatile("" : "+v"(fr), "+v"(fq));
        const int row0 = u.pm * 256 + wr * 64 + fr, col0 = u.pn * 256 + wc * 32 + 4 * fq;
#pragma unroll
        for (int ai = 0; ai < 2; ++ai)
#pragma unroll
            for (int m = 0; m < 4; ++m) { const size_t off = (size_t)(row0 + ai * 128 + m * 16) * DM + col0;
#pragma unroll
                for (int bj = 0; bj < 2; ++bj)
#pragma unroll
                    for (int n = 0; n < 2; ++n) { const f32x4 b = *(const f32x4*)(Xc + off + bj * 128 + n * 16); *(f32x4*)(Xn + off + bj * 128 + n * 16) = b + acc[ai][bj][m][n]; }
                asm volatile("" ::: "memory"); }
    }
};

struct TrJob { const float* W; bf16* WT; int K, N, ldt, mode, roff, item; };
__device__ __forceinline__ void tr_load(const TrJob& j, int lane, float (&v)[32]) {
    const int nblk = (j.N + 31) >> 5, kb = j.item / nblk, nb = j.item - kb * nblk, k0 = 64 * kb, n0 = 32 * nb;
    int nn = n0 + (lane & 31); nn = nn < j.N ? nn : j.N - 1;
    const float* p = j.W + (size_t)(k0 + (lane >> 5)) * j.N + nn;
#pragma unroll
    for (int i = 0; i < 32; ++i) v[i] = p[(size_t)(2 * i) * j.N];
}
__device__ __forceinline__ void tr_store(const TrJob& j, int lane, LAS float* scr, const float (&v)[32]) {
    const int nblk = (j.N + 31) >> 5, kb = j.item / nblk, nb = j.item - kb * nblk, k0 = 64 * kb, n0 = 32 * nb;
#pragma unroll
    for (int i = 0; i < 32; ++i) scr[(2 * i + (lane >> 5)) * 33 + (lane & 31)] = v[i];
    LDS_WAIT(); asm volatile("" ::: "memory");
    const int c = lane & 7;
#pragma unroll
    for (int jj = 0; jj < 4; ++jj) { const int n = (lane >> 3) + 8 * jj, gn = n0 + n; const LAS float* s = scr + (8 * c) * 33 + n;
        v4u o; o.x = pk2(s[0 * 33], s[1 * 33]); o.y = pk2(s[2 * 33], s[3 * 33]); o.z = pk2(s[4 * 33], s[5 * 33]); o.w = pk2(s[6 * 33], s[7 * 33]);
        if (gn < j.N) { const int dr = (j.mode == 1) ? (gn < SRC_SPLIT ? gn : gn + 240) : gn + j.roff; *(v4u*)(j.WT + (size_t)dr * j.ldt + k0 + 8 * c) = o; } }
    LDS_WAIT(); asm volatile("" ::: "memory");
}
constexpr int I_IN = (DM / 64) * ((NIN + 31) / 32), I_GT = (DM / 64) * (NG / 32), I_BR = (BW / 64) * (DM / 32), I_OUT = (DM / 64) * (DM / 32), I_UP = (DM / 64) * (DFF / 32), I_DN = (DFF / 64) * (DM / 32);
constexpr int I_LAYER = I_IN + I_GT + 4 * I_BR + I_OUT + 2 * I_UP + I_DN;
__device__ __forceinline__ TrJob tr_decode(const Frame& F, int it) {
    const int l = it / I_LAYER; int r = it - l * I_LAYER; TrJob j;
    bf16* W1 = WSP(bf16, WS_W1 + l * SZ_W1);
    if (r < I_IN) { j = TrJob{F.in[I_WIN] + (size_t)l * DM * NIN, W1, DM, NIN, DM, 1, 0, r}; return j; } r -= I_IN;
    if (r < I_GT) { j = TrJob{F.in[I_WGATE] + (size_t)l * DM * NG, W1, DM, NG, DM, 0, NP, r}; return j; } r -= I_GT;
    if (r < 4 * I_BR) { const int k = r / I_BR; j = TrJob{F.in[I_WBR] + ((size_t)l * 4 + k) * BW * DM, WSP(bf16, WS_WB + l * SZ_WB) + (size_t)k * DM * BW, BW, DM, BW, 0, 0, r - k * I_BR}; return j; } r -= 4 * I_BR;
    if (r < I_OUT) { j = TrJob{F.in[I_WOUT] + (size_t)l * DM * DM, WSP(bf16, WS_WO + l * SZ_WO), DM, DM, DM, 0, 0, r}; return j; } r -= I_OUT;
    if (r < I_UP) { j = TrJob{F.in[I_WUP] + (size_t)l * DM * DFF, WSP(bf16, WS_WUV + l * SZ_WUV), DM, DFF, DM, 0, 0, r}; return j; } r -= I_UP;
    if (r < I_UP) { j = TrJob{F.in[I_WVAL] + (size_t)l * DM * DFF, WSP(bf16, WS_WUV + l * SZ_WUV), DM, DFF, DM, 0, DFF, r}; return j; } r -= I_UP;
    j = TrJob{F.in[I_WDOWN] + (size_t)l * DFF * DM, WSP(bf16, WS_WD + l * SZ_WD), DFF, DM, DFF, 0, 0, r}; return j;
}

__device__ __forceinline__ void phase_prologue(const Frame& F0) {
    Frame F = launder(F0);
    LAS float* scr = (LAS float*)(F.lds + F.wave * 8704);
    const int gw = F.c * NWAVES + F.wave, NGW = F.G * NWAVES;
    {
        constexpr int NIT = NLAYER * I_LAYER;
        int it = gw; TrJob jc; float cur[32];
        if (it < NIT) { jc = tr_decode(F, it); tr_load(jc, F.lane, cur); }
        while (it < NIT) {
            const int itn = it + NGW; const bool hn = itn < NIT; TrJob jn = jc; float nx[32];
            if (hn) { jn = tr_decode(F, itn); tr_load(jn, F.lane, nx); }
            tr_store(jc, F.lane, scr, cur);
            if (hn) {
#pragma unroll
                for (int i = 0; i < 32; ++i) cur[i] = nx[i];
            }
            jc = jn; it = itn;
        }
    }
    const int gt = F.c * NTHR + F.tid, NGT = F.G * NTHR;
    for (int i = gt; i < NLAYER * 240 * (DM / 8); i += NGT) { const int l = i / (240 * (DM / 8)), r = i - l * (240 * (DM / 8));
        *(v4u*)(WSP(bf16, WS_W1 + l * SZ_W1) + (size_t)(SRC_SPLIT + r / (DM / 8)) * DM + (r % (DM / 8)) * 8) = (v4u){0u, 0u, 0u, 0u}; }
    for (int i = gt; i < NLAYER * 1024; i += NGT) { const int l = i >> 10, c = i & 1023; WSP(float, WS_LB)[i] = l == 0 ? 0.f : sigm(F.in[I_HGLB][1024 + c] - F.in[I_HGLB][c]); }
    for (int i = gt; i < 2049 * 64; i += NGT) { const int p = i >> 6, j = i & 63; const float pos = p < 2048 ? (float)p : 16384.f;
        const float fr = powf(10000.f, -(float)j / 64.f); const float ang = pos * fr; WSP(f32x2, WS_ROPE)[i] = (f32x2){cosf(ang), sinf(ang)}; }
    for (int i = gt; i < M * (DM / 4); i += NGT) { const int row = i / (DM / 4), c4 = i - row * (DM / 4);
        f32x4 v = (f32x4){0.f, 0.f, 0.f, 0.f};
        if (row < MP) v = ((const f32x4*)F.in[I_XP])[(size_t)row * (DM / 4) + c4]; else if (row < MR) v = ((const f32x4*)F.in[I_XS])[(size_t)(row - MP) * (DM / 4) + c4];
        WSP(f32x4, WS_X0)[i] = v; }
}

__device__ __forceinline__ float wave_sum(float v) {
#pragma unroll
    for (int o = 1; o < 64; o <<= 1) v += __shfl_xor(v, o);
    return v;
}
__device__ __forceinline__ void phase_norm(const Frame& F0, const float* X, const float* g, bf16* H) {
    Frame F = launder(F0);
    const int gw = F.c * NWAVES + F.wave, NGW = F.G * NWAVES;
    for (int row = gw; row < M; row += NGW) {
        v2u* o8 = (v2u*)(H + (size_t)row * DM) + F.lane;
        if (row >= MR) {
#pragma unroll
            for (int j = 0; j < 8; ++j) o8[64 * j] = (v2u){0u, 0u};
            continue; }
        const f32x4* xr = (const f32x4*)(X + (size_t)row * DM) + F.lane;
        f32x4 v[8]; float s = 0.f;
#pragma unroll
        for (int j = 0; j < 8; ++j) { v[j] = xr[64 * j]; s += (v[j].x * v[j].x + v[j].y * v[j].y) + (v[j].z * v[j].z + v[j].w * v[j].w); }
        const float rstd = __builtin_amdgcn_rsqf(wave_sum(s) * (1.f / DM) + EPS);
#pragma unroll
        for (int j = 0; j < 8; ++j) { const f32x4 gv = ((const f32x4*)g)[F.lane + 64 * j];
            o8[64 * j] = (v2u){pk2(v[j].x * rstd * gv.x, v[j].y * rstd * gv.y), pk2(v[j].z * rstd * gv.z, v[j].w * rstd * gv.w)}; }
    }
}
__device__ __forceinline__ void phase_final(const Frame& F0, const float* X, const float* g) {
    Frame F = launder(F0);
    const int gw = F.c * NWAVES + F.wave, NGW = F.G * NWAVES;
    for (int row = gw; row < MR; row += NGW) {
        const f32x4* xr = (const f32x4*)(X + (size_t)row * DM) + F.lane;
        f32x4* o = (f32x4*)(F.out + (row < MP ? O_YP + (size_t)row * DM : O_YS + (size_t)(row - MP) * DM)) + F.lane;
        f32x4 v[8]; float s = 0.f;
#pragma unroll
        for (int j = 0; j < 8; ++j) { v[j] = xr[64 * j]; s += (v[j].x * v[j].x + v[j].y * v[j].y) + (v[j].z * v[j].z + v[j].w * v[j].w); }
        const float rstd = __builtin_amdgcn_rsqf(wave_sum(s) * (1.f / DM) + EPS);
#pragma unroll
        for (int j = 0; j < 8; ++j) { const f32x4 gv = ((const f32x4*)g)[F.lane + 64 * j]; o[64 * j] = v[j] * rstd * gv; }
    }
}

constexpr size_t HGQ_STRIDE = (size_t)MP * 1024;
constexpr int LW_STR = 136;
constexpr int L_WT = 0, L_XC = 256 * LW_STR * 2, L_XCF = L_XC + 64 * LW_STR * 2, LXF_STR = 132;
static_assert(L_XCF + 64 * LXF_STR * 4 <= RING_BYTES, "lru lds");
__device__ __forceinline__ void lru_stage_w(const Frame& F0, int l, int n) {
    Frame F = launder(F0);
    LAS bf16* WT = (LAS bf16*)(F.lds + L_WT);
    const float* wa = F.in[I_LWA] + ((size_t)l * 8 + n) * 16384; const float* wx = F.in[I_LWX] + ((size_t)l * 8 + n) * 16384;
    for (int i = F.tid; i < 16384; i += NTHR) { const int c = i >> 7, d = i & 127;
        WT[d * LW_STR + c] = (bf16)f2bf(wa[i]); WT[(128 + d) * LW_STR + c] = (bf16)f2bf(wx[i]); }
}
__device__ __forceinline__ void lru_tile(const Frame& F0, int l, int n, int tt) {
    Frame F = launder(F0);
    LAS bf16* WT = (LAS bf16*)(F.lds + L_WT); LAS bf16* XC = (LAS bf16*)(F.lds + L_XC); LAS float* XCF = (LAS float*)(F.lds + L_XCF);
    const bf16* P = WSP(bf16, WS_P);
    const float* cw = F.in[I_LCW] + (size_t)l * 4 * 1024; const float* cb = F.in[I_LCB] + (size_t)l * 1024;
    {
        const int tk = F.tid >> 3, c0 = (F.tid & 7) * 16, row = tt * 64 + tk, ch0 = n * 128 + c0;
        float acc[16];
#pragma unroll
        for (int j = 0; j < 16; ++j) acc[j] = cb[ch0 + j];
        if (row < MP) {
            const int t = row & (SEQ - 1);
#pragma unroll
            for (int jj = 0; jj < 4; ++jj) { if (t - 3 + jj >= 0) { const v4u* src = (const v4u*)(P + (size_t)(row - 3 + jj) * NP + C_XA + ch0); const v4u a = src[0], b = src[1];
                const unsigned w[8] = {a.x, a.y, a.z, a.w, b.x, b.y, b.z, b.w}; const float* wj = cw + jj * 1024 + ch0;
#pragma unroll
                for (int q = 0; q < 8; ++q) { acc[2 * q] += wj[2 * q] * bflo(w[q]); acc[2 * q + 1] += wj[2 * q + 1] * bfhi(w[q]); } } }
        } else if (row < MR) {
            const int s = row - MP; const float* st = F.in[I_SLC] + ((size_t)l * 128 + s) * 3 * 1024 + ch0;
#pragma unroll
            for (int jj = 0; jj < 3; ++jj) { const float* wj = cw + jj * 1024 + ch0;
#pragma unroll
                for (int q = 0; q < 16; ++q) acc[q] += wj[q] * st[jj * 1024 + q]; }
            const v4u* src = (const v4u*)(P + (size_t)row * NP + C_XA + ch0); const v4u a = src[0], b = src[1];
            const unsigned w[8] = {a.x, a.y, a.z, a.w, b.x, b.y, b.z, b.w}; const float* wj = cw + 3 * 1024 + ch0;
#pragma unroll
            for (int q = 0; q < 8; ++q) { acc[2 * q] += wj[2 * q] * bflo(w[q]); acc[2 * q + 1] += wj[2 * q + 1] * bfhi(w[q]); }
        }
#pragma unroll
        for (int q = 0; q < 16; ++q) { XCF[tk * LXF_STR + c0 + q] = acc[q]; }
#pragma unroll
        for (int q = 0; q < 8; ++q) *(LAS unsigned*)(XC + tk * LW_STR + c0 + 2 * q) = pk2(acc[2 * q], acc[2 * q + 1]);
    }
    __syncthreads();
    const int w = F.wave, lane = F.lane, fr = lane & 15, g = lane >> 4;
    f32x4 ar[4], ai_[4];
#pragma unroll
    for (int rt = 0; rt < 4; ++rt) { ar[rt] = (f32x4){0.f, 0.f, 0.f, 0.f}; ai_[rt] = (f32x4){0.f, 0.f, 0.f, 0.f}; }
#pragma unroll
    for (int ks = 0; ks < 4; ++ks) {
        const bf16x8 br = *(const LAS bf16x8*)(WT + (16 * w + fr) * LW_STR + 32 * ks + 8 * g);
        const bf16x8 bi = *(const LAS bf16x8*)(WT + (128 + 16 * w + fr) * LW_STR + 32 * ks + 8 * g);
#pragma unroll
        for (int rt = 0; rt < 4; ++rt) { const bf16x8 a = *(const LAS bf16x8*)(XC + (16 * rt + fr) * LW_STR + 32 * ks + 8 * g);
            ar[rt] = __builtin_amdgcn_mfma_f32_16x16x32_bf16(a, br, ar[rt], 0, 0, 0); ai_[rt] = __builtin_amdgcn_mfma_f32_16x16x32_bf16(a, bi, ai_[rt], 0, 0, 0); }
    }
    const int d = 16 * w + fr, ch = n * 128 + d;
    const float ba = F.in[I_LBA][(size_t)l * 1024 + ch], bx = F.in[I_LBX][(size_t)l * 1024 + ch], sp = softplusf(-F.in[I_LLAM][(size_t)l * 1024 + ch]);
    float* LA = WSP(float, WS_X1); float* LU = LA + (size_t)M * 1024;
    const bool scan = (tt < 128);
    float CA = 1.f, CU = 0.f;
#pragma unroll
    for (int rt = 0; rt < 4; ++rt) {
        float A[4], U[4];
#pragma unroll
        for (int reg = 0; reg < 4; ++reg) { const int tk = 16 * rt + 4 * g + reg;
            const float r = sigm(ar[rt][reg] + ba), iv = sigm(ai_[rt][reg] + bx), la = -8.f * r * sp, a = __expf(la), xc = XCF[tk * LXF_STR + d];
            const float tq = -2.f * la, om = tq < 0.25f ? tq * (1.f + tq * (-0.5f + tq * (0.16666667f + tq * (-0.041666668f + tq * 0.0083333338f)))) : 1.f - __expf(-tq);
            A[reg] = a; U[reg] = __builtin_amdgcn_sqrtf(fmaxf(om, 0.f)) * (iv * xc); }
        if (scan) {
#pragma unroll
            for (int reg = 1; reg < 4; ++reg) { U[reg] = A[reg] * U[reg - 1] + U[reg]; A[reg] = A[reg] * A[reg - 1]; }
            float PA = 1.f, PU = 0.f, TA = 1.f, TU = 0.f;
#pragma unroll
            for (int src = 0; src < 4; ++src) { const float sa = __shfl(A[3], fr + 16 * src), su = __shfl(U[3], fr + 16 * src);
                if (src < g) { PU = sa * PU + su; PA = sa * PA; }
                TU = sa * TU + su; TA = sa * TA; }
            const float GA = PA * CA, GU = PA * CU + PU;
#pragma unroll
            for (int reg = 0; reg < 4; ++reg) { U[reg] = A[reg] * GU + U[reg]; A[reg] = A[reg] * GA; }
            CU = TA * CU + TU; CA = TA * CA;
        }
#pragma unroll
        for (int reg = 0; reg < 4; ++reg) { const size_t row = (size_t)tt * 64 + 16 * rt + 4 * g + reg; LA[row * 1024 + ch] = A[reg]; LU[row * 1024 + ch] = U[reg]; }
    }
    __syncthreads();
}
__device__ __forceinline__ void phase_conv(const Frame& F00, int l) {
    Frame F0 = launder(F00);
    { const int n = F0.c & 7; bool staged = false;
      for (int tt = F0.c >> 3; tt < 130; tt += (F0.G >> 3)) { if (!staged) { lru_stage_w(F0, l, n); __syncthreads(); staged = true; } lru_tile(F0, l, n, tt); } }
    Frame F = launder(F0);
    const bf16* P = WSP(bf16, WS_P);
    const int gt = F.c * NTHR + F.tid, NGT = F.G * NTHR;
    { const float* cw = F.in[I_SCW] + (size_t)l * 4 * SSD_CD; const float* cb = F.in[I_SCB] + (size_t)l * SSD_CD; bf16* XBC = WSP(bf16, WS_XBC);
      for (int i = gt; i < MR * (SSD_CD / 8); i += NGT) { const int row = i / (SSD_CD / 8), c = (i - row * (SSD_CD / 8)) * 8;
          float acc[8];
#pragma unroll
          for (int q = 0; q < 8; ++q) acc[q] = cb[c + q];
          if (row < MP) { const int t = row & (SEQ - 1);
#pragma unroll
              for (int jj = 0; jj < 4; ++jj) if (t - 3 + jj >= 0) { const v4u a = *(const v4u*)(P + (size_t)(row - 3 + jj) * NP + C_SX + c); const unsigned w[4] = {a.x, a.y, a.z, a.w}; const float* wj = cw + jj * SSD_CD + c;
#pragma unroll
                  for (int q = 0; q < 4; ++q) { acc[2 * q] += wj[2 * q] * bflo(w[q]); acc[2 * q + 1] += wj[2 * q + 1] * bfhi(w[q]); } }
          } else { const int s = row - MP; const float* st = F.in[I_SSC] + ((size_t)l * 128 + s) * 3 * SSD_CD + c;
#pragma unroll
              for (int jj = 0; jj < 3; ++jj) { const float* wj = cw + jj * SSD_CD + c;
#pragma unroll
                  for (int q = 0; q < 8; ++q) acc[q] += wj[q] * st[jj * SSD_CD + q]; }
              const v4u a = *(const v4u*)(P + (size_t)row * NP + C_SX + c); const unsigned w[4] = {a.x, a.y, a.z, a.w}; const float* wj = cw + 3 * SSD_CD + c;
#pragma unroll
              for (int q = 0; q < 4; ++q) { acc[2 * q] += wj[2 * q] * bflo(w[q]); acc[2 * q + 1] += wj[2 * q + 1] * bfhi(w[q]); } }
          v4u o; o.x = pk2(siluf(acc[0]), siluf(acc[1])); o.y = pk2(siluf(acc[2]), siluf(acc[3])); o.z = pk2(siluf(acc[4]), siluf(acc[5])); o.w = pk2(siluf(acc[6]), siluf(acc[7]));
          *(v4u*)(XBC + (size_t)row * SSD_CD + c) = o; } }
    { const int gw = F.c * NWAVES + F.wave, NGW = F.G * NWAVES, lane = F.lane; const float* LOGF = WSP(float, WS_HF);
      bf16* HGQ = WSP(bf16, WS_BR); float* HGE = (float*)(WSP(bf16, WS_BR) + 3 * HGQ_STRIDE);
      for (int tk = gw; tk < NBATCH * 32 * 8 * 2; tk += NGW) {
          const int b = tk >> 9, c = (tk >> 4) & 31, h = (tk >> 1) & 7, kd = (tk & 1) * 64 + lane; const size_t r0 = (size_t)b * SEQ + 64 * c; const int col = h * 128 + kd;
          float cs[64];
#pragma unroll
          for (int t = 0; t < 64; ++t) cs[t] = LOGF[(r0 + t) * 1024 + col];
#pragma unroll
          for (int t = 1; t < 64; ++t) cs[t] += cs[t - 1];
          const float beta = cs[31], bC = cs[63];
#pragma unroll
          for (int t = 0; t < 64; ++t) { const size_t row = r0 + t; const float q = bf2f(P[row * NP + C_HQ + col]), k = bf2f(P[row * NP + C_HF + col]);
              HGQ[row * 1024 + col] = (bf16)f2bf(q * __expf(fminf(cs[t] - beta, 80.f))); HGQ[HGQ_STRIDE + row * 1024 + col] = (bf16)f2bf(q * __expf(cs[t]));
              HGQ[2 * HGQ_STRIDE + row * 1024 + col] = (bf16)f2bf(k * __expf(fminf(beta - cs[t], 80.f))); }
          HGE[(size_t)(b * 32 + c) * 1024 + col] = __expf(bC); HGE[(size_t)128 * 1024 + (size_t)(b * 32 + c) * 1024 + col] = __expf(bC - beta);
      } }
    { bf16* RQK = WSP(bf16, WS_H);
      for (int i = gt; i < MP * 64; i += NGT) { const int row = i >> 6, h = (i >> 3) & 7, sg = i & 7, t = row & (SEQ - 1);
          const bf16* rp = P + (size_t)row * NP + h * 128;
          const v4u q1 = *(const v4u*)(rp + C_RQ + 8 * sg), q2 = *(const v4u*)(rp + C_RQ + 64 + 8 * sg), k1 = *(const v4u*)(rp + C_RK + 8 * sg), k2 = *(const v4u*)(rp + C_RK + 64 + 8 * sg);
          const v4u* cp = (const v4u*)(WSP(f32x2, WS_ROPE) + (size_t)t * 64 + 8 * sg); const v4u c0 = cp[0], c1 = cp[1], c2 = cp[2], c3 = cp[3];
          const unsigned q1w[4] = {q1.x, q1.y, q1.z, q1.w}, q2w[4] = {q2.x, q2.y, q2.z, q2.w}, k1w[4] = {k1.x, k1.y, k1.z, k1.w}, k2w[4] = {k2.x, k2.y, k2.z, k2.w};
          const unsigned csw[16] = {c0.x, c0.y, c0.z, c0.w, c1.x, c1.y, c1.z, c1.w, c2.x, c2.y, c2.z, c2.w, c3.x, c3.y, c3.z, c3.w};
          unsigned qa[4], qb[4], ka[4], kb[4]; const float ksc = 0.08838834764831845f;
#pragma unroll
          for (int j = 0; j < 4; ++j) {
              const float cc0 = __uint_as_float(csw[4 * j]), ss0 = __uint_as_float(csw[4 * j + 1]), cc1 = __uint_as_float(csw[4 * j + 2]), ss1 = __uint_as_float(csw[4 * j + 3]);
              const float a0 = bflo(q1w[j]), a1 = bfhi(q1w[j]), b0 = bflo(q2w[j]), b1 = bfhi(q2w[j]), e0 = bflo(k1w[j]), e1 = bfhi(k1w[j]), f0 = bflo(k2w[j]), f1 = bfhi(k2w[j]);
              qa[j] = pk2(a0 * cc0 - b0 * ss0, a1 * cc1 - b1 * ss1); qb[j] = pk2(a0 * ss0 + b0 * cc0, a1 * ss1 + b1 * cc1);
              ka[j] = pk2((e0 * cc0 - f0 * ss0) * ksc, (e1 * cc1 - f1 * ss1) * ksc); kb[j] = pk2((e0 * ss0 + f0 * cc0) * ksc, (e1 * ss1 + f1 * cc1) * ksc); }
          bf16* op = RQK + (size_t)row * 1024 + h * 128 + 8 * sg;
          *(v4u*)op = (v4u){qa[0], qa[1], qa[2], qa[3]}; *(v4u*)(op + 64) = (v4u){qb[0], qb[1], qb[2], qb[3]};
          *(v4u*)(op + HGQ_STRIDE) = (v4u){ka[0], ka[1], ka[2], ka[3]}; *(v4u*)(op + HGQ_STRIDE + 64) = (v4u){kb[0], kb[1], kb[2], kb[3]}; } }
    { float* DT = WSP(float, WS_DT); for (int i = gt; i < MR * 16; i += NGT) DT[i] = softplusf(DT[i] + F.in[I_SDTB][l * 16 + (i & 15)]); }
    for (int i = gt; i < NBATCH * 3 * 1024; i += NGT) { const int b = i / 3072, r = i - b * 3072, j = r >> 10, c = r & 1023;
        F.out[O_LC_P + (size_t)l * NBATCH * 3072 + i] = bf2f(P[((size_t)b * SEQ + SEQ - 3 + j) * NP + C_XA + c]); }
    for (int i = gt; i < MS * 3 * 1024; i += NGT) { const int s = i / 3072, r = i - s * 3072, j = r >> 10, c = r & 1023;
        F.out[O_LC_S + (size_t)l * MS * 3072 + i] = j < 2 ? F.in[I_SLC][(size_t)l * MS * 3072 + (size_t)s * 3072 + (j + 1) * 1024 + c] : bf2f(P[((size_t)MP + s) * NP + C_XA + c]); }
    for (int i = gt; i < NBATCH * 3 * SSD_CD; i += NGT) { const int b = i / (3 * SSD_CD), r = i - b * 3 * SSD_CD, j = r / SSD_CD, c = r - j * SSD_CD;
        F.out[O_SC_P + (size_t)l * NBATCH * 3 * SSD_CD + i] = bf2f(P[((size_t)b * SEQ + SEQ - 3 + j) * NP + C_SX + c]); }
    for (int i = gt; i < MS * 3 * SSD_CD; i += NGT) { const int s = i / (3 * SSD_CD), r = i - s * 3 * SSD_CD, j = r / SSD_CD, c = r - j * SSD_CD;
        F.out[O_SC_S + (size_t)l * MS * 3 * SSD_CD + i] = j < 2 ? F.in[I_SSC][(size_t)l * MS * 3 * SSD_CD + (size_t)s * 3 * SSD_CD + (j + 1) * SSD_CD + c] : bf2f(P[((size_t)MP + s) * NP + C_SX + c]); }
}

constexpr int QS_STR = 136;
typedef short s16x4 __attribute__((ext_vector_type(4)));
template <int MODE> struct CK {
    static constexpr int V = (MODE == 2) ? 64 : 128, NVT = V / 16, NVW = NVT / 2, NH = (MODE == 2) ? 16 : 8, VSTR = (MODE == 2) ? 72 : 136;
    static constexpr int O_QS = 0, O_QH = O_QS + 64 * QS_STR * 2, O_KS = O_QH + (MODE == 0 ? 64 * QS_STR * 2 : 0), O_VV = O_KS + 64 * QS_STR * 2, O_VD = O_VV + 64 * VSTR * 2,
        O_XS = O_VD + (MODE == 0 ? 0 : 64 * VSTR * 2), O_S0T = O_XS + (MODE == 2 ? 64 * VSTR * 2 : 0), O_F32 = O_S0T + V * QS_STR * 2, O_END = O_F32 + 4096;
    static_assert(O_END <= RING_BYTES, "chunk unit LDS");
};
__device__ __forceinline__ bf16x8 tr_frag(const LAS bf16* T, int stride, int row0, int row1, int col0, int fr) {
    const int q = fr >> 2, p = fr & 3;
    const s16x4 lo = __builtin_amdgcn_ds_read_tr16_b64_v4i16((LAS s16x4*)(T + (row0 + q) * stride + col0 + 4 * p));
    const s16x4 hi = __builtin_amdgcn_ds_read_tr16_b64_v4i16((LAS s16x4*)(T + (row1 + q) * stride + col0 + 4 * p));
    return (bf16x8){lo[0], lo[1], lo[2], lo[3], hi[0], hi[1], hi[2], hi[3]};
}
template <int MODE, int PV>
__device__ __forceinline__ void chunk_unit(const Frame& F0, int l, int unit) {
    Frame F = launder(F0);
    typedef CK<MODE> C; constexpr int V = C::V, NVT = C::NVT, NVW = C::NVW, NH = C::NH, VSTR = C::VSTR;
    const int b = unit / NH, h = unit - b * NH;
    LAS bf16* QS = (LAS bf16*)(F.lds + C::O_QS); LAS bf16* QH = (LAS bf16*)(F.lds + C::O_QH); LAS bf16* KS = (LAS bf16*)(F.lds + C::O_KS);
    LAS bf16* VV = (LAS bf16*)(F.lds + C::O_VV); LAS bf16* VD = (LAS bf16*)(F.lds + C::O_VD); LAS bf16* XS = (LAS bf16*)(F.lds + C::O_XS); LAS bf16* S0T = (LAS bf16*)(F.lds + C::O_S0T);
    LAS float* FA = (LAS float*)(F.lds + C::O_F32);
    const bf16* P = WSP(bf16, WS_P); const bf16* XBC = WSP(bf16, WS_XBC); const float* DT = WSP(float, WS_DT);
    const bf16* HGQ = WSP(bf16, WS_BR); const float* HGE = (const float*)(WSP(bf16, WS_BR) + 3 * HGQ_STRIDE); const bf16* RQK = WSP(bf16, WS_H);
    float* OUT = (MODE == 0) ? WSP(float, WS_OB) : (MODE == 1 ? WSP(float, WS_OB + 2 * SZ_O) : WSP(float, WS_OB + SZ_O));
    const int tid = F.tid, lane = F.lane, w = F.wave, fr = lane & 15, g = lane >> 4, tt = w & 3, vh = w >> 2;
    const float lg = (MODE == 1) ? log1pf(-exp2f(-5.f - (float)h)) : 0.f;
    float ssd_A = 0.f, ssd_D = 0.f;
    if (MODE == 2) { ssd_A = -__expf(F.in[I_SALOG][l * 16 + h]); ssd_D = F.in[I_SD][l * 16 + h]; }
    const int grp = h >> 3;
    for (int i = tid; i < V * QS_STR / 2; i += NTHR) ((LAS unsigned*)S0T)[i] = 0u;
    f32x4 S[NVT];
#pragma unroll
    for (int i = 0; i < NVT; ++i) S[i] = (f32x4){0.f, 0.f, 0.f, 0.f};
    v4u ra[8]; float rdt = 0.f, eb0 = 0.f, eb1 = 0.f;
    const int stok = tid >> 3, sg = tid & 7;
    auto load_chunk = [&](int c) {
        const size_t row = (size_t)b * SEQ + 64 * c + stok;
        if (MODE == 0) {
            const bf16* qp = HGQ + row * 1024 + h * 128 + 16 * sg;
            ra[0] = *(const v4u*)qp; ra[1] = *(const v4u*)(qp + 8); ra[2] = *(const v4u*)(qp + HGQ_STRIDE); ra[3] = *(const v4u*)(qp + HGQ_STRIDE + 8);
            ra[4] = *(const v4u*)(qp + 2 * HGQ_STRIDE); ra[5] = *(const v4u*)(qp + 2 * HGQ_STRIDE + 8);
            const bf16* vp = P + row * NP + C_HI + h * 128 + 16 * sg; ra[6] = *(const v4u*)vp; ra[7] = *(const v4u*)(vp + 8);
            if (tid < 128) { const float* ep = HGE + (size_t)(b * 32 + c) * 1024 + h * 128 + tid; eb0 = ep[0]; eb1 = ep[128 * 1024]; }
        } else if (MODE == 1) {
            const bf16* qp = RQK + row * 1024 + h * 128 + 16 * sg;
            ra[0] = *(const v4u*)qp; ra[1] = *(const v4u*)(qp + 8); ra[2] = *(const v4u*)(qp + HGQ_STRIDE); ra[3] = *(const v4u*)(qp + HGQ_STRIDE + 8);
            const bf16* vp = P + row * NP + C_RV + h * 128 + 16 * sg; ra[4] = *(const v4u*)vp; ra[5] = *(const v4u*)(vp + 8);
        } else {
            const bf16* xp = XBC + row * SSD_CD;
            ra[0] = *(const v4u*)(xp + 1024 + grp * 128 + 16 * sg); ra[1] = *(const v4u*)(xp + 1024 + grp * 128 + 16 * sg + 8);
            ra[2] = *(const v4u*)(xp + 1280 + grp * 128 + 16 * sg); ra[3] = *(const v4u*)(xp + 1280 + grp * 128 + 16 * sg + 8);
            ra[4] = *(const v4u*)(xp + h * 64 + 8 * sg);
            rdt = DT[((size_t)b * SEQ + 64 * c + lane) * 16 + h];
        }
    };
    auto stage_chunk = [&]() {
        if (MODE == 0) {
            *(LAS v4u*)(QS + stok * QS_STR + 16 * sg) = ra[0]; *(LAS v4u*)(QS + stok * QS_STR + 16 * sg + 8) = ra[1];
            *(LAS v4u*)(QH + stok * QS_STR + 16 * sg) = ra[2]; *(LAS v4u*)(QH + stok * QS_STR + 16 * sg + 8) = ra[3];
            *(LAS v4u*)(KS + stok * QS_STR + 16 * sg) = ra[4]; *(LAS v4u*)(KS + stok * QS_STR + 16 * sg + 8) = ra[5];
            *(LAS v4u*)(VV + stok * VSTR + 16 * sg) = ra[6]; *(LAS v4u*)(VV + stok * VSTR + 16 * sg + 8) = ra[7];
            if (tid < 128) { FA[512 + tid] = eb0; FA[640 + tid] = eb1; }
        } else if (MODE == 1) {
            *(LAS v4u*)(QS + stok * QS_STR + 16 * sg) = ra[0]; *(LAS v4u*)(QS + stok * QS_STR + 16 * sg + 8) = ra[1];
            *(LAS v4u*)(KS + stok * QS_STR + 16 * sg) = ra[2]; *(LAS v4u*)(KS + stok * QS_STR + 16 * sg + 8) = ra[3];
            *(LAS v4u*)(VV + stok * VSTR + 16 * sg) = ra[4]; *(LAS v4u*)(VV + stok * VSTR + 16 * sg + 8) = ra[5];
            const float ws = __expf(lg * (float)(63 - stok));
            const unsigned vw[8] = {ra[4].x, ra[4].y, ra[4].z, ra[4].w, ra[5].x, ra[5].y, ra[5].z, ra[5].w}; unsigned vd[8];
#pragma unroll
            for (int i = 0; i < 8; ++i) vd[i] = pk2(bflo(vw[i]) * ws, bfhi(vw[i]) * ws);
            *(LAS v4u*)(VD + stok * VSTR + 16 * sg) = (v4u){vd[0], vd[1], vd[2], vd[3]}; *(LAS v4u*)(VD + stok * VSTR + 16 * sg + 8) = (v4u){vd[4], vd[5], vd[6], vd[7]};
        } else {
            float bs = rdt * ssd_A;
#pragma unroll
            for (int o = 1; o < 64; o <<= 1) { const float up = __shfl_up(bs, o); if (lane >= o) bs += up; }
            const float bC = __shfl(bs, 63), bmy = __shfl(bs, stok), dtm = __shfl(rdt, stok);
            if (w == 0) { FA[lane] = bs; FA[64 + lane] = __expf(bs); }
            *(LAS v4u*)(KS + stok * QS_STR + 16 * sg) = ra[0]; *(LAS v4u*)(KS + stok * QS_STR + 16 * sg + 8) = ra[1];
            *(LAS v4u*)(QS + stok * QS_STR + 16 * sg) = ra[2]; *(LAS v4u*)(QS + stok * QS_STR + 16 * sg + 8) = ra[3];
            const float ws = __expf(bC - bmy);
            const unsigned xw[4] = {ra[4].x, ra[4].y, ra[4].z, ra[4].w}; unsigned v1[4], v2[4];
#pragma unroll
            for (int i = 0; i < 4; ++i) { const float x0 = bflo(xw[i]) * dtm, x1 = bfhi(xw[i]) * dtm; v1[i] = pk2(x0, x1); v2[i] = pk2(x0 * ws, x1 * ws); }
            *(LAS v4u*)(XS + stok * VSTR + 8 * sg) = ra[4]; *(LAS v4u*)(VV + stok * VSTR + 8 * sg) = (v4u){v1[0], v1[1], v1[2], v1[3]}; *(LAS v4u*)(VD + stok * VSTR + 8 * sg) = (v4u){v2[0], v2[1], v2[2], v2[3]};
        }
    };
    const bool sink = (PV == 0) || (F.G == 12345);
    if (PV != 2) { load_chunk(0); stage_chunk(); }
    __syncthreads();
    for (int c = 0; c < SEQ / 64; ++c) {
        if (PV != 2 && c + 1 < SEQ / 64) load_chunk(c + 1);
        if (PV != 1) {
        const size_t row0 = (size_t)b * SEQ + 64 * c;
        f32x4 sc[4];
#pragma unroll
        for (int st = 0; st < 4; ++st) { sc[st] = (f32x4){0.f, 0.f, 0.f, 0.f};
            if (st <= tt) {
#pragma unroll
                for (int ks = 0; ks < 4; ++ks) { const bf16x8 a = *(const LAS bf16x8*)(KS + (16 * st + fr) * QS_STR + 32 * ks + 8 * g), bq = *(const LAS bf16x8*)(QS + (16 * tt + fr) * QS_STR + 32 * ks + 8 * g);
                    sc[st] = __builtin_amdgcn_mfma_f32_16x16x32_bf16(a, bq, sc[st], 0, 0, 0); } } }
        const int tloc = 16 * tt + fr;
        float btt = 0.f; if (MODE == 2) btt = FA[tloc];
        unsigned pw[8];
#pragma unroll
        for (int st = 0; st < 4; ++st) { float vals[4];
#pragma unroll
            for (int reg = 0; reg < 4; ++reg) { const int s = 16 * st + 4 * g + reg; float x = sc[st][reg];
                if (MODE == 1) x *= __expf(lg * (float)(tloc - s));
                if (MODE == 2) x *= __expf(fminf(btt - FA[s], 0.f));
                vals[reg] = (st <= tt && s <= tloc) ? x : 0.f; }
            pw[2 * st] = pk2(vals[0], vals[1]); pw[2 * st + 1] = pk2(vals[2], vals[3]); }
        const bf16x8 pf0 = __builtin_bit_cast(bf16x8, ((v4u){pw[0], pw[1], pw[2], pw[3]})), pf1 = __builtin_bit_cast(bf16x8, ((v4u){pw[4], pw[5], pw[6], pw[7]}));
        LAS bf16* QX = (MODE == 0) ? QH : QS;
#pragma unroll
        for (int vi = 0; vi < NVW; ++vi) { const int vt = vh * NVW + vi;
            f32x4 o = (f32x4){0.f, 0.f, 0.f, 0.f}, oi = (f32x4){0.f, 0.f, 0.f, 0.f};
            { const bf16x8 bv = tr_frag(VV, VSTR, 4 * g, 16 + 4 * g, 16 * vt, fr); o = __builtin_amdgcn_mfma_f32_16x16x32_bf16(pf0, bv, o, 0, 0, 0); }
            if (tt >= 2) { const bf16x8 bv = tr_frag(VV, VSTR, 32 + 4 * g, 48 + 4 * g, 16 * vt, fr); o = __builtin_amdgcn_mfma_f32_16x16x32_bf16(pf1, bv, o, 0, 0, 0); }
#pragma unroll
            for (int ks = 0; ks < 4; ++ks) { const bf16x8 a = *(const LAS bf16x8*)(QX + (16 * tt + fr) * QS_STR + 32 * ks + 8 * g), bs = *(const LAS bf16x8*)(S0T + (16 * vt + fr) * QS_STR + 32 * ks + 8 * g);
                oi = __builtin_amdgcn_mfma_f32_16x16x32_bf16(a, bs, oi, 0, 0, 0); }
#pragma unroll
            for (int reg = 0; reg < 4; ++reg) { const int t = 16 * tt + 4 * g + reg; float val;
                if (MODE == 0) val = o[reg] + oi[reg];
                else if (MODE == 1) val = o[reg] + __expf(lg * (float)(t + 1)) * oi[reg];
                else val = o[reg] + FA[64 + t] * oi[reg] + ssd_D * bf2f(XS[t * VSTR + 16 * vt + fr]);
                if (sink) OUT[(row0 + t) * 1024 + h * V + 16 * vt + fr] = val; } }
        { const LAS bf16* VX = (MODE == 0) ? VV : VD;
          float e1[4], e2[4];
#pragma unroll
          for (int reg = 0; reg < 4; ++reg) { if (MODE == 0) { e1[reg] = FA[512 + 16 * w + 4 * g + reg]; e2[reg] = FA[640 + 16 * w + 4 * g + reg]; } else if (MODE == 1) { e1[reg] = __expf(lg * 64.f); e2[reg] = 1.f; } else { e1[reg] = FA[64 + 63]; e2[reg] = 1.f; } }
          const bf16x8 ka0 = tr_frag(KS, QS_STR, 8 * g, 8 * g + 4, 16 * w, fr), ka1 = tr_frag(KS, QS_STR, 32 + 8 * g, 36 + 8 * g, 16 * w, fr);
#pragma unroll
          for (int vt = 0; vt < NVT; ++vt) { f32x4 d = (f32x4){0.f, 0.f, 0.f, 0.f};
              const bf16x8 b0 = tr_frag(VX, VSTR, 8 * g, 8 * g + 4, 16 * vt, fr), b1 = tr_frag(VX, VSTR, 32 + 8 * g, 36 + 8 * g, 16 * vt, fr);
              d = __builtin_amdgcn_mfma_f32_16x16x32_bf16(ka0, b0, d, 0, 0, 0); d = __builtin_amdgcn_mfma_f32_16x16x32_bf16(ka1, b1, d, 0, 0, 0);
#pragma unroll
              for (int reg = 0; reg < 4; ++reg) S[vt][reg] = e1[reg] * S[vt][reg] + e2[reg] * d[reg]; } }
        }
        __syncthreads();
#pragma unroll
        for (int vt = 0; vt < NVT; ++vt) *(LAS v2u*)(S0T + (16 * vt + fr) * QS_STR + 16 * w + 4 * g) = (v2u){pk2(S[vt][0], S[vt][1]), pk2(S[vt][2], S[vt][3])};
        if (PV != 2 && c + 1 < SEQ / 64) stage_chunk();
        __syncthreads();
    }
    if (!sink) return;
    float* so = F.out + (MODE == 0 ? O_HG_P : (MODE == 1 ? O_RET_P : O_SSD_P)) + (((size_t)l * NBATCH + b) * NH + h) * (128 * V);
#pragma unroll
    for (int vt = 0; vt < NVT; ++vt)
#pragma unroll
        for (int reg = 0; reg < 4; ++reg) so[(size_t)(16 * w + 4 * g + reg) * V + 16 * vt + fr] = S[vt][reg];
}

constexpr int TB = 16;
constexpr int R_DEC = 0, R_KK = TB * 128 * 4, R_Q = 2 * TB * 128 * 4, R_VV = 3 * TB * 128 * 4, R_XS = R_VV + TB * 64 * 4, R_DSC = R_XS + TB * 64 * 4;
template <int MODE>
__device__ __forceinline__ void samp_unit(const Frame& F0, int l, int pair) {
    Frame F = launder(F0);
    constexpr int V = (MODE == 2) ? 64 : 128, NH = (MODE == 2) ? 16 : 8, NKR = (MODE == 2) ? 32 : 16, NJ = 128 / NKR;
    const int s = pair / NH, h = pair - s * NH; const size_t row = MP + s;
    LAS float* DEC = (LAS float*)(F.lds + R_DEC); LAS float* KK = (LAS float*)(F.lds + R_KK); LAS float* Q = (LAS float*)(F.lds + R_Q);
    LAS float* VV = (LAS float*)(F.lds + R_VV); LAS float* XS = (LAS float*)(F.lds + R_XS); LAS float* DSC = (LAS float*)(F.lds + R_DSC);
    LAS float* RED = (LAS float*)(F.lds + 65536);
    const bf16* P = WSP(bf16, WS_P); const bf16* XBC = WSP(bf16, WS_XBC);
    const int tid = F.tid;
    if (MODE == 0) {
        if (tid < 128) { const int k = tid; DEC[k] = __expf(WSP(float, WS_HF)[row * 1024 + h * 128 + k]); KK[k] = bf2f(P[row * NP + C_HF + h * 128 + k]); Q[k] = bf2f(P[row * NP + C_HQ + h * 128 + k]);
            VV[k] = bf2f(P[row * NP + C_HI + h * 128 + k]); }
    } else if (MODE == 1) {
        if (tid < 64) { const int j = tid;
            const float q1 = bf2f(P[row * NP + C_RQ + h * 128 + j]), q2 = bf2f(P[row * NP + C_RQ + h * 128 + 64 + j]);
            const float k1 = bf2f(P[row * NP + C_RK + h * 128 + j]), k2 = bf2f(P[row * NP + C_RK + h * 128 + 64 + j]);
            const f32x2 cs = WSP(f32x2, WS_ROPE)[2048 * 64 + j];
            Q[j] = q1 * cs.x - q2 * cs.y; Q[64 + j] = q1 * cs.y + q2 * cs.x;
            KK[j] = (k1 * cs.x - k2 * cs.y) * 0.08838834764831845f; KK[64 + j] = (k1 * cs.y + k2 * cs.x) * 0.08838834764831845f; }
        else if (tid < 192) { const int v = tid - 64; VV[v] = bf2f(P[row * NP + C_RV + h * 128 + v]); DEC[v] = 1.f - exp2f(-5.f - (float)h); }
    } else {
        if (tid < 320) { const int ch = tid, grp = h >> 3;
            const int cidx = ch < 64 ? h * 64 + ch : (ch < 192 ? 1024 + grp * 128 + (ch - 64) : 1280 + grp * 128 + (ch - 192));
            const float val = bf2f(XBC[row * SSD_CD + cidx]);
            if (ch < 64) { const float dtv = WSP(float, WS_DT)[row * 16 + h]; XS[ch] = val; VV[ch] = val * dtv;
                if (ch == 0) DSC[0] = __expf(dtv * (-__expf(F.in[I_SALOG][l * 16 + h]))); }
            else if (ch < 192) KK[ch - 64] = val; else Q[ch - 192] = val; }
    }
    __syncthreads();
    const int v4 = (MODE == 2) ? (tid & 15) : (tid & 31), kr = (MODE == 2) ? (tid >> 4) : (tid >> 5);
    const float* sin_ = F.in[MODE == 0 ? I_SHG : (MODE == 1 ? I_SRET : I_SSSD)] + (((size_t)l * 128 + s) * NH + h) * (128 * V);
    float* sout = F.out + (MODE == 0 ? O_HG_S : (MODE == 1 ? O_RET_S : O_SSD_S)) + (((size_t)l * 128 + s) * NH + h) * (128 * V);
    const f32x4 vv = *(const LAS f32x4*)(VV + 4 * v4);
    f32x4 sv[NJ];
#pragma unroll
    for (int j = 0; j < NJ; ++j) sv[j] = *(const f32x4*)(sin_ + (size_t)(kr + NKR * j) * V + 4 * v4);
    f32x4 po = (f32x4){0.f, 0.f, 0.f, 0.f};
#pragma unroll
    for (int j = 0; j < NJ; ++j) { const int k = kr + NKR * j; const float dec = (MODE == 2) ? DSC[0] : DEC[k]; const float kk = KK[k], q = Q[k];
        const f32x4 sn = sv[j] * dec + vv * kk; *(f32x4*)(sout + (size_t)k * V + 4 * v4) = sn; po += sn * q; }
    *(LAS f32x4*)(RED + kr * V + 4 * v4) = po;
    __syncthreads();
    if (tid < V) { float o = 0.f;
#pragma unroll
        for (int r = 0; r < NKR; ++r) o += RED[r * V + tid];
        if (MODE == 2) o += F.in[I_SD][l * 16 + h] * XS[tid];
        float* OUT = (MODE == 0) ? WSP(float, WS_OB) : (MODE == 1 ? WSP(float, WS_OB + 2 * SZ_O) : WSP(float, WS_OB + SZ_O));
        OUT[row * 1024 + h * V + tid] = o; }
    __syncthreads();
}

constexpr int CW_QUEUE = 8192;
__device__ __forceinline__ void phase_mix(const Frame& F0, int l) {
    Frame F = launder(F0);
    { const int w = F.c;
        if (w < 32) chunk_unit<0, 0>(F, l, w);
        else if (w < 64) chunk_unit<1, 0>(F, l, w - 32);
        else if (w < 128) chunk_unit<2, 0>(F, l, w - 64);
    }
    __syncthreads();
    volatile LAS unsigned* QW = (volatile LAS unsigned*)(F.lds + LDSCTL_OFF) + 16;
    unsigned* qhead = (unsigned*)(F.ws + WS_CTL) + CW_QUEUE + 64 * l;
    for (;;) {
        if (F.tid == 0) QW[0] = __hip_atomic_fetch_add(qhead, 1u, __ATOMIC_RELAXED, __HIP_MEMORY_SCOPE_AGENT);
        __syncthreads();
        const int p = (int)QW[0];
        __syncthreads();
        if (p >= 4096) break;
        if (p < 1024) samp_unit<0>(F, l, p); else if (p < 2048) samp_unit<1>(F, l, p - 1024); else samp_unit<2>(F, l, p - 2048);
    }    if (PROBE_UNIT) { Frame F2 = launder(F0); const int w = F2.c;
        if (w < 32) chunk_unit<0, PROBE_UNIT>(F2, l, w); else if (w < 64) chunk_unit<1, PROBE_UNIT>(F2, l, w - 32); else if (w < 128) chunk_unit<2, PROBE_UNIT>(F2, l, w - 64); }
}

__device__ __forceinline__ void phase_post(const Frame& F0, int l) {
    Frame F = launder(F0);
    const bf16* P = WSP(bf16, WS_P);
    const float* LA = WSP(float, WS_X1); const float* LU = LA + (size_t)M * 1024;
    bf16* BR = WSP(bf16, WS_BR);
    const int gt = F.c * NTHR + F.tid, NGT = F.G * NTHR, gw = F.c * NWAVES + F.wave, NGW = F.G * NWAVES, lane = F.lane;
    for (int task = gw; task < NBATCH * 16 * 32; task += NGW) {
        const int b = task >> 9, cg = (task >> 5) & 15, j = task & 31, ch = cg * 64 + lane;
        float h = 0.f;
        for (int jj = 0; jj < j; ++jj) { const size_t row = (size_t)b * SEQ + 64 * jj + 63; h = LA[row * 1024 + ch] * h + LU[row * 1024 + ch]; }
        float hv = 0.f;
        for (int t0 = 0; t0 < 64; t0 += 16) {
            float a[16], u[16], y[16];
#pragma unroll
            for (int q = 0; q < 16; ++q) { const size_t row = (size_t)b * SEQ + 64 * j + t0 + q; a[q] = LA[row * 1024 + ch]; u[q] = LU[row * 1024 + ch]; y[q] = bf2f(P[row * NP + C_YA + ch]); }
#pragma unroll
            for (int q = 0; q < 16; ++q) { const size_t row = (size_t)b * SEQ + 64 * j + t0 + q; hv = a[q] * h + u[q]; BR[row * BW + ch] = (bf16)f2bf(hv * y[q]); }
        }
        if (j == 31) F.out[O_LH_P + ((size_t)l * NBATCH + b) * 1024 + ch] = hv;
    }
    for (int i = gt; i < MS * 1024; i += NGT) { const int s = i >> 10, ch = i & 1023; const size_t row = MP + s;
        const float hp = F.in[I_SLH][((size_t)l * 128 + s) * 1024 + ch]; const float h = LA[row * 1024 + ch] * hp + LU[row * 1024 + ch];
        F.out[O_LH_S + ((size_t)l * 128 + s) * 1024 + ch] = h; BR[row * BW + ch] = (bf16)f2bf(h * bf2f(P[row * NP + C_YA + ch])); }
    for (int task = gw; task < MR * 3; task += NGW) {
        const int row = task / 3, br = task - row * 3;
        const f32x4* src = (const f32x4*)(WSP(float, WS_OB + (size_t)br * SZ_O) + (size_t)row * 1024 + 16 * lane);
        float x[16];
#pragma unroll
        for (int j = 0; j < 4; ++j) { const f32x4 v = src[j]; x[4 * j] = v.x; x[4 * j + 1] = v.y; x[4 * j + 2] = v.z; x[4 * j + 3] = v.w; }
        const int gcol = (br == 0) ? C_HGG : (br == 1 ? C_SZ : C_RG);
        const v4u* gp = (const v4u*)(P + (size_t)row * NP + gcol + 16 * lane); const v4u ga = gp[0], gb = gp[1];
        const unsigned gw_[8] = {ga.x, ga.y, ga.z, ga.w, gb.x, gb.y, gb.z, gb.w};
        float gt_[16];
#pragma unroll
        for (int q = 0; q < 8; ++q) { gt_[2 * q] = bflo(gw_[q]); gt_[2 * q + 1] = bfhi(gw_[q]); }
        float o[16];
        if (br == 1) {
            float ss = 0.f;
#pragma unroll
            for (int j = 0; j < 16; ++j) { x[j] *= gt_[j]; ss += x[j] * x[j]; }
#pragma unroll
            for (int m = 1; m < 32; m <<= 1) ss += __shfl_xor(ss, m);
            const float rs = __builtin_amdgcn_rsqf(ss * (1.f / 512.f) + EPS); const float* nw = F.in[I_SNW] + (size_t)l * 1024 + 16 * lane;
#pragma unroll
            for (int j = 0; j < 16; ++j) o[j] = x[j] * rs * nw[j];
        } else {
            float ss = 0.f;
#pragma unroll
            for (int j = 0; j < 16; ++j) ss += x[j] * x[j];
#pragma unroll
            for (int m = 1; m < 8; m <<= 1) ss += __shfl_xor(ss, m);
            const float rs = __builtin_amdgcn_rsqf(ss * (1.f / 128.f) + EPS);
            if (br == 0) { const float* nw = F.in[I_HGNW] + (size_t)l * 128 + ((16 * lane) & 127);
#pragma unroll
                for (int j = 0; j < 16; ++j) o[j] = x[j] * rs * nw[j] * gt_[j]; }
            else {
#pragma unroll
                for (int j = 0; j < 16; ++j) o[j] = x[j] * rs * gt_[j]; }
        }
        v4u w0, w1; w0.x = pk2(o[0], o[1]); w0.y = pk2(o[2], o[3]); w0.z = pk2(o[4], o[5]); w0.w = pk2(o[6], o[7]); w1.x = pk2(o[8], o[9]); w1.y = pk2(o[10], o[11]); w1.z = pk2(o[12], o[13]); w1.w = pk2(o[14], o[15]);
        v4u* dst = (v4u*)(BR + (size_t)(br + 1) * M * BW + (size_t)row * BW + 16 * lane); dst[0] = w0; dst[1] = w1;
    }
}

__device__ __forceinline__ void phase_act(const Frame& F0, int l) {
    Frame F = launder(F0);
    const bf16* UV = WSP(bf16, WS_P); bf16* A2 = WSP(bf16, WS_G);
    const float* cw = F.in[I_FCW] + (size_t)l * 3 * DFF; const float* cb = F.in[I_FCB] + (size_t)l * DFF;
    const int gt = F.c * NTHR + F.tid, NGT = F.G * NTHR;
    constexpr int C8 = DFF / 8;
    for (int i = gt; i < M * C8; i += NGT) {
        const int row = i / C8, c = (i - row * C8) * 8;
        v4u outw = (v4u){0u, 0u, 0u, 0u};
        if (row < MR) {
            const v4u uw = *(const v4u*)(UV + (size_t)row * NUV + c), vw = *(const v4u*)(UV + (size_t)row * NUV + DFF + c);
            float u0[8] = {bflo(uw.x), bfhi(uw.x), bflo(uw.y), bfhi(uw.y), bflo(uw.z), bfhi(uw.z), bflo(uw.w), bfhi(uw.w)};
            const float vv[8] = {bflo(vw.x), bfhi(vw.x), bflo(vw.y), bfhi(vw.y), bflo(vw.z), bfhi(vw.z), bflo(vw.w), bfhi(vw.w)};
            float u1[8], u2[8];
#pragma unroll
            for (int j = 0; j < 8; ++j) { u1[j] = 0.f; u2[j] = 0.f; }
            if (row < MP) { const int t = row & (SEQ - 1);
                if (t >= 1) { const v4u w = *(const v4u*)(UV + (size_t)(row - 1) * NUV + c); u1[0] = bflo(w.x); u1[1] = bfhi(w.x); u1[2] = bflo(w.y); u1[3] = bfhi(w.y); u1[4] = bflo(w.z); u1[5] = bfhi(w.z); u1[6] = bflo(w.w); u1[7] = bfhi(w.w); }
                if (t >= 2) { const v4u w = *(const v4u*)(UV + (size_t)(row - 2) * NUV + c); u2[0] = bflo(w.x); u2[1] = bfhi(w.x); u2[2] = bflo(w.y); u2[3] = bfhi(w.y); u2[4] = bflo(w.z); u2[5] = bfhi(w.z); u2[6] = bflo(w.w); u2[7] = bfhi(w.w); }
                if (t >= SEQ - 2) { float* so = F.out + O_FC_P + (((size_t)l * NBATCH + (row >> 11)) * 2 + (t - (SEQ - 2))) * DFF + c;
#pragma unroll
                    for (int j = 0; j < 8; ++j) so[j] = u0[j]; }
            } else { const int s = row - MP; const float* st = F.in[I_SFC] + ((size_t)l * MS + s) * 2 * DFF + c; float* so = F.out + O_FC_S + ((size_t)l * MS + s) * 2 * DFF + c;
#pragma unroll
                for (int j = 0; j < 8; ++j) { u2[j] = st[j]; u1[j] = st[DFF + j]; so[j] = st[DFF + j]; so[DFF + j] = u0[j]; } }
            float a[8];
#pragma unroll
            for (int j = 0; j < 8; ++j) { const float y = cb[c + j] + cw[c + j] * u2[j] + cw[DFF + c + j] * u1[j] + cw[2 * DFF + c + j] * u0[j]; a[j] = geluf(y) * vv[j]; }
            outw.x = pk2(a[0], a[1]); outw.y = pk2(a[2], a[3]); outw.z = pk2(a[4], a[5]); outw.w = pk2(a[6], a[7]);
        }
        *(v4u*)(A2 + (size_t)row * DFF + c) = outw;
    }
}

template <int KIND>
__device__ __forceinline__ void samp_gemm(const Frame& F0, int l) {
    Frame F = launder(F0);
    if (F.c >= 256) return;
    const int rb = F.c & 7, cb = F.c >> 3, w = F.wave, ct = w & 3, kh = w >> 2, fr = F.lane & 15, g = F.lane >> 4;
    const int nrow = 64 * cb + 16 * ct + fr;
    const size_t arow = (size_t)MP + 16 * rb + fr;
    f32x4 tot = (f32x4){0.f, 0.f, 0.f, 0.f};
    constexpr int NSEG = (KIND == 0) ? 4 : 1;
    constexpr int KH = (KIND == 0) ? 512 : (KIND == 1 ? 1024 : 2816);
#pragma unroll 1
    for (int seg = 0; seg < NSEG; ++seg) {
        const bf16* ap; const bf16* bp;
        if (KIND == 0) { ap = WSP(bf16, WS_BR) + (size_t)seg * M * BW + arow * BW + kh * KH + 8 * g; bp = WSP(bf16, WS_WB + l * SZ_WB) + (size_t)seg * DM * BW + (size_t)nrow * BW + kh * KH + 8 * g; }
        else if (KIND == 1) { ap = WSP(bf16, WS_MG) + arow * DM + kh * KH + 8 * g; bp = WSP(bf16, WS_WO + l * SZ_WO) + (size_t)nrow * DM + kh * KH + 8 * g; }
        else { ap = WSP(bf16, WS_G) + arow * DFF + kh * KH + 8 * g; bp = WSP(bf16, WS_WD + l * SZ_WD) + (size_t)nrow * DFF + kh * KH + 8 * g; }
        f32x4 a0 = (f32x4){0.f, 0.f, 0.f, 0.f}, a1 = a0;
#pragma unroll 4
        for (int st = 0; st < KH / 64; ++st) {
            const bf16x8 x0 = *(const bf16x8*)(ap + 64 * st), y0 = *(const bf16x8*)(bp + 64 * st), x1 = *(const bf16x8*)(ap + 64 * st + 32), y1 = *(const bf16x8*)(bp + 64 * st + 32);
            a0 = __builtin_amdgcn_mfma_f32_16x16x32_bf16(x0, y0, a0, 0, 0, 0); a1 = __builtin_amdgcn_mfma_f32_16x16x32_bf16(x1, y1, a1, 0, 0, 0);
        }
        a0 += a1;
        if (KIND == 0) {
#pragma unroll
            for (int reg = 0; reg < 4; ++reg) a0[reg] *= bf2f(WSP(bf16, WS_G)[((size_t)MP + 16 * rb + 4 * g + reg) * NG + seg * 2048 + 64 * cb + 16 * ct + fr]);
        }
        tot += a0;
    }
    LAS f32x4* RED = (LAS f32x4*)F.lds;
    if (kh == 1) RED[ct * 64 + F.lane] = tot;
    __syncthreads();
    if (kh == 0) {
        tot += RED[ct * 64 + F.lane];
#pragma unroll
        for (int reg = 0; reg < 4; ++reg) { const size_t row = (size_t)MP + 16 * rb + 4 * g + reg; const int d = 64 * cb + 16 * ct + fr;
            if (KIND == 0) WSP(bf16, WS_MG)[row * DM + d] = (bf16)f2bf(tot[reg]);
            else if (KIND == 1) WSP(float, WS_X1)[row * DM + d] = WSP(float, WS_X0)[row * DM + d] + tot[reg];
            else WSP(float, WS_X0)[row * DM + d] = WSP(float, WS_X1)[row * DM + d] + tot[reg]; }
    }
    __syncthreads();
}

constexpr int PH_PER_LAYER = 11, NPHASE = 1 + NLAYER * PH_PER_LAYER + 1;
__global__ void __launch_bounds__(NTHR, 2) mk_fwd(Args args) {
    extern __shared__ __attribute__((aligned(16))) unsigned char lds_raw[];
    Frame F;
    F.lds = (LAS unsigned char*)lds_raw;
    F.tid = threadIdx.x; F.lane = F.tid & 63; F.wave = __builtin_amdgcn_readfirstlane(F.tid >> 6);
    F.G = gridDim.x; F.c = blockIdx.x;
    F.in = args.in; F.out = args.out; F.ws = args.ws;
    volatile LAS unsigned* MISC = (volatile LAS unsigned*)(F.lds + LDSCTL_OFF);
    if (F.tid < 64) MISC[F.tid] = 0u;
    __syncthreads();
    unsigned* barw = (unsigned*)(F.ws + WS_CTL) + 4096;
    XcdBarrier bar; bar.bar = barw; bar.x = 0; bar.st = nullptr;
    if (!MK_SPLIT) bar = xcd_barrier_post(barw, MISC + 8);
    const int lo = args.ph_lo, hi = args.ph_hi;
#define IN(k) (lo <= (k) && (k) < hi)
#define SEAM(k) do { if (IN(k) && IN((k) + 1)) xcd_barrier(bar); } while (0)
#define X0 WSP(float, WS_X0)
#define X1 WSP(float, WS_X1)
#define H WSP(bf16, WS_H)
#define GEMM_RUN(EPI) do { pg8::gemm_phase<EPI, pg8::TileOrder>(F.lds, g, S, E); if (REP_G > 1) { Frame F1 = launder(F); pg8::gemm_phase<EPI, pg8::TileOrder>(F1.lds, g, S, E); } } while (0)

    if (IN(0) && !(SKMASK & 1)) { phase_prologue(F); } SEAM(0);

    for (int l = 0; l < NLAYER; ++l) {
        const int pb = 1 + l * PH_PER_LAYER;
        if (IN(pb + 0) && !(SKMASK & 2)) { phase_norm(F, X0, F.in[I_GMIX] + (size_t)l * DM, H); } SEAM(pb + 0);
        if (IN(pb + 1) && !(SKMASK & 4)) { const Frame F0 = F; Frame F = launder(F0);
            pg8::Gemm g{H, WSP(bf16, WS_W1 + l * SZ_W1), DM, DM, DM, 0, 0}; pg8::TileOrder S; S.init(M, N1, F.G, F.c, 1);
            Epi1 E{WSP(bf16, WS_P), WSP(float, WS_HF), WSP(float, WS_DT), WSP(bf16, WS_G), WSP(float, WS_LB) + l * 1024};
            GEMM_RUN(Epi1);
        } SEAM(pb + 1);
        if (IN(pb + 2) && !(SKMASK & 8)) { phase_conv(F, l); if (REP_CONV > 1) phase_conv(F, l); } SEAM(pb + 2);
        if (IN(pb + 3) && !(SKMASK & 16)) { phase_mix(F, l); if (REP_MIX > 1) phase_mix(F, l); } SEAM(pb + 3);
        if (IN(pb + 4) && !(SKMASK & 32)) { phase_post(F, l); if (REP_POST > 1) phase_post(F, l); } SEAM(pb + 4);
        if (IN(pb + 5) && !(SKMASK & 64)) { const Frame F0 = F; Frame F = launder(F0);
            pg8::Gemm g{WSP(bf16, WS_BR), WSP(bf16, WS_WB + l * SZ_WB), BW, BW, BW, (size_t)M * BW, (size_t)DM * BW}; pg8::TileOrder S; S.init(MP, DM, F.G, F.c, 4);
            EpiBr E{WSP(bf16, WS_G), WSP(bf16, WS_MG)};
            GEMM_RUN(EpiBr);
            samp_gemm<0>(F, l);
        } SEAM(pb + 5);
        if (IN(pb + 6) && !(SKMASK & 128)) { const Frame F0 = F; Frame F = launder(F0);
            pg8::Gemm g{WSP(bf16, WS_MG), WSP(bf16, WS_WO + l * SZ_WO), DM, DM, DM, 0, 0}; pg8::TileOrder S; S.init(MP, DM, F.G, F.c, 1);
            EpiRes E{X0, X1};
            GEMM_RUN(EpiRes);
            samp_gemm<1>(F, l);
        } SEAM(pb + 6);
        if (IN(pb + 7) && !(SKMASK & 256)) { phase_norm(F, X1, F.in[I_GFFN] + (size_t)l * DM, H); } SEAM(pb + 7);
        if (IN(pb + 8) && !(SKMASK & 512)) { const Frame F0 = F; Frame F = launder(F0);
            pg8::Gemm g{H, WSP(bf16, WS_WUV + l * SZ_WUV), DM, DM, DM, 0, 0}; pg8::TileOrder S; S.init(M, NUV, F.G, F.c, 1);
            EpiB E{WSP(bf16, WS_P), NUV};
            GEMM_RUN(EpiB);
        } SEAM(pb + 8);
        if (IN(pb + 9) && !(SKMASK & 1024)) { phase_act(F, l); } SEAM(pb + 9);
        if (IN(pb + 10) && !(SKMASK & 2048)) { const Frame F0 = F; Frame F = launder(F0);
            pg8::Gemm g{WSP(bf16, WS_G), WSP(bf16, WS_WD + l * SZ_WD), DFF, DFF, DFF, 0, 0}; pg8::TileOrder S; S.init(MP, DM, F.G, F.c, 1);
            EpiRes E{X1, X0};
            GEMM_RUN(EpiRes);
            samp_gemm<2>(F, l);
        } SEAM(pb + 10);
    }
    if (IN(NPHASE - 1) && !(SKMASK & 4096)) { phase_final(F, WSP(float, WS_X0), F.in[I_GFIN]); }
#undef IN
#undef SEAM
#undef X0
#undef X1
#undef H
#undef GEMM_RUN
}

extern "C" void kernel_launch(void* const* d_in, const int* in_sizes, int n_in, void* d_out, int out_size, void* d_ws, size_t ws_size, hipStream_t stream) {
    static int grid = 0;
    if (grid == 0) {
        if (n_in != N_INPUTS || (size_t)out_size != O_END || ws_size < WS_END) { fprintf(stderr, "kernel_launch: unexpected shapes: n_in %d out %d ws %zu (need %zu)\n", n_in, out_size, ws_size, (size_t)WS_END); grid = -1; return; }
        int dev = 0, cus = 0, per_cu = 0;
        if (hipGetDevice(&dev) != hipSuccess || hipDeviceGetAttribute(&cus, hipDeviceAttributeMultiprocessorCount, dev) != hipSuccess) { grid = -1; return; }
        if (hipFuncSetAttribute((const void*)mk_fwd, hipFuncAttributeMaxDynamicSharedMemorySize, LDS_BYTES) != hipSuccess) { fprintf(stderr, "kernel_launch: hipFuncSetAttribute failed\n"); grid = -1; return; }
        if (hipOccupancyMaxActiveBlocksPerMultiprocessor(&per_cu, (const void*)mk_fwd, NTHR, LDS_BYTES) != hipSuccess || per_cu < 1) { fprintf(stderr, "kernel_launch: occupancy query says %d\n", per_cu); }
        (void)hipGetLastError();
        grid = cus;
    }
    if (grid < 0) return;
    (void)hipMemsetAsync((char*)d_ws + WS_CTL, 0, CTL_BYTES, stream);
    Args a{};
    for (int i = 0; i < N_INPUTS; ++i) a.in[i] = (const float*)d_in[i];
    a.out = (float*)d_out; a.ws = (unsigned char*)d_ws;
#if MK_SPLIT
    for (int p = 0; p < NPHASE; ++p) { a.ph_lo = p; a.ph_hi = p + 1; hipLaunchKernelGGL(mk_fwd, dim3(grid), dim3(NTHR), LDS_BYTES, stream, a); }
#else
    a.ph_lo = 0; a.ph_hi = NPHASE;
    hipLaunchKernelGGL(mk_fwd, dim3(grid), dim3(NTHR), LDS_BYTES, stream, a);
#endif
}
```

```cpp
#include <hip/hip_runtime.h>
#include <cstdio>
#include <cstdint>

#ifndef REP_G
#define REP_G 1
#endif
#ifndef PROBE_UNIT
#define PROBE_UNIT 0
#endif
#ifndef PROBE_NWG
#define PROBE_NWG 224
#endif
#ifndef REP_CONV
#define REP_CONV 1
#endif
#ifndef REP_MIX
#define REP_MIX 1
#endif
#ifndef REP_POST
#define REP_POST 1
#endif
#ifndef SKMASK
#define SKMASK 0
#endif
#ifndef MK_SPLIT
#define MK_SPLIT 0
#endif

namespace pg8 {
#define PG8_LAS __attribute__((address_space(3)))
typedef unsigned short bf16_t;
typedef short bf16x8 __attribute__((ext_vector_type(8)));
typedef float f32x4 __attribute__((ext_vector_type(4)));
typedef unsigned u32x4 __attribute__((ext_vector_type(4)));
constexpr int BM = 256, BK = 64, HALF = 128, HTB = HALF * BK * 2, STAGE_BYTES = 8 * HTB, NXCD = 8, WGM = 8;

__host__ __device__ __forceinline__ int lds_byte(int r, int c) { const int st = (r >> 4) * 2 + (c >> 5), rr = r & 15, cc = c & 31, ob = rr * 64 + cc * 2; return st * 1024 + (ob ^ (((ob >> 9) & 1) << 5)); }
__host__ __device__ __forceinline__ void stage_rc(int b, int& R, int& C) { const int st = b / 1024, sb = b % 1024, swz = sb ^ (((sb >> 9) & 1) << 5); R = (st >> 1) * 16 + swz / 64; C = (st & 1) * 32 + (swz % 64) / 2; }
__host__ __device__ __forceinline__ int perm32(int rho) { const int n = rho >> 4, i = rho & 15; return 8 * (i >> 2) + 4 * n + (i & 3); }

struct Unit { int pm, pn, kz; };
struct Gemm { const bf16_t* A; const bf16_t* Bt; int lda, ldb, K; size_t azs, bzs; int prs, pr0; };

struct TileOrder {
    int nM, nN, nwg, G, c, nkz;
    __device__ void init(int M, int N, int G_, int c_, int nkz_) { nM = M / BM; nN = N / BM; nwg = nM * nN; G = G_; c = c_; nkz = nkz_; }
    __device__ bool next(int i, Unit& u) const {
        const int ti = i / nkz; u.kz = i - ti * nkz;
        const long L = (long)ti * G + c; if (L >= nwg) return false;
        int wgid = (int)L; { const int q = nwg / NXCD, r = nwg % NXCD, xcd = wgid % NXCD, off = wgid / NXCD; wgid = (xcd < r ? xcd * (q + 1) : r * (q + 1) + (xcd - r) * q) + off; }
        const int nig = WGM * nN, gid = wgid / nig, fm = gid * WGM, gsz = (nM - fm) < WGM ? (nM - fm) : WGM;
        u.pm = fm + ((wgid % nig) % gsz); u.pn = (wgid % nig) / gsz; return true;
    }
};

typedef __bf16 bf16x2_t __attribute__((ext_vector_type(2)));
typedef float f32x2_t __attribute__((ext_vector_type(2)));
__device__ __forceinline__ unsigned cvt_pk_bf16(float lo, float hi) { const bf16x2_t r = __builtin_convertvector((f32x2_t){lo, hi}, bf16x2_t); return __builtin_bit_cast(unsigned, r); }

template <class Epi, class Sched, bool ALIGN_EPI = true>
__device__ __forceinline__ void gemm_phase(PG8_LAS unsigned char* lds, const Gemm g, const Sched& S, const Epi& E) {
    int tid = threadIdx.x; asm volatile("" : "+v"(tid));
    const int wid = __builtin_amdgcn_readfirstlane(tid >> 6), lane = tid & 63, wr = wid >> 2, wc = wid & 3, fr = lane & 15, fq = lane >> 4;
    const int K = g.K, nt = K / BK;
    unsigned voffA[2], voffB[2];
#pragma unroll
    for (int i = 0; i < 2; ++i) { int R, C; stage_rc(tid * 16 + i * 8192, R, C); const int Rb = Epi::PERM ? ((R & ~31) + perm32(R & 31)) : R;
        voffA[i] = (unsigned)(R * g.lda + C) * 2u; voffB[i] = (unsigned)(Rb * g.ldb + C) * 2u; }
    const size_t kstep = (size_t)(BK * 2);
    const size_t hstepA = (size_t)HALF * g.lda * 2, hstepB = (size_t)HALF * g.ldb * 2;
    const size_t tstepB = 2 * hstepB;
    const unsigned ldsw = (unsigned)wid * 1024u;
    const int aoff = lds_byte(wr * 64 + fr, fq * 8), boff = lds_byte(wc * 32 + fr, fq * 8);
#define PG8_SA(b, h) (((b) * 2 + (h)) * HTB)
#define PG8_SB(b, h) ((4 + (b) * 2 + (h)) * HTB)
#define PG8_STAGE(bufoff, gbase, voff) do { _Pragma("unroll") for (int _i = 0; _i < 2; ++_i) \
        __builtin_amdgcn_global_load_lds((const unsigned*)((const char*)(gbase) + (voff)[_i]), (PG8_LAS unsigned*)(lds + (bufoff) + ldsw + _i * 8192), 16, 0, 0); } while (0)
#define PG8_LDA(dst, b, h) do { _Pragma("unroll") for (int m = 0; m < 4; ++m) _Pragma("unroll") for (int k = 0; k < 2; ++k) dst[m][k] = *(const PG8_LAS bf16x8*)(lds + PG8_SA(b, h) + aoff + m * 2048 + k * 1024); } while (0)
#define PG8_LDB(dst, b, h) do { _Pragma("unroll") for (int n = 0; n < 2; ++n) _Pragma("unroll") for (int k = 0; k < 2; ++k) dst[n][k] = *(const PG8_LAS bf16x8*)(lds + PG8_SB(b, h) + boff + n * 2048 + k * 1024); } while (0)
#define PG8_MMA(ai, bj, At, Bt) do { __builtin_amdgcn_s_setprio(1); _Pragma("unroll") for (int m = 0; m < 4; ++m) _Pragma("unroll") for (int n = 0; n < 2; ++n) _Pragma("unroll") for (int k = 0; k < 2; ++k) \
        acc[ai][bj][m][n] = __builtin_amdgcn_mfma_f32_16x16x32_bf16(Bt[n][k], At[m][k], acc[ai][bj][m][n], 0, 0, 0); __builtin_amdgcn_s_setprio(0); } while (0)
#define PG8_WAIT_V(n) asm volatile("s_waitcnt vmcnt(" #n ")" ::: "memory")
#define PG8_WAIT_L(n) asm volatile("s_waitcnt lgkmcnt(" #n ")" ::: "memory")
#define PG8_BAR __builtin_amdgcn_s_barrier()
#define PG8_SCHED __builtin_amdgcn_sched_barrier(0)
    Unit cur, nxt; int ui = 0;
    if (!S.next(0, cur)) return;
    f32x4 acc[2][2][4][2];
#pragma unroll
    for (int a = 0; a < 2; ++a)
#pragma unroll
        for (int b = 0; b < 2; ++b)
#pragma unroll
            for (int m = 0; m < 4; ++m)
#pragma unroll
                for (int n = 0; n < 2; ++n) acc[a][b][m][n] = (f32x4){0.f, 0.f, 0.f, 0.f};
    bf16x8 At[4][2], B0[2][2], B1[2][2];
    const char* cA = (const char*)g.A + (ptrdiff_t)((size_t)cur.kz * g.azs * 2) + ((ptrdiff_t)cur.pm * g.prs + g.pr0) * (ptrdiff_t)g.lda * 2;
    const char* cB = (const char*)g.Bt + (size_t)cur.kz * g.bzs * 2 + (size_t)cur.pn * tstepB;
    PG8_STAGE(PG8_SB(0, 0), cB, voffB); PG8_STAGE(PG8_SB(0, 1), cB + hstepB, voffB); PG8_STAGE(PG8_SA(0, 0), cA, voffA); PG8_STAGE(PG8_SA(0, 1), cA + hstepA, voffA);
    if (wr == 1) PG8_BAR;
    PG8_WAIT_V(2); PG8_BAR;
    PG8_STAGE(PG8_SB(1, 0), cB + kstep, voffB); PG8_STAGE(PG8_SA(1, 0), cA + kstep, voffA); PG8_STAGE(PG8_SB(1, 1), cB + hstepB + kstep, voffB);
    PG8_WAIT_V(6); PG8_BAR;
    for (;;) {
        const bool has_next = S.next(ui + 1, nxt);
        const char* nA = has_next ? (const char*)g.A + (ptrdiff_t)((size_t)nxt.kz * g.azs * 2) + ((ptrdiff_t)nxt.pm * g.prs + g.pr0) * (ptrdiff_t)g.lda * 2 : cA;
        const char* nB = has_next ? (const char*)g.Bt + (size_t)nxt.kz * g.bzs * 2 + (size_t)nxt.pn * tstepB : cB;
        for (int t = 0; t < nt; t += 2) {
            const bool last = (t == nt - 2);
            const char* a1 = cA + (size_t)(t + 1) * kstep;
            const char* a2 = last ? nA : cA + (size_t)(t + 2) * kstep; const char* b2 = last ? nB : cB + (size_t)(t + 2) * kstep;
            const char* a3 = a2 + kstep; const char* b3 = b2 + kstep;
            PG8_LDB(B0, 0, 0); PG8_LDB(B1, 0, 1); PG8_SCHED; PG8_LDA(At, 0, 0); PG8_STAGE(PG8_SA(1, 1), a1 + hstepA, voffA);
            PG8_WAIT_V(8); PG8_WAIT_L(0); PG8_BAR; PG8_MMA(0, 0, At, B0); PG8_MMA(0, 1, At, B1); PG8_BAR; PG8_SCHED;
            PG8_LDA(At, 0, 1); PG8_STAGE(PG8_SB(0, 0), b2, voffB); PG8_STAGE(PG8_SB(0, 1), b2 + hstepB, voffB); PG8_STAGE(PG8_SA(0, 0), a2, voffA);
            PG8_WAIT_V(8); PG8_WAIT_L(0); PG8_BAR; PG8_MMA(1, 0, At, B0); PG8_MMA(1, 1, At, B1); PG8_BAR; PG8_SCHED;
            PG8_LDB(B0, 1, 0); PG8_LDB(B1, 1, 1); PG8_SCHED; PG8_LDA(At, 1, 0); PG8_STAGE(PG8_SA(0, 1), a2 + hstepA, voffA);
            PG8_WAIT_V(8); PG8_WAIT_L(0); PG8_BAR; PG8_MMA(0, 0, At, B0); PG8_MMA(0, 1, At, B1); PG8_BAR; PG8_SCHED;
            PG8_LDA(At, 1, 1); PG8_STAGE(PG8_SB(1, 0), b3, voffB); PG8_STAGE(PG8_SB(1, 1), b3 + hstepB, voffB); PG8_STAGE(PG8_SA(1, 0), a3, voffA);
            PG8_WAIT_V(8); PG8_WAIT_L(0); PG8_BAR; PG8_MMA(1, 0, At, B0); PG8_MMA(1, 1, At, B1); PG8_BAR; PG8_SCHED;
        }
        if constexpr (ALIGN_EPI) { if (wr == 0) PG8_BAR; }
        E(acc, cur, wr, wc, fr, fq);
        if (!has_next) break;
        if (!E.keep(cur)) {
#pragma unroll
            for (int a = 0; a < 2; ++a)
#pragma unroll
                for (int b = 0; b < 2; ++b)
#pragma unroll
                    for (int m = 0; m < 4; ++m)
#pragma unroll
                        for (int n = 0; n < 2; ++n) acc[a][b][m][n] = (f32x4){0.f, 0.f, 0.f, 0.f};
        }
        cur = nxt; cA = nA; cB = nB; ++ui;
        if constexpr (ALIGN_EPI) { if (wr == 1) PG8_BAR; }
    }
    PG8_WAIT_V(0);
    if constexpr (!ALIGN_EPI) { if (wr == 0) PG8_BAR; }
    PG8_BAR;
#undef PG8_SA
#undef PG8_SB
#undef PG8_STAGE
#undef PG8_LDA
#undef PG8_LDB
#undef PG8_MMA
#undef PG8_WAIT_V
#undef PG8_WAIT_L
#undef PG8_BAR
#undef PG8_SCHED
}
}

constexpr int NWAVES = 8, NTHR = 512;
constexpr int DM = 2048, NBATCH = 4, SEQ = 2048, MP = NBATCH * SEQ, MS = 128, MR = MP + MS, M = 8448;
constexpr int NLAYER = 2;
constexpr int NIN = 12816, NP = 13056, NG = 8192, N1 = NP + NG;
constexpr int DFF = 5632, NUV = 2 * DFF;
constexpr int BW = 1024;
constexpr float EPS = 1e-6f;
constexpr int C_XA = 0, C_YA = 1024, C_HQ = 2048, C_HF = 3072, C_HI = 4096, C_HGG = 5120, C_SZ = 6144, C_SX = 7168, C_SDT = 8704, C_RQ = 8960, C_RK = 9984, C_RV = 11008, C_RG = 12032;
constexpr int SRC_SPLIT = 8720;
constexpr int SSD_CD = 1536;

enum { I_XP = 0, I_XS, I_SLH, I_SLC, I_SHG, I_SSSD, I_SSC, I_SRET, I_SFC, I_GMIX, I_GFFN, I_WIN, I_LCW, I_LCB, I_LWA, I_LBA, I_LWX, I_LBX, I_LLAM, I_HGLB, I_HGNW,
       I_SCW, I_SCB, I_SDTB, I_SALOG, I_SD, I_SNW, I_WBR, I_WGATE, I_WOUT, I_WUP, I_WVAL, I_FCW, I_FCB, I_WDOWN, I_GFIN, N_INPUTS };

constexpr size_t O_YP = 0, O_YS = O_YP + (size_t)MP * DM, O_LH_P = O_YS + (size_t)MS * DM, O_LH_S = O_LH_P + 2 * 4 * 1024, O_LC_P = O_LH_S + 2 * 128 * 1024,
    O_LC_S = O_LC_P + 2 * 4 * 3 * 1024, O_HG_P = O_LC_S + 2 * 128 * 3 * 1024, O_HG_S = O_HG_P + (size_t)2 * 4 * 8 * 16384, O_SSD_P = O_HG_S + (size_t)2 * 128 * 8 * 16384,
    O_SSD_S = O_SSD_P + (size_t)2 * 4 * 16 * 8192, O_SC_P = O_SSD_S + (size_t)2 * 128 * 16 * 8192, O_SC_S = O_SC_P + 2 * 4 * 3 * 1536, O_RET_P = O_SC_S + 2 * 128 * 3 * 1536,
    O_RET_S = O_RET_P + (size_t)2 * 4 * 8 * 16384, O_FC_P = O_RET_S + (size_t)2 * 128 * 8 * 16384, O_FC_S = O_FC_P + 2 * 4 * 2 * 5632, O_END = O_FC_S + (size_t)2 * 128 * 2 * 5632;
static_assert(O_END == 126119936ull, "output size");

constexpr size_t AL(size_t x) { return (x + 4095) & ~(size_t)4095; }
constexpr size_t WS_CTL = 0, CTL_BYTES = 1u << 20;
constexpr size_t WS_RSS = 65536, SZ_RSS = (size_t)M * 8;
constexpr float RSS_SCALE = 65536.f, RSS_INV = 1.f / (65536.f * 2048.f);
static_assert(WS_RSS + 5 * SZ_RSS <= CTL_BYTES, "rss buffers inside the zeroed control region");
constexpr size_t SZ_W1 = (size_t)N1 * DM * 2, SZ_WB = (size_t)4 * DM * BW * 2, SZ_WO = (size_t)DM * DM * 2, SZ_WUV = (size_t)NUV * DM * 2, SZ_WD = (size_t)DM * DFF * 2;
constexpr size_t WS_W1 = CTL_BYTES, WS_WB = WS_W1 + 2 * SZ_W1, WS_WO = WS_WB + 2 * SZ_WB, WS_WUV = WS_WO + 2 * SZ_WO, WS_WD = WS_WUV + 2 * SZ_WUV;
constexpr size_t WS_ROPE = WS_WD + 2 * SZ_WD, SZ_ROPE = AL((size_t)2049 * 64 * 8);
constexpr size_t SZ_X = (size_t)M * DM * 4;
constexpr size_t WS_X0 = WS_ROPE + SZ_ROPE, WS_X1 = WS_X0 + SZ_X;
constexpr size_t WS_H = WS_X1 + SZ_X, SZ_H = (size_t)M * DM * 2;
constexpr size_t WS_XB0 = WS_X0, WS_XB1 = WS_X0 + SZ_H;
constexpr size_t WS_P = WS_H + SZ_H, SZ_P = (size_t)M * NP * 2;
constexpr size_t WS_G = WS_P + SZ_P, SZ_G = (size_t)M * NG * 2;
constexpr size_t WS_HF = WS_G + SZ_G, SZ_HF = (size_t)M * 1024 * 4;
constexpr size_t WS_DT = WS_HF + SZ_HF, SZ_DT = AL((size_t)M * 16 * 4);
constexpr size_t WS_OB = WS_DT + SZ_DT, SZ_O = (size_t)M * 1024 * 4;
constexpr size_t WS_BR = WS_OB + 3 * SZ_O, SZ_BR = (size_t)4 * M * BW * 2;
constexpr size_t WS_MG = WS_BR + SZ_BR, SZ_MG = (size_t)M * DM * 2;
constexpr size_t WS_XBC = WS_MG + SZ_MG, SZ_XBC = (size_t)M * SSD_CD * 2;
constexpr size_t WS_LB = WS_XBC + SZ_XBC, SZ_LB = AL((size_t)NLAYER * 1024 * 4);
constexpr size_t WS_END = WS_LB + SZ_LB;
static_assert((size_t)M * NUV * 2 <= SZ_P && (size_t)M * DFF * 2 <= SZ_G && 2 * SZ_O <= SZ_X, "overlays");

constexpr int RING_BYTES = 131072, LDSCTL_OFF = RING_BYTES, LDS_BYTES = 147456;

#define GAS __attribute__((address_space(1)))
#define LAS __attribute__((address_space(3)))
typedef unsigned short bf16;
typedef unsigned v4u __attribute__((ext_vector_type(4)));
typedef unsigned v2u __attribute__((ext_vector_type(2)));
typedef float f32x4 __attribute__((ext_vector_type(4)));
typedef float f32x2 __attribute__((ext_vector_type(2)));
typedef short bf16x8 __attribute__((ext_vector_type(8)));
#define LDS_WAIT() asm volatile("s_waitcnt lgkmcnt(0)" ::: "memory")
__device__ __forceinline__ unsigned f2bf(float f) { unsigned u = __builtin_bit_cast(unsigned, f); return (u + 0x7fffu + ((u >> 16) & 1u)) >> 16; }
__device__ __forceinline__ unsigned pk2(float lo, float hi) { return pg8::cvt_pk_bf16(lo, hi); }
__device__ __forceinline__ float bf2f(unsigned short b) { return __uint_as_float(((unsigned)b) << 16); }
__device__ __forceinline__ float bflo(unsigned w) { return __uint_as_float(w << 16); }
__device__ __forceinline__ float bfhi(unsigned w) { return __uint_as_float(w & 0xffff0000u); }
__device__ __forceinline__ float sigm(float x) { return __builtin_amdgcn_rcpf(1.f + __builtin_amdgcn_exp2f(-1.4426950408889634f * x)); }
__device__ __forceinline__ float siluf(float x) { return x * sigm(x); }
__device__ __forceinline__ float geluf(float x) { return x * sigm(1.5957691216057308f * (x + 0.044715f * x * x * x)); }
__device__ __forceinline__ float softplusf(float x) { const float t = __builtin_amdgcn_exp2f(-1.4426950408889634f * fabsf(x));
    const float l1p = t < 0.03f ? t * (1.f - t * (0.5f - t * 0.33333334f)) : 0.6931471805599453f * __builtin_amdgcn_logf(1.f + t); return fmaxf(x, 0.f) + l1p; }

typedef unsigned long long u64;
__device__ __forceinline__ float rstd_of(const u64* rss, size_t row) { return __builtin_amdgcn_rsqf((float)rss[row] * RSS_INV + EPS); }
__device__ __forceinline__ void rss_add(u64* rss, size_t row, float ss) { (void)__hip_atomic_fetch_add(rss + row, (u64)(ss * RSS_SCALE + 0.5f), __ATOMIC_RELAXED, __HIP_MEMORY_SCOPE_AGENT); }

#define XB_TMO      128
#define XB_XCNT(j)  (256  + 64 * (j))
#define XB_XSUB(j)  (1280 + 64 * (j))
#define XB_XGEN(j)  (2304 + 64 * (j))
#define XB_TOP      3328
#define XB_TOPGEN   3392
#define XCD_BAR_WORDS 3456
#define XB_SPIN_CAP (1u << 19)
__device__ __forceinline__ unsigned xb_ld(unsigned* p)              { return __hip_atomic_load(p, __ATOMIC_RELAXED, __HIP_MEMORY_SCOPE_AGENT); }
__device__ __forceinline__ unsigned xb_add(unsigned* p, unsigned v) { return __hip_atomic_fetch_add(p, v, __ATOMIC_RELAXED, __HIP_MEMORY_SCOPE_AGENT); }
__device__ __forceinline__ unsigned xb_xcc_id() { return (unsigned)__builtin_amdgcn_s_getreg((3 << 11) | 20) & 0xFu; }
#define XB_SPIN(cond, bar) do { unsigned _sp = 0; while (cond) { __builtin_amdgcn_s_sleep(16); \
    if ((++_sp & 255u) == 0u) { if (xb_ld(&(bar)[XB_TMO])) break; if (_sp > XB_SPIN_CAP) { atomicAdd(&(bar)[XB_TMO], 1u); break; } } } } while (0)
struct XcdBarrier { unsigned* bar; unsigned x; volatile LAS unsigned* st; };
__device__ __forceinline__ XcdBarrier xcd_barrier_post(unsigned* bar, volatile LAS unsigned* st) {
    XcdBarrier b; b.bar = bar; b.x = xb_xcc_id(); b.st = st;
    if (threadIdx.x == 0) (void)xb_add(&bar[XB_XCNT(b.x)], 1u);
    return b;
}
__device__ __forceinline__ void xcd_barrier_complete(unsigned* bar, unsigned x, unsigned& nloc, unsigned& nx) {
    const unsigned G = gridDim.x * gridDim.y * gridDim.z;
    unsigned sum, cnt, mine, sp = 0u;
    for (;;) {
        sum = 0u; cnt = 0u; mine = 0u;
#pragma unroll
        for (unsigned j = 0; j < 16; ++j) { const unsigned c = xb_ld(&bar[XB_XCNT(j)]); sum += c; cnt += (c > 0u) ? 1u : 0u; mine = (j == x) ? c : mine; }
        if (sum == G) break;
        __builtin_amdgcn_s_sleep(1);
        if ((++sp & 255u) == 0u) { if (xb_ld(&bar[XB_TMO])) break; if (sp > XB_SPIN_CAP) { atomicAdd(&bar[XB_TMO], 1u); break; } }
    }
    nloc = mine > 0u ? mine : 1u; nx = cnt > 0u ? cnt : 1u;
}
__device__ __forceinline__ void xcd_barrier(const XcdBarrier& b) {
    asm volatile("s_waitcnt vmcnt(0)" ::: "memory");
    __syncthreads();
    if (threadIdx.x == 0) {
        unsigned* bar = b.bar;
        __builtin_amdgcn_s_waitcnt(0);
        unsigned nloc = b.st[0], nx = b.st[1];
        if (nloc == 0u) { xcd_barrier_complete(bar, b.x, nloc, nx); b.st[0] = nloc; b.st[1] = nx; }
        const unsigned old = xb_add(&bar[XB_XSUB(b.x)], 1u);
        const unsigned gen = old / nloc;
        if (old + 1u == (gen + 1u) * nloc) {
            __builtin_amdgcn_fence(__ATOMIC_RELEASE, "agent");
            asm volatile("s_waitcnt vmcnt(0)" ::: "memory");
            const unsigned og = xb_add(&bar[XB_TOP], 1u);
            const unsigned tg = og / nx;
            if (og + 1u == (tg + 1u) * nx) xb_add(&bar[XB_TOPGEN], 1u);
            else XB_SPIN(xb_ld(&bar[XB_TOPGEN]) == tg, bar);
            __builtin_amdgcn_fence(__ATOMIC_ACQUIRE, "agent");
            xb_add(&bar[XB_XGEN(b.x)], 1u);
            asm volatile("s_waitcnt vmcnt(0)" ::: "memory");
        } else {
            XB_SPIN(xb_ld(&bar[XB_XGEN(b.x)]) == gen, bar);
            __builtin_amdgcn_fence(__ATOMIC_ACQUIRE, "agent");
            asm volatile("s_waitcnt vmcnt(0)" ::: "memory");
        }
    }
    __syncthreads();
}

struct Args { const float* in[N_INPUTS]; float* out; unsigned char* ws; int ph_lo, ph_hi; };

struct Frame {
    LAS unsigned char* lds;
    int tid, lane, wave, G, c;
    const float* const* in;
    float* out;
    unsigned char* ws;
};
#define WSP(T, off) ((T*)(F.ws + (off)))
__device__ __forceinline__ Frame launder(const Frame& F0) {
    Frame F = F0;
    asm volatile("" : "+v"(F.tid), "+v"(F.lane));
    asm volatile("" : "+s"(F.wave), "+s"(F.G), "+s"(F.c));
    { int z = 0; asm volatile("" : "+s"(z)); F.in += z; F.out += z; F.ws += z; }
    asm volatile("" : "+s"(F.lds));
    return F;
}

using pg8::f32x4;
using pg8::Unit;
using pg8::cvt_pk_bf16;

struct Epi1 {
    static constexpr bool PERM = true;
    bf16* P; float* HF; float* DT; bf16* Gt; const float* LB; const u64* RSS;
    __device__ __forceinline__ bool keep(const Unit&) const { return false; }
    template <int ACT> __device__ __forceinline__ void store_act(f32x4 (&acc)[2][2][4][2], bf16* base, int ld, int row0, int colb) const {
#pragma unroll
        for (int ai = 0; ai < 2; ++ai) { float rs4[4];
#pragma unroll
            for (int m = 0; m < 4; ++m) rs4[m] = rstd_of(RSS, row0 + ai * 128 + m * 16);
#pragma unroll
            for (int m = 0; m < 4; ++m) { bf16* rowp = base + (size_t)(row0 + ai * 128 + m * 16) * ld + colb; const float rs = rs4[m];
#pragma unroll
                for (int bj = 0; bj < 2; ++bj) { f32x4 v0 = acc[ai][bj][m][0] * rs, v1 = acc[ai][bj][m][1] * rs;
#pragma unroll
                    for (int j = 0; j < 4; ++j) { if (ACT == 1) { v0[j] = geluf(v0[j]); v1[j] = geluf(v1[j]); } if (ACT == 2) { v0[j] = siluf(v0[j]); v1[j] = siluf(v1[j]); } if (ACT == 3) { v0[j] = sigm(v0[j]); v1[j] = sigm(v1[j]); } }
                    pg8::u32x4 w; w.x = cvt_pk_bf16(v0[0], v0[1]); w.y = cvt_pk_bf16(v0[2], v0[3]); w.z = cvt_pk_bf16(v1[0], v1[1]); w.w = cvt_pk_bf16(v1[2], v1[3]);
                    *(pg8::u32x4*)(rowp + bj * 128) = w; }
                asm volatile("" ::: "memory"); } }
    }
    __device__ __forceinline__ void operator()(f32x4 (&acc)[2][2][4][2], const Unit& u, int wr, int wc, int fr, int fq) const {
        asm volatile("" : "+v"(fr), "+v"(fq));
        const int row0 = u.pm * 256 + wr * 64 + fr, pn = u.pn;
        if (pn >= 51) { store_act<3>(acc, Gt, NG, row0, (pn - 51) * 256 + wc * 32 + 8 * fq); }
        else if (pn >= 12 && pn < 16) {
            const int colb = (pn - 12) * 256 + wc * 32 + 8 * fq;
#pragma unroll
            for (int bj = 0; bj < 2; ++bj) { const f32x4 l0 = *(const f32x4*)(LB + colb + bj * 128), l1 = *(const f32x4*)(LB + colb + bj * 128 + 4);
#pragma unroll
                for (int ai = 0; ai < 2; ++ai) { float rs4[4];
#pragma unroll
                    for (int m = 0; m < 4; ++m) rs4[m] = rstd_of(RSS, row0 + ai * 128 + m * 16);
#pragma unroll
                    for (int m = 0; m < 4; ++m) { const size_t r = (size_t)(row0 + ai * 128 + m * 16); const float rs = rs4[m];
                        f32x4 v0 = acc[ai][bj][m][0] * rs, v1 = acc[ai][bj][m][1] * rs, g0, g1, k0, k1;
#pragma unroll
                        for (int j = 0; j < 4; ++j) { { const float e = __builtin_amdgcn_exp2f(-1.4426950408889634f * fabsf(v0[j])), r = __builtin_amdgcn_rcpf(1.f + e), sm = e * r, sg = v0[j] >= 0.f ? r : sm, sn = v0[j] >= 0.f ? sm : r; g0[j] = 0.6931471805599453f * __builtin_amdgcn_logf(l0[j] + (1.f - l0[j]) * sg); k0[j] = (1.f - l0[j]) * sn; }
                                                      { const float e = __builtin_amdgcn_exp2f(-1.4426950408889634f * fabsf(v1[j])), r = __builtin_amdgcn_rcpf(1.f + e), sm = e * r, sg = v1[j] >= 0.f ? r : sm, sn = v1[j] >= 0.f ? sm : r; g1[j] = 0.6931471805599453f * __builtin_amdgcn_logf(l1[j] + (1.f - l1[j]) * sg); k1[j] = (1.f - l1[j]) * sn; } }
                        *(f32x4*)(HF + r * 1024 + colb + bj * 128) = g0; *(f32x4*)(HF + r * 1024 + colb + bj * 128 + 4) = g1;
                        pg8::u32x4 w; w.x = cvt_pk_bf16(k0[0], k0[1]); w.y = cvt_pk_bf16(k0[2], k0[3]); w.z = cvt_pk_bf16(k1[0], k1[1]); w.w = cvt_pk_bf16(k1[2], k1[3]);
                        *(pg8::u32x4*)(P + r * NP + C_HF + colb + bj * 128) = w; asm volatile("" ::: "memory"); } } }
        } else if (pn == 34) {
            if (wc == 0 && fq < 2) {
#pragma unroll
                for (int ai = 0; ai < 2; ++ai)
#pragma unroll
                    for (int m = 0; m < 4; ++m) { float* rowp = DT + (size_t)(row0 + ai * 128 + m * 16) * 16 + 8 * fq; const float rs = rstd_of(RSS, row0 + ai * 128 + m * 16);
                        *(f32x4*)(rowp) = acc[ai][0][m][0] * rs; *(f32x4*)(rowp + 4) = acc[ai][0][m][1] * rs; }
            }
        } else {
            const int colb = pn * 256 + wc * 32 + 8 * fq;
            if (pn >= 4 && pn < 8) store_act<1>(acc, P, NP, row0, colb);
            else if ((pn >= 8 && pn < 12) || (pn >= 20 && pn < 28) || pn >= 47) store_act<2>(acc, P, NP, row0, colb);
            else store_act<0>(acc, P, NP, row0, colb);
        }
    }
};

struct SameTile { int n; __device__ bool next(int i, Unit& u) const { if (i >= n) return false; u.pm = 0; u.pn = 0; u.kz = 0; return true; } };
template <bool P_> struct EpiNull {
    static constexpr bool PERM = P_;
    float* sinkp;
    __device__ __forceinline__ bool keep(const Unit&) const { return false; }
    __device__ __forceinline__ void operator()(f32x4 (&acc)[2][2][4][2], const Unit& u, int wr, int wc, int fr, int fq) const {
        float t = 0.f;
#pragma unroll
        for (int ai = 0; ai < 2; ++ai)
#pragma unroll
            for (int bj = 0; bj < 2; ++bj)
#pragma unroll
                for (int m = 0; m < 4; ++m) t += acc[ai][bj][m][0][0] + acc[ai][bj][m][1][3];
        if (t == 1.2345e30f) sinkp[0] = t;
    }
};

struct EpiB {
    static constexpr bool PERM = true;
    bf16* O; int ldc; const u64* RSS;
    __device__ __forceinline__ bool keep(const Unit&) const { return false; }
    __device__ __forceinline__ void operator()(f32x4 (&acc)[2][2][4][2], const Unit& u, int wr, int wc, int fr, int fq) const {
        asm volatile("" : "+v"(fr), "+v"(fq));
        const int row0 = u.pm * 256 + wr * 64 + fr, colb = u.pn * 256 + wc * 32 + 8 * fq;
#pragma unroll
        for (int ai = 0; ai < 2; ++ai)
#pragma unroll
            for (int m = 0; m < 4; ++m) { bf16* rowp = O + (size_t)(row0 + ai * 128 + m * 16) * ldc + colb; const float rs = rstd_of(RSS, row0 + ai * 128 + m * 16);
#pragma unroll
                for (int bj = 0; bj < 2; ++bj) { const f32x4 v0 = acc[ai][bj][m][0] * rs, v1 = acc[ai][bj][m][1] * rs; pg8::u32x4 w;
                    w.x = cvt_pk_bf16(v0[0], v0[1]); w.y = cvt_pk_bf16(v0[2], v0[3]); w.z = cvt_pk_bf16(v1[0], v1[1]); w.w = cvt_pk_bf16(v1[2], v1[3]);
                    *(pg8::u32x4*)(rowp + bj * 128) = w; } }
    }
};

struct EpiBr {
    static constexpr bool PERM = true;
    const bf16* Gt; bf16* O;
    __device__ __forceinline__ bool keep(const Unit& u) const { return u.kz < 3; }
    __device__ __forceinline__ void operator()(f32x4 (&acc)[2][2][4][2], const Unit& u, int wr, int wc, int fr, int fq) const {
        asm volatile("" : "+v"(fr), "+v"(fq));
        const int row0 = u.pm * 256 + wr * 64 + fr, colb = u.pn * 256 + wc * 32 + 8 * fq, kz = u.kz;
#pragma unroll
        for (int ai = 0; ai < 2; ++ai) {
                pg8::u32x4 gav[4][2], gbv[4][2];
#pragma unroll
                for (int mm = 0; mm < 4; ++mm)
#pragma unroll
                    for (int bj = 0; bj < 2; ++bj) { const size_t r = (size_t)(row0 + ai * 128 + mm * 16);
                        gav[mm][bj] = *(const pg8::u32x4*)(Gt + r * NG + kz * 2048 + colb + bj * 128);
                        gbv[mm][bj] = *(const pg8::u32x4*)(Gt + r * NG + (kz < 3 ? kz + 1 : kz) * 2048 + colb + bj * 128); }
#pragma unroll
                for (int mm = 0; mm < 4; ++mm) { const int m = mm; const size_t r = (size_t)(row0 + ai * 128 + m * 16);
#pragma unroll
                    for (int bj = 0; bj < 2; ++bj) {
                        const pg8::u32x4 ga = gav[mm][bj], gb = gbv[mm][bj];
                        float s[8] = {bflo(ga.x), bfhi(ga.x), bflo(ga.y), bfhi(ga.y), bflo(ga.z), bfhi(ga.z), bflo(ga.w), bfhi(ga.w)};
                        if (kz < 3) {
                            const float d[8] = {bflo(gb.x), bfhi(gb.x), bflo(gb.y), bfhi(gb.y), bflo(gb.z), bfhi(gb.z), bflo(gb.w), bfhi(gb.w)};
#pragma unroll
                            for (int j = 0; j < 8; ++j) s[j] = s[j] * __builtin_amdgcn_rcpf(fmaxf(d[j], 1e-20f));
                        }
                        f32x4 v0 = acc[ai][bj][m][0], v1 = acc[ai][bj][m][1];
                        v0[0] *= s[0]; v0[1] *= s[1]; v0[2] *= s[2]; v0[3] *= s[3]; v1[0] *= s[4]; v1[1] *= s[5]; v1[2] *= s[6]; v1[3] *= s[7];
                        acc[ai][bj][m][0] = v0; acc[ai][bj][m][1] = v1;
                        if (kz == 3) { pg8::u32x4 w; w.x = cvt_pk_bf16(v0[0], v0[1]); w.y = cvt_pk_bf16(v0[2], v0[3]); w.z = cvt_pk_bf16(v1[0], v1[1]); w.w = cvt_pk_bf16(v1[2], v1[3]);
                            *(pg8::u32x4*)(O + r * DM + colb + bj * 128) = w; }
                    } }
                asm volatile("" ::: "memory"); }
    }
};

struct EpiRes {
    static constexpr bool PERM = true;
    const bf16* Xc; bf16* Xn; u64* RSS;
    __device__ __forceinline__ bool keep(const Unit&) const { return false; }
    __device__ __forceinline__ void operator()(f32x4 (&acc)[2][2][4][2], const Unit& u, int wr, int wc, int fr, int fq) const {
        asm volatile("" : "+v"(fr), "+v"(fq));
        const int row0 = u.pm * 256 + wr * 64 + fr, col0 = u.pn * 256 + wc * 32 + 8 * fq;
#pragma unroll
        for (int ap = 0; ap < 4; ++ap) { const int ai = ap >> 1, mb = (ap & 1) * 2;
            pg8::u32x4 xw[2][2];
#pragma unroll
            for (int mm = 0; mm < 2; ++mm)
#pragma unroll
                for (int bj = 0; bj < 2; ++bj) xw[mm][bj] = *(const pg8::u32x4*)(Xc + (size_t)(row0 + ai * 128 + (mb + mm) * 16) * DM + col0 + bj * 128);
#pragma unroll
            for (int mm = 0; mm < 2; ++mm) { const int m = mb + mm; const size_t row = (size_t)(row0 + ai * 128 + m * 16), off = row * DM + col0; float ss = 0.f;
#pragma unroll
                for (int bj = 0; bj < 2; ++bj) { const pg8::u32x4 w_ = xw[mm][bj];
                    const f32x4 x0 = (f32x4){bflo(w_.x), bfhi(w_.x), bflo(w_.y), bfhi(w_.y)} + acc[ai][bj][m][0], x1 = (f32x4){bflo(w_.z), bfhi(w_.z), bflo(w_.w), bfhi(w_.w)} + acc[ai][bj][m][1];
                    pg8::u32x4 w; w.x = cvt_pk_bf16(x0[0], x0[1]); w.y = cvt_pk_bf16(x0[2], x0[3]); w.z = cvt_pk_bf16(x1[0], x1[1]); w.w = cvt_pk_bf16(x1[2], x1[3]);
                    *(pg8::u32x4*)(Xn + off + bj * 128) = w;
                    ss += (x0[0] * x0[0] + x0[1] * x0[1]) + (x0[2] * x0[2] + x0[3] * x0[3]) + (x1[0] * x1[0] + x1[1] * x1[1]) + (x1[2] * x1[2] + x1[3] * x1[3]); }
                ss += __shfl_xor(ss, 16); ss += __shfl_xor(ss, 32);
                if (fq == 0) rss_add(RSS, row, ss); }
            asm volatile("" ::: "memory"); }
    }
};

constexpr int XB_OFF = LDSCTL_OFF + 1024;
__device__ __forceinline__ float dpp_ror1(float x) { return __builtin_bit_cast(float, __builtin_amdgcn_update_dpp(0, __builtin_bit_cast(int, x), 0x121, 0xf, 0xf, false)); }
__device__ __forceinline__ float dpp_ror2(float x) { return __builtin_bit_cast(float, __builtin_amdgcn_update_dpp(0, __builtin_bit_cast(int, x), 0x122, 0xf, 0xf, false)); }
struct EpiAct {
    static constexpr bool PERM = true;
    bf16* A2; const u64* RSS; const float* cw; const float* cb; const float* st_in; float* fc_p; float* fc_s; LAS unsigned char* lds;
    __device__ __forceinline__ bool keep(const Unit&) const { return false; }
    __device__ __forceinline__ void operator()(f32x4 (&acc)[2][2][4][2], const Unit& u, int wr, int wc, int fr, int fq) const {
        asm volatile("" : "+v"(fr), "+v"(fq));
        const int R0 = 254 * u.pm - 2, chb = u.pn * 128 + wc * 32 + 8 * fq, wid = wr * 4 + wc;
#pragma unroll
        for (int ai = 0; ai < 2; ++ai)
#pragma unroll
            for (int m = 0; m < 4; ++m) { int R = R0 + 128 * ai + 64 * wr + 16 * m + fr; R = R < 0 ? 0 : (R >= M ? M - 1 : R); const float rs = rstd_of(RSS, R);
                acc[ai][0][m][0] *= rs; acc[ai][0][m][1] *= rs; acc[ai][1][m][0] *= rs; acc[ai][1][m][1] *= rs; }
        LAS f32x4* XB = (LAS f32x4*)(lds + XB_OFF);
        if (fr >= 14) {
#pragma unroll
            for (int ai = 0; ai < 2; ++ai) { const int slot = (((wid * 2 + ai) * 2 + (fr - 14)) * 4 + fq) * 2; XB[slot] = acc[ai][0][3][0]; XB[slot + 1] = acc[ai][0][3][1]; }
        }
        asm volatile("s_waitcnt lgkmcnt(0)" ::: "memory"); __builtin_amdgcn_s_barrier(); asm volatile("" ::: "memory");
        f32x4 w0a = *(const f32x4*)(cw + chb), w0b = *(const f32x4*)(cw + chb + 4), w1a = *(const f32x4*)(cw + DFF + chb), w1b = *(const f32x4*)(cw + DFF + chb + 4);
        f32x4 w2a = *(const f32x4*)(cw + 2 * DFF + chb), w2b = *(const f32x4*)(cw + 2 * DFF + chb + 4), ba = *(const f32x4*)(cb + chb), bb = *(const f32x4*)(cb + chb + 4);
#pragma unroll
        for (int ai = 0; ai < 2; ++ai) {
            f32x4 pva = (f32x4){0.f, 0.f, 0.f, 0.f}, pvb = pva;
            { const int kblk = 2 * ai + wr; if (kblk > 0 && fr >= 14) { const int pai = (kblk - 1) >> 1, pwr = (kblk - 1) & 1, slot = ((((pwr * 4 + wc) * 2 + pai) * 2 + (fr - 14)) * 4 + fq) * 2; pva = XB[slot]; pvb = XB[slot + 1]; } }
#pragma unroll
            for (int m = 0; m < 4; ++m) {
                const f32x4 ua = acc[ai][0][m][0], ub = acc[ai][0][m][1], va = acc[ai][1][m][0], vb = acc[ai][1][m][1];
                const f32x4 qa = (m == 0) ? pva : acc[ai][0][m - 1][0], qb = (m == 0) ? pvb : acc[ai][0][m - 1][1];
                f32x4 p1a, p1b, p2a, p2b;
#pragma unroll
                for (int i = 0; i < 4; ++i) { const float c1a = dpp_ror1(ua[i]), c1b = dpp_ror1(ub[i]), c2a = dpp_ror2(ua[i]), c2b = dpp_ror2(ub[i]);
                    const float d1a = dpp_ror1(qa[i]), d1b = dpp_ror1(qb[i]), d2a = dpp_ror2(qa[i]), d2b = dpp_ror2(qb[i]);
                    p1a[i] = fr >= 1 ? c1a : d1a; p1b[i] = fr >= 1 ? c1b : d1b; p2a[i] = fr >= 2 ? c2a : d2a; p2b[i] = fr >= 2 ? c2b : d2b; }
                const int r = 128 * ai + 64 * wr + 16 * m + fr, R = R0 + r;
                const bool prompt = (r >= 2) && (R >= 0) && (R < MP), samp = (R >= MP) && (R < MR);
                if (prompt) { const int t = R & (SEQ - 1);
                    if (t < 1) { p1a = (f32x4){0.f, 0.f, 0.f, 0.f}; p1b = p1a; } if (t < 2) { p2a = (f32x4){0.f, 0.f, 0.f, 0.f}; p2b = p2a; }
                    if (t >= SEQ - 2) { float* so = fc_p + ((size_t)(R >> 11) * 2 + (t - (SEQ - 2))) * DFF + chb; *(f32x4*)so = ua; *(f32x4*)(so + 4) = ub; } }
                if (samp) { const float* sp = st_in + (size_t)(R - MP) * 2 * DFF + chb; float* so = fc_s + (size_t)(R - MP) * 2 * DFF + chb;
                    p2a = *(const f32x4*)sp; p2b = *(const f32x4*)(sp + 4); p1a = *(const f32x4*)(sp + DFF); p1b = *(const f32x4*)(sp + DFF + 4);
                    *(f32x4*)so = p1a; *(f32x4*)(so + 4) = p1b; *(f32x4*)(so + DFF) = ua; *(f32x4*)(so + DFF + 4) = ub; }
                if (prompt || samp) {
                    const f32x4 ya = ba + w0a * p2a + w1a * p1a + w2a * ua, yb = bb + w0b * p2b + w1b * p1b + w2b * ub;
                    pg8::u32x4 w; w.x = cvt_pk_bf16(geluf(ya[0]) * va[0], geluf(ya[1]) * va[1]); w.y = cvt_pk_bf16(geluf(ya[2]) * va[2], geluf(ya[3]) * va[3]);
                    w.z = cvt_pk_bf16(geluf(yb[0]) * vb[0], geluf(yb[1]) * vb[1]); w.w = cvt_pk_bf16(geluf(yb[2]) * vb[2], geluf(yb[3]) * vb[3]);
                    *(pg8::u32x4*)(A2 + (size_t)R * DFF + chb) = w; }
                asm volatile("" ::: "memory");
            }
        }
    }
};

__device__ __forceinline__ float wave_sum(float v) {
#pragma unroll
    for (int o = 1; o < 64; o <<= 1) v += __shfl_xor(v, o);
    return v;
}
struct TrJob { const float* W; bf16* WT; const float* g; int K, N, ldt, mode, roff, item; };
template <bool NT> __device__ __forceinline__ void tr_load(const TrJob& j, int lane, float (&v)[32]) {
    const int nblk = (j.N + 31) >> 5, kb = j.item / nblk, nb = j.item - kb * nblk, k0 = 64 * kb, n0 = 32 * nb;
    int nn = n0 + (lane & 31); nn = nn < j.N ? nn : j.N - 1;
    const float* p = j.W + (size_t)(k0 + (lane >> 5)) * j.N + nn;
#pragma unroll
    for (int i = 0; i < 32; ++i) v[i] = NT ? __builtin_nontemporal_load(p + (size_t)(2 * i) * j.N) : p[(size_t)(2 * i) * j.N];
}
template <bool NT> __device__ __forceinline__ void tr_store(const TrJob& j, int lane, LAS float* scr, const float (&v)[32]) {
    const int nblk = (j.N + 31) >> 5, kb = j.item / nblk, nb = j.item - kb * nblk, k0 = 64 * kb, n0 = 32 * nb;
#pragma unroll
    for (int i = 0; i < 32; ++i) scr[(2 * i + (lane >> 5)) * 33 + (lane & 31)] = v[i];
    LDS_WAIT(); asm volatile("" ::: "memory");
    const int c = lane & 7;
    float gk[8];
#pragma unroll
    for (int q = 0; q < 8; ++q) gk[q] = j.g ? j.g[k0 + 8 * c + q] : 1.f;
#pragma unroll
    for (int jj = 0; jj < 4; ++jj) { const int n = (lane >> 3) + 8 * jj, gn = n0 + n; const LAS float* s = scr + (8 * c) * 33 + n;
        v4u o; o.x = pk2(s[0 * 33] * gk[0], s[1 * 33] * gk[1]); o.y = pk2(s[2 * 33] * gk[2], s[3 * 33] * gk[3]); o.z = pk2(s[4 * 33] * gk[4], s[5 * 33] * gk[5]); o.w = pk2(s[6 * 33] * gk[6], s[7 * 33] * gk[7]);
        if (gn < j.N) { const int dr = (j.mode == 1) ? (gn < SRC_SPLIT ? gn : gn + 240) : (j.mode >= 2 ? (gn >> 7) * 256 + (gn & 127) + (j.mode == 3 ? 128 : 0) : gn + j.roff); v4u* wp = (v4u*)(j.WT + (size_t)dr * j.ldt + k0 + 8 * c); if (NT) __builtin_nontemporal_store(o, wp); else *wp = o; } }
    LDS_WAIT(); asm volatile("" ::: "memory");
}
constexpr int I_IN = (DM / 64) * ((NIN + 31) / 32), I_GT = (DM / 64) * (NG / 32), I_BR = (BW / 64) * (DM / 32), I_OUT = (DM / 64) * (DM / 32), I_UP = (DM / 64) * (DFF / 32), I_DN = (DFF / 64) * (DM / 32);
constexpr int I_LAYER = I_IN + I_GT + 4 * I_BR + I_OUT + 2 * I_UP + I_DN;
__device__ __forceinline__ TrJob tr_decode(const Frame& F, int it) {
    const int l = it / I_LAYER; int r = it - l * I_LAYER; TrJob j;
    bf16* W1 = WSP(bf16, WS_W1 + l * SZ_W1);
    if (r < I_IN) { j = TrJob{F.in[I_WIN] + (size_t)l * DM * NIN, W1, F.in[I_GMIX] + (size_t)l * DM, DM, NIN, DM, 1, 0, r}; return j; } r -= I_IN;
    if (r < I_GT) { j = TrJob{F.in[I_WGATE] + (size_t)l * DM * NG, W1, F.in[I_GMIX] + (size_t)l * DM, DM, NG, DM, 0, NP, r}; return j; } r -= I_GT;
    if (r < 4 * I_BR) { const int k = r / I_BR; j = TrJob{F.in[I_WBR] + ((size_t)l * 4 + k) * BW * DM, WSP(bf16, WS_WB + l * SZ_WB) + (size_t)k * DM * BW, nullptr, BW, DM, BW, 0, 0, r - k * I_BR}; return j; } r -= 4 * I_BR;
    if (r < I_OUT) { j = TrJob{F.in[I_WOUT] + (size_t)l * DM * DM, WSP(bf16, WS_WO + l * SZ_WO), nullptr, DM, DM, DM, 0, 0, r}; return j; } r -= I_OUT;
    if (r < I_UP) { j = TrJob{F.in[I_WUP] + (size_t)l * DM * DFF, WSP(bf16, WS_WUV + l * SZ_WUV), F.in[I_GFFN] + (size_t)l * DM, DM, DFF, DM, 2, 0, r}; return j; } r -= I_UP;
    if (r < I_UP) { j = TrJob{F.in[I_WVAL] + (size_t)l * DM * DFF, WSP(bf16, WS_WUV + l * SZ_WUV), F.in[I_GFFN] + (size_t)l * DM, DM, DFF, DM, 3, 0, r}; return j; } r -= I_UP;
    j = TrJob{F.in[I_WDOWN] + (size_t)l * DFF * DM, WSP(bf16, WS_WD + l * SZ_WD), nullptr, DFF, DM, DFF, 0, 0, r}; return j;
}

template <bool NT> __device__ __forceinline__ void tr_run(const Frame& F0, int it_lo, int it_hi, int gw, int NGW) {
    Frame F = launder(F0);
    LAS float* scr = (LAS float*)(F.lds + F.wave * 8704);
    {
        const int NIT = it_hi;
        int it = it_lo + gw; TrJob j0, j1, j2; float r0[32], r1[32], r2[32];
        j0 = j1 = j2 = tr_decode(F, it < NIT ? it : it_lo);
        if (it < NIT) { tr_load<NT>(j0, F.lane, r0); }
        if (it + NGW < NIT) { j1 = tr_decode(F, it + NGW); tr_load<NT>(j1, F.lane, r1); }
        while (it < NIT) {
            if (it + 2 * NGW < NIT) { j2 = tr_decode(F, it + 2 * NGW); tr_load<NT>(j2, F.lane, r2); }
            tr_store<NT>(j0, F.lane, scr, r0);
            it += NGW; if (it >= NIT) break;
            if (it + 2 * NGW < NIT) { j0 = tr_decode(F, it + 2 * NGW); tr_load<NT>(j0, F.lane, r0); }
            tr_store<NT>(j1, F.lane, scr, r1);
            it += NGW; if (it >= NIT) break;
            if (it + 2 * NGW < NIT) { j1 = tr_decode(F, it + 2 * NGW); tr_load<NT>(j1, F.lane, r1); }
            tr_store<NT>(j2, F.lane, scr, r2);
            it += NGW;
        }
    }
}
constexpr int SIDE_A = 5000, SIDE_B = 5400, NIT_ALL = NLAYER * I_LAYER;
constexpr int S3 = NIT_ALL - I_DN, S2 = S3 - SIDE_A, S1 = S2 - SIDE_B, S0 = S1 - SIDE_A;
static_assert(S2 >= NIT_ALL - I_DN - I_UP, "GEMM1(1) side items must be needed after GEMM1(1) only (val weights)");
__device__ __forceinline__ void phase_prologue(const Frame& F0) {
    Frame F = launder(F0);
    const int gw = F.c * NWAVES + F.wave, NGW = F.G * NWAVES;
    tr_run<false>(F, 0, S0, gw, NGW);
    const int gt = F.c * NTHR + F.tid, NGT = F.G * NTHR;
    for (int i = gt; i < NLAYER * 240 * (DM / 8); i += NGT) { const int l = i / (240 * (DM / 8)), r = i - l * (240 * (DM / 8));
        *(v4u*)(WSP(bf16, WS_W1 + l * SZ_W1) + (size_t)(SRC_SPLIT + r / (DM / 8)) * DM + (r % (DM / 8)) * 8) = (v4u){0u, 0u, 0u, 0u}; }
    for (int i = gt; i < NLAYER * 1024; i += NGT) { const int l = i >> 10, c = i & 1023; WSP(float, WS_LB)[i] = l == 0 ? 0.f : sigm(F.in[I_HGLB][1024 + c] - F.in[I_HGLB][c]); }
    for (int i = gt; i < 2049 * 64; i += NGT) { const int p = i >> 6, j = i & 63; const float pos = p < 2048 ? (float)p : 16384.f;
        const float fr = __builtin_amdgcn_exp2f(-(float)j * (13.287712379549449f / 64.f)); const float ang = pos * fr;
        double rev = (double)ang * 0.15915494309189535; rev -= floor(rev); const float fx = (float)rev;
        WSP(f32x2, WS_ROPE)[i] = (f32x2){__builtin_amdgcn_cosf(fx), __builtin_amdgcn_sinf(fx)}; }
    for (int row = gw; row < M; row += NGW) {
        v2u* ho = (v2u*)(WSP(bf16, WS_XB0) + (size_t)row * DM) + F.lane;
        const f32x4* xi = row < MP ? (const f32x4*)F.in[I_XP] + (size_t)row * (DM / 4) + F.lane : (const f32x4*)F.in[I_XS] + (size_t)(row < MR ? row - MP : 0) * (DM / 4) + F.lane;
        float ss = 0.f;
#pragma unroll
        for (int j = 0; j < 8; ++j) { f32x4 v = xi[64 * j]; if (row >= MR) v = (f32x4){0.f, 0.f, 0.f, 0.f};
            ho[64 * j] = (v2u){pk2(v.x, v.y), pk2(v.z, v.w)}; ss += (v.x * v.x + v.y * v.y) + (v.z * v.z + v.w * v.w); }
        ss = wave_sum(ss);
        if (F.lane == 0 && row < MR) ((u64*)(F.ws + WS_RSS))[row] = (u64)(ss * RSS_SCALE + 0.5f);
        if (row >= MR) { v2u* h1 = (v2u*)(WSP(bf16, WS_XB1) + (size_t)row * DM) + F.lane;
#pragma unroll
            for (int j = 0; j < 8; ++j) h1[64 * j] = (v2u){0u, 0u}; }
    }
}

__device__ __forceinline__ void phase_final(const Frame& F0, const bf16* X, const float* g) {
    Frame F = launder(F0);
    const int gw = F.c * NWAVES + F.wave, NGW = F.G * NWAVES;
    for (int row = gw; row < MR; row += NGW) {
        const v2u* xr = (const v2u*)(X + (size_t)row * DM) + F.lane;
        f32x4* o = (f32x4*)(F.out + (row < MP ? O_YP + (size_t)row * DM : O_YS + (size_t)(row - MP) * DM)) + F.lane;
        const float rstd = rstd_of((const u64*)(F.ws + WS_RSS + 4 * SZ_RSS), row);
#pragma unroll
        for (int j = 0; j < 8; ++j) { const f32x4 gv = ((const f32x4*)g)[F.lane + 64 * j]; const v2u w = xr[64 * j];
            __builtin_nontemporal_store((f32x4){bflo(w.x), bfhi(w.x), bflo(w.y), bfhi(w.y)} * rstd * gv, o + 64 * j); }
    }
}

constexpr size_t WS_HGQ = WS_BR + (size_t)M * BW * 2;
static_assert(2 * (size_t)MP * 1024 * 2 + 3 * 128 * 1024 * 4 <= 3 * (size_t)M * BW * 2, "HGQ overlay");
constexpr size_t HGQ_STRIDE = (size_t)MP * 1024;
constexpr int LW_STR = 136;
constexpr int L_WT = 0, L_XC = 256 * LW_STR * 2, L_XCF = L_XC + 64 * LW_STR * 2, LXF_STR = 132;
static_assert(L_XCF + 64 * LXF_STR * 4 <= RING_BYTES, "lru lds");
__device__ __forceinline__ void lru_stage_w(const Frame& F0, int l, int n) {
    Frame F = launder(F0);
    LAS bf16* WT = (LAS bf16*)(F.lds + L_WT);
    const float* wa = F.in[I_LWA] + ((size_t)l * 8 + n) * 16384; const float* wx = F.in[I_LWX] + ((size_t)l * 8 + n) * 16384;
#pragma unroll 1
    for (int i0 = F.tid; i0 < 16384; i0 += 8 * NTHR) { float va[8], vx[8];
#pragma unroll
        for (int q = 0; q < 8; ++q) { va[q] = wa[i0 + q * NTHR]; vx[q] = wx[i0 + q * NTHR]; }
#pragma unroll
        for (int q = 0; q < 8; ++q) { const int i = i0 + q * NTHR, c = i >> 7, d = i & 127; WT[d * LW_STR + c] = (bf16)f2bf(va[q]); WT[(128 + d) * LW_STR + c] = (bf16)f2bf(vx[q]); } }
}
__device__ __forceinline__ void lru_tile(const Frame& F0, int l, int n, int tt) {
    Frame F = launder(F0);
    LAS bf16* WT = (LAS bf16*)(F.lds + L_WT); LAS bf16* XC = (LAS bf16*)(F.lds + L_XC); LAS float* XCF = (LAS float*)(F.lds + L_XCF);
    const bf16* P = WSP(bf16, WS_P);
    const float* cw = F.in[I_LCW] + (size_t)l * 4 * 1024; const float* cb = F.in[I_LCB] + (size_t)l * 1024;
    {
        const int tk = F.tid >> 3, c0 = (F.tid & 7) * 16, row = tt * 64 + tk, ch0 = n * 128 + c0;
        float acc[16];
#pragma unroll
        for (int j = 0; j < 16; ++j) acc[j] = cb[ch0 + j];
        if (row < MP) {
            const int t = row & (SEQ - 1);
#pragma unroll
            for (int jj = 0; jj < 4; ++jj) { if (t - 3 + jj >= 0) { const v4u* src = (const v4u*)(P + (size_t)(row - 3 + jj) * NP + C_XA + ch0); const v4u a = src[0], b = src[1];
                const unsigned w[8] = {a.x, a.y, a.z, a.w, b.x, b.y, b.z, b.w}; const float* wj = cw + jj * 1024 + ch0;
#pragma unroll
                for (int q = 0; q < 8; ++q) { acc[2 * q] += wj[2 * q] * bflo(w[q]); acc[2 * q + 1] += wj[2 * q + 1] * bfhi(w[q]); } } }
        } else if (row < MR) {
            const int s = row - MP; const float* st = F.in[I_SLC] + ((size_t)l * 128 + s) * 3 * 1024 + ch0;
#pragma unroll
            for (int jj = 0; jj < 3; ++jj) { const float* wj = cw + jj * 1024 + ch0;
#pragma unroll
                for (int q = 0; q < 16; ++q) acc[q] += wj[q] * st[jj * 1024 + q]; }
            const v4u* src = (const v4u*)(P + (size_t)row * NP + C_XA + ch0); const v4u a = src[0], b = src[1];
            const unsigned w[8] = {a.x, a.y, a.z, a.w, b.x, b.y, b.z, b.w}; const float* wj = cw + 3 * 1024 + ch0;
#pragma unroll
            for (int q = 0; q < 8; ++q) { acc[2 * q] += wj[2 * q] * bflo(w[q]); acc[2 * q + 1] += wj[2 * q + 1] * bfhi(w[q]); }
        }
#pragma unroll
        for (int q = 0; q < 16; ++q) { XCF[tk * LXF_STR + c0 + q] = acc[q]; }
#pragma unroll
        for (int q = 0; q < 8; ++q) *(LAS unsigned*)(XC + tk * LW_STR + c0 + 2 * q) = pk2(acc[2 * q], acc[2 * q + 1]);
    }
    __syncthreads();
    const int w = F.wave, lane = F.lane, fr = lane & 15, g = lane >> 4;
    f32x4 ar[4], ai_[4];
#pragma unroll
    for (int rt = 0; rt < 4; ++rt) { ar[rt] = (f32x4){0.f, 0.f, 0.f, 0.f}; ai_[rt] = (f32x4){0.f, 0.f, 0.f, 0.f}; }
#pragma unroll
    for (int ks = 0; ks < 4; ++ks) {
        const bf16x8 br = *(const LAS bf16x8*)(WT + (16 * w + fr) * LW_STR + 32 * ks + 8 * g);
        const bf16x8 bi = *(const LAS bf16x8*)(WT + (128 + 16 * w + fr) * LW_STR + 32 * ks + 8 * g);
#pragma unroll
        for (int rt = 0; rt < 4; ++rt) { const bf16x8 a = *(const LAS bf16x8*)(XC + (16 * rt + fr) * LW_STR + 32 * ks + 8 * g);
            ar[rt] = __builtin_amdgcn_mfma_f32_16x16x32_bf16(a, br, ar[rt], 0, 0, 0); ai_[rt] = __builtin_amdgcn_mfma_f32_16x16x32_bf16(a, bi, ai_[rt], 0, 0, 0); }
    }
    const int d = 16 * w + fr, ch = n * 128 + d;
    const float ba = F.in[I_LBA][(size_t)l * 1024 + ch], bx = F.in[I_LBX][(size_t)l * 1024 + ch], sp = softplusf(-F.in[I_LLAM][(size_t)l * 1024 + ch]);
    bf16* LA = WSP(bf16, WS_X1); bf16* LU = LA + (size_t)M * 1024;
    const bool scan = (tt < 128);
    float CA = 1.f, CU = 0.f;
#pragma unroll
    for (int rt = 0; rt < 4; ++rt) {
        float A[4], U[4];
#pragma unroll
        for (int reg = 0; reg < 4; ++reg) { const int tk = 16 * rt + 4 * g + reg;
            const float r = sigm(ar[rt][reg] + ba), iv = sigm(ai_[rt][reg] + bx), la = -8.f * r * sp, a = __expf(la), xc = XCF[tk * LXF_STR + d];
            const float tq = -2.f * la, om = tq < 0.25f ? tq * (1.f + tq * (-0.5f + tq * (0.16666667f + tq * (-0.041666668f + tq * 0.0083333338f)))) : 1.f - __expf(-tq);
            A[reg] = a; U[reg] = __builtin_amdgcn_sqrtf(fmaxf(om, 0.f)) * (iv * xc); }
        if (scan) {
#pragma unroll
            for (int reg = 1; reg < 4; ++reg) { U[reg] = A[reg] * U[reg - 1] + U[reg]; A[reg] = A[reg] * A[reg - 1]; }
            float PA = 1.f, PU = 0.f, TA = 1.f, TU = 0.f;
#pragma unroll
            for (int src = 0; src < 4; ++src) { const float sa = __shfl(A[3], fr + 16 * src), su = __shfl(U[3], fr + 16 * src);
                if (src < g) { PU = sa * PU + su; PA = sa * PA; }
                TU = sa * TU + su; TA = sa * TA; }
            const float GA = PA * CA, GU = PA * CU + PU;
#pragma unroll
            for (int reg = 0; reg < 4; ++reg) { U[reg] = A[reg] * GU + U[reg]; A[reg] = A[reg] * GA; }
            CU = TA * CU + TU; CA = TA * CA;
        }
#pragma unroll
        for (int reg = 0; reg < 4; ++reg) { const size_t row = (size_t)tt * 64 + 16 * rt + 4 * g + reg; const unsigned wau = pk2(A[reg], U[reg]); LA[row * 1024 + ch] = (bf16)(wau & 0xffffu); LU[row * 1024 + ch] = (bf16)(wau >> 16); }
    }
    __syncthreads();
}
__device__ __forceinline__ void phase_conv(const Frame& F00, int l) {
    Frame F0 = launder(F00);
    { const int n = F0.c & 7; bool staged = false;
      for (int tt = F0.c >> 3; tt < 130; tt += (F0.G >> 3)) { if (!staged) { lru_stage_w(F0, l, n); __syncthreads(); staged = true; } lru_tile(F0, l, n, tt); } }
    Frame F = launder(F0);
    const bf16* P = WSP(bf16, WS_P);
    const int gt = F.c * NTHR + F.tid, NGT = F.G * NTHR;
    { const float* cw = F.in[I_SCW] + (size_t)l * 4 * SSD_CD; const float* cb = F.in[I_SCB] + (size_t)l * SSD_CD; bf16* XBC = WSP(bf16, WS_XBC);
      for (int i = gt; i < (MP / 16) * (SSD_CD / 8); i += NGT) { const int run = i / (SSD_CD / 8), c = (i - run * (SSD_CD / 8)) * 8, r0 = run * 16, t0 = r0 & (SEQ - 1);
          v4u rows[19];
#pragma unroll
          for (int k = 0; k < 19; ++k) { const int rr = r0 - 3 + k; rows[k] = *(const v4u*)(P + (size_t)(rr < 0 ? 0 : rr) * NP + C_SX + c); }
          float w[4][8], bias[8];
#pragma unroll
          for (int q = 0; q < 8; ++q) { bias[q] = cb[c + q]; w[0][q] = cw[c + q]; w[1][q] = cw[SSD_CD + c + q]; w[2][q] = cw[2 * SSD_CD + c + q]; w[3][q] = cw[3 * SSD_CD + c + q]; }
#pragma unroll
          for (int k = 0; k < 16; ++k) { float acc[8];
#pragma unroll
              for (int q = 0; q < 8; ++q) acc[q] = bias[q];
#pragma unroll
              for (int jj = 0; jj < 4; ++jj) { if (t0 + k - 3 + jj >= 0) { const v4u a = rows[k + jj]; const unsigned ww[4] = {a.x, a.y, a.z, a.w};
#pragma unroll
                  for (int q = 0; q < 4; ++q) { acc[2 * q] += w[jj][2 * q] * bflo(ww[q]); acc[2 * q + 1] += w[jj][2 * q + 1] * bfhi(ww[q]); } } }
              v4u o; o.x = pk2(siluf(acc[0]), siluf(acc[1])); o.y = pk2(siluf(acc[2]), siluf(acc[3])); o.z = pk2(siluf(acc[4]), siluf(acc[5])); o.w = pk2(siluf(acc[6]), siluf(acc[7]));
              *(v4u*)(XBC + (size_t)(r0 + k) * SSD_CD + c) = o; } }
      for (int i = gt; i < MS * (SSD_CD / 8); i += NGT) { const int s_ = i / (SSD_CD / 8), c = (i - s_ * (SSD_CD / 8)) * 8; const size_t row = (size_t)MP + s_;
          float acc[8];
#pragma unroll
          for (int q = 0; q < 8; ++q) acc[q] = cb[c + q];
          const float* st = F.in[I_SSC] + ((size_t)l * 128 + s_) * 3 * SSD_CD + c;
#pragma unroll
          for (int jj = 0; jj < 3; ++jj) { const float* wj = cw + jj * SSD_CD + c;
#pragma unroll
              for (int q = 0; q < 8; ++q) acc[q] += wj[q] * st[jj * SSD_CD + q]; }
          const v4u a = *(const v4u*)(P + row * NP + C_SX + c); const unsigned ww[4] = {a.x, a.y, a.z, a.w}; const float* wj = cw + 3 * SSD_CD + c;
#pragma unroll
          for (int q = 0; q < 4; ++q) { acc[2 * q] += wj[2 * q] * bflo(ww[q]); acc[2 * q + 1] += wj[2 * q + 1] * bfhi(ww[q]); }
          v4u o; o.x = pk2(siluf(acc[0]), siluf(acc[1])); o.y = pk2(siluf(acc[2]), siluf(acc[3])); o.z = pk2(siluf(acc[4]), siluf(acc[5])); o.w = pk2(siluf(acc[6]), siluf(acc[7]));
          *(v4u*)(XBC + row * SSD_CD + c) = o; } }
    { const int gw = F.c * NWAVES + F.wave, NGW = F.G * NWAVES, lane = F.lane; const float* LOGF = WSP(float, WS_HF);
      bf16* HGQ = WSP(bf16, WS_HGQ); float* HGE = (float*)(WSP(bf16, WS_HGQ) + 2 * HGQ_STRIDE);
      for (int tk = gw; tk < NBATCH * 32 * 8; tk += NGW) {
          const int b = tk >> 8, c = (tk >> 3) & 31, h = tk & 7; const size_t r0 = (size_t)b * SEQ + 64 * c; const int col = h * 128 + 2 * lane;
          f32x2 cs[64];
#pragma unroll
          for (int t = 0; t < 64; ++t) cs[t] = *(const f32x2*)(LOGF + (r0 + t) * 1024 + col);
#pragma unroll
          for (int t = 1; t < 64; ++t) cs[t] += cs[t - 1];
          const f32x2 beta = cs[31], bC = cs[63];
#pragma unroll
          for (int hb = 0; hb < 4; ++hb) {
              unsigned qv[16], kv[16];
#pragma unroll
              for (int t = 0; t < 16; ++t) { const size_t row = r0 + 16 * hb + t; qv[t] = *(const unsigned*)(P + row * NP + C_HQ + col); kv[t] = *(const unsigned*)(P + row * NP + C_HF + col); }
#pragma unroll
              for (int t = 0; t < 16; ++t) { const size_t row = r0 + 16 * hb + t; const f32x2 cc = cs[16 * hb + t]; const float q0 = bflo(qv[t]), q1 = bfhi(qv[t]), k0 = bflo(kv[t]), k1 = bfhi(kv[t]);
                  *(unsigned*)(HGQ + row * 1024 + col) = pk2(q0 * __expf(fminf(cc.x - beta.x, 80.f)), q1 * __expf(fminf(cc.y - beta.y, 80.f)));
                  *(unsigned*)(HGQ + HGQ_STRIDE + row * 1024 + col) = pk2(k0 * __expf(fminf(beta.x - cc.x, 80.f)), k1 * __expf(fminf(beta.y - cc.y, 80.f))); } }
          *(f32x2*)(HGE + (size_t)(b * 32 + c) * 1024 + col) = (f32x2){__expf(bC.x), __expf(bC.y)};
          *(f32x2*)(HGE + (size_t)128 * 1024 + (size_t)(b * 32 + c) * 1024 + col) = (f32x2){__expf(bC.x - beta.x), __expf(bC.y - beta.y)};
          *(f32x2*)(HGE + (size_t)256 * 1024 + (size_t)(b * 32 + c) * 1024 + col) = (f32x2){__expf(beta.x), __expf(beta.y)};
      } }
    { bf16* RQK = WSP(bf16, WS_H);
      for (int i0 = gt; i0 < MP * 64; i0 += 2 * NGT) {
          v4u ld[2][8];
#pragma unroll
          for (int q = 0; q < 2; ++q) { const int i = i0 + q * NGT < MP * 64 ? i0 + q * NGT : i0; const int row = i >> 6, h = (i >> 3) & 7, sg = i & 7, t = row & (SEQ - 1);
              const bf16* rp = P + (size_t)row * NP + h * 128;
              ld[q][0] = *(const v4u*)(rp + C_RQ + 8 * sg); ld[q][1] = *(const v4u*)(rp + C_RQ + 64 + 8 * sg); ld[q][2] = *(const v4u*)(rp + C_RK + 8 * sg); ld[q][3] = *(const v4u*)(rp + C_RK + 64 + 8 * sg);
              const v4u* cp = (const v4u*)(WSP(f32x2, WS_ROPE) + (size_t)t * 64 + 8 * sg); ld[q][4] = cp[0]; ld[q][5] = cp[1]; ld[q][6] = cp[2]; ld[q][7] = cp[3]; }
#pragma unroll
          for (int q = 0; q < 2; ++q) { const int i = i0 + q * NGT; if (i >= MP * 64) continue; const int row = i >> 6, h = (i >> 3) & 7, sg = i & 7;
              const unsigned q1w[4] = {ld[q][0].x, ld[q][0].y, ld[q][0].z, ld[q][0].w}, q2w[4] = {ld[q][1].x, ld[q][1].y, ld[q][1].z, ld[q][1].w}, k1w[4] = {ld[q][2].x, ld[q][2].y, ld[q][2].z, ld[q][2].w}, k2w[4] = {ld[q][3].x, ld[q][3].y, ld[q][3].z, ld[q][3].w};
              const unsigned csw[16] = {ld[q][4].x, ld[q][4].y, ld[q][4].z, ld[q][4].w, ld[q][5].x, ld[q][5].y, ld[q][5].z, ld[q][5].w, ld[q][6].x, ld[q][6].y, ld[q][6].z, ld[q][6].w, ld[q][7].x, ld[q][7].y, ld[q][7].z, ld[q][7].w};
              unsigned qa[4], qb[4], ka[4], kb[4]; const float ksc = 0.08838834764831845f;
#pragma unroll
              for (int j = 0; j < 4; ++j) {
                  const float cc0 = __uint_as_float(csw[4 * j]), ss0 = __uint_as_float(csw[4 * j + 1]), cc1 = __uint_as_float(csw[4 * j + 2]), ss1 = __uint_as_float(csw[4 * j + 3]);
                  const float a0 = bflo(q1w[j]), a1 = bfhi(q1w[j]), b0 = bflo(q2w[j]), b1 = bfhi(q2w[j]), e0 = bflo(k1w[j]), e1 = bfhi(k1w[j]), f0 = bflo(k2w[j]), f1 = bfhi(k2w[j]);
                  qa[j] = pk2(a0 * cc0 - b0 * ss0, a1 * cc1 - b1 * ss1); qb[j] = pk2(a0 * ss0 + b0 * cc0, a1 * ss1 + b1 * cc1);
                  ka[j] = pk2((e0 * cc0 - f0 * ss0) * ksc, (e1 * cc1 - f1 * ss1) * ksc); kb[j] = pk2((e0 * ss0 + f0 * cc0) * ksc, (e1 * ss1 + f1 * cc1) * ksc); }
              bf16* op = RQK + (size_t)row * 1024 + h * 128 + 8 * sg;
              *(v4u*)op = (v4u){qa[0], qa[1], qa[2], qa[3]}; *(v4u*)(op + 64) = (v4u){qb[0], qb[1], qb[2], qb[3]};
              *(v4u*)(op + HGQ_STRIDE) = (v4u){ka[0], ka[1], ka[2], ka[3]}; *(v4u*)(op + HGQ_STRIDE + 64) = (v4u){kb[0], kb[1], kb[2], kb[3]}; } } }
    { float* DT = WSP(float, WS_DT); for (int i = gt; i < MR * 16; i += NGT) DT[i] = softplusf(DT[i] + F.in[I_SDTB][l * 16 + (i & 15)]); }
    for (int i = gt; i < NBATCH * 3 * 256; i += NGT) { const int b = i / 768, r = i - b * 768, j = r >> 8, c = (r & 255) * 4;
        const v2u w = *(const v2u*)(P + ((size_t)b * SEQ + SEQ - 3 + j) * NP + C_XA + c); *(f32x4*)(F.out + O_LC_P + (size_t)l * NBATCH * 3072 + (size_t)i * 4) = (f32x4){bflo(w.x), bfhi(w.x), bflo(w.y), bfhi(w.y)}; }
    for (int i = gt; i < NBATCH * 3 * (SSD_CD / 4); i += NGT) { const int b = i / (3 * SSD_CD / 4), r = i - b * (3 * SSD_CD / 4), j = r / (SSD_CD / 4), c = (r - j * (SSD_CD / 4)) * 4;
        const v2u w = *(const v2u*)(P + ((size_t)b * SEQ + SEQ - 3 + j) * NP + C_SX + c); *(f32x4*)(F.out + O_SC_P + (size_t)l * NBATCH * 3 * SSD_CD + (size_t)i * 4) = (f32x4){bflo(w.x), bfhi(w.x), bflo(w.y), bfhi(w.y)}; }
    for (int i = gt; i < MS * 3 * 256; i += NGT) { const int s_ = i / 768, r = i - s_ * 768, j = r >> 8, c = (r & 255) * 4; f32x4 v;
        if (j < 2) v = *(const f32x4*)(F.in[I_SLC] + (size_t)l * MS * 3072 + (size_t)s_ * 3072 + (j + 1) * 1024 + c);
        else { const v2u w = *(const v2u*)(P + ((size_t)MP + s_) * NP + C_XA + c); v = (f32x4){bflo(w.x), bfhi(w.x), bflo(w.y), bfhi(w.y)}; }
        *(f32x4*)(F.out + O_LC_S + (size_t)l * MS * 3072 + (size_t)i * 4) = v; }
    for (int i = gt; i < MS * 3 * (SSD_CD / 4); i += NGT) { const int s_ = i / (3 * SSD_CD / 4), r = i - s_ * (3 * SSD_CD / 4), j = r / (SSD_CD / 4), c = (r - j * (SSD_CD / 4)) * 4; f32x4 v;
        if (j < 2) v = *(const f32x4*)(F.in[I_SSC] + (size_t)l * MS * 3 * SSD_CD + (size_t)s_ * 3 * SSD_CD + (j + 1) * SSD_CD + c);
        else { const v2u w = *(const v2u*)(P + ((size_t)MP + s_) * NP + C_SX + c); v = (f32x4){bflo(w.x), bfhi(w.x), bflo(w.y), bfhi(w.y)}; }
        *(f32x4*)(F.out + O_SC_S + (size_t)l * MS * 3 * SSD_CD + (size_t)i * 4) = v; }
}

constexpr int QS_STR = 136;
typedef short s16x4 __attribute__((ext_vector_type(4)));
template <int MODE> struct CK {
    static constexpr int V = (MODE == 2) ? 64 : 128, NVT = V / 16, NVW = NVT / 2, NH = (MODE == 2) ? 16 : 8, VSTR = (MODE == 2) ? 72 : 136;
    static constexpr int O_QS = 0, O_QH = O_QS + 64 * QS_STR * 2, O_KS = O_QH, O_VV = O_KS + 64 * QS_STR * 2, O_VD = O_VV + 64 * VSTR * 2,
        O_XS = O_VD + (MODE == 0 ? 0 : 64 * VSTR * 2), O_S0T = O_XS + (MODE == 2 ? 64 * VSTR * 2 : 0), O_F32 = O_S0T + V * QS_STR * 2, O_OT = O_F32 + 4096, O_END = O_OT + 64 * VSTR * 2;
    static_assert(O_END <= RING_BYTES, "chunk unit LDS");
};
__device__ __forceinline__ bf16x8 tr_frag(const LAS bf16* T, int stride, int row0, int row1, int col0, int fr) {
    const int q = fr >> 2, p = fr & 3;
    const s16x4 lo = __builtin_amdgcn_ds_read_tr16_b64_v4i16((LAS s16x4*)(T + (row0 + q) * stride + col0 + 4 * p));
    const s16x4 hi = __builtin_amdgcn_ds_read_tr16_b64_v4i16((LAS s16x4*)(T + (row1 + q) * stride + col0 + 4 * p));
    return (bf16x8){lo[0], lo[1], lo[2], lo[3], hi[0], hi[1], hi[2], hi[3]};
}
template <int MODE, int PV>
__device__ __forceinline__ void chunk_unit(const Frame& F0, int l, int unit) {
    Frame F = launder(F0);
    typedef CK<MODE> C; constexpr int V = C::V, NVT = C::NVT, NVW = C::NVW, NH = C::NH, VSTR = C::VSTR;
    const int b = unit / NH, h = unit - b * NH;
    LAS bf16* QS = (LAS bf16*)(F.lds + C::O_QS); LAS bf16* QH = (LAS bf16*)(F.lds + C::O_QH); LAS bf16* KS = (LAS bf16*)(F.lds + C::O_KS);
    LAS bf16* VV = (LAS bf16*)(F.lds + C::O_VV); LAS bf16* VD = (LAS bf16*)(F.lds + C::O_VD); LAS bf16* XS = (LAS bf16*)(F.lds + C::O_XS); LAS bf16* S0T = (LAS bf16*)(F.lds + C::O_S0T);
    LAS bf16* OT = (LAS bf16*)(F.lds + C::O_OT);
    LAS float* FA = (LAS float*)(F.lds + C::O_F32);
    const bf16* P = WSP(bf16, WS_P); const bf16* XBC = WSP(bf16, WS_XBC); const float* DT = WSP(float, WS_DT);
    const bf16* HGQ = WSP(bf16, WS_HGQ); const float* HGE = (const float*)(WSP(bf16, WS_HGQ) + 2 * HGQ_STRIDE); const bf16* RQK = WSP(bf16, WS_H);
    bf16* OUT = (MODE == 0) ? WSP(bf16, WS_OB) : (MODE == 1 ? WSP(bf16, WS_OB + 2 * SZ_O) : WSP(bf16, WS_OB + SZ_O));
    const int tid = F.tid, lane = F.lane, w = F.wave, fr = lane & 15, g = lane >> 4, tt = w & 3, vh = w >> 2;
    const float gx = -__builtin_ldexpf(1.f, -5 - h);
    const float lg = (MODE == 1) ? gx * (1.f + gx * (-0.5f + gx * (0.33333334f + gx * (-0.25f + gx * 0.2f)))) : 0.f;
    float ssd_A = 0.f, ssd_D = 0.f;
    if (MODE == 2) { ssd_A = -__expf(F.in[I_SALOG][l * 16 + h]); ssd_D = F.in[I_SD][l * 16 + h]; }
    const int grp = h >> 3;
    for (int i = tid; i < V * QS_STR / 2; i += NTHR) ((LAS unsigned*)S0T)[i] = 0u;
    f32x4 S[NVT];
#pragma unroll
    for (int i = 0; i < NVT; ++i) S[i] = (f32x4){0.f, 0.f, 0.f, 0.f};
    v4u ra[8]; float rdt = 0.f, eb0 = 0.f, eb1 = 0.f; f32x4 ebn = (f32x4){1.f, 1.f, 1.f, 1.f};
    const int stok = tid >> 3, sg = tid & 7;
    auto load_chunk = [&](int c) {
        const size_t row = (size_t)b * SEQ + 64 * c + stok;
        if (MODE == 0) {
            const bf16* qp = HGQ + row * 1024 + h * 128 + 16 * sg;
            ra[0] = *(const v4u*)qp; ra[1] = *(const v4u*)(qp + 8); ra[4] = *(const v4u*)(qp + HGQ_STRIDE); ra[5] = *(const v4u*)(qp + HGQ_STRIDE + 8);
            ebn = *(const f32x4*)(HGE + (size_t)256 * 1024 + (size_t)(b * 32 + c) * 1024 + h * 128 + 16 * w + 4 * g);
            const bf16* vp = P + row * NP + C_HI + h * 128 + 16 * sg; ra[6] = *(const v4u*)vp; ra[7] = *(const v4u*)(vp + 8);
            if (tid < 128) { const float* ep = HGE + (size_t)(b * 32 + c) * 1024 + h * 128 + tid; eb0 = ep[0]; eb1 = ep[128 * 1024]; }
        } else if (MODE == 1) {
            const bf16* qp = RQK + row * 1024 + h * 128 + 16 * sg;
            ra[0] = *(const v4u*)qp; ra[1] = *(const v4u*)(qp + 8); ra[2] = *(const v4u*)(qp + HGQ_STRIDE); ra[3] = *(const v4u*)(qp + HGQ_STRIDE + 8);
            const bf16* vp = P + row * NP + C_RV + h * 128 + 16 * sg; ra[4] = *(const v4u*)vp; ra[5] = *(const v4u*)(vp + 8);
        } else {
            const bf16* xp = XBC + row * SSD_CD;
            ra[0] = *(const v4u*)(xp + 1024 + grp * 128 + 16 * sg); ra[1] = *(const v4u*)(xp + 1024 + grp * 128 + 16 * sg + 8);
            ra[2] = *(const v4u*)(xp + 1280 + grp * 128 + 16 * sg); ra[3] = *(const v4u*)(xp + 1280 + grp * 128 + 16 * sg + 8);
            ra[4] = *(const v4u*)(xp + h * 64 + 8 * sg);
            rdt = DT[((size_t)b * SEQ + 64 * c + lane) * 16 + h];
        }
    };
    auto stage_chunk = [&]() {
        if (MODE == 0) {
            *(LAS v4u*)(QS + stok * QS_STR + 16 * sg) = ra[0]; *(LAS v4u*)(QS + stok * QS_STR + 16 * sg + 8) = ra[1];
            *(LAS v4u*)(KS + stok * QS_STR + 16 * sg) = ra[4]; *(LAS v4u*)(KS + stok * QS_STR + 16 * sg + 8) = ra[5];
            *(LAS v4u*)(VV + stok * VSTR + 16 * sg) = ra[6]; *(LAS v4u*)(VV + stok * VSTR + 16 * sg + 8) = ra[7];
            if (tid < 128) { FA[512 + tid] = eb0; FA[640 + tid] = eb1; }
        } else if (MODE == 1) {
            *(LAS v4u*)(QS + stok * QS_STR + 16 * sg) = ra[0]; *(LAS v4u*)(QS + stok * QS_STR + 16 * sg + 8) = ra[1];
            *(LAS v4u*)(KS + stok * QS_STR + 16 * sg) = ra[2]; *(LAS v4u*)(KS + stok * QS_STR + 16 * sg + 8) = ra[3];
            *(LAS v4u*)(VV + stok * VSTR + 16 * sg) = ra[4]; *(LAS v4u*)(VV + stok * VSTR + 16 * sg + 8) = ra[5];
            const float ws = __expf(lg * (float)(63 - stok));
            const unsigned vw[8] = {ra[4].x, ra[4].y, ra[4].z, ra[4].w, ra[5].x, ra[5].y, ra[5].z, ra[5].w}; unsigned vd[8];
#pragma unroll
            for (int i = 0; i < 8; ++i) vd[i] = pk2(bflo(vw[i]) * ws, bfhi(vw[i]) * ws);
            *(LAS v4u*)(VD + stok * VSTR + 16 * sg) = (v4u){vd[0], vd[1], vd[2], vd[3]}; *(LAS v4u*)(VD + stok * VSTR + 16 * sg + 8) = (v4u){vd[4], vd[5], vd[6], vd[7]};
        } else {
            float bs = rdt * ssd_A;
#pragma unroll
            for (int o = 1; o < 64; o <<= 1) { const float up = __shfl_up(bs, o); if (lane >= o) bs += up; }
            const float bC = __shfl(bs, 63), bmy = __shfl(bs, stok), dtm = __shfl(rdt, stok);
            if (w == 0) { FA[lane] = bs; FA[64 + lane] = __expf(bs); }
            *(LAS v4u*)(KS + stok * QS_STR + 16 * sg) = ra[0]; *(LAS v4u*)(KS + stok * QS_STR + 16 * sg + 8) = ra[1];
            *(LAS v4u*)(QS + stok * QS_STR + 16 * sg) = ra[2]; *(LAS v4u*)(QS + stok * QS_STR + 16 * sg + 8) = ra[3];
            const float ws = __expf(bC - bmy);
            const unsigned xw[4] = {ra[4].x, ra[4].y, ra[4].z, ra[4].w}; unsigned v1[4], v2[4];
#pragma unroll
            for (int i = 0; i < 4; ++i) { const float x0 = bflo(xw[i]) * dtm, x1 = bfhi(xw[i]) * dtm; v1[i] = pk2(x0, x1); v2[i] = pk2(x0 * ws, x1 * ws); }
            *(LAS v4u*)(XS + stok * VSTR + 8 * sg) = ra[4]; *(LAS v4u*)(VV + stok * VSTR + 8 * sg) = (v4u){v1[0], v1[1], v1[2], v1[3]}; *(LAS v4u*)(VD + stok * VSTR + 8 * sg) = (v4u){v2[0], v2[1], v2[2], v2[3]};
        }
    };
    const bool sink = (PV == 0) || (F.G == 12345);
    if (PV != 2) { load_chunk(0); stage_chunk(); }
    __syncthreads();
    for (int c = 0; c < SEQ / 64; ++c) {
        if (PV != 2 && c + 1 < SEQ / 64) load_chunk(c + 1);
        if (PV != 1) {
        const size_t row0 = (size_t)b * SEQ + 64 * c;
        f32x4 sc[4];
#pragma unroll
        for (int st = 0; st < 4; ++st) { sc[st] = (f32x4){0.f, 0.f, 0.f, 0.f};
            if (st <= tt) {
#pragma unroll
                for (int ks = 0; ks < 4; ++ks) { const bf16x8 a = *(const LAS bf16x8*)(KS + (16 * st + fr) * QS_STR + 32 * ks + 8 * g), bq = *(const LAS bf16x8*)(QS + (16 * tt + fr) * QS_STR + 32 * ks + 8 * g);
                    sc[st] = __builtin_amdgcn_mfma_f32_16x16x32_bf16(a, bq, sc[st], 0, 0, 0); } } }
        const int tloc = 16 * tt + fr;
        float btt = 0.f; if (MODE == 2) btt = FA[tloc];
        unsigned pw[8];
#pragma unroll
        for (int st = 0; st < 4; ++st) { float vals[4];
#pragma unroll
            for (int reg = 0; reg < 4; ++reg) { const int s = 16 * st + 4 * g + reg; float x = sc[st][reg];
                if (MODE == 1) x *= __expf(lg * (float)(tloc - s));
                if (MODE == 2) x *= __expf(fminf(btt - FA[s], 0.f));
                vals[reg] = (st <= tt && s <= tloc) ? x : 0.f; }
            pw[2 * st] = pk2(vals[0], vals[1]); pw[2 * st + 1] = pk2(vals[2], vals[3]); }
        const bf16x8 pf0 = __builtin_bit_cast(bf16x8, ((v4u){pw[0], pw[1], pw[2], pw[3]})), pf1 = __builtin_bit_cast(bf16x8, ((v4u){pw[4], pw[5], pw[6], pw[7]}));
        LAS bf16* QX = QS;
#pragma unroll
        for (int vi = 0; vi < NVW; ++vi) { const int vt = vh * NVW + vi;
            f32x4 o = (f32x4){0.f, 0.f, 0.f, 0.f}, oi = (f32x4){0.f, 0.f, 0.f, 0.f};
            { const bf16x8 bv = tr_frag(VV, VSTR, 4 * g, 16 + 4 * g, 16 * vt, fr); o = __builtin_amdgcn_mfma_f32_16x16x32_bf16(pf0, bv, o, 0, 0, 0); }
            if (tt >= 2) { const bf16x8 bv = tr_frag(VV, VSTR, 32 + 4 * g, 48 + 4 * g, 16 * vt, fr); o = __builtin_amdgcn_mfma_f32_16x16x32_bf16(pf1, bv, o, 0, 0, 0); }
#pragma unroll
            for (int ks = 0; ks < 4; ++ks) { const bf16x8 a = *(const LAS bf16x8*)(QX + (16 * tt + fr) * QS_STR + 32 * ks + 8 * g), bs = *(const LAS bf16x8*)(S0T + (16 * vt + fr) * QS_STR + 32 * ks + 8 * g);
                oi = __builtin_amdgcn_mfma_f32_16x16x32_bf16(a, bs, oi, 0, 0, 0); }
            float vals[4];
#pragma unroll
            for (int reg = 0; reg < 4; ++reg) { const int t = 16 * tt + 4 * g + reg; float val;
                if (MODE == 0) val = o[reg] + oi[reg];
                else if (MODE == 1) val = o[reg] + __expf(lg * (float)(t + 1)) * oi[reg];
                else val = o[reg] + FA[64 + t] * oi[reg] + ssd_D * bf2f(XS[t * VSTR + 16 * vt + fr]);
                vals[reg] = val; }
            { const unsigned w01 = pk2(vals[0], vals[1]), w23 = pk2(vals[2], vals[3]); LAS bf16* op = OT + (16 * tt + 4 * g) * VSTR + 16 * vt + fr;
              op[0] = (bf16)(w01 & 0xffffu); op[VSTR] = (bf16)(w01 >> 16); op[2 * VSTR] = (bf16)(w23 & 0xffffu); op[3 * VSTR] = (bf16)(w23 >> 16); } }
        { const LAS bf16* VX = (MODE == 0) ? VV : VD;
          float e1[4], e2[4];
#pragma unroll
          for (int reg = 0; reg < 4; ++reg) { if (MODE == 0) { e1[reg] = FA[512 + 16 * w + 4 * g + reg]; e2[reg] = FA[640 + 16 * w + 4 * g + reg]; } else if (MODE == 1) { e1[reg] = __expf(lg * 64.f); e2[reg] = 1.f; } else { e1[reg] = FA[64 + 63]; e2[reg] = 1.f; } }
          const bf16x8 ka0 = tr_frag(KS, QS_STR, 8 * g, 8 * g + 4, 16 * w, fr), ka1 = tr_frag(KS, QS_STR, 32 + 8 * g, 36 + 8 * g, 16 * w, fr);
#pragma unroll
          for (int vt = 0; vt < NVT; ++vt) { f32x4 d = (f32x4){0.f, 0.f, 0.f, 0.f};
              const bf16x8 b0 = tr_frag(VX, VSTR, 8 * g, 8 * g + 4, 16 * vt, fr), b1 = tr_frag(VX, VSTR, 32 + 8 * g, 36 + 8 * g, 16 * vt, fr);
              d = __builtin_amdgcn_mfma_f32_16x16x32_bf16(ka0, b0, d, 0, 0, 0); d = __builtin_amdgcn_mfma_f32_16x16x32_bf16(ka1, b1, d, 0, 0, 0);
#pragma unroll
              for (int reg = 0; reg < 4; ++reg) S[vt][reg] = e1[reg] * S[vt][reg] + e2[reg] * d[reg]; } }
        }
        __syncthreads();
        if (PV != 1 && sink) { const LAS bf16* op = OT + stok * VSTR + (V / 8) * sg; bf16* gp = OUT + ((size_t)b * SEQ + 64 * c + stok) * 1024 + h * V + (V / 8) * sg;
            *(v4u*)gp = *(const LAS v4u*)op; if (V == 128) *(v4u*)(gp + 8) = *(const LAS v4u*)(op + 8); }
#pragma unroll
        for (int vt = 0; vt < NVT; ++vt) { const f32x4 sp_ = (MODE == 0) ? S[vt] * ebn : S[vt]; *(LAS v2u*)(S0T + (16 * vt + fr) * QS_STR + 16 * w + 4 * g) = (v2u){pk2(sp_[0], sp_[1]), pk2(sp_[2], sp_[3])}; }
        if (PV != 2 && c + 1 < SEQ / 64) stage_chunk();
        __syncthreads();
    }
    if (!sink) return;
    float* so = F.out + (MODE == 0 ? O_HG_P : (MODE == 1 ? O_RET_P : O_SSD_P)) + (((size_t)l * NBATCH + b) * NH + h) * (128 * V);
#pragma unroll
    for (int vt = 0; vt < NVT; ++vt)
#pragma unroll
        for (int reg = 0; reg < 4; ++reg) so[(size_t)(16 * w + 4 * g + reg) * V + 16 * vt + fr] = S[vt][reg];
}

constexpr int SM_FLOATS = 1024, SM_DEC = 0, SM_KK = 128, SM_Q = 256, SM_VV = 384, SM_XS = 512, SM_DSC = 576, SB_RED = 3 * SM_FLOATS * 4;
struct SmallIn { unsigned a, b, c, d; };
template <int MODE>
__device__ __forceinline__ void samp_run(const Frame& F0, int l, int p0, int pstep, int pend) {
    Frame F = launder(F0);
    constexpr int V = (MODE == 2) ? 64 : 128, NH = (MODE == 2) ? 16 : 8, NKR = (MODE == 2) ? 32 : 16, NJ = 128 / NKR;
    if (p0 >= pend) return;
    const bf16* P = WSP(bf16, WS_P); const bf16* XBC = WSP(bf16, WS_XBC);
    const int tid = F.tid;
    const int v4 = (MODE == 2) ? (tid & 15) : (tid & 31), kr = (MODE == 2) ? (tid >> 4) : (tid >> 5);
    const float* SIN = F.in[MODE == 0 ? I_SHG : (MODE == 1 ? I_SRET : I_SSSD)] + (size_t)l * 128 * NH * (128 * V);
    float* SOUT = F.out + (MODE == 0 ? O_HG_S : (MODE == 1 ? O_RET_S : O_SSD_S)) + (size_t)l * 128 * NH * (128 * V);
    bf16* OUT = (MODE == 0) ? WSP(bf16, WS_OB) : (MODE == 1 ? WSP(bf16, WS_OB + 2 * SZ_O) : WSP(bf16, WS_OB + SZ_O));
    f32x2 cs = (f32x2){0.f, 0.f};
    if (MODE == 1 && tid < 64) cs = WSP(f32x2, WS_ROPE)[2048 * 64 + tid];
    auto ldw = [&](const bf16* base, size_t idx) -> unsigned { return ((const unsigned*)base)[idx >> 1]; };
    auto sload = [&](int pair) -> SmallIn {
        SmallIn r;
        const int s = pair / NH, h = pair - s * NH; const size_t row = MP + s;
        if (MODE == 0) {
            const int k = tid & 127; r.a = WSP(unsigned, WS_HF)[row * 1024 + h * 128 + k]; r.b = ldw(P, row * NP + C_HF + h * 128 + k); r.c = ldw(P, row * NP + C_HQ + h * 128 + k); r.d = ldw(P, row * NP + C_HI + h * 128 + k);
        } else if (MODE == 1) {
            const bool qk = tid < 64; const int j = tid & 63, v = (tid - 64) & 127;
            r.a = ldw(P, row * NP + h * 128 + (qk ? C_RQ + j : C_RV + v)); r.b = ldw(P, row * NP + h * 128 + (qk ? C_RQ + 64 + j : C_RV + v));
            r.c = ldw(P, row * NP + h * 128 + (qk ? C_RK + j : C_RV + v)); r.d = ldw(P, row * NP + h * 128 + (qk ? C_RK + 64 + j : C_RV + v));
        } else {
            const int ch = tid < 320 ? tid : 318 + (tid & 1), grp = h >> 3;
            const int cidx = ch < 64 ? h * 64 + ch : (ch < 192 ? 1024 + grp * 128 + (ch - 64) : 1280 + grp * 128 + (ch - 192));
            r.a = ldw(XBC, row * SSD_CD + cidx);
            r.b = WSP(unsigned, WS_DT)[row * 16 + h]; r.c = ((const unsigned*)F.in[I_SALOG])[l * 16 + h]; r.d = ((const unsigned*)F.in[I_SD])[l * 16 + h];
        }
        return r;
    };
    auto swrite = [&](LAS float* SM, int pair, const SmallIn& r_) {
        SmallIn r = r_; asm volatile("" : "+v"(r.a), "+v"(r.b), "+v"(r.c), "+v"(r.d));
        const int h = pair % NH; const bool odd = tid & 1;
        auto bsel = [&](unsigned w) -> float { return odd ? bfhi(w) : bflo(w); };
        if (MODE == 0) { if (tid < 128) { SM[SM_DEC + tid] = __expf(__uint_as_float(r.a)); SM[SM_KK + tid] = bsel(r.b); SM[SM_Q + tid] = bsel(r.c); SM[SM_VV + tid] = bsel(r.d); } }
        else if (MODE == 1) {
            if (tid < 64) { const int j = tid; const float q1 = bsel(r.a), q2 = bsel(r.b), k1 = bsel(r.c), k2 = bsel(r.d);
                SM[SM_Q + j] = q1 * cs.x - q2 * cs.y; SM[SM_Q + 64 + j] = q1 * cs.y + q2 * cs.x;
                SM[SM_KK + j] = (k1 * cs.x - k2 * cs.y) * 0.08838834764831845f; SM[SM_KK + 64 + j] = (k1 * cs.y + k2 * cs.x) * 0.08838834764831845f; }
            else if (tid < 192) { SM[SM_VV + tid - 64] = bsel(r.a); SM[SM_DEC + tid - 64] = 1.f - __builtin_ldexpf(1.f, -5 - h); }
        } else {
            if (tid < 320) { const int ch = tid; const float val = bsel(r.a);
                if (ch < 64) { const float dtv = __uint_as_float(r.b); SM[SM_XS + ch] = val; SM[SM_VV + ch] = val * dtv; SM[SM_DSC + 64 + ch] = __uint_as_float(r.d); if (ch == 0) SM[SM_DSC] = __expf(dtv * (-__expf(__uint_as_float(r.c)))); }
                else if (ch < 192) SM[SM_KK + ch - 64] = val; else SM[SM_Q + ch - 192] = val; }
        }
    };
    auto stload = [&](int pair, f32x4 (&dst)[NJ]) {
        const float* sin_ = SIN + (size_t)pair * (128 * V);
#pragma unroll
        for (int j = 0; j < NJ; ++j) dst[j] = __builtin_nontemporal_load((const f32x4*)(sin_ + (size_t)(kr + NKR * j) * V + 4 * v4));
    };
    int cb = 0, rb = 0;
    auto step = [&](int pair, f32x4 (&cur)[NJ], f32x4 (&nw)[NJ], const SmallIn& rwr, SmallIn& rnw) {
        const int p1 = pair + pstep, p2 = pair + 2 * pstep; const int p1c = p1 < pend ? p1 : pair, p2c = p2 < pend ? p2 : pair;
        const int nb = cb == 2 ? 0 : cb + 1;
        rnw = sload(p2c);
        stload(p2c, nw);
        LAS float* SM = (LAS float*)F.lds + cb * SM_FLOATS; LAS float* RED = (LAS float*)(F.lds + SB_RED) + rb * (NKR * V);
        float* sout = SOUT + (size_t)pair * (128 * V);
        const f32x4 vv = *(const LAS f32x4*)(SM + SM_VV + 4 * v4);
        f32x4 po = (f32x4){0.f, 0.f, 0.f, 0.f};
#pragma unroll
        for (int j = 0; j < NJ; ++j) { const int k = kr + NKR * j; const float dec = (MODE == 2) ? SM[SM_DSC] : SM[SM_DEC + k]; const float kk = SM[SM_KK + k], q = SM[SM_Q + k];
            const f32x4 sn = cur[j] * dec + vv * kk; __builtin_nontemporal_store(sn, (f32x4*)(sout + (size_t)k * V + 4 * v4)); po += sn * q; }
        *(LAS f32x4*)(RED + kr * V + 4 * v4) = po;
        swrite((LAS float*)F.lds + nb * SM_FLOATS, p1c, rwr);
        __syncthreads();
        if (tid < V) { float o = 0.f;
#pragma unroll
            for (int r = 0; r < NKR; ++r) o += RED[r * V + tid];
            if (MODE == 2) o += SM[SM_DSC + 64 + tid] * SM[SM_XS + tid];
            const int s = pair / NH, h = pair - s * NH;
            OUT[(size_t)(MP + s) * 1024 + h * V + tid] = (bf16)f2bf(o); }
        cb = nb; rb ^= 1;
    };
    f32x4 s0[NJ], s1[NJ], s2[NJ]; SmallIn r0, r1, r2;
    { const int p1c = p0 + pstep < pend ? p0 + pstep : p0;
      r0 = sload(p0); stload(p0, s0); r1 = sload(p1c); stload(p1c, s1); r2.a = 0u; r2.b = 0u; r2.c = 0u; r2.d = 0u;
      swrite((LAS float*)F.lds, p0, r0); }
    __syncthreads();
    int pair = p0;
    for (; pair + 2 * pstep < pend; pair += 3 * pstep) {
        step(pair, s0, s2, r1, r2); step(pair + pstep, s1, s0, r2, r0); step(pair + 2 * pstep, s2, s1, r0, r1);
    }
    if (pair < pend) { step(pair, s0, s2, r1, r2); pair += pstep;
        if (pair < pend) step(pair, s1, s0, r2, r0); }
    __syncthreads();
}

__device__ __forceinline__ void lru_fix(const Frame& F0, int l, int gw, int NGW) {
    Frame F = launder(F0);
    const bf16* P = WSP(bf16, WS_P);
    const bf16* LA = WSP(bf16, WS_X1); const bf16* LU = LA + (size_t)M * 1024;
    bf16* BR = WSP(bf16, WS_BR);
    const int lane = F.lane;
    for (int task = gw; task < NBATCH * 8 * 32; task += NGW) {
        const int b = task >> 8, cg = (task >> 5) & 7, j = task & 31, ch = cg * 128 + 2 * lane;
        float h0 = 0.f, h1 = 0.f;
        { unsigned ca[31], cu[31];
#pragma unroll
          for (int jj = 0; jj < 31; ++jj) { const size_t row = (size_t)b * SEQ + 64 * (jj < j ? jj : 0) + 63; ca[jj] = *(const unsigned*)(LA + row * 1024 + ch); cu[jj] = *(const unsigned*)(LU + row * 1024 + ch); }
#pragma unroll
          for (int jj = 0; jj < 31; ++jj) { h0 = jj < j ? bflo(ca[jj]) * h0 + bflo(cu[jj]) : h0; h1 = jj < j ? bfhi(ca[jj]) * h1 + bfhi(cu[jj]) : h1; } }
        float hv0 = 0.f, hv1 = 0.f;
        for (int t0 = 0; t0 < 64; t0 += 16) {
            unsigned a[16], u[16], y[16];
#pragma unroll
            for (int q = 0; q < 16; ++q) { const size_t row = (size_t)b * SEQ + 64 * j + t0 + q; a[q] = *(const unsigned*)(LA + row * 1024 + ch); u[q] = *(const unsigned*)(LU + row * 1024 + ch); y[q] = *(const unsigned*)(P + row * NP + C_YA + ch); }
#pragma unroll
            for (int q = 0; q < 16; ++q) { const size_t row = (size_t)b * SEQ + 64 * j + t0 + q; hv0 = bflo(a[q]) * h0 + bflo(u[q]); hv1 = bfhi(a[q]) * h1 + bfhi(u[q]);
                *(unsigned*)(BR + row * BW + ch) = pk2(hv0 * bflo(y[q]), hv1 * bfhi(y[q])); }
        }
        if (j == 31) *(f32x2*)(F.out + O_LH_P + ((size_t)l * NBATCH + b) * 1024 + ch) = (f32x2){hv0, hv1};
    }
    for (int i = gw * 64 + lane; i < MS * 1024; i += NGW * 64) { const int s = i >> 10, ch = i & 1023; const size_t row = MP + s;
        const float hp = F.in[I_SLH][((size_t)l * 128 + s) * 1024 + ch]; const float h = bf2f(LA[row * 1024 + ch]) * hp + bf2f(LU[row * 1024 + ch]);
        F.out[O_LH_S + ((size_t)l * 128 + s) * 1024 + ch] = h; BR[row * BW + ch] = (bf16)f2bf(h * bf2f(P[row * NP + C_YA + ch])); }
}

constexpr int NCHUNK_WG = 128;
__device__ __forceinline__ void phase_mix(const Frame& F0, int l) {
    Frame F = launder(F0);
    const int w = F.c;
    if (w < 32) chunk_unit<0, 0>(F, l, w);
    else if (w < 64) chunk_unit<1, 0>(F, l, w - 32);
    else if (w < 128) chunk_unit<2, 0>(F, l, w - 64);
    else { const int cs = w - NCHUNK_WG, ns = F.G - NCHUNK_WG;
        samp_run<0>(F, l, cs, ns, 1024); samp_run<1>(F, l, cs, ns, 1024); samp_run<2>(F, l, cs, ns, 2048);
        lru_fix(F, l, cs * NWAVES + F.wave, ns * NWAVES); }
}

__device__ __forceinline__ void phase_post(const Frame& F0, int l) {
    Frame F = launder(F0);
    const bf16* P = WSP(bf16, WS_P);
    const bf16* LA = WSP(bf16, WS_X1); const bf16* LU = LA + (size_t)M * 1024;
    bf16* BR = WSP(bf16, WS_BR);
    const int gt = F.c * NTHR + F.tid, NGT = F.G * NTHR, gw = F.c * NWAVES + F.wave, NGW = F.G * NWAVES, lane = F.lane;
    for (int task0 = gw; task0 < MR * 3; task0 += 2 * NGW) {
        v4u xin[2][2], gin[2][2]; int rowv[2], brv[2]; bool ok[2];
#pragma unroll
        for (int q = 0; q < 2; ++q) { const int task = task0 + q * NGW; ok[q] = task < MR * 3; const int tk = ok[q] ? task : task0; rowv[q] = tk / 3; brv[q] = tk - rowv[q] * 3;
            const v4u* src = (const v4u*)(WSP(bf16, WS_OB + (size_t)brv[q] * SZ_O) + (size_t)rowv[q] * 1024 + 16 * lane); xin[q][0] = __builtin_nontemporal_load(src); xin[q][1] = __builtin_nontemporal_load(src + 1);
            const int gcol = (brv[q] == 0) ? C_HGG : (brv[q] == 1 ? C_SZ : C_RG);
            const v4u* gp = (const v4u*)(P + (size_t)rowv[q] * NP + gcol + 16 * lane); gin[q][0] = __builtin_nontemporal_load(gp); gin[q][1] = __builtin_nontemporal_load(gp + 1); }
#pragma unroll
        for (int q = 0; q < 2; ++q) { if (!ok[q]) continue;
            const int row = rowv[q], br = brv[q];
            const unsigned xw_[8] = {xin[q][0].x, xin[q][0].y, xin[q][0].z, xin[q][0].w, xin[q][1].x, xin[q][1].y, xin[q][1].z, xin[q][1].w};
            const unsigned gw_[8] = {gin[q][0].x, gin[q][0].y, gin[q][0].z, gin[q][0].w, gin[q][1].x, gin[q][1].y, gin[q][1].z, gin[q][1].w};
            float x[16], gt_[16], o[16];
#pragma unroll
            for (int i = 0; i < 8; ++i) { x[2 * i] = bflo(xw_[i]); x[2 * i + 1] = bfhi(xw_[i]); gt_[2 * i] = bflo(gw_[i]); gt_[2 * i + 1] = bfhi(gw_[i]); }
            if (br == 1) {
                float ss = 0.f;
#pragma unroll
                for (int j = 0; j < 16; ++j) { x[j] *= gt_[j]; ss += x[j] * x[j]; }
#pragma unroll
                for (int m = 1; m < 32; m <<= 1) ss += __shfl_xor(ss, m);
                const float rs = __builtin_amdgcn_rsqf(ss * (1.f / 512.f) + EPS); const float* nw = F.in[I_SNW] + (size_t)l * 1024 + 16 * lane;
#pragma unroll
                for (int j = 0; j < 16; ++j) o[j] = x[j] * rs * nw[j];
            } else {
                float ss = 0.f;
#pragma unroll
                for (int j = 0; j < 16; ++j) ss += x[j] * x[j];
#pragma unroll
                for (int m = 1; m < 8; m <<= 1) ss += __shfl_xor(ss, m);
                const float rs = __builtin_amdgcn_rsqf(ss * (1.f / 128.f) + EPS);
                if (br == 0) { const float* nw = F.in[I_HGNW] + (size_t)l * 128 + ((16 * lane) & 127);
#pragma unroll
                    for (int j = 0; j < 16; ++j) o[j] = x[j] * rs * nw[j] * gt_[j]; }
                else {
#pragma unroll
                    for (int j = 0; j < 16; ++j) o[j] = x[j] * rs * gt_[j]; }
            }
            v4u w0, w1; w0.x = pk2(o[0], o[1]); w0.y = pk2(o[2], o[3]); w0.z = pk2(o[4], o[5]); w0.w = pk2(o[6], o[7]); w1.x = pk2(o[8], o[9]); w1.y = pk2(o[10], o[11]); w1.z = pk2(o[12], o[13]); w1.w = pk2(o[14], o[15]);
            v4u* dst = (v4u*)(BR + (size_t)(br + 1) * M * BW + (size_t)row * BW + 16 * lane); dst[0] = w0; dst[1] = w1;
        }
    }
}

__device__ __forceinline__ void phase_act(const Frame& F0, int l) {
    Frame F = launder(F0);
    const bf16* UV = WSP(bf16, WS_P); bf16* A2 = WSP(bf16, WS_G);
    const float* cw = F.in[I_FCW] + (size_t)l * 3 * DFF; const float* cb = F.in[I_FCB] + (size_t)l * DFF;
    const int gt = F.c * NTHR + F.tid, NGT = F.G * NTHR;
    constexpr int C8 = DFF / 8;
    for (int i = gt; i < M * C8; i += NGT) {
        const int row = i / C8, c = (i - row * C8) * 8;
        v4u outw = (v4u){0u, 0u, 0u, 0u};
        if (row < MR) {
            const v4u uw = *(const v4u*)(UV + (size_t)row * NUV + c), vw = *(const v4u*)(UV + (size_t)row * NUV + DFF + c);
            float u0[8] = {bflo(uw.x), bfhi(uw.x), bflo(uw.y), bfhi(uw.y), bflo(uw.z), bfhi(uw.z), bflo(uw.w), bfhi(uw.w)};
            const float vv[8] = {bflo(vw.x), bfhi(vw.x), bflo(vw.y), bfhi(vw.y), bflo(vw.z), bfhi(vw.z), bflo(vw.w), bfhi(vw.w)};
            float u1[8], u2[8];
#pragma unroll
            for (int j = 0; j < 8; ++j) { u1[j] = 0.f; u2[j] = 0.f; }
            if (row < MP) { const int t = row & (SEQ - 1);
                if (t >= 1) { const v4u w = *(const v4u*)(UV + (size_t)(row - 1) * NUV + c); u1[0] = bflo(w.x); u1[1] = bfhi(w.x); u1[2] = bflo(w.y); u1[3] = bfhi(w.y); u1[4] = bflo(w.z); u1[5] = bfhi(w.z); u1[6] = bflo(w.w); u1[7] = bfhi(w.w); }
                if (t >= 2) { const v4u w = *(const v4u*)(UV + (size_t)(row - 2) * NUV + c); u2[0] = bflo(w.x); u2[1] = bfhi(w.x); u2[2] = bflo(w.y); u2[3] = bfhi(w.y); u2[4] = bflo(w.z); u2[5] = bfhi(w.z); u2[6] = bflo(w.w); u2[7] = bfhi(w.w); }
                if (t >= SEQ - 2) { float* so = F.out + O_FC_P + (((size_t)l * NBATCH + (row >> 11)) * 2 + (t - (SEQ - 2))) * DFF + c;
#pragma unroll
                    for (int j = 0; j < 8; ++j) so[j] = u0[j]; }
            } else { const int s = row - MP; const float* st = F.in[I_SFC] + ((size_t)l * MS + s) * 2 * DFF + c; float* so = F.out + O_FC_S + ((size_t)l * MS + s) * 2 * DFF + c;
#pragma unroll
                for (int j = 0; j < 8; ++j) { u2[j] = st[j]; u1[j] = st[DFF + j]; so[j] = st[DFF + j]; so[DFF + j] = u0[j]; } }
            float a[8];
#pragma unroll
            for (int j = 0; j < 8; ++j) { const float y = cb[c + j] + cw[c + j] * u2[j] + cw[DFF + c + j] * u1[j] + cw[2 * DFF + c + j] * u0[j]; a[j] = geluf(y) * vv[j]; }
            outw.x = pk2(a[0], a[1]); outw.y = pk2(a[2], a[3]); outw.z = pk2(a[4], a[5]); outw.w = pk2(a[6], a[7]);
        }
        *(v4u*)(A2 + (size_t)row * DFF + c) = outw;
    }
}

template <int KIND>
__device__ __forceinline__ void samp_gemm(const Frame& F0, int l) {
    Frame F = launder(F0);
    if (F.c >= 256) return;
    const int rb = F.c >> 5, cb = F.c & 31, w = F.wave, ct = w & 3, kh = w >> 2, fr = F.lane & 15, g = F.lane >> 4;
    const int nrow = 64 * cb + 16 * ct + fr;
    const size_t arow = (size_t)MP + 16 * rb + fr;
    f32x4 tot = (f32x4){0.f, 0.f, 0.f, 0.f};
    constexpr int NSEG = (KIND == 0) ? 4 : 1;
    constexpr int KH = (KIND == 0) ? 512 : (KIND == 1 ? 1024 : 2816);
    constexpr int BPS = KH / 256, NBT = NSEG * BPS;
    unsigned gq[4][4];
    if (KIND == 0) {
#pragma unroll
        for (int seg = 0; seg < 4; ++seg)
#pragma unroll
            for (int reg = 0; reg < 4; ++reg) gq[seg][reg] = WSP(bf16, WS_G)[((size_t)MP + 16 * rb + 4 * g + reg) * NG + seg * 2048 + 64 * cb + 16 * ct + fr];
    }
    auto ptrs = [&](int seg, const bf16*& ap, const bf16*& bp) {
        if (KIND == 0) { ap = WSP(bf16, WS_BR) + (size_t)seg * M * BW + arow * BW + kh * KH + 8 * g; bp = WSP(bf16, WS_WB + l * SZ_WB) + (size_t)seg * DM * BW + (size_t)nrow * BW + kh * KH + 8 * g; }
        else if (KIND == 1) { ap = WSP(bf16, WS_MG) + arow * DM + kh * KH + 8 * g; bp = WSP(bf16, WS_WO + l * SZ_WO) + (size_t)nrow * DM + kh * KH + 8 * g; }
        else { ap = WSP(bf16, WS_G) + arow * DFF + kh * KH + 8 * g; bp = WSP(bf16, WS_WD + l * SZ_WD) + (size_t)nrow * DFF + kh * KH + 8 * g; }
    };
    auto ldb = [&](int bt, bf16x8 (&x)[8], bf16x8 (&y)[8]) {
        const bf16* ap; const bf16* bp; ptrs(bt / BPS, ap, bp); const int k0 = (bt % BPS) * 256;
#pragma unroll
        for (int i = 0; i < 8; ++i) { x[i] = *(const bf16x8*)(ap + k0 + 32 * i); y[i] = *(const bf16x8*)(bp + k0 + 32 * i); }
    };
    f32x4 a0 = (f32x4){0.f, 0.f, 0.f, 0.f}, a1 = a0;
    auto mmb = [&](int bt, const bf16x8 (&x)[8], const bf16x8 (&y)[8]) {
#pragma unroll
        for (int i = 0; i < 4; ++i) { a0 = __builtin_amdgcn_mfma_f32_16x16x32_bf16(x[2 * i], y[2 * i], a0, 0, 0, 0); a1 = __builtin_amdgcn_mfma_f32_16x16x32_bf16(x[2 * i + 1], y[2 * i + 1], a1, 0, 0, 0); }
        if ((bt % BPS) == BPS - 1) { a0 += a1;
            if (KIND == 0) {
#pragma unroll
                for (int reg = 0; reg < 4; ++reg) a0[reg] *= bflo(gq[bt / BPS][reg]); }
            tot += a0; a0 = (f32x4){0.f, 0.f, 0.f, 0.f}; a1 = a0; }
    };
    bf16x8 xA[8], yA[8], xB[8], yB[8];
    ldb(0, xA, yA);
#pragma unroll
    for (int bt = 0; bt < NBT; bt += 2) {
        if (bt + 1 < NBT) ldb(bt + 1, xB, yB);
        __builtin_amdgcn_sched_barrier(0);
        mmb(bt, xA, yA);
        __builtin_amdgcn_sched_barrier(0);
        if (bt + 2 < NBT) ldb(bt + 2, xA, yA);
        __builtin_amdgcn_sched_barrier(0);
        if (bt + 1 < NBT) mmb(bt + 1, xB, yB);
        __builtin_amdgcn_sched_barrier(0);
    }
    LAS f32x4* RED = (LAS f32x4*)F.lds;
    if (kh == 1) RED[ct * 64 + F.lane] = tot;
    __syncthreads();
    if (kh == 0) {
        tot += RED[ct * 64 + F.lane];
#pragma unroll
        for (int reg = 0; reg < 4; ++reg) { const size_t row = (size_t)MP + 16 * rb + 4 * g + reg; const int d = 64 * cb + 16 * ct + fr;
            if (KIND == 0) WSP(bf16, WS_MG)[row * DM + d] = (bf16)f2bf(tot[reg]);
            else { const float x = bf2f((KIND == 1 ? WSP(bf16, WS_XB0) : WSP(bf16, WS_XB1))[row * DM + d]) + tot[reg];
                (KIND == 1 ? WSP(bf16, WS_XB1) : WSP(bf16, WS_XB0))[row * DM + d] = (bf16)f2bf(x);
                float ss = x * x;
#pragma unroll
                for (int o = 1; o < 16; o <<= 1) ss += __shfl_xor(ss, o);
                if (fr == 0) rss_add((u64*)(F.ws + WS_RSS + (size_t)(2 * l + KIND) * SZ_RSS), row, ss); } }
    }
    __syncthreads();
}

constexpr int G_GEMM1 = 249, G_UP = 242;
constexpr int PH_PER_LAYER = 8, NPHASE = 1 + NLAYER * PH_PER_LAYER + 1;
__global__ void __launch_bounds__(NTHR, 2) mk_fwd(Args args) {
    extern __shared__ __attribute__((aligned(16))) unsigned char lds_raw[];
    Frame F;
    F.lds = (LAS unsigned char*)lds_raw;
    F.tid = threadIdx.x; F.lane = F.tid & 63; F.wave = __builtin_amdgcn_readfirstlane(F.tid >> 6);
    F.G = gridDim.x; F.c = blockIdx.x;
    F.in = args.in; F.out = args.out; F.ws = args.ws;
    volatile LAS unsigned* MISC = (volatile LAS unsigned*)(F.lds + LDSCTL_OFF);
    if (F.tid < 64) MISC[F.tid] = 0u;
    __syncthreads();
    unsigned* barw = (unsigned*)(F.ws + WS_CTL) + 4096;
    XcdBarrier bar; bar.bar = barw; bar.x = 0; bar.st = nullptr;
    if (!MK_SPLIT) bar = xcd_barrier_post(barw, MISC + 8);
    const int lo = args.ph_lo, hi = args.ph_hi;
#define IN(k) (lo <= (k) && (k) < hi)
#define SEAM(k) do { if (IN(k) && IN((k) + 1)) xcd_barrier(bar); } while (0)
#define XB0 WSP(bf16, WS_XB0)
#define XB1 WSP(bf16, WS_XB1)
#define RSSB(j) ((u64*)(F.ws + WS_RSS + (size_t)(j) * SZ_RSS))
#define GEMM_RUN(EPI) do { pg8::gemm_phase<EPI, pg8::TileOrder>(F.lds, g, S, E); if (REP_G > 1) { Frame F1 = launder(F); pg8::gemm_phase<EPI, pg8::TileOrder>(F1.lds, g, S, E); } } while (0)

    if (IN(0) && !(SKMASK & 1)) { phase_prologue(F); } SEAM(0);

    for (int l = 0; l < NLAYER; ++l) {
        const int pb = 1 + l * PH_PER_LAYER;
        if (IN(pb + 0) && !(SKMASK & 2)) { const Frame F0 = F; Frame F = launder(F0);
            pg8::Gemm g{XB0, WSP(bf16, WS_W1 + l * SZ_W1), DM, DM, DM, 0, 0, 256, 0}; pg8::TileOrder S; S.init(M, N1, G_GEMM1, F.c, 1);
            Epi1 E{WSP(bf16, WS_P), WSP(float, WS_HF), WSP(float, WS_DT), WSP(bf16, WS_G), WSP(float, WS_LB) + l * 1024, RSSB(2 * l)};
            if (F.c < G_GEMM1) GEMM_RUN(Epi1);
            else tr_run<true>(F0, l == 0 ? S0 : S2, l == 0 ? S1 : S3, (F.c - G_GEMM1) * NWAVES + F.wave, (F.G - G_GEMM1) * NWAVES);
        } SEAM(pb + 0);
        if (IN(pb + 1) && !(SKMASK & 4)) { phase_conv(F, l); } SEAM(pb + 1);
        if (IN(pb + 2) && !(SKMASK & 8)) { phase_mix(F, l); } SEAM(pb + 2);
        if (IN(pb + 3) && !(SKMASK & 16)) { phase_post(F, l); } SEAM(pb + 3);
        if (IN(pb + 4) && !(SKMASK & 32)) { const Frame F0 = F; Frame F = launder(F0);
            pg8::Gemm g{WSP(bf16, WS_BR), WSP(bf16, WS_WB + l * SZ_WB), BW, BW, BW, (size_t)M * BW, (size_t)DM * BW, 256, 0}; pg8::TileOrder S; S.init(MP, DM, F.G, F.c, 4);
            EpiBr E{WSP(bf16, WS_G), WSP(bf16, WS_MG)};
            GEMM_RUN(EpiBr);
            samp_gemm<0>(F, l);
        } SEAM(pb + 4);
        if (IN(pb + 5) && !(SKMASK & 64)) { const Frame F0 = F; Frame F = launder(F0);
            pg8::Gemm g{WSP(bf16, WS_MG), WSP(bf16, WS_WO + l * SZ_WO), DM, DM, DM, 0, 0, 256, 0}; pg8::TileOrder S; S.init(MP, DM, F.G, F.c, 1);
            EpiRes E{XB0, XB1, RSSB(2 * l + 1)};
            GEMM_RUN(EpiRes);
            samp_gemm<1>(F, l);
        } SEAM(pb + 5);
        if (IN(pb + 6) && !(SKMASK & 128)) { const Frame F0 = F; Frame F = launder(F0);
            pg8::Gemm g{XB1, WSP(bf16, WS_WUV + l * SZ_WUV), DM, DM, DM, 0, 0, 254, -2}; pg8::TileOrder S; S.init(M, NUV, G_UP, F.c, 1);
            EpiAct E{WSP(bf16, WS_G), RSSB(2 * l + 1), F.in[I_FCW] + (size_t)l * 3 * DFF, F.in[I_FCB] + (size_t)l * DFF, F.in[I_SFC] + (size_t)l * MS * 2 * DFF,
                     F.out + O_FC_P + (size_t)l * NBATCH * 2 * DFF, F.out + O_FC_S + (size_t)l * MS * 2 * DFF, F.lds};
            if (F.c < G_UP) GEMM_RUN(EpiAct);
            else tr_run<true>(F0, l == 0 ? S1 : S3, l == 0 ? S2 : NIT_ALL, (F.c - G_UP) * NWAVES + F.wave, (F.G - G_UP) * NWAVES);
        } SEAM(pb + 6);
        if (IN(pb + 7) && !(SKMASK & 256)) { const Frame F0 = F; Frame F = launder(F0);
            pg8::Gemm g{WSP(bf16, WS_G), WSP(bf16, WS_WD + l * SZ_WD), DFF, DFF, DFF, 0, 0, 256, 0}; pg8::TileOrder S; S.init(MP, DM, F.G, F.c, 1);
            EpiRes E{XB1, XB0, RSSB(2 * l + 2)};
            GEMM_RUN(EpiRes);
            samp_gemm<2>(F, l);
        } SEAM(pb + 7);
    }
    if (IN(NPHASE - 1) && !(SKMASK & 1024)) { phase_final(F, WSP(bf16, WS_XB0), F.in[I_GFIN]); }
#undef IN
#undef SEAM
#undef XB0
#undef XB1
#undef RSSB
#undef GEMM_RUN
}

extern "C" void kernel_launch(void* const* d_in, const int* in_sizes, int n_in, void* d_out, int out_size, void* d_ws, size_t ws_size, hipStream_t stream) {
    static int grid = 0;
    if (grid == 0) {
        if (n_in != N_INPUTS || (size_t)out_size != O_END || ws_size < WS_END) { fprintf(stderr, "kernel_launch: unexpected shapes: n_in %d out %d ws %zu (need %zu)\n", n_in, out_size, ws_size, (size_t)WS_END); grid = -1; return; }
        int dev = 0, cus = 0, per_cu = 0;
        if (hipGetDevice(&dev) != hipSuccess || hipDeviceGetAttribute(&cus, hipDeviceAttributeMultiprocessorCount, dev) != hipSuccess) { grid = -1; return; }
        if (hipFuncSetAttribute((const void*)mk_fwd, hipFuncAttributeMaxDynamicSharedMemorySize, LDS_BYTES) != hipSuccess) { fprintf(stderr, "kernel_launch: hipFuncSetAttribute failed\n"); grid = -1; return; }
        if (hipOccupancyMaxActiveBlocksPerMultiprocessor(&per_cu, (const void*)mk_fwd, NTHR, LDS_BYTES) != hipSuccess || per_cu < 1) { fprintf(stderr, "kernel_launch: occupancy query says %d\n", per_cu); }
        (void)hipGetLastError();
        grid = cus;
    }
    if (grid < 0) return;
    (void)hipMemsetAsync((char*)d_ws + WS_CTL, 0, CTL_BYTES, stream);
    Args a{};
    for (int i = 0; i < N_INPUTS; ++i) a.in[i] = (const float*)d_in[i];
    a.out = (float*)d_out; a.ws = (unsigned char*)d_ws;
#if MK_SPLIT
    for (int p = 0; p < NPHASE; ++p) { a.ph_lo = p; a.ph_hi = p + 1; hipLaunchKernelGGL(mk_fwd, dim3(grid), dim3(NTHR), LDS_BYTES, stream, a); }
#else
    a.ph_lo = 0; a.ph_hi = NPHASE;
    hipLaunchKernelGGL(mk_fwd, dim3(grid), dim3(NTHR), LDS_BYTES, stream, a);
#endif
}
```

```cpp
#include <hip/hip_runtime.h>
#include <cstdio>
#include <cstdint>

#ifndef REP_G
#define REP_G 1
#endif
#ifndef PROBE_UNIT
#define PROBE_UNIT 0
#endif
#ifndef PROBE_NWG
#define PROBE_NWG 224
#endif
#ifndef REP_CONV
#define REP_CONV 1
#endif
#ifndef REP_MIX
#define REP_MIX 1
#endif
#ifndef REP_POST
#define REP_POST 1
#endif
#ifndef SKMASK
#define SKMASK 0
#endif
#ifndef MK_SPLIT
#define MK_SPLIT 0
#endif

namespace pg8 {
#define PG8_LAS __attribute__((address_space(3)))
typedef unsigned short bf16_t;
typedef short bf16x8 __attribute__((ext_vector_type(8)));
typedef float f32x4 __attribute__((ext_vector_type(4)));
typedef unsigned u32x4 __attribute__((ext_vector_type(4)));
constexpr int BM = 256, BK = 64, HALF = 128, HTB = HALF * BK * 2, STAGE_BYTES = 8 * HTB, NXCD = 8, WGM = 8;

__host__ __device__ __forceinline__ int lds_byte(int r, int c) { const int st = (r >> 4) * 2 + (c >> 5), rr = r & 15, cc = c & 31, ob = rr * 64 + cc * 2; return st * 1024 + (ob ^ (((ob >> 9) & 1) << 5)); }
__host__ __device__ __forceinline__ void stage_rc(int b, int& R, int& C) { const int st = b / 1024, sb = b % 1024, swz = sb ^ (((sb >> 9) & 1) << 5); R = (st >> 1) * 16 + swz / 64; C = (st & 1) * 32 + (swz % 64) / 2; }
__host__ __device__ __forceinline__ int perm32(int rho) { const int n = rho >> 4, i = rho & 15; return 8 * (i >> 2) + 4 * n + (i & 3); }

struct Unit { int pm, pn, kz; };
struct Gemm { const bf16_t* A; const bf16_t* Bt; int lda, ldb, K; size_t azs, bzs; int prs, pr0; };

struct TileOrder {
    int nM, nN, nwg, G, c, nkz;
    __device__ void init(int M, int N, int G_, int c_, int nkz_) { nM = M / BM; nN = N / BM; nwg = nM * nN; G = G_; c = c_; nkz = nkz_; }
    __device__ bool next(int i, Unit& u) const {
        const int ti = i / nkz; u.kz = i - ti * nkz;
        const long L = (long)ti * G + c; if (L >= nwg) return false;
        int wgid = (int)L; { const int q = nwg / NXCD, r = nwg % NXCD, xcd = wgid % NXCD, off = wgid / NXCD; wgid = (xcd < r ? xcd * (q + 1) : r * (q + 1) + (xcd - r) * q) + off; }
        const int nig = WGM * nN, gid = wgid / nig, fm = gid * WGM, gsz = (nM - fm) < WGM ? (nM - fm) : WGM;
        u.pm = fm + ((wgid % nig) % gsz); u.pn = (wgid % nig) / gsz; return true;
    }
};

typedef __bf16 bf16x2_t __attribute__((ext_vector_type(2)));
typedef float f32x2_t __attribute__((ext_vector_type(2)));
__device__ __forceinline__ unsigned cvt_pk_bf16(float lo, float hi) { const bf16x2_t r = __builtin_convertvector((f32x2_t){lo, hi}, bf16x2_t); return __builtin_bit_cast(unsigned, r); }

template <class Epi, class Sched, bool ALIGN_EPI = true>
__device__ __forceinline__ void gemm_phase(PG8_LAS unsigned char* lds, const Gemm g, const Sched& S, const Epi& E) {
    int tid = threadIdx.x; asm volatile("" : "+v"(tid));
    const int wid = __builtin_amdgcn_readfirstlane(tid >> 6), lane = tid & 63, wr = wid >> 2, wc = wid & 3, fr = lane & 15, fq = lane >> 4;
    const int K = g.K, nt = K / BK;
    unsigned voffA[2], voffB[2];
#pragma unroll
    for (int i = 0; i < 2; ++i) { int R, C; stage_rc(tid * 16 + i * 8192, R, C); const int Rb = Epi::PERM ? ((R & ~31) + perm32(R & 31)) : R;
        voffA[i] = (unsigned)(R * g.lda + C) * 2u; voffB[i] = (unsigned)(Rb * g.ldb + C) * 2u; }
    const size_t kstep = (size_t)(BK * 2);
    const size_t hstepA = (size_t)HALF * g.lda * 2, hstepB = (size_t)HALF * g.ldb * 2;
    const size_t tstepB = 2 * hstepB;
    const unsigned ldsw = (unsigned)wid * 1024u;
    const int aoff = lds_byte(wr * 64 + fr, fq * 8), boff = lds_byte(wc * 32 + fr, fq * 8);
#define PG8_SA(b, h) (((b) * 2 + (h)) * HTB)
#define PG8_SB(b, h) ((4 + (b) * 2 + (h)) * HTB)
#define PG8_STAGE(bufoff, gbase, voff) do { _Pragma("unroll") for (int _i = 0; _i < 2; ++_i) \
        __builtin_amdgcn_global_load_lds((const unsigned*)((const char*)(gbase) + (voff)[_i]), (PG8_LAS unsigned*)(lds + (bufoff) + ldsw + _i * 8192), 16, 0, 0); } while (0)
#define PG8_LDA(dst, b, h) do { _Pragma("unroll") for (int m = 0; m < 4; ++m) _Pragma("unroll") for (int k = 0; k < 2; ++k) dst[m][k] = *(const PG8_LAS bf16x8*)(lds + PG8_SA(b, h) + aoff + m * 2048 + k * 1024); } while (0)
#define PG8_LDB(dst, b, h) do { _Pragma("unroll") for (int n = 0; n < 2; ++n) _Pragma("unroll") for (int k = 0; k < 2; ++k) dst[n][k] = *(const PG8_LAS bf16x8*)(lds + PG8_SB(b, h) + boff + n * 2048 + k * 1024); } while (0)
#define PG8_MMA(ai, bj, At, Bt) do { __builtin_amdgcn_s_setprio(1); _Pragma("unroll") for (int m = 0; m < 4; ++m) _Pragma("unroll") for (int n = 0; n < 2; ++n) _Pragma("unroll") for (int k = 0; k < 2; ++k) \
        acc[ai][bj][m][n] = __builtin_amdgcn_mfma_f32_16x16x32_bf16(Bt[n][k], At[m][k], acc[ai][bj][m][n], 0, 0, 0); __builtin_amdgcn_s_setprio(0); } while (0)
#define PG8_WAIT_V(n) asm volatile("s_waitcnt vmcnt(" #n ")" ::: "memory")
#define PG8_WAIT_L(n) asm volatile("s_waitcnt lgkmcnt(" #n ")" ::: "memory")
#define PG8_BAR __builtin_amdgcn_s_barrier()
#define PG8_SCHED __builtin_amdgcn_sched_barrier(0)
    Unit cur, nxt; int ui = 0;
    if (!S.next(0, cur)) return;
    f32x4 acc[2][2][4][2];
#pragma unroll
    for (int a = 0; a < 2; ++a)
#pragma unroll
        for (int b = 0; b < 2; ++b)
#pragma unroll
            for (int m = 0; m < 4; ++m)
#pragma unroll
                for (int n = 0; n < 2; ++n) acc[a][b][m][n] = (f32x4){0.f, 0.f, 0.f, 0.f};
    bf16x8 At[4][2], B0[2][2], B1[2][2];
    const char* cA = (const char*)g.A + (ptrdiff_t)((size_t)cur.kz * g.azs * 2) + ((ptrdiff_t)cur.pm * g.prs + g.pr0) * (ptrdiff_t)g.lda * 2;
    const char* cB = (const char*)g.Bt + (size_t)cur.kz * g.bzs * 2 + (size_t)cur.pn * tstepB;
    PG8_STAGE(PG8_SB(0, 0), cB, voffB); PG8_STAGE(PG8_SB(0, 1), cB + hstepB, voffB); PG8_STAGE(PG8_SA(0, 0), cA, voffA); PG8_STAGE(PG8_SA(0, 1), cA + hstepA, voffA);
    if (wr == 1) PG8_BAR;
    PG8_WAIT_V(2); PG8_BAR;
    PG8_STAGE(PG8_SB(1, 0), cB + kstep, voffB); PG8_STAGE(PG8_SA(1, 0), cA + kstep, voffA); PG8_STAGE(PG8_SB(1, 1), cB + hstepB + kstep, voffB);
    PG8_WAIT_V(6); PG8_BAR;
    for (;;) {
        const bool has_next = S.next(ui + 1, nxt);
        const char* nA = has_next ? (const char*)g.A + (ptrdiff_t)((size_t)nxt.kz * g.azs * 2) + ((ptrdiff_t)nxt.pm * g.prs + g.pr0) * (ptrdiff_t)g.lda * 2 : cA;
        const char* nB = has_next ? (const char*)g.Bt + (size_t)nxt.kz * g.bzs * 2 + (size_t)nxt.pn * tstepB : cB;
        for (int t = 0; t < nt; t += 2) {
            const bool last = (t == nt - 2);
            const char* a1 = cA + (size_t)(t + 1) * kstep;
            const char* a2 = last ? nA : cA + (size_t)(t + 2) * kstep; const char* b2 = last ? nB : cB + (size_t)(t + 2) * kstep;
            const char* a3 = a2 + kstep; const char* b3 = b2 + kstep;
            PG8_LDB(B0, 0, 0); PG8_LDB(B1, 0, 1); PG8_SCHED; PG8_LDA(At, 0, 0); PG8_STAGE(PG8_SA(1, 1), a1 + hstepA, voffA);
            PG8_WAIT_V(8); PG8_WAIT_L(0); PG8_BAR; PG8_MMA(0, 0, At, B0); PG8_MMA(0, 1, At, B1); PG8_BAR; PG8_SCHED;
            PG8_LDA(At, 0, 1); PG8_STAGE(PG8_SB(0, 0), b2, voffB); PG8_STAGE(PG8_SB(0, 1), b2 + hstepB, voffB); PG8_STAGE(PG8_SA(0, 0), a2, voffA);
            PG8_WAIT_V(8); PG8_WAIT_L(0); PG8_BAR; PG8_MMA(1, 0, At, B0); PG8_MMA(1, 1, At, B1); PG8_BAR; PG8_SCHED;
            PG8_LDB(B0, 1, 0); PG8_LDB(B1, 1, 1); PG8_SCHED; PG8_LDA(At, 1, 0); PG8_STAGE(PG8_SA(0, 1), a2 + hstepA, voffA);
            PG8_WAIT_V(8); PG8_WAIT_L(0); PG8_BAR; PG8_MMA(0, 0, At, B0); PG8_MMA(0, 1, At, B1); PG8_BAR; PG8_SCHED;
            PG8_LDA(At, 1, 1); PG8_STAGE(PG8_SB(1, 0), b3, voffB); PG8_STAGE(PG8_SB(1, 1), b3 + hstepB, voffB); PG8_STAGE(PG8_SA(1, 0), a3, voffA);
            PG8_WAIT_V(8); PG8_WAIT_L(0); PG8_BAR; PG8_MMA(1, 0, At, B0); PG8_MMA(1, 1, At, B1); PG8_BAR; PG8_SCHED;
        }
        if constexpr (ALIGN_EPI) { if (wr == 0) PG8_BAR; }
        E(acc, cur, wr, wc, fr, fq);
        if (!has_next) break;
        if (!E.keep(cur)) {
#pragma unroll
            for (int a = 0; a < 2; ++a)
#pragma unroll
                for (int b = 0; b < 2; ++b)
#pragma unroll
                    for (int m = 0; m < 4; ++m)
#pragma unroll
                        for (int n = 0; n < 2; ++n) acc[a][b][m][n] = (f32x4){0.f, 0.f, 0.f, 0.f};
        }
        cur = nxt; cA = nA; cB = nB; ++ui;
        if constexpr (ALIGN_EPI) { if (wr == 1) PG8_BAR; }
    }
    PG8_WAIT_V(0);
    if constexpr (!ALIGN_EPI) { if (wr == 0) PG8_BAR; }
    PG8_BAR;
#undef PG8_SA
#undef PG8_SB
#undef PG8_STAGE
#undef PG8_LDA
#undef PG8_LDB
#undef PG8_MMA
#undef PG8_WAIT_V
#undef PG8_WAIT_L
#undef PG8_BAR
#undef PG8_SCHED
}
}

constexpr int NWAVES = 8, NTHR = 512;
constexpr int DM = 2048, NBATCH = 4, SEQ = 2048, MP = NBATCH * SEQ, MS = 128, MR = MP + MS, M = 8448;
constexpr int NLAYER = 2;
constexpr int NIN = 12816, NP = 13056, NG = 8192, N1 = NP + NG;
constexpr int DFF = 5632, NUV = 2 * DFF;
constexpr int BW = 1024;
constexpr float EPS = 1e-6f;
constexpr int C_XA = 0, C_YA = 1024, C_HQ = 2048, C_HF = 3072, C_HI = 4096, C_HGG = 5120, C_SZ = 6144, C_SX = 7168, C_SDT = 8704, C_RQ = 8960, C_RK = 9984, C_RV = 11008, C_RG = 12032;
constexpr int SRC_SPLIT = 8720;
constexpr int SSD_CD = 1536;

enum { I_XP = 0, I_XS, I_SLH, I_SLC, I_SHG, I_SSSD, I_SSC, I_SRET, I_SFC, I_GMIX, I_GFFN, I_WIN, I_LCW, I_LCB, I_LWA, I_LBA, I_LWX, I_LBX, I_LLAM, I_HGLB, I_HGNW,
       I_SCW, I_SCB, I_SDTB, I_SALOG, I_SD, I_SNW, I_WBR, I_WGATE, I_WOUT, I_WUP, I_WVAL, I_FCW, I_FCB, I_WDOWN, I_GFIN, N_INPUTS };

constexpr size_t O_YP = 0, O_YS = O_YP + (size_t)MP * DM, O_LH_P = O_YS + (size_t)MS * DM, O_LH_S = O_LH_P + 2 * 4 * 1024, O_LC_P = O_LH_S + 2 * 128 * 1024,
    O_LC_S = O_LC_P + 2 * 4 * 3 * 1024, O_HG_P = O_LC_S + 2 * 128 * 3 * 1024, O_HG_S = O_HG_P + (size_t)2 * 4 * 8 * 16384, O_SSD_P = O_HG_S + (size_t)2 * 128 * 8 * 16384,
    O_SSD_S = O_SSD_P + (size_t)2 * 4 * 16 * 8192, O_SC_P = O_SSD_S + (size_t)2 * 128 * 16 * 8192, O_SC_S = O_SC_P + 2 * 4 * 3 * 1536, O_RET_P = O_SC_S + 2 * 128 * 3 * 1536,
    O_RET_S = O_RET_P + (size_t)2 * 4 * 8 * 16384, O_FC_P = O_RET_S + (size_t)2 * 128 * 8 * 16384, O_FC_S = O_FC_P + 2 * 4 * 2 * 5632, O_END = O_FC_S + (size_t)2 * 128 * 2 * 5632;
static_assert(O_END == 126119936ull, "output size");

constexpr size_t AL(size_t x) { return (x + 4095) & ~(size_t)4095; }
constexpr size_t WS_CTL = 0, CTL_BYTES = 1u << 20;
constexpr size_t WS_RSS = 65536, SZ_RSS = (size_t)M * 8;
constexpr float RSS_SCALE = 65536.f, RSS_INV = 1.f / (65536.f * 2048.f);
static_assert(WS_RSS + 5 * SZ_RSS <= CTL_BYTES, "rss buffers inside the zeroed control region");
constexpr size_t SZ_W1 = (size_t)N1 * DM * 2, SZ_WB = (size_t)4 * DM * BW * 2, SZ_WO = (size_t)DM * DM * 2, SZ_WUV = (size_t)NUV * DM * 2, SZ_WD = (size_t)DM * DFF * 2;
constexpr size_t WS_W1 = CTL_BYTES, WS_WB = WS_W1 + 2 * SZ_W1, WS_WO = WS_WB + 2 * SZ_WB, WS_WUV = WS_WO + 2 * SZ_WO, WS_WD = WS_WUV + 2 * SZ_WUV;
constexpr size_t WS_ROPE = WS_WD + 2 * SZ_WD, SZ_ROPE = AL((size_t)2049 * 64 * 8);
constexpr size_t SZ_X = (size_t)M * DM * 4;
constexpr size_t WS_X0 = WS_ROPE + SZ_ROPE, WS_X1 = WS_X0 + SZ_X;
constexpr size_t WS_H = WS_X1 + SZ_X, SZ_H = (size_t)M * DM * 2;
constexpr size_t WS_XB0 = WS_X0, WS_XB1 = WS_X0 + SZ_H;
constexpr size_t WS_P = WS_H + SZ_H, SZ_P = (size_t)M * NP * 2;
constexpr size_t WS_G = WS_P + SZ_P, SZ_G = (size_t)M * NG * 2;
constexpr size_t WS_HF = WS_G + SZ_G, SZ_HF = (size_t)M * 1024 * 4;
constexpr size_t WS_DT = WS_HF + SZ_HF, SZ_DT = AL((size_t)M * 16 * 4);
constexpr size_t WS_OB = WS_DT + SZ_DT, SZ_O = (size_t)M * 1024 * 4;
constexpr size_t WS_BR = WS_OB + 3 * SZ_O, SZ_BR = (size_t)4 * M * BW * 2;
constexpr size_t WS_MG = WS_BR + SZ_BR, SZ_MG = (size_t)M * DM * 2;
constexpr size_t WS_XBC = WS_MG + SZ_MG, SZ_XBC = (size_t)M * SSD_CD * 2;
constexpr size_t WS_LB = WS_XBC + SZ_XBC, SZ_LB = AL((size_t)NLAYER * 1024 * 4);
constexpr size_t WS_END = WS_LB + SZ_LB;
static_assert((size_t)M * NUV * 2 <= SZ_P && (size_t)M * DFF * 2 <= SZ_G && 2 * SZ_O <= SZ_X, "overlays");

constexpr int RING_BYTES = 131072, LDSCTL_OFF = RING_BYTES, LDS_BYTES = 147456;

#define GAS __attribute__((address_space(1)))
#define LAS __attribute__((address_space(3)))
typedef unsigned short bf16;
typedef unsigned v4u __attribute__((ext_vector_type(4)));
typedef unsigned v2u __attribute__((ext_vector_type(2)));
typedef float f32x4 __attribute__((ext_vector_type(4)));
typedef float f32x2 __attribute__((ext_vector_type(2)));
typedef short bf16x8 __attribute__((ext_vector_type(8)));
#define LDS_WAIT() asm volatile("s_waitcnt lgkmcnt(0)" ::: "memory")
__device__ __forceinline__ unsigned f2bf(float f) { unsigned u = __builtin_bit_cast(unsigned, f); return (u + 0x7fffu + ((u >> 16) & 1u)) >> 16; }
__device__ __forceinline__ unsigned pk2(float lo, float hi) { return pg8::cvt_pk_bf16(lo, hi); }
__device__ __forceinline__ float bf2f(unsigned short b) { return __uint_as_float(((unsigned)b) << 16); }
__device__ __forceinline__ float bflo(unsigned w) { return __uint_as_float(w << 16); }
__device__ __forceinline__ float bfhi(unsigned w) { return __uint_as_float(w & 0xffff0000u); }
__device__ __forceinline__ float sigm(float x) { return __builtin_amdgcn_rcpf(1.f + __builtin_amdgcn_exp2f(-1.4426950408889634f * x)); }
__device__ __forceinline__ float siluf(float x) { return x * sigm(x); }
__device__ __forceinline__ float geluf(float x) { return x * sigm(1.5957691216057308f * (x + 0.044715f * x * x * x)); }
__device__ __forceinline__ float softplusf(float x) { const float t = __builtin_amdgcn_exp2f(-1.4426950408889634f * fabsf(x));
    const float l1p = t < 0.03f ? t * (1.f - t * (0.5f - t * 0.33333334f)) : 0.6931471805599453f * __builtin_amdgcn_logf(1.f + t); return fmaxf(x, 0.f) + l1p; }

typedef unsigned long long u64;
__device__ __forceinline__ float rstd_of(const u64* rss, size_t row) { return __builtin_amdgcn_rsqf((float)rss[row] * RSS_INV + EPS); }
__device__ __forceinline__ void rss_add(u64* rss, size_t row, float ss) { (void)__hip_atomic_fetch_add(rss + row, (u64)(ss * RSS_SCALE + 0.5f), __ATOMIC_RELAXED, __HIP_MEMORY_SCOPE_AGENT); }

#define XB_TMO      128
#define XB_XCNT(j)  (256  + 64 * (j))
#define XB_XSUB(j)  (1280 + 64 * (j))
#define XB_XGEN(j)  (2304 + 64 * (j))
#define XB_TOP      3328
#define XB_TOPGEN   3392
#define XCD_BAR_WORDS 3456
#define XB_SPIN_CAP (1u << 19)
__device__ __forceinline__ unsigned xb_ld(unsigned* p)              { return __hip_atomic_load(p, __ATOMIC_RELAXED, __HIP_MEMORY_SCOPE_AGENT); }
__device__ __forceinline__ unsigned xb_add(unsigned* p, unsigned v) { return __hip_atomic_fetch_add(p, v, __ATOMIC_RELAXED, __HIP_MEMORY_SCOPE_AGENT); }
__device__ __forceinline__ unsigned xb_xcc_id() { return (unsigned)__builtin_amdgcn_s_getreg((3 << 11) | 20) & 0xFu; }
#define XB_SPIN(cond, bar) do { unsigned _sp = 0; while (cond) { __builtin_amdgcn_s_sleep(16); \
    if ((++_sp & 255u) == 0u) { if (xb_ld(&(bar)[XB_TMO])) break; if (_sp > XB_SPIN_CAP) { atomicAdd(&(bar)[XB_TMO], 1u); break; } } } } while (0)
struct XcdBarrier { unsigned* bar; unsigned x; volatile LAS unsigned* st; };
__device__ __forceinline__ XcdBarrier xcd_barrier_post(unsigned* bar, volatile LAS unsigned* st) {
    XcdBarrier b; b.bar = bar; b.x = xb_xcc_id(); b.st = st;
    if (threadIdx.x == 0) (void)xb_add(&bar[XB_XCNT(b.x)], 1u);
    return b;
}
__device__ __forceinline__ void xcd_barrier_complete(unsigned* bar, unsigned x, unsigned& nloc, unsigned& nx) {
    const unsigned G = gridDim.x * gridDim.y * gridDim.z;
    unsigned sum, cnt, mine, sp = 0u;
    for (;;) {
        sum = 0u; cnt = 0u; mine = 0u;
#pragma unroll
        for (unsigned j = 0; j < 16; ++j) { const unsigned c = xb_ld(&bar[XB_XCNT(j)]); sum += c; cnt += (c > 0u) ? 1u : 0u; mine = (j == x) ? c : mine; }
        if (sum == G) break;
        __builtin_amdgcn_s_sleep(1);
        if ((++sp & 255u) == 0u) { if (xb_ld(&bar[XB_TMO])) break; if (sp > XB_SPIN_CAP) { atomicAdd(&bar[XB_TMO], 1u); break; } }
    }
    nloc = mine > 0u ? mine : 1u; nx = cnt > 0u ? cnt : 1u;
}
__device__ __forceinline__ void xcd_barrier(const XcdBarrier& b) {
    asm volatile("s_waitcnt vmcnt(0)" ::: "memory");
    __syncthreads();
    if (threadIdx.x == 0) {
        unsigned* bar = b.bar;
        __builtin_amdgcn_s_waitcnt(0);
        unsigned nloc = b.st[0], nx = b.st[1];
        if (nloc == 0u) { xcd_barrier_complete(bar, b.x, nloc, nx); b.st[0] = nloc; b.st[1] = nx; }
        const unsigned old = xb_add(&bar[XB_XSUB(b.x)], 1u);
        const unsigned gen = old / nloc;
        if (old + 1u == (gen + 1u) * nloc) {
            __builtin_amdgcn_fence(__ATOMIC_RELEASE, "agent");
            asm volatile("s_waitcnt vmcnt(0)" ::: "memory");
            const unsigned og = xb_add(&bar[XB_TOP], 1u);
            const unsigned tg = og / nx;
            if (og + 1u == (tg + 1u) * nx) xb_add(&bar[XB_TOPGEN], 1u);
            else XB_SPIN(xb_ld(&bar[XB_TOPGEN]) == tg, bar);
            __builtin_amdgcn_fence(__ATOMIC_ACQUIRE, "agent");
            xb_add(&bar[XB_XGEN(b.x)], 1u);
            asm volatile("s_waitcnt vmcnt(0)" ::: "memory");
        } else {
            XB_SPIN(xb_ld(&bar[XB_XGEN(b.x)]) == gen, bar);
            __builtin_amdgcn_fence(__ATOMIC_ACQUIRE, "agent");
            asm volatile("s_waitcnt vmcnt(0)" ::: "memory");
        }
    }
    __syncthreads();
}

struct Args { const float* in[N_INPUTS]; float* out; unsigned char* ws; int ph_lo, ph_hi; };

struct Frame {
    LAS unsigned char* lds;
    int tid, lane, wave, G, c;
    const float* const* in;
    float* out;
    unsigned char* ws;
};
#define WSP(T, off) ((T*)(F.ws + (off)))
__device__ __forceinline__ Frame launder(const Frame& F0) {
    Frame F = F0;
    asm volatile("" : "+v"(F.tid), "+v"(F.lane));
    asm volatile("" : "+s"(F.wave), "+s"(F.G), "+s"(F.c));
    { int z = 0; asm volatile("" : "+s"(z)); F.in += z; F.out += z; F.ws += z; }
    asm volatile("" : "+s"(F.lds));
    return F;
}

using pg8::f32x4;
using pg8::Unit;
using pg8::cvt_pk_bf16;

struct Epi1 {
    static constexpr bool PERM = true;
    bf16* P; float* HF; float* DT; bf16* Gt; const float* LB; const u64* RSS;
    __device__ __forceinline__ bool keep(const Unit&) const { return false; }
    template <int ACT> __device__ __forceinline__ void store_act(f32x4 (&acc)[2][2][4][2], bf16* base, int ld, int row0, int colb) const {
#pragma unroll
        for (int ai = 0; ai < 2; ++ai) { float rs4[4];
#pragma unroll
            for (int m = 0; m < 4; ++m) rs4[m] = rstd_of(RSS, row0 + ai * 128 + m * 16);
#pragma unroll
            for (int m = 0; m < 4; ++m) { bf16* rowp = base + (size_t)(row0 + ai * 128 + m * 16) * ld + colb; const float rs = rs4[m];
#pragma unroll
                for (int bj = 0; bj < 2; ++bj) { f32x4 v0 = acc[ai][bj][m][0] * rs, v1 = acc[ai][bj][m][1] * rs;
#pragma unroll
                    for (int j = 0; j < 4; ++j) { if (ACT == 1) { v0[j] = geluf(v0[j]); v1[j] = geluf(v1[j]); } if (ACT == 2) { v0[j] = siluf(v0[j]); v1[j] = siluf(v1[j]); } if (ACT == 3) { v0[j] = sigm(v0[j]); v1[j] = sigm(v1[j]); } }
                    pg8::u32x4 w; w.x = cvt_pk_bf16(v0[0], v0[1]); w.y = cvt_pk_bf16(v0[2], v0[3]); w.z = cvt_pk_bf16(v1[0], v1[1]); w.w = cvt_pk_bf16(v1[2], v1[3]);
                    *(pg8::u32x4*)(rowp + bj * 128) = w; }
                asm volatile("" ::: "memory"); } }
    }
    __device__ __forceinline__ void operator()(f32x4 (&acc)[2][2][4][2], const Unit& u, int wr, int wc, int fr, int fq) const {
        asm volatile("" : "+v"(fr), "+v"(fq));
        const int row0 = u.pm * 256 + wr * 64 + fr, pn = u.pn;
        if (pn >= 51) { store_act<3>(acc, Gt, NG, row0, (pn - 51) * 256 + wc * 32 + 8 * fq); }
        else if (pn >= 12 && pn < 16) {
            const int colb = (pn - 12) * 256 + wc * 32 + 8 * fq;
#pragma unroll
            for (int bj = 0; bj < 2; ++bj) { const f32x4 l0 = *(const f32x4*)(LB + colb + bj * 128), l1 = *(const f32x4*)(LB + colb + bj * 128 + 4);
#pragma unroll
                for (int ai = 0; ai < 2; ++ai) { float rs4[4];
#pragma unroll
                    for (int m = 0; m < 4; ++m) rs4[m] = rstd_of(RSS, row0 + ai * 128 + m * 16);
#pragma unroll
                    for (int m = 0; m < 4; ++m) { const size_t r = (size_t)(row0 + ai * 128 + m * 16); const float rs = rs4[m];
                        f32x4 v0 = acc[ai][bj][m][0] * rs, v1 = acc[ai][bj][m][1] * rs, g0, g1, k0, k1;
#pragma unroll
                        for (int j = 0; j < 4; ++j) { { const float e = __builtin_amdgcn_exp2f(-1.4426950408889634f * fabsf(v0[j])), r = __builtin_amdgcn_rcpf(1.f + e), sm = e * r, sg = v0[j] >= 0.f ? r : sm, sn = v0[j] >= 0.f ? sm : r; g0[j] = 0.6931471805599453f * __builtin_amdgcn_logf(l0[j] + (1.f - l0[j]) * sg); k0[j] = (1.f - l0[j]) * sn; }
                                                      { const float e = __builtin_amdgcn_exp2f(-1.4426950408889634f * fabsf(v1[j])), r = __builtin_amdgcn_rcpf(1.f + e), sm = e * r, sg = v1[j] >= 0.f ? r : sm, sn = v1[j] >= 0.f ? sm : r; g1[j] = 0.6931471805599453f * __builtin_amdgcn_logf(l1[j] + (1.f - l1[j]) * sg); k1[j] = (1.f - l1[j]) * sn; } }
                        *(f32x4*)(HF + r * 1024 + colb + bj * 128) = g0; *(f32x4*)(HF + r * 1024 + colb + bj * 128 + 4) = g1;
                        pg8::u32x4 w; w.x = cvt_pk_bf16(k0[0], k0[1]); w.y = cvt_pk_bf16(k0[2], k0[3]); w.z = cvt_pk_bf16(k1[0], k1[1]); w.w = cvt_pk_bf16(k1[2], k1[3]);
                        *(pg8::u32x4*)(P + r * NP + C_HF + colb + bj * 128) = w; asm volatile("" ::: "memory"); } } }
        } else if (pn == 34) {
            if (wc == 0 && fq < 2) {
#pragma unroll
                for (int ai = 0; ai < 2; ++ai)
#pragma unroll
                    for (int m = 0; m < 4; ++m) { float* rowp = DT + (size_t)(row0 + ai * 128 + m * 16) * 16 + 8 * fq; const float rs = rstd_of(RSS, row0 + ai * 128 + m * 16);
                        *(f32x4*)(rowp) = acc[ai][0][m][0] * rs; *(f32x4*)(rowp + 4) = acc[ai][0][m][1] * rs; }
            }
        } else {
            const int colb = pn * 256 + wc * 32 + 8 * fq;
            if (pn >= 4 && pn < 8) store_act<1>(acc, P, NP, row0, colb);
            else if ((pn >= 8 && pn < 12) || (pn >= 20 && pn < 28) || pn >= 47) store_act<2>(acc, P, NP, row0, colb);
            else store_act<0>(acc, P, NP, row0, colb);
        }
    }
};

struct SameTile { int n; __device__ bool next(int i, Unit& u) const { if (i >= n) return false; u.pm = 0; u.pn = 0; u.kz = 0; return true; } };
template <bool P_> struct EpiNull {
    static constexpr bool PERM = P_;
    float* sinkp;
    __device__ __forceinline__ bool keep(const Unit&) const { return false; }
    __device__ __forceinline__ void operator()(f32x4 (&acc)[2][2][4][2], const Unit& u, int wr, int wc, int fr, int fq) const {
        float t = 0.f;
#pragma unroll
        for (int ai = 0; ai < 2; ++ai)
#pragma unroll
            for (int bj = 0; bj < 2; ++bj)
#pragma unroll
                for (int m = 0; m < 4; ++m) t += acc[ai][bj][m][0][0] + acc[ai][bj][m][1][3];
        if (t == 1.2345e30f) sinkp[0] = t;
    }
};

struct EpiB {
    static constexpr bool PERM = true;
    bf16* O; int ldc; const u64* RSS;
    __device__ __forceinline__ bool keep(const Unit&) const { return false; }
    __device__ __forceinline__ void operator()(f32x4 (&acc)[2][2][4][2], const Unit& u, int wr, int wc, int fr, int fq) const {
        asm volatile("" : "+v"(fr), "+v"(fq));
        const int row0 = u.pm * 256 + wr * 64 + fr, colb = u.pn * 256 + wc * 32 + 8 * fq;
#pragma unroll
        for (int ai = 0; ai < 2; ++ai)
#pragma unroll
            for (int m = 0; m < 4; ++m) { bf16* rowp = O + (size_t)(row0 + ai * 128 + m * 16) * ldc + colb; const float rs = rstd_of(RSS, row0 + ai * 128 + m * 16);
#pragma unroll
                for (int bj = 0; bj < 2; ++bj) { const f32x4 v0 = acc[ai][bj][m][0] * rs, v1 = acc[ai][bj][m][1] * rs; pg8::u32x4 w;
                    w.x = cvt_pk_bf16(v0[0], v0[1]); w.y = cvt_pk_bf16(v0[2], v0[3]); w.z = cvt_pk_bf16(v1[0], v1[1]); w.w = cvt_pk_bf16(v1[2], v1[3]);
                    *(pg8::u32x4*)(rowp + bj * 128) = w; } }
    }
};

struct EpiBr {
    static constexpr bool PERM = true;
    const bf16* Gt; bf16* O;
    __device__ __forceinline__ bool keep(const Unit& u) const { return u.kz < 3; }
    __device__ __forceinline__ void operator()(f32x4 (&acc)[2][2][4][2], const Unit& u, int wr, int wc, int fr, int fq) const {
        asm volatile("" : "+v"(fr), "+v"(fq));
        const int row0 = u.pm * 256 + wr * 64 + fr, colb = u.pn * 256 + wc * 32 + 8 * fq, kz = u.kz;
#pragma unroll
        for (int ai = 0; ai < 2; ++ai) {
                pg8::u32x4 gav[4][2], gbv[4][2];
#pragma unroll
                for (int mm = 0; mm < 4; ++mm)
#pragma unroll
                    for (int bj = 0; bj < 2; ++bj) { const size_t r = (size_t)(row0 + ai * 128 + mm * 16);
                        gav[mm][bj] = *(const pg8::u32x4*)(Gt + r * NG + kz * 2048 + colb + bj * 128);
                        gbv[mm][bj] = *(const pg8::u32x4*)(Gt + r * NG + (kz < 3 ? kz + 1 : kz) * 2048 + colb + bj * 128); }
#pragma unroll
                for (int mm = 0; mm < 4; ++mm) { const int m = mm; const size_t r = (size_t)(row0 + ai * 128 + m * 16);
#pragma unroll
                    for (int bj = 0; bj < 2; ++bj) {
                        const pg8::u32x4 ga = gav[mm][bj], gb = gbv[mm][bj];
                        float s[8] = {bflo(ga.x), bfhi(ga.x), bflo(ga.y), bfhi(ga.y), bflo(ga.z), bfhi(ga.z), bflo(ga.w), bfhi(ga.w)};
                        if (kz < 3) {
                            const float d[8] = {bflo(gb.x), bfhi(gb.x), bflo(gb.y), bfhi(gb.y), bflo(gb.z), bfhi(gb.z), bflo(gb.w), bfhi(gb.w)};
#pragma unroll
                            for (int j = 0; j < 8; ++j) s[j] = s[j] * __builtin_amdgcn_rcpf(fmaxf(d[j], 1e-20f));
                        }
                        f32x4 v0 = acc[ai][bj][m][0], v1 = acc[ai][bj][m][1];
                        v0[0] *= s[0]; v0[1] *= s[1]; v0[2] *= s[2]; v0[3] *= s[3]; v1[0] *= s[4]; v1[1] *= s[5]; v1[2] *= s[6]; v1[3] *= s[7];
                        acc[ai][bj][m][0] = v0; acc[ai][bj][m][1] = v1;
                        if (kz == 3) { pg8::u32x4 w; w.x = cvt_pk_bf16(v0[0], v0[1]); w.y = cvt_pk_bf16(v0[2], v0[3]); w.z = cvt_pk_bf16(v1[0], v1[1]); w.w = cvt_pk_bf16(v1[2], v1[3]);
                            *(pg8::u32x4*)(O + r * DM + colb + bj * 128) = w; }
                    } }
                asm volatile("" ::: "memory"); }
    }
};

struct EpiRes {
    static constexpr bool PERM = true;
    const bf16* Xc; bf16* Xn; u64* RSS;
    __device__ __forceinline__ bool keep(const Unit&) const { return false; }
    __device__ __forceinline__ void operator()(f32x4 (&acc)[2][2][4][2], const Unit& u, int wr, int wc, int fr, int fq) const {
        asm volatile("" : "+v"(fr), "+v"(fq));
        const int row0 = u.pm * 256 + wr * 64 + fr, col0 = u.pn * 256 + wc * 32 + 8 * fq;
#pragma unroll
        for (int ap = 0; ap < 4; ++ap) { const int ai = ap >> 1, mb = (ap & 1) * 2;
            pg8::u32x4 xw[2][2];
#pragma unroll
            for (int mm = 0; mm < 2; ++mm)
#pragma unroll
                for (int bj = 0; bj < 2; ++bj) xw[mm][bj] = *(const pg8::u32x4*)(Xc + (size_t)(row0 + ai * 128 + (mb + mm) * 16) * DM + col0 + bj * 128);
#pragma unroll
            for (int mm = 0; mm < 2; ++mm) { const int m = mb + mm; const size_t row = (size_t)(row0 + ai * 128 + m * 16), off = row * DM + col0; float ss = 0.f;
#pragma unroll
                for (int bj = 0; bj < 2; ++bj) { const pg8::u32x4 w_ = xw[mm][bj];
                    const f32x4 x0 = (f32x4){bflo(w_.x), bfhi(w_.x), bflo(w_.y), bfhi(w_.y)} + acc[ai][bj][m][0], x1 = (f32x4){bflo(w_.z), bfhi(w_.z), bflo(w_.w), bfhi(w_.w)} + acc[ai][bj][m][1];
                    pg8::u32x4 w; w.x = cvt_pk_bf16(x0[0], x0[1]); w.y = cvt_pk_bf16(x0[2], x0[3]); w.z = cvt_pk_bf16(x1[0], x1[1]); w.w = cvt_pk_bf16(x1[2], x1[3]);
                    *(pg8::u32x4*)(Xn + off + bj * 128) = w;
                    ss += (x0[0] * x0[0] + x0[1] * x0[1]) + (x0[2] * x0[2] + x0[3] * x0[3]) + (x1[0] * x1[0] + x1[1] * x1[1]) + (x1[2] * x1[2] + x1[3] * x1[3]); }
                ss += __shfl_xor(ss, 16); ss += __shfl_xor(ss, 32);
                if (fq == 0) rss_add(RSS, row, ss); }
            asm volatile("" ::: "memory"); }
    }
};

constexpr int XB_OFF = LDSCTL_OFF + 1024;
__device__ __forceinline__ float dpp_ror1(float x) { return __builtin_bit_cast(float, __builtin_amdgcn_update_dpp(0, __builtin_bit_cast(int, x), 0x121, 0xf, 0xf, false)); }
__device__ __forceinline__ float dpp_ror2(float x) { return __builtin_bit_cast(float, __builtin_amdgcn_update_dpp(0, __builtin_bit_cast(int, x), 0x122, 0xf, 0xf, false)); }
struct EpiAct {
    static constexpr bool PERM = true;
    bf16* A2; const u64* RSS; const float* cw; const float* cb; const float* st_in; float* fc_p; float* fc_s; LAS unsigned char* lds;
    __device__ __forceinline__ bool keep(const Unit&) const { return false; }
    __device__ __forceinline__ void operator()(f32x4 (&acc)[2][2][4][2], const Unit& u, int wr, int wc, int fr, int fq) const {
        asm volatile("" : "+v"(fr), "+v"(fq));
        const int R0 = 254 * u.pm - 2, chb = u.pn * 128 + wc * 32 + 8 * fq, wid = wr * 4 + wc;
#pragma unroll
        for (int ai = 0; ai < 2; ++ai)
#pragma unroll
            for (int m = 0; m < 4; ++m) { int R = R0 + 128 * ai + 64 * wr + 16 * m + fr; R = R < 0 ? 0 : (R >= M ? M - 1 : R); const float rs = rstd_of(RSS, R);
                acc[ai][0][m][0] *= rs; acc[ai][0][m][1] *= rs; acc[ai][1][m][0] *= rs; acc[ai][1][m][1] *= rs; }
        LAS f32x4* XB = (LAS f32x4*)(lds + XB_OFF);
        if (fr >= 14) {
#pragma unroll
            for (int ai = 0; ai < 2; ++ai) { const int slot = (((wid * 2 + ai) * 2 + (fr - 14)) * 4 + fq) * 2; XB[slot] = acc[ai][0][3][0]; XB[slot + 1] = acc[ai][0][3][1]; }
        }
        asm volatile("s_waitcnt lgkmcnt(0)" ::: "memory"); __builtin_amdgcn_s_barrier(); asm volatile("" ::: "memory");
        f32x4 w0a = *(const f32x4*)(cw + chb), w0b = *(const f32x4*)(cw + chb + 4), w1a = *(const f32x4*)(cw + DFF + chb), w1b = *(const f32x4*)(cw + DFF + chb + 4);
        f32x4 w2a = *(const f32x4*)(cw + 2 * DFF + chb), w2b = *(const f32x4*)(cw + 2 * DFF + chb + 4), ba = *(const f32x4*)(cb + chb), bb = *(const f32x4*)(cb + chb + 4);
#pragma unroll
        for (int ai = 0; ai < 2; ++ai) {
            f32x4 pva = (f32x4){0.f, 0.f, 0.f, 0.f}, pvb = pva;
            { const int kblk = 2 * ai + wr; if (kblk > 0 && fr >= 14) { const int pai = (kblk - 1) >> 1, pwr = (kblk - 1) & 1, slot = ((((pwr * 4 + wc) * 2 + pai) * 2 + (fr - 14)) * 4 + fq) * 2; pva = XB[slot]; pvb = XB[slot + 1]; } }
#pragma unroll
            for (int m = 0; m < 4; ++m) {
                const f32x4 ua = acc[ai][0][m][0], ub = acc[ai][0][m][1], va = acc[ai][1][m][0], vb = acc[ai][1][m][1];
                const f32x4 qa = (m == 0) ? pva : acc[ai][0][m - 1][0], qb = (m == 0) ? pvb : acc[ai][0][m - 1][1];
                f32x4 p1a, p1b, p2a, p2b;
#pragma unroll
                for (int i = 0; i < 4; ++i) { const float c1a = dpp_ror1(ua[i]), c1b = dpp_ror1(ub[i]), c2a = dpp_ror2(ua[i]), c2b = dpp_ror2(ub[i]);
                    const float d1a = dpp_ror1(qa[i]), d1b = dpp_ror1(qb[i]), d2a = dpp_ror2(qa[i]), d2b = dpp_ror2(qb[i]);
                    p1a[i] = fr >= 1 ? c1a : d1a; p1b[i] = fr >= 1 ? c1b : d1b; p2a[i] = fr >= 2 ? c2a : d2a; p2b[i] = fr >= 2 ? c2b : d2b; }
                const int r = 128 * ai + 64 * wr + 16 * m + fr, R = R0 + r;
                const bool prompt = (r >= 2) && (R >= 0) && (R < MP), samp = (R >= MP) && (R < MR);
                if (prompt) { const int t = R & (SEQ - 1);
                    if (t < 1) { p1a = (f32x4){0.f, 0.f, 0.f, 0.f}; p1b = p1a; } if (t < 2) { p2a = (f32x4){0.f, 0.f, 0.f, 0.f}; p2b = p2a; }
                    if (t >= SEQ - 2) { float* so = fc_p + ((size_t)(R >> 11) * 2 + (t - (SEQ - 2))) * DFF + chb; *(f32x4*)so = ua; *(f32x4*)(so + 4) = ub; } }
                if (samp) { const float* sp = st_in + (size_t)(R - MP) * 2 * DFF + chb; float* so = fc_s + (size_t)(R - MP) * 2 * DFF + chb;
                    p2a = *(const f32x4*)sp; p2b = *(const f32x4*)(sp + 4); p1a = *(const f32x4*)(sp + DFF); p1b = *(const f32x4*)(sp + DFF + 4);
                    *(f32x4*)so = p1a; *(f32x4*)(so + 4) = p1b; *(f32x4*)(so + DFF) = ua; *(f32x4*)(so + DFF + 4) = ub; }
                if (prompt || samp) {
                    const f32x4 ya = ba + w0a * p2a + w1a * p1a + w2a * ua, yb = bb + w0b * p2b + w1b * p1b + w2b * ub;
                    pg8::u32x4 w; w.x = cvt_pk_bf16(geluf(ya[0]) * va[0], geluf(ya[1]) * va[1]); w.y = cvt_pk_bf16(geluf(ya[2]) * va[2], geluf(ya[3]) * va[3]);
                    w.z = cvt_pk_bf16(geluf(yb[0]) * vb[0], geluf(yb[1]) * vb[1]); w.w = cvt_pk_bf16(geluf(yb[2]) * vb[2], geluf(yb[3]) * vb[3]);
                    *(pg8::u32x4*)(A2 + (size_t)R * DFF + chb) = w; }
                asm volatile("" ::: "memory");
            }
        }
    }
};

__device__ __forceinline__ float wave_sum(float v) {
#pragma unroll
    for (int o = 1; o < 64; o <<= 1) v += __shfl_xor(v, o);
    return v;
}
struct TrJob { const float* W; bf16* WT; const float* g; int K, N, ldt, mode, roff, item; };
template <bool NT> __device__ __forceinline__ void tr_load(const TrJob& j, int lane, float (&v)[32]) {
    const int nblk = (j.N + 31) >> 5, kb = j.item / nblk, nb = j.item - kb * nblk, k0 = 64 * kb, n0 = 32 * nb;
    int nn = n0 + (lane & 31); nn = nn < j.N ? nn : j.N - 1;
    const float* p = j.W + (size_t)(k0 + (lane >> 5)) * j.N + nn;
#pragma unroll
    for (int i = 0; i < 32; ++i) v[i] = NT ? __builtin_nontemporal_load(p + (size_t)(2 * i) * j.N) : p[(size_t)(2 * i) * j.N];
}
template <bool NT> __device__ __forceinline__ void tr_store(const TrJob& j, int lane, LAS float* scr, const float (&v)[32]) {
    const int nblk = (j.N + 31) >> 5, kb = j.item / nblk, nb = j.item - kb * nblk, k0 = 64 * kb, n0 = 32 * nb;
#pragma unroll
    for (int i = 0; i < 32; ++i) scr[(2 * i + (lane >> 5)) * 33 + (lane & 31)] = v[i];
    LDS_WAIT(); asm volatile("" ::: "memory");
    const int c = lane & 7;
    float gk[8];
#pragma unroll
    for (int q = 0; q < 8; ++q) gk[q] = j.g ? j.g[k0 + 8 * c + q] : 1.f;
#pragma unroll
    for (int jj = 0; jj < 4; ++jj) { const int n = (lane >> 3) + 8 * jj, gn = n0 + n; const LAS float* s = scr + (8 * c) * 33 + n;
        v4u o; o.x = pk2(s[0 * 33] * gk[0], s[1 * 33] * gk[1]); o.y = pk2(s[2 * 33] * gk[2], s[3 * 33] * gk[3]); o.z = pk2(s[4 * 33] * gk[4], s[5 * 33] * gk[5]); o.w = pk2(s[6 * 33] * gk[6], s[7 * 33] * gk[7]);
        if (gn < j.N) { const int dr = (j.mode == 1) ? (gn < SRC_SPLIT ? gn : gn + 240) : (j.mode >= 2 ? (gn >> 7) * 256 + (gn & 127) + (j.mode == 3 ? 128 : 0) : gn + j.roff); v4u* wp = (v4u*)(j.WT + (size_t)dr * j.ldt + k0 + 8 * c); if (NT) __builtin_nontemporal_store(o, wp); else *wp = o; } }
    LDS_WAIT(); asm volatile("" ::: "memory");
}
constexpr int I_IN = (DM / 64) * ((NIN + 31) / 32), I_GT = (DM / 64) * (NG / 32), I_BR = (BW / 64) * (DM / 32), I_OUT = (DM / 64) * (DM / 32), I_UP = (DM / 64) * (DFF / 32), I_DN = (DFF / 64) * (DM / 32);
constexpr int I_LAYER = I_IN + I_GT + 4 * I_BR + I_OUT + 2 * I_UP + I_DN;
__device__ __forceinline__ TrJob tr_decode(const Frame& F, int it) {
    const int l = it / I_LAYER; int r = it - l * I_LAYER; TrJob j;
    bf16* W1 = WSP(bf16, WS_W1 + l * SZ_W1);
    if (r < I_IN) { j = TrJob{F.in[I_WIN] + (size_t)l * DM * NIN, W1, F.in[I_GMIX] + (size_t)l * DM, DM, NIN, DM, 1, 0, r}; return j; } r -= I_IN;
    if (r < I_GT) { j = TrJob{F.in[I_WGATE] + (size_t)l * DM * NG, W1, F.in[I_GMIX] + (size_t)l * DM, DM, NG, DM, 0, NP, r}; return j; } r -= I_GT;
    if (r < 4 * I_BR) { const int k = r / I_BR; j = TrJob{F.in[I_WBR] + ((size_t)l * 4 + k) * BW * DM, WSP(bf16, WS_WB + l * SZ_WB) + (size_t)k * DM * BW, nullptr, BW, DM, BW, 0, 0, r - k * I_BR}; return j; } r -= 4 * I_BR;
    if (r < I_OUT) { j = TrJob{F.in[I_WOUT] + (size_t)l * DM * DM, WSP(bf16, WS_WO + l * SZ_WO), nullptr, DM, DM, DM, 0, 0, r}; return j; } r -= I_OUT;
    if (r < I_UP) { j = TrJob{F.in[I_WUP] + (size_t)l * DM * DFF, WSP(bf16, WS_WUV + l * SZ_WUV), F.in[I_GFFN] + (size_t)l * DM, DM, DFF, DM, 2, 0, r}; return j; } r -= I_UP;
    if (r < I_UP) { j = TrJob{F.in[I_WVAL] + (size_t)l * DM * DFF, WSP(bf16, WS_WUV + l * SZ_WUV), F.in[I_GFFN] + (size_t)l * DM, DM, DFF, DM, 3, 0, r}; return j; } r -= I_UP;
    j = TrJob{F.in[I_WDOWN] + (size_t)l * DFF * DM, WSP(bf16, WS_WD + l * SZ_WD), nullptr, DFF, DM, DFF, 0, 0, r}; return j;
}

template <bool NT> __device__ __forceinline__ void tr_run(const Frame& F0, int it_lo, int it_hi, int gw, int NGW) {
    Frame F = launder(F0);
    LAS float* scr = (LAS float*)(F.lds + F.wave * 8704);
    {
        const int NIT = it_hi;
        int it = it_lo + gw; TrJob j0, j1, j2; float r0[32], r1[32], r2[32];
        j0 = j1 = j2 = tr_decode(F, it < NIT ? it : it_lo);
        if (it < NIT) { tr_load<NT>(j0, F.lane, r0); }
        if (it + NGW < NIT) { j1 = tr_decode(F, it + NGW); tr_load<NT>(j1, F.lane, r1); }
        while (it < NIT) {
            if (it + 2 * NGW < NIT) { j2 = tr_decode(F, it + 2 * NGW); tr_load<NT>(j2, F.lane, r2); }
            tr_store<NT>(j0, F.lane, scr, r0);
            it += NGW; if (it >= NIT) break;
            if (it + 2 * NGW < NIT) { j0 = tr_decode(F, it + 2 * NGW); tr_load<NT>(j0, F.lane, r0); }
            tr_store<NT>(j1, F.lane, scr, r1);
            it += NGW; if (it >= NIT) break;
            if (it + 2 * NGW < NIT) { j1 = tr_decode(F, it + 2 * NGW); tr_load<NT>(j1, F.lane, r1); }
            tr_store<NT>(j2, F.lane, scr, r2);
            it += NGW;
        }
    }
}
constexpr int SIDE_A = 5000, SIDE_B = 5400, NIT_ALL = NLAYER * I_LAYER;
constexpr int S3 = NIT_ALL - I_DN, S2 = S3 - SIDE_A, S1 = S2 - SIDE_B, S0 = S1 - SIDE_A;
static_assert(S2 >= NIT_ALL - I_DN - I_UP, "GEMM1(1) side items must be needed after GEMM1(1) only (val weights)");
__device__ __forceinline__ void phase_prologue(const Frame& F0) {
    Frame F = launder(F0);
    const int gw = F.c * NWAVES + F.wave, NGW = F.G * NWAVES;
    tr_run<false>(F, 0, S0, gw, NGW);
    const int gt = F.c * NTHR + F.tid, NGT = F.G * NTHR;
    for (int i = gt; i < NLAYER * 240 * (DM / 8); i += NGT) { const int l = i / (240 * (DM / 8)), r = i - l * (240 * (DM / 8));
        *(v4u*)(WSP(bf16, WS_W1 + l * SZ_W1) + (size_t)(SRC_SPLIT + r / (DM / 8)) * DM + (r % (DM / 8)) * 8) = (v4u){0u, 0u, 0u, 0u}; }
    for (int i = gt; i < NLAYER * 1024; i += NGT) { const int l = i >> 10, c = i & 1023; WSP(float, WS_LB)[i] = l == 0 ? 0.f : sigm(F.in[I_HGLB][1024 + c] - F.in[I_HGLB][c]); }
    for (int i = gt; i < 2049 * 64; i += NGT) { const int p = i >> 6, j = i & 63; const float pos = p < 2048 ? (float)p : 16384.f;
        const float fr = __builtin_amdgcn_exp2f(-(float)j * (13.287712379549449f / 64.f)); const float ang = pos * fr;
        double rev = (double)ang * 0.15915494309189535; rev -= floor(rev); const float fx = (float)rev;
        WSP(f32x2, WS_ROPE)[i] = (f32x2){__builtin_amdgcn_cosf(fx), __builtin_amdgcn_sinf(fx)}; }
    for (int row = gw; row < M; row += NGW) {
        v2u* ho = (v2u*)(WSP(bf16, WS_XB0) + (size_t)row * DM) + F.lane;
        const f32x4* xi = row < MP ? (const f32x4*)F.in[I_XP] + (size_t)row * (DM / 4) + F.lane : (const f32x4*)F.in[I_XS] + (size_t)(row < MR ? row - MP : 0) * (DM / 4) + F.lane;
        float ss = 0.f;
#pragma unroll
        for (int j = 0; j < 8; ++j) { f32x4 v = xi[64 * j]; if (row >= MR) v = (f32x4){0.f, 0.f, 0.f, 0.f};
            ho[64 * j] = (v2u){pk2(v.x, v.y), pk2(v.z, v.w)}; ss += (v.x * v.x + v.y * v.y) + (v.z * v.z + v.w * v.w); }
        ss = wave_sum(ss);
        if (F.lane == 0 && row < MR) ((u64*)(F.ws + WS_RSS))[row] = (u64)(ss * RSS_SCALE + 0.5f);
        if (row >= MR) { v2u* h1 = (v2u*)(WSP(bf16, WS_XB1) + (size_t)row * DM) + F.lane;
#pragma unroll
            for (int j = 0; j < 8; ++j) h1[64 * j] = (v2u){0u, 0u}; }
    }
}

__device__ __forceinline__ void phase_final(const Frame& F0, const bf16* X, const float* g) {
    Frame F = launder(F0);
    const int gw = F.c * NWAVES + F.wave, NGW = F.G * NWAVES;
    for (int row = gw; row < MR; row += NGW) {
        const v2u* xr = (const v2u*)(X + (size_t)row * DM) + F.lane;
        f32x4* o = (f32x4*)(F.out + (row < MP ? O_YP + (size_t)row * DM : O_YS + (size_t)(row - MP) * DM)) + F.lane;
        const float rstd = rstd_of((const u64*)(F.ws + WS_RSS + 4 * SZ_RSS), row);
#pragma unroll
        for (int j = 0; j < 8; ++j) { const f32x4 gv = ((const f32x4*)g)[F.lane + 64 * j]; const v2u w = xr[64 * j];
            __builtin_nontemporal_store((f32x4){bflo(w.x), bfhi(w.x), bflo(w.y), bfhi(w.y)} * rstd * gv, o + 64 * j); }
    }
}

constexpr size_t WS_HGQ = WS_BR + (size_t)M * BW * 2;
static_assert(2 * (size_t)MP * 1024 * 2 + 3 * 128 * 1024 * 4 <= 3 * (size_t)M * BW * 2, "HGQ overlay");
constexpr size_t HGQ_STRIDE = (size_t)MP * 1024;
constexpr int LW_STR = 136;
constexpr int L_WT = 0, L_XC = 256 * LW_STR * 2, L_XCF = L_XC + 64 * LW_STR * 2, LXF_STR = 132;
static_assert(L_XCF + 64 * LXF_STR * 4 <= RING_BYTES, "lru lds");
__device__ __forceinline__ void lru_stage_w(const Frame& F0, int l, int n) {
    Frame F = launder(F0);
    LAS bf16* WT = (LAS bf16*)(F.lds + L_WT);
    const float* wa = F.in[I_LWA] + ((size_t)l * 8 + n) * 16384; const float* wx = F.in[I_LWX] + ((size_t)l * 8 + n) * 16384;
#pragma unroll 1
    for (int i0 = F.tid; i0 < 16384; i0 += 8 * NTHR) { float va[8], vx[8];
#pragma unroll
        for (int q = 0; q < 8; ++q) { va[q] = wa[i0 + q * NTHR]; vx[q] = wx[i0 + q * NTHR]; }
#pragma unroll
        for (int q = 0; q < 8; ++q) { const int i = i0 + q * NTHR, c = i >> 7, d = i & 127; WT[d * LW_STR + c] = (bf16)f2bf(va[q]); WT[(128 + d) * LW_STR + c] = (bf16)f2bf(vx[q]); } }
}
__device__ __forceinline__ void lru_tile(const Frame& F0, int l, int n, int tt) {
    Frame F = launder(F0);
    LAS bf16* WT = (LAS bf16*)(F.lds + L_WT); LAS bf16* XC = (LAS bf16*)(F.lds + L_XC); LAS float* XCF = (LAS float*)(F.lds + L_XCF);
    const bf16* P = WSP(bf16, WS_P);
    const float* cw = F.in[I_LCW] + (size_t)l * 4 * 1024; const float* cb = F.in[I_LCB] + (size_t)l * 1024;
    {
        const int tk = F.tid >> 3, c0 = (F.tid & 7) * 16, row = tt * 64 + tk, ch0 = n * 128 + c0;
        float acc[16];
#pragma unroll
        for (int j = 0; j < 16; ++j) acc[j] = cb[ch0 + j];
        if (row < MP) {
            const int t = row & (SEQ - 1);
#pragma unroll
            for (int jj = 0; jj < 4; ++jj) { if (t - 3 + jj >= 0) { const v4u* src = (const v4u*)(P + (size_t)(row - 3 + jj) * NP + C_XA + ch0); const v4u a = src[0], b = src[1];
                const unsigned w[8] = {a.x, a.y, a.z, a.w, b.x, b.y, b.z, b.w}; const float* wj = cw + jj * 1024 + ch0;
#pragma unroll
                for (int q = 0; q < 8; ++q) { acc[2 * q] += wj[2 * q] * bflo(w[q]); acc[2 * q + 1] += wj[2 * q + 1] * bfhi(w[q]); } } }
        } else if (row < MR) {
            const int s = row - MP; const float* st = F.in[I_SLC] + ((size_t)l * 128 + s) * 3 * 1024 + ch0;
#pragma unroll
            for (int jj = 0; jj < 3; ++jj) { const float* wj = cw + jj * 1024 + ch0;
#pragma unroll
                for (int q = 0; q < 16; ++q) acc[q] += wj[q] * st[jj * 1024 + q]; }
            const v4u* src = (const v4u*)(P + (size_t)row * NP + C_XA + ch0); const v4u a = src[0], b = src[1];
            const unsigned w[8] = {a.x, a.y, a.z, a.w, b.x, b.y, b.z, b.w}; const float* wj = cw + 3 * 1024 + ch0;
#pragma unroll
            for (int q = 0; q < 8; ++q) { acc[2 * q] += wj[2 * q] * bflo(w[q]); acc[2 * q + 1] += wj[2 * q + 1] * bfhi(w[q]); }
        }
#pragma unroll
        for (int q = 0; q < 16; ++q) { XCF[tk * LXF_STR + c0 + q] = acc[q]; }
#pragma unroll
        for (int q = 0; q < 8; ++q) *(LAS unsigned*)(XC + tk * LW_STR + c0 + 2 * q) = pk2(acc[2 * q], acc[2 * q + 1]);
    }
    __syncthreads();
    const int w = F.wave, lane = F.lane, fr = lane & 15, g = lane >> 4;
    f32x4 ar[4], ai_[4];
#pragma unroll
    for (int rt = 0; rt < 4; ++rt) { ar[rt] = (f32x4){0.f, 0.f, 0.f, 0.f}; ai_[rt] = (f32x4){0.f, 0.f, 0.f, 0.f}; }
#pragma unroll
    for (int ks = 0; ks < 4; ++ks) {
        const bf16x8 br = *(const LAS bf16x8*)(WT + (16 * w + fr) * LW_STR + 32 * ks + 8 * g);
        const bf16x8 bi = *(const LAS bf16x8*)(WT + (128 + 16 * w + fr) * LW_STR + 32 * ks + 8 * g);
#pragma unroll
        for (int rt = 0; rt < 4; ++rt) { const bf16x8 a = *(const LAS bf16x8*)(XC + (16 * rt + fr) * LW_STR + 32 * ks + 8 * g);
            ar[rt] = __builtin_amdgcn_mfma_f32_16x16x32_bf16(a, br, ar[rt], 0, 0, 0); ai_[rt] = __builtin_amdgcn_mfma_f32_16x16x32_bf16(a, bi, ai_[rt], 0, 0, 0); }
    }
    const int d = 16 * w + fr, ch = n * 128 + d;
    const float ba = F.in[I_LBA][(size_t)l * 1024 + ch], bx = F.in[I_LBX][(size_t)l * 1024 + ch], sp = softplusf(-F.in[I_LLAM][(size_t)l * 1024 + ch]);
    bf16* LA = WSP(bf16, WS_X1); bf16* LU = LA + (size_t)M * 1024;
    const bool scan = (tt < 128);
    float CA = 1.f, CU = 0.f;
#pragma unroll
    for (int rt = 0; rt < 4; ++rt) {
        float A[4], U[4];
#pragma unroll
        for (int reg = 0; reg < 4; ++reg) { const int tk = 16 * rt + 4 * g + reg;
            const float r = sigm(ar[rt][reg] + ba), iv = sigm(ai_[rt][reg] + bx), la = -8.f * r * sp, a = __expf(la), xc = XCF[tk * LXF_STR + d];
            const float tq = -2.f * la, om = tq < 0.25f ? tq * (1.f + tq * (-0.5f + tq * (0.16666667f + tq * (-0.041666668f + tq * 0.0083333338f)))) : 1.f - __expf(-tq);
            A[reg] = a; U[reg] = __builtin_amdgcn_sqrtf(fmaxf(om, 0.f)) * (iv * xc); }
        if (scan) {
#pragma unroll
            for (int reg = 1; reg < 4; ++reg) { U[reg] = A[reg] * U[reg - 1] + U[reg]; A[reg] = A[reg] * A[reg - 1]; }
            float PA = 1.f, PU = 0.f, TA = 1.f, TU = 0.f;
#pragma unroll
            for (int src = 0; src < 4; ++src) { const float sa = __shfl(A[3], fr + 16 * src), su = __shfl(U[3], fr + 16 * src);
                if (src < g) { PU = sa * PU + su; PA = sa * PA; }
                TU = sa * TU + su; TA = sa * TA; }
            const float GA = PA * CA, GU = PA * CU + PU;
#pragma unroll
            for (int reg = 0; reg < 4; ++reg) { U[reg] = A[reg] * GU + U[reg]; A[reg] = A[reg] * GA; }
            CU = TA * CU + TU; CA = TA * CA;
        }
#pragma unroll
        for (int reg = 0; reg < 4; ++reg) { const size_t row = (size_t)tt * 64 + 16 * rt + 4 * g + reg; const unsigned wau = pk2(A[reg], U[reg]); LA[row * 1024 + ch] = (bf16)(wau & 0xffffu); LU[row * 1024 + ch] = (bf16)(wau >> 16); }
    }
    __syncthreads();
}
__device__ __forceinline__ void phase_conv(const Frame& F00, int l) {
    Frame F0 = launder(F00);
    { const int n = F0.c & 7; bool staged = false;
      for (int tt = F0.c >> 3; tt < 130; tt += (F0.G >> 3)) { if (!staged) { lru_stage_w(F0, l, n); __syncthreads(); staged = true; } lru_tile(F0, l, n, tt); } }
    Frame F = launder(F0);
    const bf16* P = WSP(bf16, WS_P);
    const int gt = F.c * NTHR + F.tid, NGT = F.G * NTHR;
    { const float* cw = F.in[I_SCW] + (size_t)l * 4 * SSD_CD; const float* cb = F.in[I_SCB] + (size_t)l * SSD_CD; bf16* XBC = WSP(bf16, WS_XBC);
      for (int i = gt; i < (MP / 16) * (SSD_CD / 8); i += NGT) { const int run = i / (SSD_CD / 8), c = (i - run * (SSD_CD / 8)) * 8, r0 = run * 16, t0 = r0 & (SEQ - 1);
          v4u rows[19];
#pragma unroll
          for (int k = 0; k < 19; ++k) { const int rr = r0 - 3 + k; rows[k] = *(const v4u*)(P + (size_t)(rr < 0 ? 0 : rr) * NP + C_SX + c); }
          float w[4][8], bias[8];
#pragma unroll
          for (int q = 0; q < 8; ++q) { bias[q] = cb[c + q]; w[0][q] = cw[c + q]; w[1][q] = cw[SSD_CD + c + q]; w[2][q] = cw[2 * SSD_CD + c + q]; w[3][q] = cw[3 * SSD_CD + c + q]; }
#pragma unroll
          for (int k = 0; k < 16; ++k) { float acc[8];
#pragma unroll
              for (int q = 0; q < 8; ++q) acc[q] = bias[q];
#pragma unroll
              for (int jj = 0; jj < 4; ++jj) { if (t0 + k - 3 + jj >= 0) { const v4u a = rows[k + jj]; const unsigned ww[4] = {a.x, a.y, a.z, a.w};
#pragma unroll
                  for (int q = 0; q < 4; ++q) { acc[2 * q] += w[jj][2 * q] * bflo(ww[q]); acc[2 * q + 1] += w[jj][2 * q + 1] * bfhi(ww[q]); } } }
              v4u o; o.x = pk2(siluf(acc[0]), siluf(acc[1])); o.y = pk2(siluf(acc[2]), siluf(acc[3])); o.z = pk2(siluf(acc[4]), siluf(acc[5])); o.w = pk2(siluf(acc[6]), siluf(acc[7]));
              *(v4u*)(XBC + (size_t)(r0 + k) * SSD_CD + c) = o; } }
      for (int i = gt; i < MS * (SSD_CD / 8); i += NGT) { const int s_ = i / (SSD_CD / 8), c = (i - s_ * (SSD_CD / 8)) * 8; const size_t row = (size_t)MP + s_;
          float acc[8];
#pragma unroll
          for (int q = 0; q < 8; ++q) acc[q] = cb[c + q];
          const float* st = F.in[I_SSC] + ((size_t)l * 128 + s_) * 3 * SSD_CD + c;
#pragma unroll
          for (int jj = 0; jj < 3; ++jj) { const float* wj = cw + jj * SSD_CD + c;
#pragma unroll
              for (int q = 0; q < 8; ++q) acc[q] += wj[q] * st[jj * SSD_CD + q]; }
          const v4u a = *(const v4u*)(P + row * NP + C_SX + c); const unsigned ww[4] = {a.x, a.y, a.z, a.w}; const float* wj = cw + 3 * SSD_CD + c;
#pragma unroll
          for (int q = 0; q < 4; ++q) { acc[2 * q] += wj[2 * q] * bflo(ww[q]); acc[2 * q + 1] += wj[2 * q + 1] * bfhi(ww[q]); }
          v4u o; o.x = pk2(siluf(acc[0]), siluf(acc[1])); o.y = pk2(siluf(acc[2]), siluf(acc[3])); o.z = pk2(siluf(acc[4]), siluf(acc[5])); o.w = pk2(siluf(acc[6]), siluf(acc[7]));
          *(v4u*)(XBC + row * SSD_CD + c) = o; } }
    { const int gw = F.c * NWAVES + F.wave, NGW = F.G * NWAVES, lane = F.lane; const float* LOGF = WSP(float, WS_HF);
      bf16* HGQ = WSP(bf16, WS_HGQ); float* HGE = (float*)(WSP(bf16, WS_HGQ) + 2 * HGQ_STRIDE);
      for (int tk = gw; tk < NBATCH * 32 * 8; tk += NGW) {
          const int b = tk >> 8, c = (tk >> 3) & 31, h = tk & 7; const size_t r0 = (size_t)b * SEQ + 64 * c; const int col = h * 128 + 2 * lane;
          f32x2 cs[64];
#pragma unroll
          for (int t = 0; t < 64; ++t) cs[t] = *(const f32x2*)(LOGF + (r0 + t) * 1024 + col);
#pragma unroll
          for (int t = 1; t < 64; ++t) cs[t] += cs[t - 1];
          const f32x2 beta = cs[31], bC = cs[63];
#pragma unroll
          for (int hb = 0; hb < 4; ++hb) {
              unsigned qv[16], kv[16];
#pragma unroll
              for (int t = 0; t < 16; ++t) { const size_t row = r0 + 16 * hb + t; qv[t] = *(const unsigned*)(P + row * NP + C_HQ + col); kv[t] = *(const unsigned*)(P + row * NP + C_HF + col); }
#pragma unroll
              for (int t = 0; t < 16; ++t) { const size_t row = r0 + 16 * hb + t; const f32x2 cc = cs[16 * hb + t]; const float q0 = bflo(qv[t]), q1 = bfhi(qv[t]), k0 = bflo(kv[t]), k1 = bfhi(kv[t]);
                  *(unsigned*)(HGQ + row * 1024 + col) = pk2(q0 * __expf(fminf(cc.x - beta.x, 80.f)), q1 * __expf(fminf(cc.y - beta.y, 80.f)));
                  *(unsigned*)(HGQ + HGQ_STRIDE + row * 1024 + col) = pk2(k0 * __expf(fminf(beta.x - cc.x, 80.f)), k1 * __expf(fminf(beta.y - cc.y, 80.f))); } }
          *(f32x2*)(HGE + (size_t)(b * 32 + c) * 1024 + col) = (f32x2){__expf(bC.x), __expf(bC.y)};
          *(f32x2*)(HGE + (size_t)128 * 1024 + (size_t)(b * 32 + c) * 1024 + col) = (f32x2){__expf(bC.x - beta.x), __expf(bC.y - beta.y)};
          *(f32x2*)(HGE + (size_t)256 * 1024 + (size_t)(b * 32 + c) * 1024 + col) = (f32x2){__expf(beta.x), __expf(beta.y)};
      } }
    { bf16* RQK = WSP(bf16, WS_H);
      for (int i0 = gt; i0 < MP * 64; i0 += 2 * NGT) {
          v4u ld[2][8];
#pragma unroll
          for (int q = 0; q < 2; ++q) { const int i = i0 + q * NGT < MP * 64 ? i0 + q * NGT : i0; const int row = i >> 6, h = (i >> 3) & 7, sg = i & 7, t = row & (SEQ - 1);
              const bf16* rp = P + (size_t)row * NP + h * 128;
              ld[q][0] = *(const v4u*)(rp + C_RQ + 8 * sg); ld[q][1] = *(const v4u*)(rp + C_RQ + 64 + 8 * sg); ld[q][2] = *(const v4u*)(rp + C_RK + 8 * sg); ld[q][3] = *(const v4u*)(rp + C_RK + 64 + 8 * sg);
              const v4u* cp = (const v4u*)(WSP(f32x2, WS_ROPE) + (size_t)t * 64 + 8 * sg); ld[q][4] = cp[0]; ld[q][5] = cp[1]; ld[q][6] = cp[2]; ld[q][7] = cp[3]; }
#pragma unroll
          for (int q = 0; q < 2; ++q) { const int i = i0 + q * NGT; if (i >= MP * 64) continue; const int row = i >> 6, h = (i >> 3) & 7, sg = i & 7;
              const unsigned q1w[4] = {ld[q][0].x, ld[q][0].y, ld[q][0].z, ld[q][0].w}, q2w[4] = {ld[q][1].x, ld[q][1].y, ld[q][1].z, ld[q][1].w}, k1w[4] = {ld[q][2].x, ld[q][2].y, ld[q][2].z, ld[q][2].w}, k2w[4] = {ld[q][3].x, ld[q][3].y, ld[q][3].z, ld[q][3].w};
              const unsigned csw[16] = {ld[q][4].x, ld[q][4].y, ld[q][4].z, ld[q][4].w, ld[q][5].x, ld[q][5].y, ld[q][5].z, ld[q][5].w, ld[q][6].x, ld[q][6].y, ld[q][6].z, ld[q][6].w, ld[q][7].x, ld[q][7].y, ld[q][7].z, ld[q][7].w};
              unsigned qa[4], qb[4], ka[4], kb[4]; const float ksc = 0.08838834764831845f;
#pragma unroll
              for (int j = 0; j < 4; ++j) {
                  const float cc0 = __uint_as_float(csw[4 * j]), ss0 = __uint_as_float(csw[4 * j + 1]), cc1 = __uint_as_float(csw[4 * j + 2]), ss1 = __uint_as_float(csw[4 * j + 3]);
                  const float a0 = bflo(q1w[j]), a1 = bfhi(q1w[j]), b0 = bflo(q2w[j]), b1 = bfhi(q2w[j]), e0 = bflo(k1w[j]), e1 = bfhi(k1w[j]), f0 = bflo(k2w[j]), f1 = bfhi(k2w[j]);
                  qa[j] = pk2(a0 * cc0 - b0 * ss0, a1 * cc1 - b1 * ss1); qb[j] = pk2(a0 * ss0 + b0 * cc0, a1 * ss1 + b1 * cc1);
                  ka[j] = pk2((e0 * cc0 - f0 * ss0) * ksc, (e1 * cc1 - f1 * ss1) * ksc); kb[j] = pk2((e0 * ss0 + f0 * cc0) * ksc, (e1 * ss1 + f1 * cc1) * ksc); }
              bf16* op = RQK + (size_t)row * 1024 + h * 128 + 8 * sg;
              *(v4u*)op = (v4u){qa[0], qa[1], qa[2], qa[3]}; *(v4u*)(op + 64) = (v4u){qb[0], qb[1], qb[2], qb[3]};
              *(v4u*)(op + HGQ_STRIDE) = (v4u){ka[0], ka[1], ka[2], ka[3]}; *(v4u*)(op + HGQ_STRIDE + 64) = (v4u){kb[0], kb[1], kb[2], kb[3]}; } } }
    { float* DT = WSP(float, WS_DT); for (int i = gt; i < MR * 16; i += NGT) DT[i] = softplusf(DT[i] + F.in[I_SDTB][l * 16 + (i & 15)]); }
    for (int i = gt; i < NBATCH * 3 * 256; i += NGT) { const int b = i / 768, r = i - b * 768, j = r >> 8, c = (r & 255) * 4;
        const v2u w = *(const v2u*)(P + ((size_t)b * SEQ + SEQ - 3 + j) * NP + C_XA + c); *(f32x4*)(F.out + O_LC_P + (size_t)l * NBATCH * 3072 + (size_t)i * 4) = (f32x4){bflo(w.x), bfhi(w.x), bflo(w.y), bfhi(w.y)}; }
    for (int i = gt; i < NBATCH * 3 * (SSD_CD / 4); i += NGT) { const int b = i / (3 * SSD_CD / 4), r = i - b * (3 * SSD_CD / 4), j = r / (SSD_CD / 4), c = (r - j * (SSD_CD / 4)) * 4;
        const v2u w = *(const v2u*)(P + ((size_t)b * SEQ + SEQ - 3 + j) * NP + C_SX + c); *(f32x4*)(F.out + O_SC_P + (size_t)l * NBATCH * 3 * SSD_CD + (size_t)i * 4) = (f32x4){bflo(w.x), bfhi(w.x), bflo(w.y), bfhi(w.y)}; }
    for (int i = gt; i < MS * 3 * 256; i += NGT) { const int s_ = i / 768, r = i - s_ * 768, j = r >> 8, c = (r & 255) * 4; f32x4 v;
        if (j < 2) v = *(const f32x4*)(F.in[I_SLC] + (size_t)l * MS * 3072 + (size_t)s_ * 3072 + (j + 1) * 1024 + c);
        else { const v2u w = *(const v2u*)(P + ((size_t)MP + s_) * NP + C_XA + c); v = (f32x4){bflo(w.x), bfhi(w.x), bflo(w.y), bfhi(w.y)}; }
        *(f32x4*)(F.out + O_LC_S + (size_t)l * MS * 3072 + (size_t)i * 4) = v; }
    for (int i = gt; i < MS * 3 * (SSD_CD / 4); i += NGT) { const int s_ = i / (3 * SSD_CD / 4), r = i - s_ * (3 * SSD_CD / 4), j = r / (SSD_CD / 4), c = (r - j * (SSD_CD / 4)) * 4; f32x4 v;
        if (j < 2) v = *(const f32x4*)(F.in[I_SSC] + (size_t)l * MS * 3 * SSD_CD + (size_t)s_ * 3 * SSD_CD + (j + 1) * SSD_CD + c);
        else { const v2u w = *(const v2u*)(P + ((size_t)MP + s_) * NP + C_SX + c); v = (f32x4){bflo(w.x), bfhi(w.x), bflo(w.y), bfhi(w.y)}; }
        *(f32x4*)(F.out + O_SC_S + (size_t)l * MS * 3 * SSD_CD + (size_t)i * 4) = v; }
}

constexpr int QS_STR = 136;
typedef short s16x4 __attribute__((ext_vector_type(4)));
template <int MODE> struct CK {
    static constexpr int V = (MODE == 2) ? 64 : 128, NVT = V / 16, NVW = NVT / 2, NH = (MODE == 2) ? 16 : 8, VSTR = (MODE == 2) ? 72 : 136;
    static constexpr int O_QS = 0, O_QH = O_QS + 64 * QS_STR * 2, O_KS = O_QH, O_VV = O_KS + 64 * QS_STR * 2, O_VD = O_VV + 64 * VSTR * 2,
        O_XS = O_VD + (MODE == 0 ? 0 : 64 * VSTR * 2), O_S0T = O_XS + (MODE == 2 ? 64 * VSTR * 2 : 0), O_F32 = O_S0T + V * QS_STR * 2, O_OT = O_F32 + 4096, O_END = O_OT + 64 * VSTR * 2;
    static_assert(O_END <= RING_BYTES, "chunk unit LDS");
};
__device__ __forceinline__ bf16x8 tr_frag(const LAS bf16* T, int stride, int row0, int row1, int col0, int fr) {
    const int q = fr >> 2, p = fr & 3;
    const s16x4 lo = __builtin_amdgcn_ds_read_tr16_b64_v4i16((LAS s16x4*)(T + (row0 + q) * stride + col0 + 4 * p));
    const s16x4 hi = __builtin_amdgcn_ds_read_tr16_b64_v4i16((LAS s16x4*)(T + (row1 + q) * stride + col0 + 4 * p));
    return (bf16x8){lo[0], lo[1], lo[2], lo[3], hi[0], hi[1], hi[2], hi[3]};
}
template <int MODE, int PV>
__device__ __forceinline__ void chunk_unit(const Frame& F0, int l, int unit) {
    Frame F = launder(F0);
    typedef CK<MODE> C; constexpr int V = C::V, NVT = C::NVT, NVW = C::NVW, NH = C::NH, VSTR = C::VSTR;
    const int b = unit / NH, h = unit - b * NH;
    LAS bf16* QS = (LAS bf16*)(F.lds + C::O_QS); LAS bf16* QH = (LAS bf16*)(F.lds + C::O_QH); LAS bf16* KS = (LAS bf16*)(F.lds + C::O_KS);
    LAS bf16* VV = (LAS bf16*)(F.lds + C::O_VV); LAS bf16* VD = (LAS bf16*)(F.lds + C::O_VD); LAS bf16* XS = (LAS bf16*)(F.lds + C::O_XS); LAS bf16* S0T = (LAS bf16*)(F.lds + C::O_S0T);
    LAS bf16* OT = (LAS bf16*)(F.lds + C::O_OT);
    LAS float* FA = (LAS float*)(F.lds + C::O_F32);
    const bf16* P = WSP(bf16, WS_P); const bf16* XBC = WSP(bf16, WS_XBC); const float* DT = WSP(float, WS_DT);
    const bf16* HGQ = WSP(bf16, WS_HGQ); const float* HGE = (const float*)(WSP(bf16, WS_HGQ) + 2 * HGQ_STRIDE); const bf16* RQK = WSP(bf16, WS_H);
    bf16* OUT = (MODE == 0) ? WSP(bf16, WS_OB) : (MODE == 1 ? WSP(bf16, WS_OB + 2 * SZ_O) : WSP(bf16, WS_OB + SZ_O));
    const int tid = F.tid, lane = F.lane, w = F.wave, fr = lane & 15, g = lane >> 4, tt = w & 3, vh = w >> 2;
    const float gx = -__builtin_ldexpf(1.f, -5 - h);
    const float lg = (MODE == 1) ? gx * (1.f + gx * (-0.5f + gx * (0.33333334f + gx * (-0.25f + gx * 0.2f)))) : 0.f;
    float ssd_A = 0.f, ssd_D = 0.f;
    if (MODE == 2) { ssd_A = -__expf(F.in[I_SALOG][l * 16 + h]); ssd_D = F.in[I_SD][l * 16 + h]; }
    const int grp = h >> 3;
    for (int i = tid; i < V * QS_STR / 2; i += NTHR) ((LAS unsigned*)S0T)[i] = 0u;
    f32x4 S[NVT];
#pragma unroll
    for (int i = 0; i < NVT; ++i) S[i] = (f32x4){0.f, 0.f, 0.f, 0.f};
    v4u ra[8]; float rdt = 0.f, eb0 = 0.f, eb1 = 0.f; f32x4 ebn = (f32x4){1.f, 1.f, 1.f, 1.f};
    const int stok = tid >> 3, sg = tid & 7;
    auto load_chunk = [&](int c) {
        const size_t row = (size_t)b * SEQ + 64 * c + stok;
        if (MODE == 0) {
            const bf16* qp = HGQ + row * 1024 + h * 128 + 16 * sg;
            ra[0] = *(const v4u*)qp; ra[1] = *(const v4u*)(qp + 8); ra[4] = *(const v4u*)(qp + HGQ_STRIDE); ra[5] = *(const v4u*)(qp + HGQ_STRIDE + 8);
            ebn = *(const f32x4*)(HGE + (size_t)256 * 1024 + (size_t)(b * 32 + c) * 1024 + h * 128 + 16 * w + 4 * g);
            const bf16* vp = P + row * NP + C_HI + h * 128 + 16 * sg; ra[6] = *(const v4u*)vp; ra[7] = *(const v4u*)(vp + 8);
            if (tid < 128) { const float* ep = HGE + (size_t)(b * 32 + c) * 1024 + h * 128 + tid; eb0 = ep[0]; eb1 = ep[128 * 1024]; }
        } else if (MODE == 1) {
            const bf16* qp = RQK + row * 1024 + h * 128 + 16 * sg;
            ra[0] = *(const v4u*)qp; ra[1] = *(const v4u*)(qp + 8); ra[2] = *(const v4u*)(qp + HGQ_STRIDE); ra[3] = *(const v4u*)(qp + HGQ_STRIDE + 8);
            const bf16* vp = P + row * NP + C_RV + h * 128 + 16 * sg; ra[4] = *(const v4u*)vp; ra[5] = *(const v4u*)(vp + 8);
        } else {
            const bf16* xp = XBC + row * SSD_CD;
            ra[0] = *(const v4u*)(xp + 1024 + grp * 128 + 16 * sg); ra[1] = *(const v4u*)(xp + 1024 + grp * 128 + 16 * sg + 8);
            ra[2] = *(const v4u*)(xp + 1280 + grp * 128 + 16 * sg); ra[3] = *(const v4u*)(xp + 1280 + grp * 128 + 16 * sg + 8);
            ra[4] = *(const v4u*)(xp + h * 64 + 8 * sg);
            rdt = DT[((size_t)b * SEQ + 64 * c + lane) * 16 + h];
        }
    };
    auto stage_chunk = [&]() {
        if (MODE == 0) {
            *(LAS v4u*)(QS + stok * QS_STR + 16 * sg) = ra[0]; *(LAS v4u*)(QS + stok * QS_STR + 16 * sg + 8) = ra[1];
            *(LAS v4u*)(KS + stok * QS_STR + 16 * sg) = ra[4]; *(LAS v4u*)(KS + stok * QS_STR + 16 * sg + 8) = ra[5];
            *(LAS v4u*)(VV + stok * VSTR + 16 * sg) = ra[6]; *(LAS v4u*)(VV + stok * VSTR + 16 * sg + 8) = ra[7];
            if (tid < 128) { FA[512 + tid] = eb0; FA[640 + tid] = eb1; }
        } else if (MODE == 1) {
            *(LAS v4u*)(QS + stok * QS_STR + 16 * sg) = ra[0]; *(LAS v4u*)(QS + stok * QS_STR + 16 * sg + 8) = ra[1];
            *(LAS v4u*)(KS + stok * QS_STR + 16 * sg) = ra[2]; *(LAS v4u*)(KS + stok * QS_STR + 16 * sg + 8) = ra[3];
            *(LAS v4u*)(VV + stok * VSTR + 16 * sg) = ra[4]; *(LAS v4u*)(VV + stok * VSTR + 16 * sg + 8) = ra[5];
            const float ws = __expf(lg * (float)(63 - stok));
            const unsigned vw[8] = {ra[4].x, ra[4].y, ra[4].z, ra[4].w, ra[5].x, ra[5].y, ra[5].z, ra[5].w}; unsigned vd[8];
#pragma unroll
            for (int i = 0; i < 8; ++i) vd[i] = pk2(bflo(vw[i]) * ws, bfhi(vw[i]) * ws);
            *(LAS v4u*)(VD + stok * VSTR + 16 * sg) = (v4u){vd[0], vd[1], vd[2], vd[3]}; *(LAS v4u*)(VD + stok * VSTR + 16 * sg + 8) = (v4u){vd[4], vd[5], vd[6], vd[7]};
        } else {
            float bs = rdt * ssd_A;
#pragma unroll
            for (int o = 1; o < 64; o <<= 1) { const float up = __shfl_up(bs, o); if (lane >= o) bs += up; }
            const float bC = __shfl(bs, 63), bmy = __shfl(bs, stok), dtm = __shfl(rdt, stok);
            if (w == 0) { FA[lane] = bs; FA[64 + lane] = __expf(bs); }
            *(LAS v4u*)(KS + stok * QS_STR + 16 * sg) = ra[0]; *(LAS v4u*)(KS + stok * QS_STR + 16 * sg + 8) = ra[1];
            *(LAS v4u*)(QS + stok * QS_STR + 16 * sg) = ra[2]; *(LAS v4u*)(QS + stok * QS_STR + 16 * sg + 8) = ra[3];
            const float ws = __expf(bC - bmy);
            const unsigned xw[4] = {ra[4].x, ra[4].y, ra[4].z, ra[4].w}; unsigned v1[4], v2[4];
#pragma unroll
            for (int i = 0; i < 4; ++i) { const float x0 = bflo(xw[i]) * dtm, x1 = bfhi(xw[i]) * dtm; v1[i] = pk2(x0, x1); v2[i] = pk2(x0 * ws, x1 * ws); }
            *(LAS v4u*)(XS + stok * VSTR + 8 * sg) = ra[4]; *(LAS v4u*)(VV + stok * VSTR + 8 * sg) = (v4u){v1[0], v1[1], v1[2], v1[3]}; *(LAS v4u*)(VD + stok * VSTR + 8 * sg) = (v4u){v2[0], v2[1], v2[2], v2[3]};
        }
    };
    const bool sink = (PV == 0) || (F.G == 12345);
    if (PV != 2) { load_chunk(0); stage_chunk(); }
    __syncthreads();
    for (int c = 0; c < SEQ / 64; ++c) {
        if (PV != 2 && c + 1 < SEQ / 64) load_chunk(c + 1);
        if (PV != 1) {
        const size_t row0 = (size_t)b * SEQ + 64 * c;
        f32x4 sc[4];
#pragma unroll
        for (int st = 0; st < 4; ++st) { sc[st] = (f32x4){0.f, 0.f, 0.f, 0.f};
            if (st <= tt) {
#pragma unroll
                for (int ks = 0; ks < 4; ++ks) { const bf16x8 a = *(const LAS bf16x8*)(KS + (16 * st + fr) * QS_STR + 32 * ks + 8 * g), bq = *(const LAS bf16x8*)(QS + (16 * tt + fr) * QS_STR + 32 * ks + 8 * g);
                    sc[st] = __builtin_amdgcn_mfma_f32_16x16x32_bf16(a, bq, sc[st], 0, 0, 0); } } }
        const int tloc = 16 * tt + fr;
        float btt = 0.f; if (MODE == 2) btt = FA[tloc];
        unsigned pw[8];
#pragma unroll
        for (int st = 0; st < 4; ++st) { float vals[4];
#pragma unroll
            for (int reg = 0; reg < 4; ++reg) { const int s = 16 * st + 4 * g + reg; float x = sc[st][reg];
                if (MODE == 1) x *= __expf(lg * (float)(tloc - s));
                if (MODE == 2) x *= __expf(fminf(btt - FA[s], 0.f));
                vals[reg] = (st <= tt && s <= tloc) ? x : 0.f; }
            pw[2 * st] = pk2(vals[0], vals[1]); pw[2 * st + 1] = pk2(vals[2], vals[3]); }
        const bf16x8 pf0 = __builtin_bit_cast(bf16x8, ((v4u){pw[0], pw[1], pw[2], pw[3]})), pf1 = __builtin_bit_cast(bf16x8, ((v4u){pw[4], pw[5], pw[6], pw[7]}));
        LAS bf16* QX = QS;
#pragma unroll
        for (int vi = 0; vi < NVW; ++vi) { const int vt = vh * NVW + vi;
            f32x4 o = (f32x4){0.f, 0.f, 0.f, 0.f}, oi = (f32x4){0.f, 0.f, 0.f, 0.f};
            { const bf16x8 bv = tr_frag(VV, VSTR, 4 * g, 16 + 4 * g, 16 * vt, fr); o = __builtin_amdgcn_mfma_f32_16x16x32_bf16(pf0, bv, o, 0, 0, 0); }
            if (tt >= 2) { const bf16x8 bv = tr_frag(VV, VSTR, 32 + 4 * g, 48 + 4 * g, 16 * vt, fr); o = __builtin_amdgcn_mfma_f32_16x16x32_bf16(pf1, bv, o, 0, 0, 0); }
#pragma unroll
            for (int ks = 0; ks < 4; ++ks) { const bf16x8 a = *(const LAS bf16x8*)(QX + (16 * tt + fr) * QS_STR + 32 * ks + 8 * g), bs = *(const LAS bf16x8*)(S0T + (16 * vt + fr) * QS_STR + 32 * ks + 8 * g);
                oi = __builtin_amdgcn_mfma_f32_16x16x32_bf16(a, bs, oi, 0, 0, 0); }
            float vals[4];
#pragma unroll
            for (int reg = 0; reg < 4; ++reg) { const int t = 16 * tt + 4 * g + reg; float val;
                if (MODE == 0) val = o[reg] + oi[reg];
                else if (MODE == 1) val = o[reg] + __expf(lg * (float)(t + 1)) * oi[reg];
                else val = o[reg] + FA[64 + t] * oi[reg] + ssd_D * bf2f(XS[t * VSTR + 16 * vt + fr]);
                vals[reg] = val; }
            { const unsigned w01 = pk2(vals[0], vals[1]), w23 = pk2(vals[2], vals[3]); LAS bf16* op = OT + (16 * tt + 4 * g) * VSTR + 16 * vt + fr;
              op[0] = (bf16)(w01 & 0xffffu); op[VSTR] = (bf16)(w01 >> 16); op[2 * VSTR] = (bf16)(w23 & 0xffffu); op[3 * VSTR] = (bf16)(w23 >> 16); } }
        { const LAS bf16* VX = (MODE == 0) ? VV : VD;
          float e1[4], e2[4];
#pragma unroll
          for (int reg = 0; reg < 4; ++reg) { if (MODE == 0) { e1[reg] = FA[512 + 16 * w + 4 * g + reg]; e2[reg] = FA[640 + 16 * w + 4 * g + reg]; } else if (MODE == 1) { e1[reg] = __expf(lg * 64.f); e2[reg] = 1.f; } else { e1[reg] = FA[64 + 63]; e2[reg] = 1.f; } }
          const bf16x8 ka0 = tr_frag(KS, QS_STR, 8 * g, 8 * g + 4, 16 * w, fr), ka1 = tr_frag(KS, QS_STR, 32 + 8 * g, 36 + 8 * g, 16 * w, fr);
#pragma unroll
          for (int vt = 0; vt < NVT; ++vt) { f32x4 d = (f32x4){0.f, 0.f, 0.f, 0.f};
              const bf16x8 b0 = tr_frag(VX, VSTR, 8 * g, 8 * g + 4, 16 * vt, fr), b1 = tr_frag(VX, VSTR, 32 + 8 * g, 36 + 8 * g, 16 * vt, fr);
              d = __builtin_amdgcn_mfma_f32_16x16x32_bf16(ka0, b0, d, 0, 0, 0); d = __builtin_amdgcn_mfma_f32_16x16x32_bf16(ka1, b1, d, 0, 0, 0);
#pragma unroll
              for (int reg = 0; reg < 4; ++reg) S[vt][reg] = e1[reg] * S[vt][reg] + e2[reg] * d[reg]; } }
        }
        __syncthreads();
        if (PV != 1 && sink) { const LAS bf16* op = OT + stok * VSTR + (V / 8) * sg; bf16* gp = OUT + ((size_t)b * SEQ + 64 * c + stok) * 1024 + h * V + (V / 8) * sg;
            *(v4u*)gp = *(const LAS v4u*)op; if (V == 128) *(v4u*)(gp + 8) = *(const LAS v4u*)(op + 8); }
#pragma unroll
        for (int vt = 0; vt < NVT; ++vt) { const f32x4 sp_ = (MODE == 0) ? S[vt] * ebn : S[vt]; *(LAS v2u*)(S0T + (16 * vt + fr) * QS_STR + 16 * w + 4 * g) = (v2u){pk2(sp_[0], sp_[1]), pk2(sp_[2], sp_[3])}; }
        if (PV != 2 && c + 1 < SEQ / 64) stage_chunk();
        __syncthreads();
    }
    if (!sink) return;
    float* so = F.out + (MODE == 0 ? O_HG_P : (MODE == 1 ? O_RET_P : O_SSD_P)) + (((size_t)l * NBATCH + b) * NH + h) * (128 * V);
#pragma unroll
    for (int vt = 0; vt < NVT; ++vt)
#pragma unroll
        for (int reg = 0; reg < 4; ++reg) __builtin_nontemporal_store(S[vt][reg], so + (size_t)(16 * w + 4 * g + reg) * V + 16 * vt + fr);
}

constexpr int SM_FLOATS = 1024, SM_DEC = 0, SM_KK = 128, SM_Q = 256, SM_VV = 384, SM_XS = 512, SM_DSC = 576, SB_RED = 3 * SM_FLOATS * 4;
struct SmallIn { unsigned a, b, c, d; };
template <int MODE>
__device__ __forceinline__ void samp_run(const Frame& F0, int l, int p0, int pstep, int pend) {
    Frame F = launder(F0);
    constexpr int V = (MODE == 2) ? 64 : 128, NH = (MODE == 2) ? 16 : 8, NKR = (MODE == 2) ? 32 : 16, NJ = 128 / NKR;
    if (p0 >= pend) return;
    const bf16* P = WSP(bf16, WS_P); const bf16* XBC = WSP(bf16, WS_XBC);
    const int tid = F.tid;
    const int v4 = (MODE == 2) ? (tid & 15) : (tid & 31), kr = (MODE == 2) ? (tid >> 4) : (tid >> 5);
    const float* SIN = F.in[MODE == 0 ? I_SHG : (MODE == 1 ? I_SRET : I_SSSD)] + (size_t)l * 128 * NH * (128 * V);
    float* SOUT = F.out + (MODE == 0 ? O_HG_S : (MODE == 1 ? O_RET_S : O_SSD_S)) + (size_t)l * 128 * NH * (128 * V);
    bf16* OUT = (MODE == 0) ? WSP(bf16, WS_OB) : (MODE == 1 ? WSP(bf16, WS_OB + 2 * SZ_O) : WSP(bf16, WS_OB + SZ_O));
    f32x2 cs = (f32x2){0.f, 0.f};
    if (MODE == 1 && tid < 64) cs = WSP(f32x2, WS_ROPE)[2048 * 64 + tid];
    auto ldw = [&](const bf16* base, size_t idx) -> unsigned { return ((const unsigned*)base)[idx >> 1]; };
    auto sload = [&](int pair) -> SmallIn {
        SmallIn r;
        const int s = pair / NH, h = pair - s * NH; const size_t row = MP + s;
        if (MODE == 0) {
            const int k = tid & 127; r.a = WSP(unsigned, WS_HF)[row * 1024 + h * 128 + k]; r.b = ldw(P, row * NP + C_HF + h * 128 + k); r.c = ldw(P, row * NP + C_HQ + h * 128 + k); r.d = ldw(P, row * NP + C_HI + h * 128 + k);
        } else if (MODE == 1) {
            const bool qk = tid < 64; const int j = tid & 63, v = (tid - 64) & 127;
            r.a = ldw(P, row * NP + h * 128 + (qk ? C_RQ + j : C_RV + v)); r.b = ldw(P, row * NP + h * 128 + (qk ? C_RQ + 64 + j : C_RV + v));
            r.c = ldw(P, row * NP + h * 128 + (qk ? C_RK + j : C_RV + v)); r.d = ldw(P, row * NP + h * 128 + (qk ? C_RK + 64 + j : C_RV + v));
        } else {
            const int ch = tid < 320 ? tid : 318 + (tid & 1), grp = h >> 3;
            const int cidx = ch < 64 ? h * 64 + ch : (ch < 192 ? 1024 + grp * 128 + (ch - 64) : 1280 + grp * 128 + (ch - 192));
            r.a = ldw(XBC, row * SSD_CD + cidx);
            r.b = WSP(unsigned, WS_DT)[row * 16 + h]; r.c = ((const unsigned*)F.in[I_SALOG])[l * 16 + h]; r.d = ((const unsigned*)F.in[I_SD])[l * 16 + h];
        }
        return r;
    };
    auto swrite = [&](LAS float* SM, int pair, const SmallIn& r_) {
        SmallIn r = r_; asm volatile("" : "+v"(r.a), "+v"(r.b), "+v"(r.c), "+v"(r.d));
        const int h = pair % NH; const bool odd = tid & 1;
        auto bsel = [&](unsigned w) -> float { return odd ? bfhi(w) : bflo(w); };
        if (MODE == 0) { if (tid < 128) { SM[SM_DEC + tid] = __expf(__uint_as_float(r.a)); SM[SM_KK + tid] = bsel(r.b); SM[SM_Q + tid] = bsel(r.c); SM[SM_VV + tid] = bsel(r.d); } }
        else if (MODE == 1) {
            if (tid < 64) { const int j = tid; const float q1 = bsel(r.a), q2 = bsel(r.b), k1 = bsel(r.c), k2 = bsel(r.d);
                SM[SM_Q + j] = q1 * cs.x - q2 * cs.y; SM[SM_Q + 64 + j] = q1 * cs.y + q2 * cs.x;
                SM[SM_KK + j] = (k1 * cs.x - k2 * cs.y) * 0.08838834764831845f; SM[SM_KK + 64 + j] = (k1 * cs.y + k2 * cs.x) * 0.08838834764831845f; }
            else if (tid < 192) { SM[SM_VV + tid - 64] = bsel(r.a); SM[SM_DEC + tid - 64] = 1.f - __builtin_ldexpf(1.f, -5 - h); }
        } else {
            if (tid < 320) { const int ch = tid; const float val = bsel(r.a);
                if (ch < 64) { const float dtv = __uint_as_float(r.b); SM[SM_XS + ch] = val; SM[SM_VV + ch] = val * dtv; SM[SM_DSC + 64 + ch] = __uint_as_float(r.d); if (ch == 0) SM[SM_DSC] = __expf(dtv * (-__expf(__uint_as_float(r.c)))); }
                else if (ch < 192) SM[SM_KK + ch - 64] = val; else SM[SM_Q + ch - 192] = val; }
        }
    };
    auto stload = [&](int pair, f32x4 (&dst)[NJ]) {
        const float* sin_ = SIN + (size_t)pair * (128 * V);
#pragma unroll
        for (int j = 0; j < NJ; ++j) dst[j] = __builtin_nontemporal_load((const f32x4*)(sin_ + (size_t)(kr + NKR * j) * V + 4 * v4));
    };
    int cb = 0, rb = 0;
    auto step = [&](int pair, f32x4 (&cur)[NJ], f32x4 (&nw)[NJ], const SmallIn& rwr, SmallIn& rnw) {
        const int p1 = pair + pstep, p2 = pair + 2 * pstep; const int p1c = p1 < pend ? p1 : pair, p2c = p2 < pend ? p2 : pair;
        const int nb = cb == 2 ? 0 : cb + 1;
        rnw = sload(p2c);
        stload(p2c, nw);
        LAS float* SM = (LAS float*)F.lds + cb * SM_FLOATS; LAS float* RED = (LAS float*)(F.lds + SB_RED) + rb * (NKR * V);
        float* sout = SOUT + (size_t)pair * (128 * V);
        const f32x4 vv = *(const LAS f32x4*)(SM + SM_VV + 4 * v4);
        f32x4 po = (f32x4){0.f, 0.f, 0.f, 0.f};
#pragma unroll
        for (int j = 0; j < NJ; ++j) { const int k = kr + NKR * j; const float dec = (MODE == 2) ? SM[SM_DSC] : SM[SM_DEC + k]; const float kk = SM[SM_KK + k], q = SM[SM_Q + k];
            const f32x4 sn = cur[j] * dec + vv * kk; __builtin_nontemporal_store(sn, (f32x4*)(sout + (size_t)k * V + 4 * v4)); po += sn * q; }
        *(LAS f32x4*)(RED + kr * V + 4 * v4) = po;
        swrite((LAS float*)F.lds + nb * SM_FLOATS, p1c, rwr);
        __syncthreads();
        if (tid < V) { float o = 0.f;
#pragma unroll
            for (int r = 0; r < NKR; ++r) o += RED[r * V + tid];
            if (MODE == 2) o += SM[SM_DSC + 64 + tid] * SM[SM_XS + tid];
            const int s = pair / NH, h = pair - s * NH;
            OUT[(size_t)(MP + s) * 1024 + h * V + tid] = (bf16)f2bf(o); }
        cb = nb; rb ^= 1;
    };
    f32x4 s0[NJ], s1[NJ], s2[NJ]; SmallIn r0, r1, r2;
    { const int p1c = p0 + pstep < pend ? p0 + pstep : p0;
      r0 = sload(p0); stload(p0, s0); r1 = sload(p1c); stload(p1c, s1); r2.a = 0u; r2.b = 0u; r2.c = 0u; r2.d = 0u;
      swrite((LAS float*)F.lds, p0, r0); }
    __syncthreads();
    int pair = p0;
    for (; pair + 2 * pstep < pend; pair += 3 * pstep) {
        step(pair, s0, s2, r1, r2); step(pair + pstep, s1, s0, r2, r0); step(pair + 2 * pstep, s2, s1, r0, r1);
    }
    if (pair < pend) { step(pair, s0, s2, r1, r2); pair += pstep;
        if (pair < pend) step(pair, s1, s0, r2, r0); }
    __syncthreads();
}

__device__ __forceinline__ void lru_fix(const Frame& F0, int l, int gw, int NGW) {
    Frame F = launder(F0);
    const bf16* P = WSP(bf16, WS_P);
    const bf16* LA = WSP(bf16, WS_X1); const bf16* LU = LA + (size_t)M * 1024;
    bf16* BR = WSP(bf16, WS_BR);
    const int lane = F.lane;
    for (int task = gw; task < NBATCH * 8 * 32; task += NGW) {
        const int b = task >> 8, cg = (task >> 5) & 7, j = task & 31, ch = cg * 128 + 2 * lane;
        float h0 = 0.f, h1 = 0.f;
        { unsigned ca[31], cu[31];
#pragma unroll
          for (int jj = 0; jj < 31; ++jj) { const size_t row = (size_t)b * SEQ + 64 * (jj < j ? jj : 0) + 63; ca[jj] = *(const unsigned*)(LA + row * 1024 + ch); cu[jj] = *(const unsigned*)(LU + row * 1024 + ch); }
#pragma unroll
          for (int jj = 0; jj < 31; ++jj) { h0 = jj < j ? bflo(ca[jj]) * h0 + bflo(cu[jj]) : h0; h1 = jj < j ? bfhi(ca[jj]) * h1 + bfhi(cu[jj]) : h1; } }
        float hv0 = 0.f, hv1 = 0.f;
        for (int t0 = 0; t0 < 64; t0 += 16) {
            unsigned a[16], u[16], y[16];
#pragma unroll
            for (int q = 0; q < 16; ++q) { const size_t row = (size_t)b * SEQ + 64 * j + t0 + q; a[q] = *(const unsigned*)(LA + row * 1024 + ch); u[q] = *(const unsigned*)(LU + row * 1024 + ch); y[q] = *(const unsigned*)(P + row * NP + C_YA + ch); }
#pragma unroll
            for (int q = 0; q < 16; ++q) { const size_t row = (size_t)b * SEQ + 64 * j + t0 + q; hv0 = bflo(a[q]) * h0 + bflo(u[q]); hv1 = bfhi(a[q]) * h1 + bfhi(u[q]);
                *(unsigned*)(BR + row * BW + ch) = pk2(hv0 * bflo(y[q]), hv1 * bfhi(y[q])); }
        }
        if (j == 31) *(f32x2*)(F.out + O_LH_P + ((size_t)l * NBATCH + b) * 1024 + ch) = (f32x2){hv0, hv1};
    }
    for (int i = gw * 64 + lane; i < MS * 1024; i += NGW * 64) { const int s = i >> 10, ch = i & 1023; const size_t row = MP + s;
        const float hp = F.in[I_SLH][((size_t)l * 128 + s) * 1024 + ch]; const float h = bf2f(LA[row * 1024 + ch]) * hp + bf2f(LU[row * 1024 + ch]);
        F.out[O_LH_S + ((size_t)l * 128 + s) * 1024 + ch] = h; BR[row * BW + ch] = (bf16)f2bf(h * bf2f(P[row * NP + C_YA + ch])); }
}

constexpr int NCHUNK_WG = 128;
__device__ __forceinline__ void phase_mix(const Frame& F0, int l) {
    Frame F = launder(F0);
    const int w = F.c;
    if (w < 32) chunk_unit<0, 0>(F, l, w);
    else if (w < 64) chunk_unit<1, 0>(F, l, w - 32);
    else if (w < 128) chunk_unit<2, 0>(F, l, w - 64);
    else { const int cs = w - NCHUNK_WG, ns = F.G - NCHUNK_WG;
        samp_run<0>(F, l, cs, ns, 1024); samp_run<1>(F, l, cs, ns, 1024); samp_run<2>(F, l, cs, ns, 2048);
        lru_fix(F, l, cs * NWAVES + F.wave, ns * NWAVES); }
}

__device__ __forceinline__ void phase_post(const Frame& F0, int l) {
    Frame F = launder(F0);
    const bf16* P = WSP(bf16, WS_P);
    const bf16* LA = WSP(bf16, WS_X1); const bf16* LU = LA + (size_t)M * 1024;
    bf16* BR = WSP(bf16, WS_BR);
    const int gt = F.c * NTHR + F.tid, NGT = F.G * NTHR, gw = F.c * NWAVES + F.wave, NGW = F.G * NWAVES, lane = F.lane;
    for (int task0 = gw; task0 < MR * 3; task0 += 2 * NGW) {
        v4u xin[2][2], gin[2][2]; int rowv[2], brv[2]; bool ok[2];
#pragma unroll
        for (int q = 0; q < 2; ++q) { const int task = task0 + q * NGW; ok[q] = task < MR * 3; const int tk = ok[q] ? task : task0; rowv[q] = tk / 3; brv[q] = tk - rowv[q] * 3;
            const v4u* src = (const v4u*)(WSP(bf16, WS_OB + (size_t)brv[q] * SZ_O) + (size_t)rowv[q] * 1024 + 16 * lane); xin[q][0] = src[0]; xin[q][1] = src[1];
            const int gcol = (brv[q] == 0) ? C_HGG : (brv[q] == 1 ? C_SZ : C_RG);
            const v4u* gp = (const v4u*)(P + (size_t)rowv[q] * NP + gcol + 16 * lane); gin[q][0] = gp[0]; gin[q][1] = gp[1]; }
#pragma unroll
        for (int q = 0; q < 2; ++q) { if (!ok[q]) continue;
            const int row = rowv[q], br = brv[q];
            const unsigned xw_[8] = {xin[q][0].x, xin[q][0].y, xin[q][0].z, xin[q][0].w, xin[q][1].x, xin[q][1].y, xin[q][1].z, xin[q][1].w};
            const unsigned gw_[8] = {gin[q][0].x, gin[q][0].y, gin[q][0].z, gin[q][0].w, gin[q][1].x, gin[q][1].y, gin[q][1].z, gin[q][1].w};
            float x[16], gt_[16], o[16];
#pragma unroll
            for (int i = 0; i < 8; ++i) { x[2 * i] = bflo(xw_[i]); x[2 * i + 1] = bfhi(xw_[i]); gt_[2 * i] = bflo(gw_[i]); gt_[2 * i + 1] = bfhi(gw_[i]); }
            if (br == 1) {
                float ss = 0.f;
#pragma unroll
                for (int j = 0; j < 16; ++j) { x[j] *= gt_[j]; ss += x[j] * x[j]; }
#pragma unroll
                for (int m = 1; m < 32; m <<= 1) ss += __shfl_xor(ss, m);
                const float rs = __builtin_amdgcn_rsqf(ss * (1.f / 512.f) + EPS); const float* nw = F.in[I_SNW] + (size_t)l * 1024 + 16 * lane;
#pragma unroll
                for (int j = 0; j < 16; ++j) o[j] = x[j] * rs * nw[j];
            } else {
                float ss = 0.f;
#pragma unroll
                for (int j = 0; j < 16; ++j) ss += x[j] * x[j];
#pragma unroll
                for (int m = 1; m < 8; m <<= 1) ss += __shfl_xor(ss, m);
                const float rs = __builtin_amdgcn_rsqf(ss * (1.f / 128.f) + EPS);
                if (br == 0) { const float* nw = F.in[I_HGNW] + (size_t)l * 128 + ((16 * lane) & 127);
#pragma unroll
                    for (int j = 0; j < 16; ++j) o[j] = x[j] * rs * nw[j] * gt_[j]; }
                else {
#pragma unroll
                    for (int j = 0; j < 16; ++j) o[j] = x[j] * rs * gt_[j]; }
            }
            v4u w0, w1; w0.x = pk2(o[0], o[1]); w0.y = pk2(o[2], o[3]); w0.z = pk2(o[4], o[5]); w0.w = pk2(o[6], o[7]); w1.x = pk2(o[8], o[9]); w1.y = pk2(o[10], o[11]); w1.z = pk2(o[12], o[13]); w1.w = pk2(o[14], o[15]);
            v4u* dst = (v4u*)(BR + (size_t)(br + 1) * M * BW + (size_t)row * BW + 16 * lane); dst[0] = w0; dst[1] = w1;
        }
    }
}

__device__ __forceinline__ void phase_act(const Frame& F0, int l) {
    Frame F = launder(F0);
    const bf16* UV = WSP(bf16, WS_P); bf16* A2 = WSP(bf16, WS_G);
    const float* cw = F.in[I_FCW] + (size_t)l * 3 * DFF; const float* cb = F.in[I_FCB] + (size_t)l * DFF;
    const int gt = F.c * NTHR + F.tid, NGT = F.G * NTHR;
    constexpr int C8 = DFF / 8;
    for (int i = gt; i < M * C8; i += NGT) {
        const int row = i / C8, c = (i - row * C8) * 8;
        v4u outw = (v4u){0u, 0u, 0u, 0u};
        if (row < MR) {
            const v4u uw = *(const v4u*)(UV + (size_t)row * NUV + c), vw = *(const v4u*)(UV + (size_t)row * NUV + DFF + c);
            float u0[8] = {bflo(uw.x), bfhi(uw.x), bflo(uw.y), bfhi(uw.y), bflo(uw.z), bfhi(uw.z), bflo(uw.w), bfhi(uw.w)};
            const float vv[8] = {bflo(vw.x), bfhi(vw.x), bflo(vw.y), bfhi(vw.y), bflo(vw.z), bfhi(vw.z), bflo(vw.w), bfhi(vw.w)};
            float u1[8], u2[8];
#pragma unroll
            for (int j = 0; j < 8; ++j) { u1[j] = 0.f; u2[j] = 0.f; }
            if (row < MP) { const int t = row & (SEQ - 1);
                if (t >= 1) { const v4u w = *(const v4u*)(UV + (size_t)(row - 1) * NUV + c); u1[0] = bflo(w.x); u1[1] = bfhi(w.x); u1[2] = bflo(w.y); u1[3] = bfhi(w.y); u1[4] = bflo(w.z); u1[5] = bfhi(w.z); u1[6] = bflo(w.w); u1[7] = bfhi(w.w); }
                if (t >= 2) { const v4u w = *(const v4u*)(UV + (size_t)(row - 2) * NUV + c); u2[0] = bflo(w.x); u2[1] = bfhi(w.x); u2[2] = bflo(w.y); u2[3] = bfhi(w.y); u2[4] = bflo(w.z); u2[5] = bfhi(w.z); u2[6] = bflo(w.w); u2[7] = bfhi(w.w); }
                if (t >= SEQ - 2) { float* so = F.out + O_FC_P + (((size_t)l * NBATCH + (row >> 11)) * 2 + (t - (SEQ - 2))) * DFF + c;
#pragma unroll
                    for (int j = 0; j < 8; ++j) so[j] = u0[j]; }
            } else { const int s = row - MP; const float* st = F.in[I_SFC] + ((size_t)l * MS + s) * 2 * DFF + c; float* so = F.out + O_FC_S + ((size_t)l * MS + s) * 2 * DFF + c;
#pragma unroll
                for (int j = 0; j < 8; ++j) { u2[j] = st[j]; u1[j] = st[DFF + j]; so[j] = st[DFF + j]; so[DFF + j] = u0[j]; } }
            float a[8];
#pragma unroll
            for (int j = 0; j < 8; ++j) { const float y = cb[c + j] + cw[c + j] * u2[j] + cw[DFF + c + j] * u1[j] + cw[2 * DFF + c + j] * u0[j]; a[j] = geluf(y) * vv[j]; }
            outw.x = pk2(a[0], a[1]); outw.y = pk2(a[2], a[3]); outw.z = pk2(a[4], a[5]); outw.w = pk2(a[6], a[7]);
        }
        *(v4u*)(A2 + (size_t)row * DFF + c) = outw;
    }
}

template <int KIND>
__device__ __forceinline__ void samp_gemm(const Frame& F0, int l) {
    Frame F = launder(F0);
    if (F.c >= 256) return;
    const int rb = F.c >> 5, cb = F.c & 31, w = F.wave, ct = w & 3, kh = w >> 2, fr = F.lane & 15, g = F.lane >> 4;
    const int nrow = 64 * cb + 16 * ct + fr;
    const size_t arow = (size_t)MP + 16 * rb + fr;
    f32x4 tot = (f32x4){0.f, 0.f, 0.f, 0.f};
    constexpr int NSEG = (KIND == 0) ? 4 : 1;
    constexpr int KH = (KIND == 0) ? 512 : (KIND == 1 ? 1024 : 2816);
    constexpr int BPS = KH / 256, NBT = NSEG * BPS;
    unsigned gq[4][4];
    if (KIND == 0) {
#pragma unroll
        for (int seg = 0; seg < 4; ++seg)
#pragma unroll
            for (int reg = 0; reg < 4; ++reg) gq[seg][reg] = WSP(bf16, WS_G)[((size_t)MP + 16 * rb + 4 * g + reg) * NG + seg * 2048 + 64 * cb + 16 * ct + fr];
    }
    auto ptrs = [&](int seg, const bf16*& ap, const bf16*& bp) {
        if (KIND == 0) { ap = WSP(bf16, WS_BR) + (size_t)seg * M * BW + arow * BW + kh * KH + 8 * g; bp = WSP(bf16, WS_WB + l * SZ_WB) + (size_t)seg * DM * BW + (size_t)nrow * BW + kh * KH + 8 * g; }
        else if (KIND == 1) { ap = WSP(bf16, WS_MG) + arow * DM + kh * KH + 8 * g; bp = WSP(bf16, WS_WO + l * SZ_WO) + (size_t)nrow * DM + kh * KH + 8 * g; }
        else { ap = WSP(bf16, WS_G) + arow * DFF + kh * KH + 8 * g; bp = WSP(bf16, WS_WD + l * SZ_WD) + (size_t)nrow * DFF + kh * KH + 8 * g; }
    };
    auto ldb = [&](int bt, bf16x8 (&x)[8], bf16x8 (&y)[8]) {
        const bf16* ap; const bf16* bp; ptrs(bt / BPS, ap, bp); const int k0 = (bt % BPS) * 256;
#pragma unroll
        for (int i = 0; i < 8; ++i) { x[i] = *(const bf16x8*)(ap + k0 + 32 * i); y[i] = *(const bf16x8*)(bp + k0 + 32 * i); }
    };
    f32x4 a0 = (f32x4){0.f, 0.f, 0.f, 0.f}, a1 = a0;
    auto mmb = [&](int bt, const bf16x8 (&x)[8], const bf16x8 (&y)[8]) {
#pragma unroll
        for (int i = 0; i < 4; ++i) { a0 = __builtin_amdgcn_mfma_f32_16x16x32_bf16(x[2 * i], y[2 * i], a0, 0, 0, 0); a1 = __builtin_amdgcn_mfma_f32_16x16x32_bf16(x[2 * i + 1], y[2 * i + 1], a1, 0, 0, 0); }
        if ((bt % BPS) == BPS - 1) { a0 += a1;
            if (KIND == 0) {
#pragma unroll
                for (int reg = 0; reg < 4; ++reg) a0[reg] *= bflo(gq[bt / BPS][reg]); }
            tot += a0; a0 = (f32x4){0.f, 0.f, 0.f, 0.f}; a1 = a0; }
    };
    bf16x8 xA[8], yA[8], xB[8], yB[8];
    ldb(0, xA, yA);
#pragma unroll
    for (int bt = 0; bt < NBT; bt += 2) {
        if (bt + 1 < NBT) ldb(bt + 1, xB, yB);
        __builtin_amdgcn_sched_barrier(0);
        mmb(bt, xA, yA);
        __builtin_amdgcn_sched_barrier(0);
        if (bt + 2 < NBT) ldb(bt + 2, xA, yA);
        __builtin_amdgcn_sched_barrier(0);
        if (bt + 1 < NBT) mmb(bt + 1, xB, yB);
        __builtin_amdgcn_sched_barrier(0);
    }
    LAS f32x4* RED = (LAS f32x4*)F.lds;
    if (kh == 1) RED[ct * 64 + F.lane] = tot;
    __syncthreads();
    if (kh == 0) {
        tot += RED[ct * 64 + F.lane];
#pragma unroll
        for (int reg = 0; reg < 4; ++reg) { const size_t row = (size_t)MP + 16 * rb + 4 * g + reg; const int d = 64 * cb + 16 * ct + fr;
            if (KIND == 0) WSP(bf16, WS_MG)[row * DM + d] = (bf16)f2bf(tot[reg]);
            else { const float x = bf2f((KIND == 1 ? WSP(bf16, WS_XB0) : WSP(bf16, WS_XB1))[row * DM + d]) + tot[reg];
                (KIND == 1 ? WSP(bf16, WS_XB1) : WSP(bf16, WS_XB0))[row * DM + d] = (bf16)f2bf(x);
                float ss = x * x;
#pragma unroll
                for (int o = 1; o < 16; o <<= 1) ss += __shfl_xor(ss, o);
                if (fr == 0) rss_add((u64*)(F.ws + WS_RSS + (size_t)(2 * l + KIND) * SZ_RSS), row, ss); } }
    }
    __syncthreads();
}

constexpr int G_GEMM1 = 249, G_UP = 242;
constexpr int PH_PER_LAYER = 8, NPHASE = 1 + NLAYER * PH_PER_LAYER + 1;
__global__ void __launch_bounds__(NTHR, 2) mk_fwd(Args args) {
    extern __shared__ __attribute__((aligned(16))) unsigned char lds_raw[];
    Frame F;
    F.lds = (LAS unsigned char*)lds_raw;
    F.tid = threadIdx.x; F.lane = F.tid & 63; F.wave = __builtin_amdgcn_readfirstlane(F.tid >> 6);
    F.G = gridDim.x; F.c = blockIdx.x;
    F.in = args.in; F.out = args.out; F.ws = args.ws;
    volatile LAS unsigned* MISC = (volatile LAS unsigned*)(F.lds + LDSCTL_OFF);
    if (F.tid < 64) MISC[F.tid] = 0u;
    __syncthreads();
    unsigned* barw = (unsigned*)(F.ws + WS_CTL) + 4096;
    XcdBarrier bar; bar.bar = barw; bar.x = 0; bar.st = nullptr;
    if (!MK_SPLIT) bar = xcd_barrier_post(barw, MISC + 8);
    const int lo = args.ph_lo, hi = args.ph_hi;
#define IN(k) (lo <= (k) && (k) < hi)
#define SEAM(k) do { if (IN(k) && IN((k) + 1)) xcd_barrier(bar); } while (0)
#define XB0 WSP(bf16, WS_XB0)
#define XB1 WSP(bf16, WS_XB1)
#define RSSB(j) ((u64*)(F.ws + WS_RSS + (size_t)(j) * SZ_RSS))
#define GEMM_RUN(EPI) do { pg8::gemm_phase<EPI, pg8::TileOrder>(F.lds, g, S, E); if (REP_G > 1) { Frame F1 = launder(F); pg8::gemm_phase<EPI, pg8::TileOrder>(F1.lds, g, S, E); } } while (0)

    if (IN(0) && !(SKMASK & 1)) { phase_prologue(F); } SEAM(0);

    for (int l = 0; l < NLAYER; ++l) {
        const int pb = 1 + l * PH_PER_LAYER;
        if (IN(pb + 0) && !(SKMASK & 2)) { const Frame F0 = F; Frame F = launder(F0);
            pg8::Gemm g{XB0, WSP(bf16, WS_W1 + l * SZ_W1), DM, DM, DM, 0, 0, 256, 0}; pg8::TileOrder S; S.init(M, N1, G_GEMM1, F.c, 1);
            Epi1 E{WSP(bf16, WS_P), WSP(float, WS_HF), WSP(float, WS_DT), WSP(bf16, WS_G), WSP(float, WS_LB) + l * 1024, RSSB(2 * l)};
            if (F.c < G_GEMM1) GEMM_RUN(Epi1);
            else tr_run<true>(F0, l == 0 ? S0 : S2, l == 0 ? S1 : S3, (F.c - G_GEMM1) * NWAVES + F.wave, (F.G - G_GEMM1) * NWAVES);
        } SEAM(pb + 0);
        if (IN(pb + 1) && !(SKMASK & 4)) { phase_conv(F, l); } SEAM(pb + 1);
        if (IN(pb + 2) && !(SKMASK & 8)) { phase_mix(F, l); } SEAM(pb + 2);
        if (IN(pb + 3) && !(SKMASK & 16)) { phase_post(F, l); } SEAM(pb + 3);
        if (IN(pb + 4) && !(SKMASK & 32)) { const Frame F0 = F; Frame F = launder(F0);
            pg8::Gemm g{WSP(bf16, WS_BR), WSP(bf16, WS_WB + l * SZ_WB), BW, BW, BW, (size_t)M * BW, (size_t)DM * BW, 256, 0}; pg8::TileOrder S; S.init(MP, DM, F.G, F.c, 4);
            EpiBr E{WSP(bf16, WS_G), WSP(bf16, WS_MG)};
            GEMM_RUN(EpiBr);
            samp_gemm<0>(F, l);
        } SEAM(pb + 4);
        if (IN(pb + 5) && !(SKMASK & 64)) { const Frame F0 = F; Frame F = launder(F0);
            pg8::Gemm g{WSP(bf16, WS_MG), WSP(bf16, WS_WO + l * SZ_WO), DM, DM, DM, 0, 0, 256, 0}; pg8::TileOrder S; S.init(MP, DM, F.G, F.c, 1);
            EpiRes E{XB0, XB1, RSSB(2 * l + 1)};
            GEMM_RUN(EpiRes);
            samp_gemm<1>(F, l);
        } SEAM(pb + 5);
        if (IN(pb + 6) && !(SKMASK & 128)) { const Frame F0 = F; Frame F = launder(F0);
            pg8::Gemm g{XB1, WSP(bf16, WS_WUV + l * SZ_WUV), DM, DM, DM, 0, 0, 254, -2}; pg8::TileOrder S; S.init(M, NUV, G_UP, F.c, 1);
            EpiAct E{WSP(bf16, WS_G), RSSB(2 * l + 1), F.in[I_FCW] + (size_t)l * 3 * DFF, F.in[I_FCB] + (size_t)l * DFF, F.in[I_SFC] + (size_t)l * MS * 2 * DFF,
                     F.out + O_FC_P + (size_t)l * NBATCH * 2 * DFF, F.out + O_FC_S + (size_t)l * MS * 2 * DFF, F.lds};
            if (F.c < G_UP) GEMM_RUN(EpiAct);
            else tr_run<true>(F0, l == 0 ? S1 : S3, l == 0 ? S2 : NIT_ALL, (F.c - G_UP) * NWAVES + F.wave, (F.G - G_UP) * NWAVES);
        } SEAM(pb + 6);
        if (IN(pb + 7) && !(SKMASK & 256)) { const Frame F0 = F; Frame F = launder(F0);
            pg8::Gemm g{WSP(bf16, WS_G), WSP(bf16, WS_WD + l * SZ_WD), DFF, DFF, DFF, 0, 0, 256, 0}; pg8::TileOrder S; S.init(MP, DM, F.G, F.c, 1);
            EpiRes E{XB1, XB0, RSSB(2 * l + 2)};
            GEMM_RUN(EpiRes);
            samp_gemm<2>(F, l);
        } SEAM(pb + 7);
    }
    if (IN(NPHASE - 1) && !(SKMASK & 1024)) { phase_final(F, WSP(bf16, WS_XB0), F.in[I_GFIN]); }
#undef IN
#undef SEAM
#undef XB0
#undef XB1
#undef RSSB
#undef GEMM_RUN
}

extern "C" void kernel_launch(void* const* d_in, const int* in_sizes, int n_in, void* d_out, int out_size, void* d_ws, size_t ws_size, hipStream_t stream) {
    static int grid = 0;
    if (grid == 0) {
        if (n_in != N_INPUTS || (size_t)out_size != O_END || ws_size < WS_END) { fprintf(stderr, "kernel_launch: unexpected shapes: n_in %d out %d ws %zu (need %zu)\n", n_in, out_size, ws_size, (size_t)WS_END); grid = -1; return; }
        int dev = 0, cus = 0, per_cu = 0;
        if (hipGetDevice(&dev) != hipSuccess || hipDeviceGetAttribute(&cus, hipDeviceAttributeMultiprocessorCount, dev) != hipSuccess) { grid = -1; return; }
        if (hipFuncSetAttribute((const void*)mk_fwd, hipFuncAttributeMaxDynamicSharedMemorySize, LDS_BYTES) != hipSuccess) { fprintf(stderr, "kernel_launch: hipFuncSetAttribute failed\n"); grid = -1; return; }
        if (hipOccupancyMaxActiveBlocksPerMultiprocessor(&per_cu, (const void*)mk_fwd, NTHR, LDS_BYTES) != hipSuccess || per_cu < 1) { fprintf(stderr, "kernel_launch: occupancy query says %d\n", per_cu); }
        (void)hipGetLastError();
        grid = cus;
    }
    if (grid < 0) return;
    (void)hipMemsetAsync((char*)d_ws + WS_CTL, 0, CTL_BYTES, stream);
    Args a{};
    for (int i = 0; i < N_INPUTS; ++i) a.in[i] = (const float*)d_in[i];
    a.out = (float*)d_out; a.ws = (unsigned char*)d_ws;
#if MK_SPLIT
    for (int p = 0; p < NPHASE; ++p) { a.ph_lo = p; a.ph_hi = p + 1; hipLaunchKernelGGL(mk_fwd, dim3(grid), dim3(NTHR), LDS_BYTES, stream, a); }
#else
    a.ph_lo = 0; a.ph_hi = NPHASE;
    hipLaunchKernelGGL(mk_fwd, dim3(grid), dim3(NTHR), LDS_BYTES, stream, a);
#endif
}
```

```cpp
#include <hip/hip_runtime.h>
#include <cstdio>
#include <cstdint>

#ifndef REP_G
#define REP_G 1
#endif
#ifndef PROBE_UNIT
#define PROBE_UNIT 0
#endif
#ifndef PROBE_NWG
#define PROBE_NWG 224
#endif
#ifndef REP_CONV
#define REP_CONV 1
#endif
#ifndef REP_MIX
#define REP_MIX 1
#endif
#ifndef REP_POST
#define REP_POST 1
#endif
#ifndef SKMASK
#define SKMASK 0
#endif
#ifndef MK_SPLIT
#define MK_SPLIT 0
#endif

namespace pg8 {
#define PG8_LAS __attribute__((address_space(3)))
typedef unsigned short bf16_t;
typedef short bf16x8 __attribute__((ext_vector_type(8)));
typedef float f32x4 __attribute__((ext_vector_type(4)));
typedef unsigned u32x4 __attribute__((ext_vector_type(4)));
constexpr int BM = 256, BK = 64, HALF = 128, HTB = HALF * BK * 2, STAGE_BYTES = 8 * HTB, NXCD = 8, WGM = 8;

__host__ __device__ __forceinline__ int lds_byte(int r, int c) { const int st = (r >> 4) * 2 + (c >> 5), rr = r & 15, cc = c & 31, ob = rr * 64 + cc * 2; return st * 1024 + (ob ^ (((ob >> 9) & 1) << 5)); }
__host__ __device__ __forceinline__ void stage_rc(int b, int& R, int& C) { const int st = b / 1024, sb = b % 1024, swz = sb ^ (((sb >> 9) & 1) << 5); R = (st >> 1) * 16 + swz / 64; C = (st & 1) * 32 + (swz % 64) / 2; }
__host__ __device__ __forceinline__ int perm32(int rho) { const int n = rho >> 4, i = rho & 15; return 8 * (i >> 2) + 4 * n + (i & 3); }

struct Unit { int pm, pn, kz; };
struct Gemm { const bf16_t* A; const bf16_t* Bt; int lda, ldb, K; size_t azs, bzs; int prs, pr0; };

struct TileOrder {
    int nM, nN, nwg, G, c, nkz;
    __device__ void init(int M, int N, int G_, int c_, int nkz_) { nM = M / BM; nN = N / BM; nwg = nM * nN; G = G_; c = c_; nkz = nkz_; }
    __device__ bool next(int i, Unit& u) const {
        const int ti = i / nkz; u.kz = i - ti * nkz;
        const long L = (long)ti * G + c; if (L >= nwg) return false;
        int wgid = (int)L; { const int q = nwg / NXCD, r = nwg % NXCD, xcd = wgid % NXCD, off = wgid / NXCD; wgid = (xcd < r ? xcd * (q + 1) : r * (q + 1) + (xcd - r) * q) + off; }
        const int nig = WGM * nN, gid = wgid / nig, fm = gid * WGM, gsz = (nM - fm) < WGM ? (nM - fm) : WGM;
        u.pm = fm + ((wgid % nig) % gsz); u.pn = (wgid % nig) / gsz; return true;
    }
};

typedef __bf16 bf16x2_t __attribute__((ext_vector_type(2)));
typedef float f32x2_t __attribute__((ext_vector_type(2)));
__device__ __forceinline__ unsigned cvt_pk_bf16(float lo, float hi) { const bf16x2_t r = __builtin_convertvector((f32x2_t){lo, hi}, bf16x2_t); return __builtin_bit_cast(unsigned, r); }

template <class Epi, class Sched, bool ALIGN_EPI = true>
__device__ __forceinline__ void gemm_phase(PG8_LAS unsigned char* lds, const Gemm g, const Sched& S, const Epi& E) {
    int tid = threadIdx.x; asm volatile("" : "+v"(tid));
    const int wid = __builtin_amdgcn_readfirstlane(tid >> 6), lane = tid & 63, wr = wid >> 2, wc = wid & 3, fr = lane & 15, fq = lane >> 4;
    const int K = g.K, nt = K / BK;
    unsigned voffA[2], voffB[2];
#pragma unroll
    for (int i = 0; i < 2; ++i) { int R, C; stage_rc(tid * 16 + i * 8192, R, C); const int Rb = Epi::PERM ? ((R & ~31) + perm32(R & 31)) : R;
        voffA[i] = (unsigned)(R * g.lda + C) * 2u; voffB[i] = (unsigned)(Rb * g.ldb + C) * 2u; }
    const size_t kstep = (size_t)(BK * 2);
    const size_t hstepA = (size_t)HALF * g.lda * 2, hstepB = (size_t)HALF * g.ldb * 2;
    const size_t tstepB = 2 * hstepB;
    const unsigned ldsw = (unsigned)wid * 1024u;
    const int aoff = lds_byte(wr * 64 + fr, fq * 8), boff = lds_byte(wc * 32 + fr, fq * 8);
#define PG8_SA(b, h) (((b) * 2 + (h)) * HTB)
#define PG8_SB(b, h) ((4 + (b) * 2 + (h)) * HTB)
#define PG8_STAGE(bufoff, gbase, voff) do { _Pragma("unroll") for (int _i = 0; _i < 2; ++_i) \
        __builtin_amdgcn_global_load_lds((const unsigned*)((const char*)(gbase) + (voff)[_i]), (PG8_LAS unsigned*)(lds + (bufoff) + ldsw + _i * 8192), 16, 0, 0); } while (0)
#define PG8_LDA(dst, b, h) do { _Pragma("unroll") for (int m = 0; m < 4; ++m) _Pragma("unroll") for (int k = 0; k < 2; ++k) dst[m][k] = *(const PG8_LAS bf16x8*)(lds + PG8_SA(b, h) + aoff + m * 2048 + k * 1024); } while (0)
#define PG8_LDB(dst, b, h) do { _Pragma("unroll") for (int n = 0; n < 2; ++n) _Pragma("unroll") for (int k = 0; k < 2; ++k) dst[n][k] = *(const PG8_LAS bf16x8*)(lds + PG8_SB(b, h) + boff + n * 2048 + k * 1024); } while (0)
#define PG8_MMA(ai, bj, At, Bt) do { __builtin_amdgcn_s_setprio(1); _Pragma("unroll") for (int m = 0; m < 4; ++m) _Pragma("unroll") for (int n = 0; n < 2; ++n) _Pragma("unroll") for (int k = 0; k < 2; ++k) \
        acc[ai][bj][m][n] = __builtin_amdgcn_mfma_f32_16x16x32_bf16(Bt[n][k], At[m][k], acc[ai][bj][m][n], 0, 0, 0); __builtin_amdgcn_s_setprio(0); } while (0)
#define PG8_WAIT_V(n) asm volatile("s_waitcnt vmcnt(" #n ")" ::: "memory")
#define PG8_WAIT_L(n) asm volatile("s_waitcnt lgkmcnt(" #n ")" ::: "memory")
#define PG8_BAR __builtin_amdgcn_s_barrier()
#define PG8_SCHED __builtin_amdgcn_sched_barrier(0)
    Unit cur, nxt; int ui = 0;
    if (!S.next(0, cur)) return;
    f32x4 acc[2][2][4][2];
#pragma unroll
    for (int a = 0; a < 2; ++a)
#pragma unroll
        for (int b = 0; b < 2; ++b)
#pragma unroll
            for (int m = 0; m < 4; ++m)
#pragma unroll
                for (int n = 0; n < 2; ++n) acc[a][b][m][n] = (f32x4){0.f, 0.f, 0.f, 0.f};
    bf16x8 At[4][2], B0[2][2], B1[2][2];
    const char* cA = (const char*)g.A + (ptrdiff_t)((size_t)cur.kz * g.azs * 2) + ((ptrdiff_t)cur.pm * g.prs + g.pr0) * (ptrdiff_t)g.lda * 2;
    const char* cB = (const char*)g.Bt + (size_t)cur.kz * g.bzs * 2 + (size_t)cur.pn * tstepB;
    PG8_STAGE(PG8_SB(0, 0), cB, voffB); PG8_STAGE(PG8_SB(0, 1), cB + hstepB, voffB); PG8_STAGE(PG8_SA(0, 0), cA, voffA); PG8_STAGE(PG8_SA(0, 1), cA + hstepA, voffA);
    if (wr == 1) PG8_BAR;
    PG8_WAIT_V(2); PG8_BAR;
    PG8_STAGE(PG8_SB(1, 0), cB + kstep, voffB); PG8_STAGE(PG8_SA(1, 0), cA + kstep, voffA); PG8_STAGE(PG8_SB(1, 1), cB + hstepB + kstep, voffB);
    PG8_WAIT_V(6); PG8_BAR;
    for (;;) {
        const bool has_next = S.next(ui + 1, nxt);
        const char* nA = has_next ? (const char*)g.A + (ptrdiff_t)((size_t)nxt.kz * g.azs * 2) + ((ptrdiff_t)nxt.pm * g.prs + g.pr0) * (ptrdiff_t)g.lda * 2 : cA;
        const char* nB = has_next ? (const char*)g.Bt + (size_t)nxt.kz * g.bzs * 2 + (size_t)nxt.pn * tstepB : cB;
        for (int t = 0; t < nt; t += 2) {
            const bool last = (t == nt - 2);
            const char* a1 = cA + (size_t)(t + 1) * kstep;
            const char* a2 = last ? nA : cA + (size_t)(t + 2) * kstep; const char* b2 = last ? nB : cB + (size_t)(t + 2) * kstep;
            const char* a3 = a2 + kstep; const char* b3 = b2 + kstep;
            PG8_LDB(B0, 0, 0); PG8_LDB(B1, 0, 1); PG8_SCHED; PG8_LDA(At, 0, 0); PG8_STAGE(PG8_SA(1, 1), a1 + hstepA, voffA);
            PG8_WAIT_V(8); PG8_WAIT_L(0); PG8_BAR; PG8_MMA(0, 0, At, B0); PG8_MMA(0, 1, At, B1); PG8_BAR; PG8_SCHED;
            PG8_LDA(At, 0, 1); PG8_STAGE(PG8_SB(0, 0), b2, voffB); PG8_STAGE(PG8_SB(0, 1), b2 + hstepB, voffB); PG8_STAGE(PG8_SA(0, 0), a2, voffA);
            PG8_WAIT_V(8); PG8_WAIT_L(0); PG8_BAR; PG8_MMA(1, 0, At, B0); PG8_MMA(1, 1, At, B1); PG8_BAR; PG8_SCHED;
            PG8_LDB(B0, 1, 0); PG8_LDB(B1, 1, 1); PG8_SCHED; PG8_LDA(At, 1, 0); PG8_STAGE(PG8_SA(0, 1), a2 + hstepA, voffA);
            PG8_WAIT_V(8); PG8_WAIT_L(0); PG8_BAR; PG8_MMA(0, 0, At, B0); PG8_MMA(0, 1, At, B1); PG8_BAR; PG8_SCHED;
            PG8_LDA(At, 1, 1); PG8_STAGE(PG8_SB(1, 0), b3, voffB); PG8_STAGE(PG8_SB(1, 1), b3 + hstepB, voffB); PG8_STAGE(PG8_SA(1, 0), a3, voffA);
            PG8_WAIT_V(8); PG8_WAIT_L(0); PG8_BAR; PG8_MMA(1, 0, At, B0); PG8_MMA(1, 1, At, B1); PG8_BAR; PG8_SCHED;
        }
        if constexpr (ALIGN_EPI) { if (wr == 0) PG8_BAR; }
        E(acc, cur, wr, wc, fr, fq);
        if (!has_next) break;
        if (!E.keep(cur)) {
#pragma unroll
            for (int a = 0; a < 2; ++a)
#pragma unroll
                for (int b = 0; b < 2; ++b)
#pragma unroll
                    for (int m = 0; m < 4; ++m)
#pragma unroll
                        for (int n = 0; n < 2; ++n) acc[a][b][m][n] = (f32x4){0.f, 0.f, 0.f, 0.f};
        }
        cur = nxt; cA = nA; cB = nB; ++ui;
        if constexpr (ALIGN_EPI) { if (wr == 1) PG8_BAR; }
    }
    PG8_WAIT_V(0);
    if constexpr (!ALIGN_EPI) { if (wr == 0) PG8_BAR; }
    PG8_BAR;
#undef PG8_SA
#undef PG8_SB
#undef PG8_STAGE
#undef PG8_LDA
#undef PG8_LDB
#undef PG8_MMA
#undef PG8_WAIT_V
#undef PG8_WAIT_L
#undef PG8_BAR
#undef PG8_SCHED
}
}

constexpr int NWAVES = 8, NTHR = 512;
constexpr int DM = 2048, NBATCH = 4, SEQ = 2048, MP = NBATCH * SEQ, MS = 128, MR = MP + MS, M = 8448;
constexpr int NLAYER = 2;
constexpr int NIN = 12816, NP = 13056, NG = 8192, N1 = NP + NG;
constexpr int DFF = 5632, NUV = 2 * DFF;
constexpr int BW = 1024;
constexpr float EPS = 1e-6f;
constexpr int C_XA = 0, C_YA = 1024, C_HQ = 2048, C_HF = 3072, C_HI = 4096, C_HGG = 5120, C_SZ = 6144, C_SX = 7168, C_SDT = 8704, C_RQ = 8960, C_RK = 9984, C_RV = 11008, C_RG = 12032;
constexpr int SRC_SPLIT = 8720;
constexpr int SSD_CD = 1536;

enum { I_XP = 0, I_XS, I_SLH, I_SLC, I_SHG, I_SSSD, I_SSC, I_SRET, I_SFC, I_GMIX, I_GFFN, I_WIN, I_LCW, I_LCB, I_LWA, I_LBA, I_LWX, I_LBX, I_LLAM, I_HGLB, I_HGNW,
       I_SCW, I_SCB, I_SDTB, I_SALOG, I_SD, I_SNW, I_WBR, I_WGATE, I_WOUT, I_WUP, I_WVAL, I_FCW, I_FCB, I_WDOWN, I_GFIN, N_INPUTS };

constexpr size_t O_YP = 0, O_YS = O_YP + (size_t)MP * DM, O_LH_P = O_YS + (size_t)MS * DM, O_LH_S = O_LH_P + 2 * 4 * 1024, O_LC_P = O_LH_S + 2 * 128 * 1024,
    O_LC_S = O_LC_P + 2 * 4 * 3 * 1024, O_HG_P = O_LC_S + 2 * 128 * 3 * 1024, O_HG_S = O_HG_P + (size_t)2 * 4 * 8 * 16384, O_SSD_P = O_HG_S + (size_t)2 * 128 * 8 * 16384,
    O_SSD_S = O_SSD_P + (size_t)2 * 4 * 16 * 8192, O_SC_P = O_SSD_S + (size_t)2 * 128 * 16 * 8192, O_SC_S = O_SC_P + 2 * 4 * 3 * 1536, O_RET_P = O_SC_S + 2 * 128 * 3 * 1536,
    O_RET_S = O_RET_P + (size_t)2 * 4 * 8 * 16384, O_FC_P = O_RET_S + (size_t)2 * 128 * 8 * 16384, O_FC_S = O_FC_P + 2 * 4 * 2 * 5632, O_END = O_FC_S + (size_t)2 * 128 * 2 * 5632;
static_assert(O_END == 126119936ull, "output size");

constexpr size_t AL(size_t x) { return (x + 4095) & ~(size_t)4095; }
constexpr size_t WS_CTL = 0, CTL_BYTES = 1u << 20;
constexpr size_t WS_RSS = 65536, SZ_RSS = (size_t)M * 8;
constexpr float RSS_SCALE = 65536.f, RSS_INV = 1.f / (65536.f * 2048.f);
static_assert(WS_RSS + 5 * SZ_RSS <= CTL_BYTES, "rss buffers inside the zeroed control region");
constexpr size_t SZ_W1 = (size_t)N1 * DM * 2, SZ_WB = (size_t)4 * DM * BW * 2, SZ_WO = (size_t)DM * DM * 2, SZ_WUV = (size_t)NUV * DM * 2, SZ_WD = (size_t)DM * DFF * 2;
constexpr size_t WS_W1 = CTL_BYTES, WS_WB = WS_W1 + 2 * SZ_W1, WS_WO = WS_WB + 2 * SZ_WB, WS_WUV = WS_WO + 2 * SZ_WO, WS_WD = WS_WUV + 2 * SZ_WUV;
constexpr size_t WS_ROPE = WS_WD + 2 * SZ_WD, SZ_ROPE = AL((size_t)2049 * 64 * 8);
constexpr size_t SZ_X = (size_t)M * DM * 4;
constexpr size_t WS_X0 = WS_ROPE + SZ_ROPE, WS_X1 = WS_X0 + SZ_X;
constexpr size_t WS_H = WS_X1 + SZ_X, SZ_H = (size_t)M * DM * 2;
constexpr size_t WS_XB0 = WS_X0, WS_XB1 = WS_X0 + SZ_H;
constexpr size_t WS_P = WS_H + SZ_H, SZ_P = (size_t)M * NP * 2;
constexpr size_t WS_G = WS_P + SZ_P, SZ_G = (size_t)M * NG * 2;
constexpr size_t WS_HF = WS_G + SZ_G, SZ_HF = (size_t)M * 1024 * 4;
constexpr size_t WS_DT = WS_HF + SZ_HF, SZ_DT = AL((size_t)M * 16 * 4);
constexpr size_t WS_OB = WS_DT + SZ_DT, SZ_O = (size_t)M * 1024 * 4;
constexpr size_t WS_BR = WS_OB + 3 * SZ_O, SZ_BR = (size_t)4 * M * BW * 2;
constexpr size_t WS_MG = WS_BR + SZ_BR, SZ_MG = (size_t)M * DM * 2;
constexpr size_t WS_XBC = WS_MG + SZ_MG, SZ_XBC = (size_t)M * SSD_CD * 2;
constexpr size_t WS_LB = WS_XBC + SZ_XBC, SZ_LB = AL((size_t)NLAYER * 1024 * 4);
constexpr size_t WS_END = WS_LB + SZ_LB;
static_assert((size_t)M * NUV * 2 <= SZ_P && (size_t)M * DFF * 2 <= SZ_G && 2 * SZ_O <= SZ_X, "overlays");

constexpr int RING_BYTES = 131072, LDSCTL_OFF = RING_BYTES, LDS_BYTES = 147456;

#define GAS __attribute__((address_space(1)))
#define LAS __attribute__((address_space(3)))
typedef unsigned short bf16;
typedef unsigned v4u __attribute__((ext_vector_type(4)));
typedef unsigned v2u __attribute__((ext_vector_type(2)));
typedef float f32x4 __attribute__((ext_vector_type(4)));
typedef float f32x2 __attribute__((ext_vector_type(2)));
typedef short bf16x8 __attribute__((ext_vector_type(8)));
#define LDS_WAIT() asm volatile("s_waitcnt lgkmcnt(0)" ::: "memory")
__device__ __forceinline__ unsigned f2bf(float f) { unsigned u = __builtin_bit_cast(unsigned, f); return (u + 0x7fffu + ((u >> 16) & 1u)) >> 16; }
__device__ __forceinline__ unsigned pk2(float lo, float hi) { return pg8::cvt_pk_bf16(lo, hi); }
__device__ __forceinline__ float bf2f(unsigned short b) { return __uint_as_float(((unsigned)b) << 16); }
__device__ __forceinline__ float bflo(unsigned w) { return __uint_as_float(w << 16); }
__device__ __forceinline__ float bfhi(unsigned w) { return __uint_as_float(w & 0xffff0000u); }
__device__ __forceinline__ float sigm(float x) { return __builtin_amdgcn_rcpf(1.f + __builtin_amdgcn_exp2f(-1.4426950408889634f * x)); }
__device__ __forceinline__ float siluf(float x) { return x * sigm(x); }
__device__ __forceinline__ float geluf(float x) { return x * sigm(1.5957691216057308f * (x + 0.044715f * x * x * x)); }
__device__ __forceinline__ float softplusf(float x) { const float t = __builtin_amdgcn_exp2f(-1.4426950408889634f * fabsf(x));
    const float l1p = t < 0.03f ? t * (1.f - t * (0.5f - t * 0.33333334f)) : 0.6931471805599453f * __builtin_amdgcn_logf(1.f + t); return fmaxf(x, 0.f) + l1p; }

typedef unsigned long long u64;
__device__ __forceinline__ float rstd_of(const u64* rss, size_t row) { return __builtin_amdgcn_rsqf((float)rss[row] * RSS_INV + EPS); }
__device__ __forceinline__ void rss_add(u64* rss, size_t row, float ss) { (void)__hip_atomic_fetch_add(rss + row, (u64)(ss * RSS_SCALE + 0.5f), __ATOMIC_RELAXED, __HIP_MEMORY_SCOPE_AGENT); }

#define XB_TMO      128
#define XB_XCNT(j)  (256  + 64 * (j))
#define XB_XSUB(j)  (1280 + 64 * (j))
#define XB_XGEN(j)  (2304 + 64 * (j))
#define XB_TOP      3328
#define XB_TOPGEN   3392
#define XCD_BAR_WORDS 3456
#define XB_SPIN_CAP (1u << 19)
__device__ __forceinline__ unsigned xb_ld(unsigned* p)              { return __hip_atomic_load(p, __ATOMIC_RELAXED, __HIP_MEMORY_SCOPE_AGENT); }
__device__ __forceinline__ unsigned xb_add(unsigned* p, unsigned v) { return __hip_atomic_fetch_add(p, v, __ATOMIC_RELAXED, __HIP_MEMORY_SCOPE_AGENT); }
__device__ __forceinline__ unsigned xb_xcc_id() { return (unsigned)__builtin_amdgcn_s_getreg((3 << 11) | 20) & 0xFu; }
#define XB_SPIN(cond, bar) do { unsigned _sp = 0; while (cond) { __builtin_amdgcn_s_sleep(16); \
    if ((++_sp & 255u) == 0u) { if (xb_ld(&(bar)[XB_TMO])) break; if (_sp > XB_SPIN_CAP) { atomicAdd(&(bar)[XB_TMO], 1u); break; } } } } while (0)
struct XcdBarrier { unsigned* bar; unsigned x; volatile LAS unsigned* st; };
__device__ __forceinline__ XcdBarrier xcd_barrier_post(unsigned* bar, volatile LAS unsigned* st) {
    XcdBarrier b; b.bar = bar; b.x = xb_xcc_id(); b.st = st;
    if (threadIdx.x == 0) (void)xb_add(&bar[XB_XCNT(b.x)], 1u);
    return b;
}
__device__ __forceinline__ void xcd_barrier_complete(unsigned* bar, unsigned x, unsigned& nloc, unsigned& nx) {
    const unsigned G = gridDim.x * gridDim.y * gridDim.z;
    unsigned sum, cnt, mine, sp = 0u;
    for (;;) {
        sum = 0u; cnt = 0u; mine = 0u;
#pragma unroll
        for (unsigned j = 0; j < 16; ++j) { const unsigned c = xb_ld(&bar[XB_XCNT(j)]); sum += c; cnt += (c > 0u) ? 1u : 0u; mine = (j == x) ? c : mine; }
        if (sum == G) break;
        __builtin_amdgcn_s_sleep(1);
        if ((++sp & 255u) == 0u) { if (xb_ld(&bar[XB_TMO])) break; if (sp > XB_SPIN_CAP) { atomicAdd(&bar[XB_TMO], 1u); break; } }
    }
    nloc = mine > 0u ? mine : 1u; nx = cnt > 0u ? cnt : 1u;
}
__device__ __forceinline__ void xcd_barrier(const XcdBarrier& b) {
    asm volatile("s_waitcnt vmcnt(0)" ::: "memory");
    __syncthreads();
    if (threadIdx.x == 0) {
        unsigned* bar = b.bar;
        __builtin_amdgcn_s_waitcnt(0);
        unsigned nloc = b.st[0], nx = b.st[1];
        if (nloc == 0u) { xcd_barrier_complete(bar, b.x, nloc, nx); b.st[0] = nloc; b.st[1] = nx; }
        const unsigned old = xb_add(&bar[XB_XSUB(b.x)], 1u);
        const unsigned gen = old / nloc;
        if (old + 1u == (gen + 1u) * nloc) {
            __builtin_amdgcn_fence(__ATOMIC_RELEASE, "agent");
            asm volatile("s_waitcnt vmcnt(0)" ::: "memory");
            const unsigned og = xb_add(&bar[XB_TOP], 1u);
            const unsigned tg = og / nx;
            if (og + 1u == (tg + 1u) * nx) xb_add(&bar[XB_TOPGEN], 1u);
            else XB_SPIN(xb_ld(&bar[XB_TOPGEN]) == tg, bar);
            __builtin_amdgcn_fence(__ATOMIC_ACQUIRE, "agent");
            xb_add(&bar[XB_XGEN(b.x)], 1u);
            asm volatile("s_waitcnt vmcnt(0)" ::: "memory");
        } else {
            XB_SPIN(xb_ld(&bar[XB_XGEN(b.x)]) == gen, bar);
            __builtin_amdgcn_fence(__ATOMIC_ACQUIRE, "agent");
            asm volatile("s_waitcnt vmcnt(0)" ::: "memory");
        }
    }
    __syncthreads();
}

struct Args { const float* in[N_INPUTS]; float* out; unsigned char* ws; int ph_lo, ph_hi; };

struct Frame {
    LAS unsigned char* lds;
    int tid, lane, wave, G, c;
    const float* const* in;
    float* out;
    unsigned char* ws;
};
#define WSP(T, off) ((T*)(F.ws + (off)))
__device__ __forceinline__ Frame launder(const Frame& F0) {
    Frame F = F0;
    asm volatile("" : "+v"(F.tid), "+v"(F.lane));
    asm volatile("" : "+s"(F.wave), "+s"(F.G), "+s"(F.c));
    { int z = 0; asm volatile("" : "+s"(z)); F.in += z; F.out += z; F.ws += z; }
    asm volatile("" : "+s"(F.lds));
    return F;
}

using pg8::f32x4;
using pg8::Unit;
using pg8::cvt_pk_bf16;

struct Epi1 {
    static constexpr bool PERM = true;
    bf16* P; float* HF; float* DT; bf16* Gt; const float* LB; const u64* RSS;
    __device__ __forceinline__ bool keep(const Unit&) const { return false; }
    template <int ACT> __device__ __forceinline__ void store_act(f32x4 (&acc)[2][2][4][2], bf16* base, int ld, int row0, int colb) const {
#pragma unroll
        for (int ai = 0; ai < 2; ++ai) { float rs4[4];
#pragma unroll
            for (int m = 0; m < 4; ++m) rs4[m] = rstd_of(RSS, row0 + ai * 128 + m * 16);
#pragma unroll
            for (int m = 0; m < 4; ++m) { bf16* rowp = base + (size_t)(row0 + ai * 128 + m * 16) * ld + colb; const float rs = rs4[m];
#pragma unroll
                for (int bj = 0; bj < 2; ++bj) { f32x4 v0 = acc[ai][bj][m][0] * rs, v1 = acc[ai][bj][m][1] * rs;
#pragma unroll
                    for (int j = 0; j < 4; ++j) { if (ACT == 1) { v0[j] = geluf(v0[j]); v1[j] = geluf(v1[j]); } if (ACT == 2) { v0[j] = siluf(v0[j]); v1[j] = siluf(v1[j]); } if (ACT == 3) { v0[j] = sigm(v0[j]); v1[j] = sigm(v1[j]); } }
                    pg8::u32x4 w; w.x = cvt_pk_bf16(v0[0], v0[1]); w.y = cvt_pk_bf16(v0[2], v0[3]); w.z = cvt_pk_bf16(v1[0], v1[1]); w.w = cvt_pk_bf16(v1[2], v1[3]);
                    *(pg8::u32x4*)(rowp + bj * 128) = w; }
                asm volatile("" ::: "memory"); } }
    }
    __device__ __forceinline__ void operator()(f32x4 (&acc)[2][2][4][2], const Unit& u, int wr, int wc, int fr, int fq) const {
        asm volatile("" : "+v"(fr), "+v"(fq));
        const int row0 = u.pm * 256 + wr * 64 + fr, pn = u.pn;
        if (pn >= 51) { store_act<3>(acc, Gt, NG, row0, (pn - 51) * 256 + wc * 32 + 8 * fq); }
        else if (pn >= 12 && pn < 16) {
            const int colb = (pn - 12) * 256 + wc * 32 + 8 * fq;
#pragma unroll
            for (int bj = 0; bj < 2; ++bj) { const f32x4 l0 = *(const f32x4*)(LB + colb + bj * 128), l1 = *(const f32x4*)(LB + colb + bj * 128 + 4);
#pragma unroll
                for (int ai = 0; ai < 2; ++ai) { float rs4[4];
#pragma unroll
                    for (int m = 0; m < 4; ++m) rs4[m] = rstd_of(RSS, row0 + ai * 128 + m * 16);
#pragma unroll
                    for (int m = 0; m < 4; ++m) { const size_t r = (size_t)(row0 + ai * 128 + m * 16); const float rs = rs4[m];
                        f32x4 v0 = acc[ai][bj][m][0] * rs, v1 = acc[ai][bj][m][1] * rs, g0, g1, k0, k1;
#pragma unroll
                        for (int j = 0; j < 4; ++j) { { const float e = __builtin_amdgcn_exp2f(-1.4426950408889634f * fabsf(v0[j])), r = __builtin_amdgcn_rcpf(1.f + e), sm = e * r, sg = v0[j] >= 0.f ? r : sm, sn = v0[j] >= 0.f ? sm : r; g0[j] = 0.6931471805599453f * __builtin_amdgcn_logf(l0[j] + (1.f - l0[j]) * sg); k0[j] = (1.f - l0[j]) * sn; }
                                                      { const float e = __builtin_amdgcn_exp2f(-1.4426950408889634f * fabsf(v1[j])), r = __builtin_amdgcn_rcpf(1.f + e), sm = e * r, sg = v1[j] >= 0.f ? r : sm, sn = v1[j] >= 0.f ? sm : r; g1[j] = 0.6931471805599453f * __builtin_amdgcn_logf(l1[j] + (1.f - l1[j]) * sg); k1[j] = (1.f - l1[j]) * sn; } }
                        *(f32x4*)(HF + r * 1024 + colb + bj * 128) = g0; *(f32x4*)(HF + r * 1024 + colb + bj * 128 + 4) = g1;
                        pg8::u32x4 w; w.x = cvt_pk_bf16(k0[0], k0[1]); w.y = cvt_pk_bf16(k0[2], k0[3]); w.z = cvt_pk_bf16(k1[0], k1[1]); w.w = cvt_pk_bf16(k1[2], k1[3]);
                        *(pg8::u32x4*)(P + r * NP + C_HF + colb + bj * 128) = w; asm volatile("" ::: "memory"); } } }
        } else if (pn == 34) {
            if (wc == 0 && fq < 2) {
#pragma unroll
                for (int ai = 0; ai < 2; ++ai)
#pragma unroll
                    for (int m = 0; m < 4; ++m) { float* rowp = DT + (size_t)(row0 + ai * 128 + m * 16) * 16 + 8 * fq; const float rs = rstd_of(RSS, row0 + ai * 128 + m * 16);
                        *(f32x4*)(rowp) = acc[ai][0][m][0] * rs; *(f32x4*)(rowp + 4) = acc[ai][0][m][1] * rs; }
            }
        } else {
            const int colb = pn * 256 + wc * 32 + 8 * fq;
            if (pn >= 4 && pn < 8) store_act<1>(acc, P, NP, row0, colb);
            else if ((pn >= 8 && pn < 12) || (pn >= 20 && pn < 28) || pn >= 47) store_act<2>(acc, P, NP, row0, colb);
            else store_act<0>(acc, P, NP, row0, colb);
        }
    }
};

struct SameTile { int n; __device__ bool next(int i, Unit& u) const { if (i >= n) return false; u.pm = 0; u.pn = 0; u.kz = 0; return true; } };
template <bool P_> struct EpiNull {
    static constexpr bool PERM = P_;
    float* sinkp;
    __device__ __forceinline__ bool keep(const Unit&) const { return false; }
    __device__ __forceinline__ void operator()(f32x4 (&acc)[2][2][4][2], const Unit& u, int wr, int wc, int fr, int fq) const {
        float t = 0.f;
#pragma unroll
        for (int ai = 0; ai < 2; ++ai)
#pragma unroll
            for (int bj = 0; bj < 2; ++bj)
#pragma unroll
                for (int m = 0; m < 4; ++m) t += acc[ai][bj][m][0][0] + acc[ai][bj][m][1][3];
        if (t == 1.2345e30f) sinkp[0] = t;
    }
};

struct EpiB {
    static constexpr bool PERM = true;
    bf16* O; int ldc; const u64* RSS;
    __device__ __forceinline__ bool keep(const Unit&) const { return false; }
    __device__ __forceinline__ void operator()(f32x4 (&acc)[2][2][4][2], const Unit& u, int wr, int wc, int fr, int fq) const {
        asm volatile("" : "+v"(fr), "+v"(fq));
        const int row0 = u.pm * 256 + wr * 64 + fr, colb = u.pn * 256 + wc * 32 + 8 * fq;
#pragma unroll
        for (int ai = 0; ai < 2; ++ai)
#pragma unroll
            for (int m = 0; m < 4; ++m) { bf16* rowp = O + (size_t)(row0 + ai * 128 + m * 16) * ldc + colb; const float rs = rstd_of(RSS, row0 + ai * 128 + m * 16);
#pragma unroll
                for (int bj = 0; bj < 2; ++bj) { const f32x4 v0 = acc[ai][bj][m][0] * rs, v1 = acc[ai][bj][m][1] * rs; pg8::u32x4 w;
                    w.x = cvt_pk_bf16(v0[0], v0[1]); w.y = cvt_pk_bf16(v0[2], v0[3]); w.z = cvt_pk_bf16(v1[0], v1[1]); w.w = cvt_pk_bf16(v1[2], v1[3]);
                    *(pg8::u32x4*)(rowp + bj * 128) = w; } }
    }
};

struct EpiBr {
    static constexpr bool PERM = true;
    const bf16* Gt; bf16* O;
    __device__ __forceinline__ bool keep(const Unit& u) const { return u.kz < 3; }
    __device__ __forceinline__ void operator()(f32x4 (&acc)[2][2][4][2], const Unit& u, int wr, int wc, int fr, int fq) const {
        asm volatile("" : "+v"(fr), "+v"(fq));
        const int row0 = u.pm * 256 + wr * 64 + fr, colb = u.pn * 256 + wc * 32 + 8 * fq, kz = u.kz;
#pragma unroll
        for (int ai = 0; ai < 2; ++ai) {
                pg8::u32x4 gav[4][2], gbv[4][2];
#pragma unroll
                for (int mm = 0; mm < 4; ++mm)
#pragma unroll
                    for (int bj = 0; bj < 2; ++bj) { const size_t r = (size_t)(row0 + ai * 128 + mm * 16);
                        gav[mm][bj] = *(const pg8::u32x4*)(Gt + r * NG + kz * 2048 + colb + bj * 128);
                        gbv[mm][bj] = *(const pg8::u32x4*)(Gt + r * NG + (kz < 3 ? kz + 1 : kz) * 2048 + colb + bj * 128); }
#pragma unroll
                for (int mm = 0; mm < 4; ++mm) { const int m = mm; const size_t r = (size_t)(row0 + ai * 128 + m * 16);
#pragma unroll
                    for (int bj = 0; bj < 2; ++bj) {
                        const pg8::u32x4 ga = gav[mm][bj], gb = gbv[mm][bj];
                        float s[8] = {bflo(ga.x), bfhi(ga.x), bflo(ga.y), bfhi(ga.y), bflo(ga.z), bfhi(ga.z), bflo(ga.w), bfhi(ga.w)};
                        if (kz < 3) {
                            const float d[8] = {bflo(gb.x), bfhi(gb.x), bflo(gb.y), bfhi(gb.y), bflo(gb.z), bfhi(gb.z), bflo(gb.w), bfhi(gb.w)};
#pragma unroll
                            for (int j = 0; j < 8; ++j) s[j] = s[j] * __builtin_amdgcn_rcpf(fmaxf(d[j], 1e-20f));
                        }
                        f32x4 v0 = acc[ai][bj][m][0], v1 = acc[ai][bj][m][1];
                        v0[0] *= s[0]; v0[1] *= s[1]; v0[2] *= s[2]; v0[3] *= s[3]; v1[0] *= s[4]; v1[1] *= s[5]; v1[2] *= s[6]; v1[3] *= s[7];
                        acc[ai][bj][m][0] = v0; acc[ai][bj][m][1] = v1;
                        if (kz == 3) { pg8::u32x4 w; w.x = cvt_pk_bf16(v0[0], v0[1]); w.y = cvt_pk_bf16(v0[2], v0[3]); w.z = cvt_pk_bf16(v1[0], v1[1]); w.w = cvt_pk_bf16(v1[2], v1[3]);
                            *(pg8::u32x4*)(O + r * DM + colb + bj * 128) = w; }
                    } }
                asm volatile("" ::: "memory"); }
    }
};

struct EpiRes {
    static constexpr bool PERM = true;
    const bf16* Xc; bf16* Xn; u64* RSS;
    __device__ __forceinline__ bool keep(const Unit&) const { return false; }
    __device__ __forceinline__ void operator()(f32x4 (&acc)[2][2][4][2], const Unit& u, int wr, int wc, int fr, int fq) const {
        asm volatile("" : "+v"(fr), "+v"(fq));
        const int row0 = u.pm * 256 + wr * 64 + fr, col0 = u.pn * 256 + wc * 32 + 8 * fq;
#pragma unroll
        for (int ap = 0; ap < 4; ++ap) { const int ai = ap >> 1, mb = (ap & 1) * 2;
            pg8::u32x4 xw[2][2];
#pragma unroll
            for (int mm = 0; mm < 2; ++mm)
#pragma unroll
                for (int bj = 0; bj < 2; ++bj) xw[mm][bj] = *(const pg8::u32x4*)(Xc + (size_t)(row0 + ai * 128 + (mb + mm) * 16) * DM + col0 + bj * 128);
#pragma unroll
            for (int mm = 0; mm < 2; ++mm) { const int m = mb + mm; const size_t row = (size_t)(row0 + ai * 128 + m * 16), off = row * DM + col0; float ss = 0.f;
#pragma unroll
                for (int bj = 0; bj < 2; ++bj) { const pg8::u32x4 w_ = xw[mm][bj];
                    const f32x4 x0 = (f32x4){bflo(w_.x), bfhi(w_.x), bflo(w_.y), bfhi(w_.y)} + acc[ai][bj][m][0], x1 = (f32x4){bflo(w_.z), bfhi(w_.z), bflo(w_.w), bfhi(w_.w)} + acc[ai][bj][m][1];
                    pg8::u32x4 w; w.x = cvt_pk_bf16(x0[0], x0[1]); w.y = cvt_pk_bf16(x0[2], x0[3]); w.z = cvt_pk_bf16(x1[0], x1[1]); w.w = cvt_pk_bf16(x1[2], x1[3]);
                    *(pg8::u32x4*)(Xn + off + bj * 128) = w;
                    ss += (x0[0] * x0[0] + x0[1] * x0[1]) + (x0[2] * x0[2] + x0[3] * x0[3]) + (x1[0] * x1[0] + x1[1] * x1[1]) + (x1[2] * x1[2] + x1[3] * x1[3]); }
                ss += __shfl_xor(ss, 16); ss += __shfl_xor(ss, 32);
                if (fq == 0) rss_add(RSS, row, ss); }
            asm volatile("" ::: "memory"); }
    }
};

constexpr int XB_OFF = LDSCTL_OFF + 1024;
__device__ __forceinline__ float dpp_ror1(float x) { return __builtin_bit_cast(float, __builtin_amdgcn_update_dpp(0, __builtin_bit_cast(int, x), 0x121, 0xf, 0xf, false)); }
__device__ __forceinline__ float dpp_ror2(float x) { return __builtin_bit_cast(float, __builtin_amdgcn_update_dpp(0, __builtin_bit_cast(int, x), 0x122, 0xf, 0xf, false)); }
struct EpiAct {
    static constexpr bool PERM = true;
    bf16* A2; const u64* RSS; const float* cw; const float* cb; const float* st_in; float* fc_p; float* fc_s; LAS unsigned char* lds;
    __device__ __forceinline__ bool keep(const Unit&) const { return false; }
    __device__ __forceinline__ void operator()(f32x4 (&acc)[2][2][4][2], const Unit& u, int wr, int wc, int fr, int fq) const {
        asm volatile("" : "+v"(fr), "+v"(fq));
        const int R0 = 254 * u.pm - 2, chb = u.pn * 128 + wc * 32 + 8 * fq, wid = wr * 4 + wc;
#pragma unroll
        for (int ai = 0; ai < 2; ++ai)
#pragma unroll
            for (int m = 0; m < 4; ++m) { int R = R0 + 128 * ai + 64 * wr + 16 * m + fr; R = R < 0 ? 0 : (R >= M ? M - 1 : R); const float rs = rstd_of(RSS, R);
                acc[ai][0][m][0] *= rs; acc[ai][0][m][1] *= rs; acc[ai][1][m][0] *= rs; acc[ai][1][m][1] *= rs; }
        LAS f32x4* XB = (LAS f32x4*)(lds + XB_OFF);
        if (fr >= 14) {
#pragma unroll
            for (int ai = 0; ai < 2; ++ai) { const int slot = (((wid * 2 + ai) * 2 + (fr - 14)) * 4 + fq) * 2; XB[slot] = acc[ai][0][3][0]; XB[slot + 1] = acc[ai][0][3][1]; }
        }
        asm volatile("s_waitcnt lgkmcnt(0)" ::: "memory"); __builtin_amdgcn_s_barrier(); asm volatile("" ::: "memory");
        f32x4 w0a = *(const f32x4*)(cw + chb), w0b = *(const f32x4*)(cw + chb + 4), w1a = *(const f32x4*)(cw + DFF + chb), w1b = *(const f32x4*)(cw + DFF + chb + 4);
        f32x4 w2a = *(const f32x4*)(cw + 2 * DFF + chb), w2b = *(const f32x4*)(cw + 2 * DFF + chb + 4), ba = *(const f32x4*)(cb + chb), bb = *(const f32x4*)(cb + chb + 4);
#pragma unroll
        for (int ai = 0; ai < 2; ++ai) {
            f32x4 pva = (f32x4){0.f, 0.f, 0.f, 0.f}, pvb = pva;
            { const int kblk = 2 * ai + wr; if (kblk > 0 && fr >= 14) { const int pai = (kblk - 1) >> 1, pwr = (kblk - 1) & 1, slot = ((((pwr * 4 + wc) * 2 + pai) * 2 + (fr - 14)) * 4 + fq) * 2; pva = XB[slot]; pvb = XB[slot + 1]; } }
#pragma unroll
            for (int m = 0; m < 4; ++m) {
                const f32x4 ua = acc[ai][0][m][0], ub = acc[ai][0][m][1], va = acc[ai][1][m][0], vb = acc[ai][1][m][1];
                const f32x4 qa = (m == 0) ? pva : acc[ai][0][m - 1][0], qb = (m == 0) ? pvb : acc[ai][0][m - 1][1];
                f32x4 p1a, p1b, p2a, p2b;
#pragma unroll
                for (int i = 0; i < 4; ++i) { const float c1a = dpp_ror1(ua[i]), c1b = dpp_ror1(ub[i]), c2a = dpp_ror2(ua[i]), c2b = dpp_ror2(ub[i]);
                    const float d1a = dpp_ror1(qa[i]), d1b = dpp_ror1(qb[i]), d2a = dpp_ror2(qa[i]), d2b = dpp_ror2(qb[i]);
                    p1a[i] = fr >= 1 ? c1a : d1a; p1b[i] = fr >= 1 ? c1b : d1b; p2a[i] = fr >= 2 ? c2a : d2a; p2b[i] = fr >= 2 ? c2b : d2b; }
                const int r = 128 * ai + 64 * wr + 16 * m + fr, R = R0 + r;
                const bool prompt = (r >= 2) && (R >= 0) && (R < MP), samp = (R >= MP) && (R < MR);
                if (prompt) { const int t = R & (SEQ - 1);
                    if (t < 1) { p1a = (f32x4){0.f, 0.f, 0.f, 0.f}; p1b = p1a; } if (t < 2) { p2a = (f32x4){0.f, 0.f, 0.f, 0.f}; p2b = p2a; }
                    if (t >= SEQ - 2) { float* so = fc_p + ((size_t)(R >> 11) * 2 + (t - (SEQ - 2))) * DFF + chb; *(f32x4*)so = ua; *(f32x4*)(so + 4) = ub; } }
                if (samp) { const float* sp = st_in + (size_t)(R - MP) * 2 * DFF + chb; float* so = fc_s + (size_t)(R - MP) * 2 * DFF + chb;
                    p2a = *(const f32x4*)sp; p2b = *(const f32x4*)(sp + 4); p1a = *(const f32x4*)(sp + DFF); p1b = *(const f32x4*)(sp + DFF + 4);
                    *(f32x4*)so = p1a; *(f32x4*)(so + 4) = p1b; *(f32x4*)(so + DFF) = ua; *(f32x4*)(so + DFF + 4) = ub; }
                if (prompt || samp) {
                    const f32x4 ya = ba + w0a * p2a + w1a * p1a + w2a * ua, yb = bb + w0b * p2b + w1b * p1b + w2b * ub;
                    pg8::u32x4 w; w.x = cvt_pk_bf16(geluf(ya[0]) * va[0], geluf(ya[1]) * va[1]); w.y = cvt_pk_bf16(geluf(ya[2]) * va[2], geluf(ya[3]) * va[3]);
                    w.z = cvt_pk_bf16(geluf(yb[0]) * vb[0], geluf(yb[1]) * vb[1]); w.w = cvt_pk_bf16(geluf(yb[2]) * vb[2], geluf(yb[3]) * vb[3]);
                    *(pg8::u32x4*)(A2 + (size_t)R * DFF + chb) = w; }
                asm volatile("" ::: "memory");
            }
        }
    }
};

__device__ __forceinline__ float wave_sum(float v) {
#pragma unroll
    for (int o = 1; o < 64; o <<= 1) v += __shfl_xor(v, o);
    return v;
}
struct TrJob { const float* W; bf16* WT; const float* g; int K, N, ldt, mode, roff, item; };
template <bool NT> __device__ __forceinline__ void tr_load(const TrJob& j, int lane, float (&v)[32]) {
    const int nblk = (j.N + 31) >> 5, kb = j.item / nblk, nb = j.item - kb * nblk, k0 = 64 * kb, n0 = 32 * nb;
    int nn = n0 + (lane & 31); nn = nn < j.N ? nn : j.N - 1;
    const float* p = j.W + (size_t)(k0 + (lane >> 5)) * j.N + nn;
#pragma unroll
    for (int i = 0; i < 32; ++i) v[i] = NT ? __builtin_nontemporal_load(p + (size_t)(2 * i) * j.N) : p[(size_t)(2 * i) * j.N];
}
template <bool NT> __device__ __forceinline__ void tr_store(const TrJob& j, int lane, LAS float* scr, const float (&v)[32]) {
    const int nblk = (j.N + 31) >> 5, kb = j.item / nblk, nb = j.item - kb * nblk, k0 = 64 * kb, n0 = 32 * nb;
#pragma unroll
    for (int i = 0; i < 32; ++i) scr[(2 * i + (lane >> 5)) * 33 + (lane & 31)] = v[i];
    LDS_WAIT(); asm volatile("" ::: "memory");
    const int c = lane & 7;
    float gk[8];
#pragma unroll
    for (int q = 0; q < 8; ++q) gk[q] = j.g ? j.g[k0 + 8 * c + q] : 1.f;
#pragma unroll
    for (int jj = 0; jj < 4; ++jj) { const int n = (lane >> 3) + 8 * jj, gn = n0 + n; const LAS float* s = scr + (8 * c) * 33 + n;
        v4u o; o.x = pk2(s[0 * 33] * gk[0], s[1 * 33] * gk[1]); o.y = pk2(s[2 * 33] * gk[2], s[3 * 33] * gk[3]); o.z = pk2(s[4 * 33] * gk[4], s[5 * 33] * gk[5]); o.w = pk2(s[6 * 33] * gk[6], s[7 * 33] * gk[7]);
        if (gn < j.N) { const int dr = (j.mode == 1) ? (gn < SRC_SPLIT ? gn : gn + 240) : (j.mode >= 2 ? (gn >> 7) * 256 + (gn & 127) + (j.mode == 3 ? 128 : 0) : gn + j.roff); v4u* wp = (v4u*)(j.WT + (size_t)dr * j.ldt + k0 + 8 * c); if (NT) __builtin_nontemporal_store(o, wp); else *wp = o; } }
    LDS_WAIT(); asm volatile("" ::: "memory");
}
constexpr int I_IN = (DM / 64) * ((NIN + 31) / 32), I_GT = (DM / 64) * (NG / 32), I_BR = (BW / 64) * (DM / 32), I_OUT = (DM / 64) * (DM / 32), I_UP = (DM / 64) * (DFF / 32), I_DN = (DFF / 64) * (DM / 32);
constexpr int I_LAYER = I_IN + I_GT + 4 * I_BR + I_OUT + 2 * I_UP + I_DN;
__device__ __forceinline__ TrJob tr_decode(const Frame& F, int it) {
    const int l = it / I_LAYER; int r = it - l * I_LAYER; TrJob j;
    bf16* W1 = WSP(bf16, WS_W1 + l * SZ_W1);
    if (r < I_IN) { j = TrJob{F.in[I_WIN] + (size_t)l * DM * NIN, W1, F.in[I_GMIX] + (size_t)l * DM, DM, NIN, DM, 1, 0, r}; return j; } r -= I_IN;
    if (r < I_GT) { j = TrJob{F.in[I_WGATE] + (size_t)l * DM * NG, W1, F.in[I_GMIX] + (size_t)l * DM, DM, NG, DM, 0, NP, r}; return j; } r -= I_GT;
    if (r < 4 * I_BR) { const int k = r / I_BR; j = TrJob{F.in[I_WBR] + ((size_t)l * 4 + k) * BW * DM, WSP(bf16, WS_WB + l * SZ_WB) + (size_t)k * DM * BW, nullptr, BW, DM, BW, 0, 0, r - k * I_BR}; return j; } r -= 4 * I_BR;
    if (r < I_OUT) { j = TrJob{F.in[I_WOUT] + (size_t)l * DM * DM, WSP(bf16, WS_WO + l * SZ_WO), nullptr, DM, DM, DM, 0, 0, r}; return j; } r -= I_OUT;
    if (r < I_UP) { j = TrJob{F.in[I_WUP] + (size_t)l * DM * DFF, WSP(bf16, WS_WUV + l * SZ_WUV), F.in[I_GFFN] + (size_t)l * DM, DM, DFF, DM, 2, 0, r}; return j; } r -= I_UP;
    if (r < I_UP) { j = TrJob{F.in[I_WVAL] + (size_t)l * DM * DFF, WSP(bf16, WS_WUV + l * SZ_WUV), F.in[I_GFFN] + (size_t)l * DM, DM, DFF, DM, 3, 0, r}; return j; } r -= I_UP;
    j = TrJob{F.in[I_WDOWN] + (size_t)l * DFF * DM, WSP(bf16, WS_WD + l * SZ_WD), nullptr, DFF, DM, DFF, 0, 0, r}; return j;
}

template <bool NT> __device__ __forceinline__ void tr_run(const Frame& F0, int it_lo, int it_hi, int gw, int NGW) {
    Frame F = launder(F0);
    LAS float* scr = (LAS float*)(F.lds + F.wave * 8704);
    {
        const int NIT = it_hi;
        int it = it_lo + gw; TrJob j0, j1, j2; float r0[32], r1[32], r2[32];
        j0 = j1 = j2 = tr_decode(F, it < NIT ? it : it_lo);
        if (it < NIT) { tr_load<NT>(j0, F.lane, r0); }
        if (it + NGW < NIT) { j1 = tr_decode(F, it + NGW); tr_load<NT>(j1, F.lane, r1); }
        while (it < NIT) {
            if (it + 2 * NGW < NIT) { j2 = tr_decode(F, it + 2 * NGW); tr_load<NT>(j2, F.lane, r2); }
            tr_store<NT>(j0, F.lane, scr, r0);
            it += NGW; if (it >= NIT) break;
            if (it + 2 * NGW < NIT) { j0 = tr_decode(F, it + 2 * NGW); tr_load<NT>(j0, F.lane, r0); }
            tr_store<NT>(j1, F.lane, scr, r1);
            it += NGW; if (it >= NIT) break;
            if (it + 2 * NGW < NIT) { j1 = tr_decode(F, it + 2 * NGW); tr_load<NT>(j1, F.lane, r1); }
            tr_store<NT>(j2, F.lane, scr, r2);
            it += NGW;
        }
    }
}
constexpr int SIDE_A = 5000, SIDE_B = 5400, NIT_ALL = NLAYER * I_LAYER;
constexpr int S3 = NIT_ALL - I_DN, S2 = S3 - SIDE_A, S1 = S2 - SIDE_B, S0 = S1 - SIDE_A;
static_assert(S2 >= NIT_ALL - I_DN - I_UP, "GEMM1(1) side items must be needed after GEMM1(1) only (val weights)");
__device__ __forceinline__ void phase_prologue(const Frame& F0) {
    Frame F = launder(F0);
    const int gw = F.c * NWAVES + F.wave, NGW = F.G * NWAVES;
    tr_run<false>(F, 0, S0, gw, NGW);
    const int gt = F.c * NTHR + F.tid, NGT = F.G * NTHR;
    for (int i = gt; i < NLAYER * 240 * (DM / 8); i += NGT) { const int l = i / (240 * (DM / 8)), r = i - l * (240 * (DM / 8));
        *(v4u*)(WSP(bf16, WS_W1 + l * SZ_W1) + (size_t)(SRC_SPLIT + r / (DM / 8)) * DM + (r % (DM / 8)) * 8) = (v4u){0u, 0u, 0u, 0u}; }
    for (int i = gt; i < NLAYER * 1024; i += NGT) { const int l = i >> 10, c = i & 1023; WSP(float, WS_LB)[i] = l == 0 ? 0.f : sigm(F.in[I_HGLB][1024 + c] - F.in[I_HGLB][c]); }
    for (int i = gt; i < 2049 * 64; i += NGT) { const int p = i >> 6, j = i & 63; const float pos = p < 2048 ? (float)p : 16384.f;
        const float fr = __builtin_amdgcn_exp2f(-(float)j * (13.287712379549449f / 64.f)); const float ang = pos * fr;
        double rev = (double)ang * 0.15915494309189535; rev -= floor(rev); const float fx = (float)rev;
        WSP(f32x2, WS_ROPE)[i] = (f32x2){__builtin_amdgcn_cosf(fx), __builtin_amdgcn_sinf(fx)}; }
    for (int row = gw; row < M; row += NGW) {
        v2u* ho = (v2u*)(WSP(bf16, WS_XB0) + (size_t)row * DM) + F.lane;
        const f32x4* xi = row < MP ? (const f32x4*)F.in[I_XP] + (size_t)row * (DM / 4) + F.lane : (const f32x4*)F.in[I_XS] + (size_t)(row < MR ? row - MP : 0) * (DM / 4) + F.lane;
        float ss = 0.f;
#pragma unroll
        for (int j = 0; j < 8; ++j) { f32x4 v = xi[64 * j]; if (row >= MR) v = (f32x4){0.f, 0.f, 0.f, 0.f};
            ho[64 * j] = (v2u){pk2(v.x, v.y), pk2(v.z, v.w)}; ss += (v.x * v.x + v.y * v.y) + (v.z * v.z + v.w * v.w); }
        ss = wave_sum(ss);
        if (F.lane == 0 && row < MR) ((u64*)(F.ws + WS_RSS))[row] = (u64)(ss * RSS_SCALE + 0.5f);
        if (row >= MR) { v2u* h1 = (v2u*)(WSP(bf16, WS_XB1) + (size_t)row * DM) + F.lane;
#pragma unroll
            for (int j = 0; j < 8; ++j) h1[64 * j] = (v2u){0u, 0u}; }
    }
}

__device__ __forceinline__ void phase_final(const Frame& F0, const bf16* X, const float* g) {
    Frame F = launder(F0);
    const int gw = F.c * NWAVES + F.wave, NGW = F.G * NWAVES;
    for (int row = gw; row < MR; row += NGW) {
        const v2u* xr = (const v2u*)(X + (size_t)row * DM) + F.lane;
        f32x4* o = (f32x4*)(F.out + (row < MP ? O_YP + (size_t)row * DM : O_YS + (size_t)(row - MP) * DM)) + F.lane;
        const float rstd = rstd_of((const u64*)(F.ws + WS_RSS + 4 * SZ_RSS), row);
#pragma unroll
        for (int j = 0; j < 8; ++j) { const f32x4 gv = ((const f32x4*)g)[F.lane + 64 * j]; const v2u w = xr[64 * j];
            __builtin_nontemporal_store((f32x4){bflo(w.x), bfhi(w.x), bflo(w.y), bfhi(w.y)} * rstd * gv, o + 64 * j); }
    }
}

constexpr size_t WS_HGQ = WS_BR + (size_t)M * BW * 2;
static_assert(2 * (size_t)MP * 1024 * 2 + 3 * 128 * 1024 * 4 <= 3 * (size_t)M * BW * 2, "HGQ overlay");
constexpr size_t HGQ_STRIDE = (size_t)MP * 1024;
constexpr int LW_STR = 136;
constexpr int L_WT = 0, L_XC = 256 * LW_STR * 2, L_XCF = L_XC + 64 * LW_STR * 2, LXF_STR = 132;
static_assert(L_XCF + 64 * LXF_STR * 4 <= RING_BYTES, "lru lds");
__device__ __forceinline__ void lru_stage_w(const Frame& F0, int l, int n) {
    Frame F = launder(F0);
    LAS bf16* WT = (LAS bf16*)(F.lds + L_WT);
    const float* wa = F.in[I_LWA] + ((size_t)l * 8 + n) * 16384; const float* wx = F.in[I_LWX] + ((size_t)l * 8 + n) * 16384;
#pragma unroll 1
    for (int i0 = F.tid; i0 < 16384; i0 += 8 * NTHR) { float va[8], vx[8];
#pragma unroll
        for (int q = 0; q < 8; ++q) { va[q] = wa[i0 + q * NTHR]; vx[q] = wx[i0 + q * NTHR]; }
#pragma unroll
        for (int q = 0; q < 8; ++q) { const int i = i0 + q * NTHR, c = i >> 7, d = i & 127; WT[d * LW_STR + c] = (bf16)f2bf(va[q]); WT[(128 + d) * LW_STR + c] = (bf16)f2bf(vx[q]); } }
}
__device__ __forceinline__ void lru_tile(const Frame& F0, int l, int n, int tt) {
    Frame F = launder(F0);
    LAS bf16* WT = (LAS bf16*)(F.lds + L_WT); LAS bf16* XC = (LAS bf16*)(F.lds + L_XC); LAS float* XCF = (LAS float*)(F.lds + L_XCF);
    const bf16* P = WSP(bf16, WS_P);
    const float* cw = F.in[I_LCW] + (size_t)l * 4 * 1024; const float* cb = F.in[I_LCB] + (size_t)l * 1024;
    {
        const int tk = F.tid >> 3, c0 = (F.tid & 7) * 16, row = tt * 64 + tk, ch0 = n * 128 + c0;
        float acc[16];
#pragma unroll
        for (int j = 0; j < 16; ++j) acc[j] = cb[ch0 + j];
        if (row < MP) {
            const int t = row & (SEQ - 1);
#pragma unroll
            for (int jj = 0; jj < 4; ++jj) { if (t - 3 + jj >= 0) { const v4u* src = (const v4u*)(P + (size_t)(row - 3 + jj) * NP + C_XA + ch0); const v4u a = src[0], b = src[1];
                const unsigned w[8] = {a.x, a.y, a.z, a.w, b.x, b.y, b.z, b.w}; const float* wj = cw + jj * 1024 + ch0;
#pragma unroll
                for (int q = 0; q < 8; ++q) { acc[2 * q] += wj[2 * q] * bflo(w[q]); acc[2 * q + 1] += wj[2 * q + 1] * bfhi(w[q]); } } }
        } else if (row < MR) {
            const int s = row - MP; const float* st = F.in[I_SLC] + ((size_t)l * 128 + s) * 3 * 1024 + ch0;
#pragma unroll
            for (int jj = 0; jj < 3; ++jj) { const float* wj = cw + jj * 1024 + ch0;
#pragma unroll
                for (int q = 0; q < 16; ++q) acc[q] += wj[q] * st[jj * 1024 + q]; }
            const v4u* src = (const v4u*)(P + (size_t)row * NP + C_XA + ch0); const v4u a = src[0], b = src[1];
            const unsigned w[8] = {a.x, a.y, a.z, a.w, b.x, b.y, b.z, b.w}; const float* wj = cw + 3 * 1024 + ch0;
#pragma unroll
            for (int q = 0; q < 8; ++q) { acc[2 * q] += wj[2 * q] * bflo(w[q]); acc[2 * q + 1] += wj[2 * q + 1] * bfhi(w[q]); }
        }
#pragma unroll
        for (int q = 0; q < 16; ++q) { XCF[tk * LXF_STR + c0 + q] = acc[q]; }
#pragma unroll
        for (int q = 0; q < 8; ++q) *(LAS unsigned*)(XC + tk * LW_STR + c0 + 2 * q) = pk2(acc[2 * q], acc[2 * q + 1]);
    }
    __syncthreads();
    const int w = F.wave, lane = F.lane, fr = lane & 15, g = lane >> 4;
    f32x4 ar[4], ai_[4];
#pragma unroll
    for (int rt = 0; rt < 4; ++rt) { ar[rt] = (f32x4){0.f, 0.f, 0.f, 0.f}; ai_[rt] = (f32x4){0.f, 0.f, 0.f, 0.f}; }
#pragma unroll
    for (int ks = 0; ks < 4; ++ks) {
        const bf16x8 br = *(const LAS bf16x8*)(WT + (16 * w + fr) * LW_STR + 32 * ks + 8 * g);
        const bf16x8 bi = *(const LAS bf16x8*)(WT + (128 + 16 * w + fr) * LW_STR + 32 * ks + 8 * g);
#pragma unroll
        for (int rt = 0; rt < 4; ++rt) { const bf16x8 a = *(const LAS bf16x8*)(XC + (16 * rt + fr) * LW_STR + 32 * ks + 8 * g);
            ar[rt] = __builtin_amdgcn_mfma_f32_16x16x32_bf16(a, br, ar[rt], 0, 0, 0); ai_[rt] = __builtin_amdgcn_mfma_f32_16x16x32_bf16(a, bi, ai_[rt], 0, 0, 0); }
    }
    const int d = 16 * w + fr, ch = n * 128 + d;
    const float ba = F.in[I_LBA][(size_t)l * 1024 + ch], bx = F.in[I_LBX][(size_t)l * 1024 + ch], sp = softplusf(-F.in[I_LLAM][(size_t)l * 1024 + ch]);
    bf16* LA = WSP(bf16, WS_X1); bf16* LU = LA + (size_t)M * 1024;
    const bool scan = (tt < 128);
    float CA = 1.f, CU = 0.f;
#pragma unroll
    for (int rt = 0; rt < 4; ++rt) {
        float A[4], U[4];
#pragma unroll
        for (int reg = 0; reg < 4; ++reg) { const int tk = 16 * rt + 4 * g + reg;
            const float r = sigm(ar[rt][reg] + ba), iv = sigm(ai_[rt][reg] + bx), la = -8.f * r * sp, a = __expf(la), xc = XCF[tk * LXF_STR + d];
            const float tq = -2.f * la, om = tq < 0.25f ? tq * (1.f + tq * (-0.5f + tq * (0.16666667f + tq * (-0.041666668f + tq * 0.0083333338f)))) : 1.f - __expf(-tq);
            A[reg] = a; U[reg] = __builtin_amdgcn_sqrtf(fmaxf(om, 0.f)) * (iv * xc); }
        if (scan) {
#pragma unroll
            for (int reg = 1; reg < 4; ++reg) { U[reg] = A[reg] * U[reg - 1] + U[reg]; A[reg] = A[reg] * A[reg - 1]; }
            float PA = 1.f, PU = 0.f, TA = 1.f, TU = 0.f;
#pragma unroll
            for (int src = 0; src < 4; ++src) { const float sa = __shfl(A[3], fr + 16 * src), su = __shfl(U[3], fr + 16 * src);
                if (src < g) { PU = sa * PU + su; PA = sa * PA; }
                TU = sa * TU + su; TA = sa * TA; }
            const float GA = PA * CA, GU = PA * CU + PU;
#pragma unroll
            for (int reg = 0; reg < 4; ++reg) { U[reg] = A[reg] * GU + U[reg]; A[reg] = A[reg] * GA; }
            CU = TA * CU + TU; CA = TA * CA;
        }
#pragma unroll
        for (int reg = 0; reg < 4; ++reg) { const size_t row = (size_t)tt * 64 + 16 * rt + 4 * g + reg; const unsigned wau = pk2(A[reg], U[reg]); LA[row * 1024 + ch] = (bf16)(wau & 0xffffu); LU[row * 1024 + ch] = (bf16)(wau >> 16); }
    }
    __syncthreads();
}
__device__ __forceinline__ void phase_conv(const Frame& F00, int l) {
    Frame F0 = launder(F00);
    { const int n = F0.c & 7; bool staged = false;
      for (int tt = F0.c >> 3; tt < 130; tt += (F0.G >> 3)) { if (!staged) { lru_stage_w(F0, l, n); __syncthreads(); staged = true; } lru_tile(F0, l, n, tt); } }
    Frame F = launder(F0);
    const bf16* P = WSP(bf16, WS_P);
    const int gt = F.c * NTHR + F.tid, NGT = F.G * NTHR;
    { const float* cw = F.in[I_SCW] + (size_t)l * 4 * SSD_CD; const float* cb = F.in[I_SCB] + (size_t)l * SSD_CD; bf16* XBC = WSP(bf16, WS_XBC);
      for (int i = gt; i < (MP / 16) * (SSD_CD / 8); i += NGT) { const int run = i / (SSD_CD / 8), c = (i - run * (SSD_CD / 8)) * 8, r0 = run * 16, t0 = r0 & (SEQ - 1);
          v4u rows[19];
#pragma unroll
          for (int k = 0; k < 19; ++k) { const int rr = r0 - 3 + k; rows[k] = *(const v4u*)(P + (size_t)(rr < 0 ? 0 : rr) * NP + C_SX + c); }
          float w[4][8], bias[8];
#pragma unroll
          for (int q = 0; q < 8; ++q) { bias[q] = cb[c + q]; w[0][q] = cw[c + q]; w[1][q] = cw[SSD_CD + c + q]; w[2][q] = cw[2 * SSD_CD + c + q]; w[3][q] = cw[3 * SSD_CD + c + q]; }
#pragma unroll
          for (int k = 0; k < 16; ++k) { float acc[8];
#pragma unroll
              for (int q = 0; q < 8; ++q) acc[q] = bias[q];
#pragma unroll
              for (int jj = 0; jj < 4; ++jj) { if (t0 + k - 3 + jj >= 0) { const v4u a = rows[k + jj]; const unsigned ww[4] = {a.x, a.y, a.z, a.w};
#pragma unroll
                  for (int q = 0; q < 4; ++q) { acc[2 * q] += w[jj][2 * q] * bflo(ww[q]); acc[2 * q + 1] += w[jj][2 * q + 1] * bfhi(ww[q]); } } }
              v4u o; o.x = pk2(siluf(acc[0]), siluf(acc[1])); o.y = pk2(siluf(acc[2]), siluf(acc[3])); o.z = pk2(siluf(acc[4]), siluf(acc[5])); o.w = pk2(siluf(acc[6]), siluf(acc[7]));
              *(v4u*)(XBC + (size_t)(r0 + k) * SSD_CD + c) = o; } }
      for (int i = gt; i < MS * (SSD_CD / 8); i += NGT) { const int s_ = i / (SSD_CD / 8), c = (i - s_ * (SSD_CD / 8)) * 8; const size_t row = (size_t)MP + s_;
          float acc[8];
#pragma unroll
          for (int q = 0; q < 8; ++q) acc[q] = cb[c + q];
          const float* st = F.in[I_SSC] + ((size_t)l * 128 + s_) * 3 * SSD_CD + c;
#pragma unroll
          for (int jj = 0; jj < 3; ++jj) { const float* wj = cw + jj * SSD_CD + c;
#pragma unroll
              for (int q = 0; q < 8; ++q) acc[q] += wj[q] * st[jj * SSD_CD + q]; }
          const v4u a = *(const v4u*)(P + row * NP + C_SX + c); const unsigned ww[4] = {a.x, a.y, a.z, a.w}; const float* wj = cw + 3 * SSD_CD + c;
#pragma unroll
          for (int q = 0; q < 4; ++q) { acc[2 * q] += wj[2 * q] * bflo(ww[q]); acc[2 * q + 1] += wj[2 * q + 1] * bfhi(ww[q]); }
          v4u o; o.x = pk2(siluf(acc[0]), siluf(acc[1])); o.y = pk2(siluf(acc[2]), siluf(acc[3])); o.z = pk2(siluf(acc[4]), siluf(acc[5])); o.w = pk2(siluf(acc[6]), siluf(acc[7]));
          *(v4u*)(XBC + row * SSD_CD + c) = o; } }
    { const int gw = F.c * NWAVES + F.wave, NGW = F.G * NWAVES, lane = F.lane; const float* LOGF = WSP(float, WS_HF);
      bf16* HGQ = WSP(bf16, WS_HGQ); float* HGE = (float*)(WSP(bf16, WS_HGQ) + 2 * HGQ_STRIDE);
      for (int tk = gw; tk < NBATCH * 32 * 8; tk += NGW) {
          const int b = tk >> 8, c = (tk >> 3) & 31, h = tk & 7; const size_t r0 = (size_t)b * SEQ + 64 * c; const int col = h * 128 + 2 * lane;
          f32x2 cs[64];
#pragma unroll
          for (int t = 0; t < 64; ++t) cs[t] = *(const f32x2*)(LOGF + (r0 + t) * 1024 + col);
#pragma unroll
          for (int t = 1; t < 64; ++t) cs[t] += cs[t - 1];
          const f32x2 beta = cs[31], bC = cs[63];
#pragma unroll
          for (int hb = 0; hb < 4; ++hb) {
              unsigned qv[16], kv[16];
#pragma unroll
              for (int t = 0; t < 16; ++t) { const size_t row = r0 + 16 * hb + t; qv[t] = *(const unsigned*)(P + row * NP + C_HQ + col); kv[t] = *(const unsigned*)(P + row * NP + C_HF + col); }
#pragma unroll
              for (int t = 0; t < 16; ++t) { const size_t row = r0 + 16 * hb + t; const f32x2 cc = cs[16 * hb + t]; const float q0 = bflo(qv[t]), q1 = bfhi(qv[t]), k0 = bflo(kv[t]), k1 = bfhi(kv[t]);
                  *(unsigned*)(HGQ + row * 1024 + col) = pk2(q0 * __expf(fminf(cc.x - beta.x, 80.f)), q1 * __expf(fminf(cc.y - beta.y, 80.f)));
                  *(unsigned*)(HGQ + HGQ_STRIDE + row * 1024 + col) = pk2(k0 * __expf(fminf(beta.x - cc.x, 80.f)), k1 * __expf(fminf(beta.y - cc.y, 80.f))); } }
          *(f32x2*)(HGE + (size_t)(b * 32 + c) * 1024 + col) = (f32x2){__expf(bC.x), __expf(bC.y)};
          *(f32x2*)(HGE + (size_t)128 * 1024 + (size_t)(b * 32 + c) * 1024 + col) = (f32x2){__expf(bC.x - beta.x), __expf(bC.y - beta.y)};
          *(f32x2*)(HGE + (size_t)256 * 1024 + (size_t)(b * 32 + c) * 1024 + col) = (f32x2){__expf(beta.x), __expf(beta.y)};
      } }
    { bf16* RQK = WSP(bf16, WS_H);
      for (int i0 = gt; i0 < MP * 64; i0 += 2 * NGT) {
          v4u ld[2][8];
#pragma unroll
          for (int q = 0; q < 2; ++q) { const int i = i0 + q * NGT < MP * 64 ? i0 + q * NGT : i0; const int row = i >> 6, h = (i >> 3) & 7, sg = i & 7, t = row & (SEQ - 1);
              const bf16* rp = P + (size_t)row * NP + h * 128;
              ld[q][0] = *(const v4u*)(rp + C_RQ + 8 * sg); ld[q][1] = *(const v4u*)(rp + C_RQ + 64 + 8 * sg); ld[q][2] = *(const v4u*)(rp + C_RK + 8 * sg); ld[q][3] = *(const v4u*)(rp + C_RK + 64 + 8 * sg);
              const v4u* cp = (const v4u*)(WSP(f32x2, WS_ROPE) + (size_t)t * 64 + 8 * sg); ld[q][4] = cp[0]; ld[q][5] = cp[1]; ld[q][6] = cp[2]; ld[q][7] = cp[3]; }
#pragma unroll
          for (int q = 0; q < 2; ++q) { const int i = i0 + q * NGT; if (i >= MP * 64) continue; const int row = i >> 6, h = (i >> 3) & 7, sg = i & 7;
              const unsigned q1w[4] = {ld[q][0].x, ld[q][0].y, ld[q][0].z, ld[q][0].w}, q2w[4] = {ld[q][1].x, ld[q][1].y, ld[q][1].z, ld[q][1].w}, k1w[4] = {ld[q][2].x, ld[q][2].y, ld[q][2].z, ld[q][2].w}, k2w[4] = {ld[q][3].x, ld[q][3].y, ld[q][3].z, ld[q][3].w};
              const unsigned csw[16] = {ld[q][4].x, ld[q][4].y, ld[q][4].z, ld[q][4].w, ld[q][5].x, ld[q][5].y, ld[q][5].z, ld[q][5].w, ld[q][6].x, ld[q][6].y, ld[q][6].z, ld[q][6].w, ld[q][7].x, ld[q][7].y, ld[q][7].z, ld[q][7].w};
              unsigned qa[4], qb[4], ka[4], kb[4]; const float ksc = 0.08838834764831845f;
#pragma unroll
              for (int j = 0; j < 4; ++j) {
                  const float cc0 = __uint_as_float(csw[4 * j]), ss0 = __uint_as_float(csw[4 * j + 1]), cc1 = __uint_as_float(csw[4 * j + 2]), ss1 = __uint_as_float(csw[4 * j + 3]);
                  const float a0 = bflo(q1w[j]), a1 = bfhi(q1w[j]), b0 = bflo(q2w[j]), b1 = bfhi(q2w[j]), e0 = bflo(k1w[j]), e1 = bfhi(k1w[j]), f0 = bflo(k2w[j]), f1 = bfhi(k2w[j]);
                  qa[j] = pk2(a0 * cc0 - b0 * ss0, a1 * cc1 - b1 * ss1); qb[j] = pk2(a0 * ss0 + b0 * cc0, a1 * ss1 + b1 * cc1);
                  ka[j] = pk2((e0 * cc0 - f0 * ss0) * ksc, (e1 * cc1 - f1 * ss1) * ksc); kb[j] = pk2((e0 * ss0 + f0 * cc0) * ksc, (e1 * ss1 + f1 * cc1) * ksc); }
              bf16* op = RQK + (size_t)row * 1024 + h * 128 + 8 * sg;
              *(v4u*)op = (v4u){qa[0], qa[1], qa[2], qa[3]}; *(v4u*)(op + 64) = (v4u){qb[0], qb[1], qb[2], qb[3]};
              *(v4u*)(op + HGQ_STRIDE) = (v4u){ka[0], ka[1], ka[2], ka[3]}; *(v4u*)(op + HGQ_STRIDE + 64) = (v4u){kb[0], kb[1], kb[2], kb[3]}; } } }
    { float* DT = WSP(float, WS_DT); for (int i = gt; i < MR * 16; i += NGT) DT[i] = softplusf(DT[i] + F.in[I_SDTB][l * 16 + (i & 15)]); }
    for (int i = gt; i < NBATCH * 3 * 256; i += NGT) { const int b = i / 768, r = i - b * 768, j = r >> 8, c = (r & 255) * 4;
        const v2u w = *(const v2u*)(P + ((size_t)b * SEQ + SEQ - 3 + j) * NP + C_XA + c); *(f32x4*)(F.out + O_LC_P + (size_t)l * NBATCH * 3072 + (size_t)i * 4) = (f32x4){bflo(w.x), bfhi(w.x), bflo(w.y), bfhi(w.y)}; }
    for (int i = gt; i < NBATCH * 3 * (SSD_CD / 4); i += NGT) { const int b = i / (3 * SSD_CD / 4), r = i - b * (3 * SSD_CD / 4), j = r / (SSD_CD / 4), c = (r - j * (SSD_CD / 4)) * 4;
        const v2u w = *(const v2u*)(P + ((size_t)b * SEQ + SEQ - 3 + j) * NP + C_SX + c); *(f32x4*)(F.out + O_SC_P + (size_t)l * NBATCH * 3 * SSD_CD + (size_t)i * 4) = (f32x4){bflo(w.x), bfhi(w.x), bflo(w.y), bfhi(w.y)}; }
    for (int i = gt; i < MS * 3 * 256; i += NGT) { const int s_ = i / 768, r = i - s_ * 768, j = r >> 8, c = (r & 255) * 4; f32x4 v;
        if (j < 2) v = *(const f32x4*)(F.in[I_SLC] + (size_t)l * MS * 3072 + (size_t)s_ * 3072 + (j + 1) * 1024 + c);
        else { const v2u w = *(const v2u*)(P + ((size_t)MP + s_) * NP + C_XA + c); v = (f32x4){bflo(w.x), bfhi(w.x), bflo(w.y), bfhi(w.y)}; }
        *(f32x4*)(F.out + O_LC_S + (size_t)l * MS * 3072 + (size_t)i * 4) = v; }
    for (int i = gt; i < MS * 3 * (SSD_CD / 4); i += NGT) { const int s_ = i / (3 * SSD_CD / 4), r = i - s_ * (3 * SSD_CD / 4), j = r / (SSD_CD / 4), c = (r - j * (SSD_CD / 4)) * 4; f32x4 v;
        if (j < 2) v = *(const f32x4*)(F.in[I_SSC] + (size_t)l * MS * 3 * SSD_CD + (size_t)s_ * 3 * SSD_CD + (j + 1) * SSD_CD + c);
        else { const v2u w = *(const v2u*)(P + ((size_t)MP + s_) * NP + C_SX + c); v = (f32x4){bflo(w.x), bfhi(w.x), bflo(w.y), bfhi(w.y)}; }
        *(f32x4*)(F.out + O_SC_S + (size_t)l * MS * 3 * SSD_CD + (size_t)i * 4) = v; }
}

constexpr int QS_STR = 136;
typedef short s16x4 __attribute__((ext_vector_type(4)));
template <int MODE> struct CK {
    static constexpr int V = (MODE == 2) ? 64 : 128, NVT = V / 16, NVW = NVT / 2, NH = (MODE == 2) ? 16 : 8, VSTR = (MODE == 2) ? 72 : 136;
    static constexpr int O_QS = 0, O_QH = O_QS + 64 * QS_STR * 2, O_KS = O_QH, O_VV = O_KS + 64 * QS_STR * 2, O_VD = O_VV + 64 * VSTR * 2,
        O_XS = O_VD + (MODE == 0 ? 0 : 64 * VSTR * 2), O_S0T = O_XS + (MODE == 2 ? 64 * VSTR * 2 : 0), O_F32 = O_S0T + V * QS_STR * 2, O_OT = O_F32 + 4096, O_END = O_OT + 64 * VSTR * 2;
    static_assert(O_END <= RING_BYTES, "chunk unit LDS");
};
__device__ __forceinline__ bf16x8 tr_frag(const LAS bf16* T, int stride, int row0, int row1, int col0, int fr) {
    const int q = fr >> 2, p = fr & 3;
    const s16x4 lo = __builtin_amdgcn_ds_read_tr16_b64_v4i16((LAS s16x4*)(T + (row0 + q) * stride + col0 + 4 * p));
    const s16x4 hi = __builtin_amdgcn_ds_read_tr16_b64_v4i16((LAS s16x4*)(T + (row1 + q) * stride + col0 + 4 * p));
    return (bf16x8){lo[0], lo[1], lo[2], lo[3], hi[0], hi[1], hi[2], hi[3]};
}
template <int MODE, int PV>
__device__ __forceinline__ void chunk_unit(const Frame& F0, int l, int unit) {
    Frame F = launder(F0);
    typedef CK<MODE> C; constexpr int V = C::V, NVT = C::NVT, NVW = C::NVW, NH = C::NH, VSTR = C::VSTR;
    const int b = unit / NH, h = unit - b * NH;
    LAS bf16* QS = (LAS bf16*)(F.lds + C::O_QS); LAS bf16* QH = (LAS bf16*)(F.lds + C::O_QH); LAS bf16* KS = (LAS bf16*)(F.lds + C::O_KS);
    LAS bf16* VV = (LAS bf16*)(F.lds + C::O_VV); LAS bf16* VD = (LAS bf16*)(F.lds + C::O_VD); LAS bf16* XS = (LAS bf16*)(F.lds + C::O_XS); LAS bf16* S0T = (LAS bf16*)(F.lds + C::O_S0T);
    LAS bf16* OT = (LAS bf16*)(F.lds + C::O_OT);
    LAS float* FA = (LAS float*)(F.lds + C::O_F32);
    const bf16* P = WSP(bf16, WS_P); const bf16* XBC = WSP(bf16, WS_XBC); const float* DT = WSP(float, WS_DT);
    const bf16* HGQ = WSP(bf16, WS_HGQ); const float* HGE = (const float*)(WSP(bf16, WS_HGQ) + 2 * HGQ_STRIDE); const bf16* RQK = WSP(bf16, WS_H);
    bf16* OUT = (MODE == 0) ? WSP(bf16, WS_OB) : (MODE == 1 ? WSP(bf16, WS_OB + 2 * SZ_O) : WSP(bf16, WS_OB + SZ_O));
    const int tid = F.tid, lane = F.lane, w = F.wave, fr = lane & 15, g = lane >> 4, tt = w & 3, vh = w >> 2;
    const float gx = -__builtin_ldexpf(1.f, -5 - h);
    const float lg = (MODE == 1) ? gx * (1.f + gx * (-0.5f + gx * (0.33333334f + gx * (-0.25f + gx * 0.2f)))) : 0.f;
    float ssd_A = 0.f, ssd_D = 0.f;
    if (MODE == 2) { ssd_A = -__expf(F.in[I_SALOG][l * 16 + h]); ssd_D = F.in[I_SD][l * 16 + h]; }
    const int grp = h >> 3;
    f32x4 S[NVT];
#pragma unroll
    for (int i = 0; i < NVT; ++i) S[i] = (f32x4){0.f, 0.f, 0.f, 0.f};
    v4u ra[8]; float rdt = 0.f, eb0 = 0.f, eb1 = 0.f; f32x4 ebn = (f32x4){1.f, 1.f, 1.f, 1.f};
    const int stok = tid >> 3, sg = tid & 7;
    auto load_chunk = [&](int c) {
        const size_t row = (size_t)b * SEQ + 64 * c + stok;
        if (MODE == 0) {
            const bf16* qp = HGQ + row * 1024 + h * 128 + 16 * sg;
            ra[0] = *(const v4u*)qp; ra[1] = *(const v4u*)(qp + 8); ra[4] = *(const v4u*)(qp + HGQ_STRIDE); ra[5] = *(const v4u*)(qp + HGQ_STRIDE + 8);
            ebn = *(const f32x4*)(HGE + (size_t)256 * 1024 + (size_t)(b * 32 + c) * 1024 + h * 128 + 16 * w + 4 * g);
            const bf16* vp = P + row * NP + C_HI + h * 128 + 16 * sg; ra[6] = *(const v4u*)vp; ra[7] = *(const v4u*)(vp + 8);
            if (tid < 128) { const float* ep = HGE + (size_t)(b * 32 + c) * 1024 + h * 128 + tid; eb0 = ep[0]; eb1 = ep[128 * 1024]; }
        } else if (MODE == 1) {
            const bf16* qp = RQK + row * 1024 + h * 128 + 16 * sg;
            ra[0] = *(const v4u*)qp; ra[1] = *(const v4u*)(qp + 8); ra[2] = *(const v4u*)(qp + HGQ_STRIDE); ra[3] = *(const v4u*)(qp + HGQ_STRIDE + 8);
            const bf16* vp = P + row * NP + C_RV + h * 128 + 16 * sg; ra[4] = *(const v4u*)vp; ra[5] = *(const v4u*)(vp + 8);
        } else {
            const bf16* xp = XBC + row * SSD_CD;
            ra[0] = *(const v4u*)(xp + 1024 + grp * 128 + 16 * sg); ra[1] = *(const v4u*)(xp + 1024 + grp * 128 + 16 * sg + 8);
            ra[2] = *(const v4u*)(xp + 1280 + grp * 128 + 16 * sg); ra[3] = *(const v4u*)(xp + 1280 + grp * 128 + 16 * sg + 8);
            ra[4] = *(const v4u*)(xp + h * 64 + 8 * sg);
            rdt = DT[((size_t)b * SEQ + 64 * c + lane) * 16 + h];
        }
    };
    auto stage_chunk = [&]() {
        if (MODE == 0) {
            *(LAS v4u*)(QS + stok * QS_STR + 16 * sg) = ra[0]; *(LAS v4u*)(QS + stok * QS_STR + 16 * sg + 8) = ra[1];
            *(LAS v4u*)(KS + stok * QS_STR + 16 * sg) = ra[4]; *(LAS v4u*)(KS + stok * QS_STR + 16 * sg + 8) = ra[5];
            *(LAS v4u*)(VV + stok * VSTR + 16 * sg) = ra[6]; *(LAS v4u*)(VV + stok * VSTR + 16 * sg + 8) = ra[7];
            if (tid < 128) { FA[512 + tid] = eb0; FA[640 + tid] = eb1; }
        } else if (MODE == 1) {
            *(LAS v4u*)(QS + stok * QS_STR + 16 * sg) = ra[0]; *(LAS v4u*)(QS + stok * QS_STR + 16 * sg + 8) = ra[1];
            *(LAS v4u*)(KS + stok * QS_STR + 16 * sg) = ra[2]; *(LAS v4u*)(KS + stok * QS_STR + 16 * sg + 8) = ra[3];
            *(LAS v4u*)(VV + stok * VSTR + 16 * sg) = ra[4]; *(LAS v4u*)(VV + stok * VSTR + 16 * sg + 8) = ra[5];
            const float ws = __expf(lg * (float)(63 - stok));
            const unsigned vw[8] = {ra[4].x, ra[4].y, ra[4].z, ra[4].w, ra[5].x, ra[5].y, ra[5].z, ra[5].w}; unsigned vd[8];
#pragma unroll
            for (int i = 0; i < 8; ++i) vd[i] = pk2(bflo(vw[i]) * ws, bfhi(vw[i]) * ws);
            *(LAS v4u*)(VD + stok * VSTR + 16 * sg) = (v4u){vd[0], vd[1], vd[2], vd[3]}; *(LAS v4u*)(VD + stok * VSTR + 16 * sg + 8) = (v4u){vd[4], vd[5], vd[6], vd[7]};
        } else {
            float bs = rdt * ssd_A;
#pragma unroll
            for (int o = 1; o < 64; o <<= 1) { const float up = __shfl_up(bs, o); if (lane >= o) bs += up; }
            const float bC = __shfl(bs, 63), bmy = __shfl(bs, stok), dtm = __shfl(rdt, stok);
            if (w == 0) { FA[lane] = bs; FA[64 + lane] = __expf(bs); }
            *(LAS v4u*)(KS + stok * QS_STR + 16 * sg) = ra[0]; *(LAS v4u*)(KS + stok * QS_STR + 16 * sg + 8) = ra[1];
            *(LAS v4u*)(QS + stok * QS_STR + 16 * sg) = ra[2]; *(LAS v4u*)(QS + stok * QS_STR + 16 * sg + 8) = ra[3];
            const float ws = __expf(bC - bmy);
            const unsigned xw[4] = {ra[4].x, ra[4].y, ra[4].z, ra[4].w}; unsigned v1[4], v2[4];
#pragma unroll
            for (int i = 0; i < 4; ++i) { const float x0 = bflo(xw[i]) * dtm, x1 = bfhi(xw[i]) * dtm; v1[i] = pk2(x0, x1); v2[i] = pk2(x0 * ws, x1 * ws); }
            *(LAS v4u*)(XS + stok * VSTR + 8 * sg) = ra[4]; *(LAS v4u*)(VV + stok * VSTR + 8 * sg) = (v4u){v1[0], v1[1], v1[2], v1[3]}; *(LAS v4u*)(VD + stok * VSTR + 8 * sg) = (v4u){v2[0], v2[1], v2[2], v2[3]};
        }
    };
    const bool sink = (PV == 0) || (F.G == 12345);
    if (PV != 2) load_chunk(0);
    for (int i = tid; i < V * QS_STR / 2; i += NTHR) ((LAS unsigned*)S0T)[i] = 0u;
    if (PV != 2) stage_chunk();
    __syncthreads();
    for (int c = 0; c < SEQ / 64; ++c) {
        if (PV != 2 && c + 1 < SEQ / 64) load_chunk(c + 1);
        if (PV != 1) {
        const size_t row0 = (size_t)b * SEQ + 64 * c;
        f32x4 sc[4];
#pragma unroll
        for (int st = 0; st < 4; ++st) { sc[st] = (f32x4){0.f, 0.f, 0.f, 0.f};
            if (st <= tt) {
#pragma unroll
                for (int ks = 0; ks < 4; ++ks) { const bf16x8 a = *(const LAS bf16x8*)(KS + (16 * st + fr) * QS_STR + 32 * ks + 8 * g), bq = *(const LAS bf16x8*)(QS + (16 * tt + fr) * QS_STR + 32 * ks + 8 * g);
                    sc[st] = __builtin_amdgcn_mfma_f32_16x16x32_bf16(a, bq, sc[st], 0, 0, 0); } } }
        const int tloc = 16 * tt + fr;
        float btt = 0.f; if (MODE == 2) btt = FA[tloc];
        unsigned pw[8];
#pragma unroll
        for (int st = 0; st < 4; ++st) { float vals[4];
#pragma unroll
            for (int reg = 0; reg < 4; ++reg) { const int s = 16 * st + 4 * g + reg; float x = sc[st][reg];
                if (MODE == 1) x *= __expf(lg * (float)(tloc - s));
                if (MODE == 2) x *= __expf(fminf(btt - FA[s], 0.f));
                vals[reg] = (st <= tt && s <= tloc) ? x : 0.f; }
            pw[2 * st] = pk2(vals[0], vals[1]); pw[2 * st + 1] = pk2(vals[2], vals[3]); }
        const bf16x8 pf0 = __builtin_bit_cast(bf16x8, ((v4u){pw[0], pw[1], pw[2], pw[3]})), pf1 = __builtin_bit_cast(bf16x8, ((v4u){pw[4], pw[5], pw[6], pw[7]}));
        LAS bf16* QX = QS;
#pragma unroll
        for (int vi = 0; vi < NVW; ++vi) { const int vt = vh * NVW + vi;
            f32x4 o = (f32x4){0.f, 0.f, 0.f, 0.f}, oi = (f32x4){0.f, 0.f, 0.f, 0.f};
            { const bf16x8 bv = tr_frag(VV, VSTR, 4 * g, 16 + 4 * g, 16 * vt, fr); o = __builtin_amdgcn_mfma_f32_16x16x32_bf16(pf0, bv, o, 0, 0, 0); }
            if (tt >= 2) { const bf16x8 bv = tr_frag(VV, VSTR, 32 + 4 * g, 48 + 4 * g, 16 * vt, fr); o = __builtin_amdgcn_mfma_f32_16x16x32_bf16(pf1, bv, o, 0, 0, 0); }
#pragma unroll
            for (int ks = 0; ks < 4; ++ks) { const bf16x8 a = *(const LAS bf16x8*)(QX + (16 * tt + fr) * QS_STR + 32 * ks + 8 * g), bs = *(const LAS bf16x8*)(S0T + (16 * vt + fr) * QS_STR + 32 * ks + 8 * g);
                oi = __builtin_amdgcn_mfma_f32_16x16x32_bf16(a, bs, oi, 0, 0, 0); }
            float vals[4];
#pragma unroll
            for (int reg = 0; reg < 4; ++reg) { const int t = 16 * tt + 4 * g + reg; float val;
                if (MODE == 0) val = o[reg] + oi[reg];
                else if (MODE == 1) val = o[reg] + __expf(lg * (float)(t + 1)) * oi[reg];
                else val = o[reg] + FA[64 + t] * oi[reg] + ssd_D * bf2f(XS[t * VSTR + 16 * vt + fr]);
                vals[reg] = val; }
            { const unsigned w01 = pk2(vals[0], vals[1]), w23 = pk2(vals[2], vals[3]); LAS bf16* op = OT + (16 * tt + 4 * g) * VSTR + 16 * vt + fr;
              op[0] = (bf16)(w01 & 0xffffu); op[VSTR] = (bf16)(w01 >> 16); op[2 * VSTR] = (bf16)(w23 & 0xffffu); op[3 * VSTR] = (bf16)(w23 >> 16); } }
        { const LAS bf16* VX = (MODE == 0) ? VV : VD;
          float e1[4], e2[4];
#pragma unroll
          for (int reg = 0; reg < 4; ++reg) { if (MODE == 0) { e1[reg] = FA[512 + 16 * w + 4 * g + reg]; e2[reg] = FA[640 + 16 * w + 4 * g + reg]; } else if (MODE == 1) { e1[reg] = __expf(lg * 64.f); e2[reg] = 1.f; } else { e1[reg] = FA[64 + 63]; e2[reg] = 1.f; } }
          const bf16x8 ka0 = tr_frag(KS, QS_STR, 8 * g, 8 * g + 4, 16 * w, fr), ka1 = tr_frag(KS, QS_STR, 32 + 8 * g, 36 + 8 * g, 16 * w, fr);
#pragma unroll
          for (int vt = 0; vt < NVT; ++vt) { f32x4 d = (f32x4){0.f, 0.f, 0.f, 0.f};
              const bf16x8 b0 = tr_frag(VX, VSTR, 8 * g, 8 * g + 4, 16 * vt, fr), b1 = tr_frag(VX, VSTR, 32 + 8 * g, 36 + 8 * g, 16 * vt, fr);
              d = __builtin_amdgcn_mfma_f32_16x16x32_bf16(ka0, b0, d, 0, 0, 0); d = __builtin_amdgcn_mfma_f32_16x16x32_bf16(ka1, b1, d, 0, 0, 0);
#pragma unroll
              for (int reg = 0; reg < 4; ++reg) S[vt][reg] = e1[reg] * S[vt][reg] + e2[reg] * d[reg]; } }
        }
        __syncthreads();
        if (PV != 1 && sink) { const LAS bf16* op = OT + stok * VSTR + (V / 8) * sg; bf16* gp = OUT + ((size_t)b * SEQ + 64 * c + stok) * 1024 + h * V + (V / 8) * sg;
            *(v4u*)gp = *(const LAS v4u*)op; if (V == 128) *(v4u*)(gp + 8) = *(const LAS v4u*)(op + 8); }
#pragma unroll
        for (int vt = 0; vt < NVT; ++vt) { const f32x4 sp_ = (MODE == 0) ? S[vt] * ebn : S[vt]; *(LAS v2u*)(S0T + (16 * vt + fr) * QS_STR + 16 * w + 4 * g) = (v2u){pk2(sp_[0], sp_[1]), pk2(sp_[2], sp_[3])}; }
        if (PV != 2 && c + 1 < SEQ / 64) stage_chunk();
        __syncthreads();
    }
    if (!sink) return;
    float* so = F.out + (MODE == 0 ? O_HG_P : (MODE == 1 ? O_RET_P : O_SSD_P)) + (((size_t)l * NBATCH + b) * NH + h) * (128 * V);
#pragma unroll
    for (int vt = 0; vt < NVT; ++vt)
#pragma unroll
        for (int reg = 0; reg < 4; ++reg) so[(size_t)(16 * w + 4 * g + reg) * V + 16 * vt + fr] = S[vt][reg];
}

constexpr int SM_FLOATS = 1024, SM_DEC = 0, SM_KK = 128, SM_Q = 256, SM_VV = 384, SM_XS = 512, SM_DSC = 576, SB_RED = 3 * SM_FLOATS * 4;
struct SmallIn { unsigned a, b, c, d; };
template <int MODE>
__device__ __forceinline__ void samp_run(const Frame& F0, int l, int p0, int pstep, int pend) {
    Frame F = launder(F0);
    constexpr int V = (MODE == 2) ? 64 : 128, NH = (MODE == 2) ? 16 : 8, NKR = (MODE == 2) ? 32 : 16, NJ = 128 / NKR;
    if (p0 >= pend) return;
    const bf16* P = WSP(bf16, WS_P); const bf16* XBC = WSP(bf16, WS_XBC);
    const int tid = F.tid;
    const int v4 = (MODE == 2) ? (tid & 15) : (tid & 31), kr = (MODE == 2) ? (tid >> 4) : (tid >> 5);
    const float* SIN = F.in[MODE == 0 ? I_SHG : (MODE == 1 ? I_SRET : I_SSSD)] + (size_t)l * 128 * NH * (128 * V);
    float* SOUT = F.out + (MODE == 0 ? O_HG_S : (MODE == 1 ? O_RET_S : O_SSD_S)) + (size_t)l * 128 * NH * (128 * V);
    bf16* OUT = (MODE == 0) ? WSP(bf16, WS_OB) : (MODE == 1 ? WSP(bf16, WS_OB + 2 * SZ_O) : WSP(bf16, WS_OB + SZ_O));
    f32x2 cs = (f32x2){0.f, 0.f};
    if (MODE == 1 && tid < 64) cs = WSP(f32x2, WS_ROPE)[2048 * 64 + tid];
    auto ldw = [&](const bf16* base, size_t idx) -> unsigned { return ((const unsigned*)base)[idx >> 1]; };
    auto sload = [&](int pair) -> SmallIn {
        SmallIn r;
        const int s = pair / NH, h = pair - s * NH; const size_t row = MP + s;
        if (MODE == 0) {
            const int k = tid & 127; r.a = WSP(unsigned, WS_HF)[row * 1024 + h * 128 + k]; r.b = ldw(P, row * NP + C_HF + h * 128 + k); r.c = ldw(P, row * NP + C_HQ + h * 128 + k); r.d = ldw(P, row * NP + C_HI + h * 128 + k);
        } else if (MODE == 1) {
            const bool qk = tid < 64; const int j = tid & 63, v = (tid - 64) & 127;
            r.a = ldw(P, row * NP + h * 128 + (qk ? C_RQ + j : C_RV + v)); r.b = ldw(P, row * NP + h * 128 + (qk ? C_RQ + 64 + j : C_RV + v));
            r.c = ldw(P, row * NP + h * 128 + (qk ? C_RK + j : C_RV + v)); r.d = ldw(P, row * NP + h * 128 + (qk ? C_RK + 64 + j : C_RV + v));
        } else {
            const int ch = tid < 320 ? tid : 318 + (tid & 1), grp = h >> 3;
            const int cidx = ch < 64 ? h * 64 + ch : (ch < 192 ? 1024 + grp * 128 + (ch - 64) : 1280 + grp * 128 + (ch - 192));
            r.a = ldw(XBC, row * SSD_CD + cidx);
            r.b = WSP(unsigned, WS_DT)[row * 16 + h]; r.c = ((const unsigned*)F.in[I_SALOG])[l * 16 + h]; r.d = ((const unsigned*)F.in[I_SD])[l * 16 + h];
        }
        return r;
    };
    auto swrite = [&](LAS float* SM, int pair, const SmallIn& r_) {
        SmallIn r = r_; asm volatile("" : "+v"(r.a), "+v"(r.b), "+v"(r.c), "+v"(r.d));
        const int h = pair % NH; const bool odd = tid & 1;
        auto bsel = [&](unsigned w) -> float { return odd ? bfhi(w) : bflo(w); };
        if (MODE == 0) { if (tid < 128) { SM[SM_DEC + tid] = __expf(__uint_as_float(r.a)); SM[SM_KK + tid] = bsel(r.b); SM[SM_Q + tid] = bsel(r.c); SM[SM_VV + tid] = bsel(r.d); } }
        else if (MODE == 1) {
            if (tid < 64) { const int j = tid; const float q1 = bsel(r.a), q2 = bsel(r.b), k1 = bsel(r.c), k2 = bsel(r.d);
                SM[SM_Q + j] = q1 * cs.x - q2 * cs.y; SM[SM_Q + 64 + j] = q1 * cs.y + q2 * cs.x;
                SM[SM_KK + j] = (k1 * cs.x - k2 * cs.y) * 0.08838834764831845f; SM[SM_KK + 64 + j] = (k1 * cs.y + k2 * cs.x) * 0.08838834764831845f; }
            else if (tid < 192) { SM[SM_VV + tid - 64] = bsel(r.a); SM[SM_DEC + tid - 64] = 1.f - __builtin_ldexpf(1.f, -5 - h); }
        } else {
            if (tid < 320) { const int ch = tid; const float val = bsel(r.a);
                if (ch < 64) { const float dtv = __uint_as_float(r.b); SM[SM_XS + ch] = val; SM[SM_VV + ch] = val * dtv; SM[SM_DSC + 64 + ch] = __uint_as_float(r.d); if (ch == 0) SM[SM_DSC] = __expf(dtv * (-__expf(__uint_as_float(r.c)))); }
                else if (ch < 192) SM[SM_KK + ch - 64] = val; else SM[SM_Q + ch - 192] = val; }
        }
    };
    auto stload = [&](int pair, f32x4 (&dst)[NJ]) {
        const float* sin_ = SIN + (size_t)pair * (128 * V);
#pragma unroll
        for (int j = 0; j < NJ; ++j) dst[j] = __builtin_nontemporal_load((const f32x4*)(sin_ + (size_t)(kr + NKR * j) * V + 4 * v4));
    };
    int cb = 0, rb = 0;
    auto step = [&](int pair, f32x4 (&cur)[NJ], f32x4 (&nw)[NJ], const SmallIn& rwr, SmallIn& rnw) {
        const int p1 = pair + pstep, p2 = pair + 2 * pstep; const int p1c = p1 < pend ? p1 : pair, p2c = p2 < pend ? p2 : pair;
        const int nb = cb == 2 ? 0 : cb + 1;
        rnw = sload(p2c);
        stload(p2c, nw);
        LAS float* SM = (LAS float*)F.lds + cb * SM_FLOATS; LAS float* RED = (LAS float*)(F.lds + SB_RED) + rb * (NKR * V);
        float* sout = SOUT + (size_t)pair * (128 * V);
        const f32x4 vv = *(const LAS f32x4*)(SM + SM_VV + 4 * v4);
        f32x4 po = (f32x4){0.f, 0.f, 0.f, 0.f};
#pragma unroll
        for (int j = 0; j < NJ; ++j) { const int k = kr + NKR * j; const float dec = (MODE == 2) ? SM[SM_DSC] : SM[SM_DEC + k]; const float kk = SM[SM_KK + k], q = SM[SM_Q + k];
            const f32x4 sn = cur[j] * dec + vv * kk; __builtin_nontemporal_store(sn, (f32x4*)(sout + (size_t)k * V + 4 * v4)); po += sn * q; }
        *(LAS f32x4*)(RED + kr * V + 4 * v4) = po;
        swrite((LAS float*)F.lds + nb * SM_FLOATS, p1c, rwr);
        __syncthreads();
        if (tid < V) { float o = 0.f;
#pragma unroll
            for (int r = 0; r < NKR; ++r) o += RED[r * V + tid];
            if (MODE == 2) o += SM[SM_DSC + 64 + tid] * SM[SM_XS + tid];
            const int s = pair / NH, h = pair - s * NH;
            OUT[(size_t)(MP + s) * 1024 + h * V + tid] = (bf16)f2bf(o); }
        cb = nb; rb ^= 1;
    };
    f32x4 s0[NJ], s1[NJ], s2[NJ]; SmallIn r0, r1, r2;
    { const int p1c = p0 + pstep < pend ? p0 + pstep : p0;
      r0 = sload(p0); stload(p0, s0); r1 = sload(p1c); stload(p1c, s1); r2.a = 0u; r2.b = 0u; r2.c = 0u; r2.d = 0u;
      swrite((LAS float*)F.lds, p0, r0); }
    __syncthreads();
    int pair = p0;
    for (; pair + 2 * pstep < pend; pair += 3 * pstep) {
        step(pair, s0, s2, r1, r2); step(pair + pstep, s1, s0, r2, r0); step(pair + 2 * pstep, s2, s1, r0, r1);
    }
    if (pair < pend) { step(pair, s0, s2, r1, r2); pair += pstep;
        if (pair < pend) step(pair, s1, s0, r2, r0); }
    __syncthreads();
}

__device__ __forceinline__ void lru_fix(const Frame& F0, int l, int gw, int NGW) {
    Frame F = launder(F0);
    const bf16* P = WSP(bf16, WS_P);
    const bf16* LA = WSP(bf16, WS_X1); const bf16* LU = LA + (size_t)M * 1024;
    bf16* BR = WSP(bf16, WS_BR);
    const int lane = F.lane;
    for (int task = gw; task < NBATCH * 8 * 32; task += NGW) {
        const int b = task >> 8, cg = (task >> 5) & 7, j = task & 31, ch = cg * 128 + 2 * lane;
        float h0 = 0.f, h1 = 0.f;
        { unsigned ca[31], cu[31];
#pragma unroll
          for (int jj = 0; jj < 31; ++jj) { const size_t row = (size_t)b * SEQ + 64 * (jj < j ? jj : 0) + 63; ca[jj] = *(const unsigned*)(LA + row * 1024 + ch); cu[jj] = *(const unsigned*)(LU + row * 1024 + ch); }
#pragma unroll
          for (int jj = 0; jj < 31; ++jj) { h0 = jj < j ? bflo(ca[jj]) * h0 + bflo(cu[jj]) : h0; h1 = jj < j ? bfhi(ca[jj]) * h1 + bfhi(cu[jj]) : h1; } }
        float hv0 = 0.f, hv1 = 0.f;
        for (int t0 = 0; t0 < 64; t0 += 16) {
            unsigned a[16], u[16], y[16];
#pragma unroll
            for (int q = 0; q < 16; ++q) { const size_t row = (size_t)b * SEQ + 64 * j + t0 + q; a[q] = *(const unsigned*)(LA + row * 1024 + ch); u[q] = *(const unsigned*)(LU + row * 1024 + ch); y[q] = *(const unsigned*)(P + row * NP + C_YA + ch); }
#pragma unroll
            for (int q = 0; q < 16; ++q) { const size_t row = (size_t)b * SEQ + 64 * j + t0 + q; hv0 = bflo(a[q]) * h0 + bflo(u[q]); hv1 = bfhi(a[q]) * h1 + bfhi(u[q]);
                *(unsigned*)(BR + row * BW + ch) = pk2(hv0 * bflo(y[q]), hv1 * bfhi(y[q])); }
        }
        if (j == 31) *(f32x2*)(F.out + O_LH_P + ((size_t)l * NBATCH + b) * 1024 + ch) = (f32x2){hv0, hv1};
    }
    for (int i = gw * 64 + lane; i < MS * 1024; i += NGW * 64) { const int s = i >> 10, ch = i & 1023; const size_t row = MP + s;
        const float hp = F.in[I_SLH][((size_t)l * 128 + s) * 1024 + ch]; const float h = bf2f(LA[row * 1024 + ch]) * hp + bf2f(LU[row * 1024 + ch]);
        F.out[O_LH_S + ((size_t)l * 128 + s) * 1024 + ch] = h; BR[row * BW + ch] = (bf16)f2bf(h * bf2f(P[row * NP + C_YA + ch])); }
}

constexpr int NCHUNK_WG = 128;
__device__ __forceinline__ void phase_mix(const Frame& F0, int l) {
    Frame F = launder(F0);
    const int w = F.c;
    if (w < 32) chunk_unit<0, 0>(F, l, w);
    else if (w < 64) chunk_unit<1, 0>(F, l, w - 32);
    else if (w < 128) chunk_unit<2, 0>(F, l, w - 64);
    else { const int cs = w - NCHUNK_WG, ns = F.G - NCHUNK_WG;
        samp_run<0>(F, l, cs, ns, 1024); samp_run<1>(F, l, cs, ns, 1024); samp_run<2>(F, l, cs, ns, 2048);
        lru_fix(F, l, cs * NWAVES + F.wave, ns * NWAVES); }
}

__device__ __forceinline__ void phase_post(const Frame& F0, int l) {
    Frame F = launder(F0);
    const bf16* P = WSP(bf16, WS_P);
    const bf16* LA = WSP(bf16, WS_X1); const bf16* LU = LA + (size_t)M * 1024;
    bf16* BR = WSP(bf16, WS_BR);
    const int gt = F.c * NTHR + F.tid, NGT = F.G * NTHR, gw = F.c * NWAVES + F.wave, NGW = F.G * NWAVES, lane = F.lane;
    for (int task0 = gw; task0 < MR * 3; task0 += 2 * NGW) {
        v4u xin[2][2], gin[2][2]; int rowv[2], brv[2]; bool ok[2];
#pragma unroll
        for (int q = 0; q < 2; ++q) { const int task = task0 + q * NGW; ok[q] = task < MR * 3; const int tk = ok[q] ? task : task0; rowv[q] = tk / 3; brv[q] = tk - rowv[q] * 3;
            const v4u* src = (const v4u*)(WSP(bf16, WS_OB + (size_t)brv[q] * SZ_O) + (size_t)rowv[q] * 1024 + 16 * lane); xin[q][0] = src[0]; xin[q][1] = src[1];
            const int gcol = (brv[q] == 0) ? C_HGG : (brv[q] == 1 ? C_SZ : C_RG);
            const v4u* gp = (const v4u*)(P + (size_t)rowv[q] * NP + gcol + 16 * lane); gin[q][0] = gp[0]; gin[q][1] = gp[1]; }
#pragma unroll
        for (int q = 0; q < 2; ++q) { if (!ok[q]) continue;
            const int row = rowv[q], br = brv[q];
            const unsigned xw_[8] = {xin[q][0].x, xin[q][0].y, xin[q][0].z, xin[q][0].w, xin[q][1].x, xin[q][1].y, xin[q][1].z, xin[q][1].w};
            const unsigned gw_[8] = {gin[q][0].x, gin[q][0].y, gin[q][0].z, gin[q][0].w, gin[q][1].x, gin[q][1].y, gin[q][1].z, gin[q][1].w};
            float x[16], gt_[16], o[16];
#pragma unroll
            for (int i = 0; i < 8; ++i) { x[2 * i] = bflo(xw_[i]); x[2 * i + 1] = bfhi(xw_[i]); gt_[2 * i] = bflo(gw_[i]); gt_[2 * i + 1] = bfhi(gw_[i]); }
            if (br == 1) {
                float ss = 0.f;
#pragma unroll
                for (int j = 0; j < 16; ++j) { x[j] *= gt_[j]; ss += x[j] * x[j]; }
#pragma unroll
                for (int m = 1; m < 32; m <<= 1) ss += __shfl_xor(ss, m);
                const float rs = __builtin_amdgcn_rsqf(ss * (1.f / 512.f) + EPS); const float* nw = F.in[I_SNW] + (size_t)l * 1024 + 16 * lane;
#pragma unroll
                for (int j = 0; j < 16; ++j) o[j] = x[j] * rs * nw[j];
            } else {
                float ss = 0.f;
#pragma unroll
                for (int j = 0; j < 16; ++j) ss += x[j] * x[j];
#pragma unroll
                for (int m = 1; m < 8; m <<= 1) ss += __shfl_xor(ss, m);
                const float rs = __builtin_amdgcn_rsqf(ss * (1.f / 128.f) + EPS);
                if (br == 0) { const float* nw = F.in[I_HGNW] + (size_t)l * 128 + ((16 * lane) & 127);
#pragma unroll
                    for (int j = 0; j < 16; ++j) o[j] = x[j] * rs * nw[j] * gt_[j]; }
                else {
#pragma unroll
                    for (int j = 0; j < 16; ++j) o[j] = x[j] * rs * gt_[j]; }
            }
            v4u w0, w1; w0.x = pk2(o[0], o[1]); w0.y = pk2(o[2], o[3]); w0.z = pk2(o[4], o[5]); w0.w = pk2(o[6], o[7]); w1.x = pk2(o[8], o[9]); w1.y = pk2(o[10], o[11]); w1.z = pk2(o[12], o[13]); w1.w = pk2(o[14], o[15]);
            v4u* dst = (v4u*)(BR + (size_t)(br + 1) * M * BW + (size_t)row * BW + 16 * lane); dst[0] = w0; dst[1] = w1;
        }
    }
}

__device__ __forceinline__ void phase_act(const Frame& F0, int l) {
    Frame F = launder(F0);
    const bf16* UV = WSP(bf16, WS_P); bf16* A2 = WSP(bf16, WS_G);
    const float* cw = F.in[I_FCW] + (size_t)l * 3 * DFF; const float* cb = F.in[I_FCB] + (size_t)l * DFF;
    const int gt = F.c * NTHR + F.tid, NGT = F.G * NTHR;
    constexpr int C8 = DFF / 8;
    for (int i = gt; i < M * C8; i += NGT) {
        const int row = i / C8, c = (i - row * C8) * 8;
        v4u outw = (v4u){0u, 0u, 0u, 0u};
        if (row < MR) {
            const v4u uw = *(const v4u*)(UV + (size_t)row * NUV + c), vw = *(const v4u*)(UV + (size_t)row * NUV + DFF + c);
            float u0[8] = {bflo(uw.x), bfhi(uw.x), bflo(uw.y), bfhi(uw.y), bflo(uw.z), bfhi(uw.z), bflo(uw.w), bfhi(uw.w)};
            const float vv[8] = {bflo(vw.x), bfhi(vw.x), bflo(vw.y), bfhi(vw.y), bflo(vw.z), bfhi(vw.z), bflo(vw.w), bfhi(vw.w)};
            float u1[8], u2[8];
#pragma unroll
            for (int j = 0; j < 8; ++j) { u1[j] = 0.f; u2[j] = 0.f; }
            if (row < MP) { const int t = row & (SEQ - 1);
                if (t >= 1) { const v4u w = *(const v4u*)(UV + (size_t)(row - 1) * NUV + c); u1[0] = bflo(w.x); u1[1] = bfhi(w.x); u1[2] = bflo(w.y); u1[3] = bfhi(w.y); u1[4] = bflo(w.z); u1[5] = bfhi(w.z); u1[6] = bflo(w.w); u1[7] = bfhi(w.w); }
                if (t >= 2) { const v4u w = *(const v4u*)(UV + (size_t)(row - 2) * NUV + c); u2[0] = bflo(w.x); u2[1] = bfhi(w.x); u2[2] = bflo(w.y); u2[3] = bfhi(w.y); u2[4] = bflo(w.z); u2[5] = bfhi(w.z); u2[6] = bflo(w.w); u2[7] = bfhi(w.w); }
                if (t >= SEQ - 2) { float* so = F.out + O_FC_P + (((size_t)l * NBATCH + (row >> 11)) * 2 + (t - (SEQ - 2))) * DFF + c;
#pragma unroll
                    for (int j = 0; j < 8; ++j) so[j] = u0[j]; }
            } else { const int s = row - MP; const float* st = F.in[I_SFC] + ((size_t)l * MS + s) * 2 * DFF + c; float* so = F.out + O_FC_S + ((size_t)l * MS + s) * 2 * DFF + c;
#pragma unroll
                for (int j = 0; j < 8; ++j) { u2[j] = st[j]; u1[j] = st[DFF + j]; so[j] = st[DFF + j]; so[DFF + j] = u0[j]; } }
            float a[8];
#pragma unroll
            for (int j = 0; j < 8; ++j) { const float y = cb[c + j] + cw[c + j] * u2[j] + cw[DFF + c + j] * u1[j] + cw[2 * DFF + c + j] * u0[j]; a[j] = geluf(y) * vv[j]; }
            outw.x = pk2(a[0], a[1]); outw.y = pk2(a[2], a[3]); outw.z = pk2(a[4], a[5]); outw.w = pk2(a[6], a[7]);
        }
        *(v4u*)(A2 + (size_t)row * DFF + c) = outw;
    }
}

template <int KIND>
__device__ __forceinline__ void samp_gemm(const Frame& F0, int l) {
    Frame F = launder(F0);
    if (F.c >= 256) return;
    const int rb = F.c >> 5, cb = F.c & 31, w = F.wave, ct = w & 3, kh = w >> 2, fr = F.lane & 15, g = F.lane >> 4;
    const int nrow = 64 * cb + 16 * ct + fr;
    const size_t arow = (size_t)MP + 16 * rb + fr;
    f32x4 tot = (f32x4){0.f, 0.f, 0.f, 0.f};
    constexpr int NSEG = (KIND == 0) ? 4 : 1;
    constexpr int KH = (KIND == 0) ? 512 : (KIND == 1 ? 1024 : 2816);
    constexpr int BPS = KH / 256, NBT = NSEG * BPS;
    unsigned gq[4][4];
    if (KIND == 0) {
#pragma unroll
        for (int seg = 0; seg < 4; ++seg)
#pragma unroll
            for (int reg = 0; reg < 4; ++reg) gq[seg][reg] = WSP(bf16, WS_G)[((size_t)MP + 16 * rb + 4 * g + reg) * NG + seg * 2048 + 64 * cb + 16 * ct + fr];
    }
    auto ptrs = [&](int seg, const bf16*& ap, const bf16*& bp) {
        if (KIND == 0) { ap = WSP(bf16, WS_BR) + (size_t)seg * M * BW + arow * BW + kh * KH + 8 * g; bp = WSP(bf16, WS_WB + l * SZ_WB) + (size_t)seg * DM * BW + (size_t)nrow * BW + kh * KH + 8 * g; }
        else if (KIND == 1) { ap = WSP(bf16, WS_MG) + arow * DM + kh * KH + 8 * g; bp = WSP(bf16, WS_WO + l * SZ_WO) + (size_t)nrow * DM + kh * KH + 8 * g; }
        else { ap = WSP(bf16, WS_G) + arow * DFF + kh * KH + 8 * g; bp = WSP(bf16, WS_WD + l * SZ_WD) + (size_t)nrow * DFF + kh * KH + 8 * g; }
    };
    auto ldb = [&](int bt, bf16x8 (&x)[8], bf16x8 (&y)[8]) {
        const bf16* ap; const bf16* bp; ptrs(bt / BPS, ap, bp); const int k0 = (bt % BPS) * 256;
#pragma unroll
        for (int i = 0; i < 8; ++i) { x[i] = *(const bf16x8*)(ap + k0 + 32 * i); y[i] = *(const bf16x8*)(bp + k0 + 32 * i); }
    };
    f32x4 a0 = (f32x4){0.f, 0.f, 0.f, 0.f}, a1 = a0;
    auto mmb = [&](int bt, const bf16x8 (&x)[8], const bf16x8 (&y)[8]) {
#pragma unroll
        for (int i = 0; i < 4; ++i) { a0 = __builtin_amdgcn_mfma_f32_16x16x32_bf16(x[2 * i], y[2 * i], a0, 0, 0, 0); a1 = __builtin_amdgcn_mfma_f32_16x16x32_bf16(x[2 * i + 1], y[2 * i + 1], a1, 0, 0, 0); }
        if ((bt % BPS) == BPS - 1) { a0 += a1;
            if (KIND == 0) {
#pragma unroll
                for (int reg = 0; reg < 4; ++reg) a0[reg] *= bflo(gq[bt / BPS][reg]); }
            tot += a0; a0 = (f32x4){0.f, 0.f, 0.f, 0.f}; a1 = a0; }
    };
    bf16x8 xA[8], yA[8], xB[8], yB[8];
    ldb(0, xA, yA);
#pragma unroll
    for (int bt = 0; bt < NBT; bt += 2) {
        if (bt + 1 < NBT) ldb(bt + 1, xB, yB);
        __builtin_amdgcn_sched_barrier(0);
        mmb(bt, xA, yA);
        __builtin_amdgcn_sched_barrier(0);
        if (bt + 2 < NBT) ldb(bt + 2, xA, yA);
        __builtin_amdgcn_sched_barrier(0);
        if (bt + 1 < NBT) mmb(bt + 1, xB, yB);
        __builtin_amdgcn_sched_barrier(0);
    }
    LAS f32x4* RED = (LAS f32x4*)F.lds;
    if (kh == 1) RED[ct * 64 + F.lane] = tot;
    __syncthreads();
    if (kh == 0) {
        tot += RED[ct * 64 + F.lane];
#pragma unroll
        for (int reg = 0; reg < 4; ++reg) { const size_t row = (size_t)MP + 16 * rb + 4 * g + reg; const int d = 64 * cb + 16 * ct + fr;
            if (KIND == 0) WSP(bf16, WS_MG)[row * DM + d] = (bf16)f2bf(tot[reg]);
            else { const float x = bf2f((KIND == 1 ? WSP(bf16, WS_XB0) : WSP(bf16, WS_XB1))[row * DM + d]) + tot[reg];
                (KIND == 1 ? WSP(bf16, WS_XB1) : WSP(bf16, WS_XB0))[row * DM + d] = (bf16)f2bf(x);
                float ss = x * x;
#pragma unroll
                for (int o = 1; o < 16; o <<= 1) ss += __shfl_xor(ss, o);
                if (fr == 0) rss_add((u64*)(F.ws + WS_RSS + (size_t)(2 * l + KIND) * SZ_RSS), row, ss); } }
    }
    __syncthreads();
}

constexpr int G_GEMM1 = 249, G_UP = 242;
constexpr int PH_PER_LAYER = 8, NPHASE = 1 + NLAYER * PH_PER_LAYER + 1;
__global__ void __launch_bounds__(NTHR, 2) mk_fwd(Args args) {
    extern __shared__ __attribute__((aligned(16))) unsigned char lds_raw[];
    Frame F;
    F.lds = (LAS unsigned char*)lds_raw;
    F.tid = threadIdx.x; F.lane = F.tid & 63; F.wave = __builtin_amdgcn_readfirstlane(F.tid >> 6);
    F.G = gridDim.x; F.c = blockIdx.x;
    F.in = args.in; F.out = args.out; F.ws = args.ws;
    volatile LAS unsigned* MISC = (volatile LAS unsigned*)(F.lds + LDSCTL_OFF);
    if (F.tid < 64) MISC[F.tid] = 0u;
    __syncthreads();
    unsigned* barw = (unsigned*)(F.ws + WS_CTL) + 4096;
    XcdBarrier bar; bar.bar = barw; bar.x = 0; bar.st = nullptr;
    if (!MK_SPLIT) bar = xcd_barrier_post(barw, MISC + 8);
    const int lo = args.ph_lo, hi = args.ph_hi;
#define IN(k) (lo <= (k) && (k) < hi)
#define SEAM(k) do { if (IN(k) && IN((k) + 1)) xcd_barrier(bar); } while (0)
#define XB0 WSP(bf16, WS_XB0)
#define XB1 WSP(bf16, WS_XB1)
#define RSSB(j) ((u64*)(F.ws + WS_RSS + (size_t)(j) * SZ_RSS))
#define GEMM_RUN(EPI) do { pg8::gemm_phase<EPI, pg8::TileOrder>(F.lds, g, S, E); if (REP_G > 1) { Frame F1 = launder(F); pg8::gemm_phase<EPI, pg8::TileOrder>(F1.lds, g, S, E); } } while (0)

    if (IN(0) && !(SKMASK & 1)) { phase_prologue(F); } SEAM(0);

    for (int l = 0; l < NLAYER; ++l) {
        const int pb = 1 + l * PH_PER_LAYER;
        if (IN(pb + 0) && !(SKMASK & 2)) { const Frame F0 = F; Frame F = launder(F0);
            pg8::Gemm g{XB0, WSP(bf16, WS_W1 + l * SZ_W1), DM, DM, DM, 0, 0, 256, 0}; pg8::TileOrder S; S.init(M, N1, G_GEMM1, F.c, 1);
            Epi1 E{WSP(bf16, WS_P), WSP(float, WS_HF), WSP(float, WS_DT), WSP(bf16, WS_G), WSP(float, WS_LB) + l * 1024, RSSB(2 * l)};
            if (F.c < G_GEMM1) GEMM_RUN(Epi1);
            else tr_run<true>(F0, l == 0 ? S0 : S2, l == 0 ? S1 : S3, (F.c - G_GEMM1) * NWAVES + F.wave, (F.G - G_GEMM1) * NWAVES);
        } SEAM(pb + 0);
        if (IN(pb + 1) && !(SKMASK & 4)) { phase_conv(F, l); } SEAM(pb + 1);
        if (IN(pb + 2) && !(SKMASK & 8)) { phase_mix(F, l); } SEAM(pb + 2);
        if (IN(pb + 3) && !(SKMASK & 16)) { phase_post(F, l); } SEAM(pb + 3);
        if (IN(pb + 4) && !(SKMASK & 32)) { const Frame F0 = F; Frame F = launder(F0);
            pg8::Gemm g{WSP(bf16, WS_BR), WSP(bf16, WS_WB + l * SZ_WB), BW, BW, BW, (size_t)M * BW, (size_t)DM * BW, 256, 0}; pg8::TileOrder S; S.init(MP, DM, F.G, F.c, 4);
            EpiBr E{WSP(bf16, WS_G), WSP(bf16, WS_MG)};
            GEMM_RUN(EpiBr);
            samp_gemm<0>(F, l);
        } SEAM(pb + 4);
        if (IN(pb + 5) && !(SKMASK & 64)) { const Frame F0 = F; Frame F = launder(F0);
            pg8::Gemm g{WSP(bf16, WS_MG), WSP(bf16, WS_WO + l * SZ_WO), DM, DM, DM, 0, 0, 256, 0}; pg8::TileOrder S; S.init(MP, DM, F.G, F.c, 1);
            EpiRes E{XB0, XB1, RSSB(2 * l + 1)};
            GEMM_RUN(EpiRes);
            samp_gemm<1>(F, l);
        } SEAM(pb + 5);
        if (IN(pb + 6) && !(SKMASK & 128)) { const Frame F0 = F; Frame F = launder(F0);
            pg8::Gemm g{XB1, WSP(bf16, WS_WUV + l * SZ_WUV), DM, DM, DM, 0, 0, 254, -2}; pg8::TileOrder S; S.init(M, NUV, G_UP, F.c, 1);
            EpiAct E{WSP(bf16, WS_G), RSSB(2 * l + 1), F.in[I_FCW] + (size_t)l * 3 * DFF, F.in[I_FCB] + (size_t)l * DFF, F.in[I_SFC] + (size_t)l * MS * 2 * DFF,
                     F.out + O_FC_P + (size_t)l * NBATCH * 2 * DFF, F.out + O_FC_S + (size_t)l * MS * 2 * DFF, F.lds};
            if (F.c < G_UP) GEMM_RUN(EpiAct);
            else tr_run<true>(F0, l == 0 ? S1 : S3, l == 0 ? S2 : NIT_ALL, (F.c - G_UP) * NWAVES + F.wave, (F.G - G_UP) * NWAVES);
        } SEAM(pb + 6);
        if (IN(pb + 7) && !(SKMASK & 256)) { const Frame F0 = F; Frame F = launder(F0);
            pg8::Gemm g{WSP(bf16, WS_G), WSP(bf16, WS_WD + l * SZ_WD), DFF, DFF, DFF, 0, 0, 256, 0}; pg8::TileOrder S; S.init(MP, DM, F.G, F.c, 1);
            EpiRes E{XB1, XB0, RSSB(2 * l + 2)};
            GEMM_RUN(EpiRes);
            samp_gemm<2>(F, l);
        } SEAM(pb + 7);
    }
    if (IN(NPHASE - 1) && !(SKMASK & 1024)) { phase_final(F, WSP(bf16, WS_XB0), F.in[I_GFIN]); }
#undef IN
#undef SEAM
#undef XB0
#undef XB1
#undef RSSB
#undef GEMM_RUN
}

extern "C" void kernel_launch(void* const* d_in, const int* in_sizes, int n_in, void* d_out, int out_size, void* d_ws, size_t ws_size, hipStream_t stream) {
    static int grid = 0;
    if (grid == 0) {
        if (n_in != N_INPUTS || (size_t)out_size != O_END || ws_size < WS_END) { fprintf(stderr, "kernel_launch: unexpected shapes: n_in %d out %d ws %zu (need %zu)\n", n_in, out_size, ws_size, (size_t)WS_END); grid = -1; return; }
        int dev = 0, cus = 0, per_cu = 0;
        if (hipGetDevice(&dev) != hipSuccess || hipDeviceGetAttribute(&cus, hipDeviceAttributeMultiprocessorCount, dev) != hipSuccess) { grid = -1; return; }
        if (hipFuncSetAttribute((const void*)mk_fwd, hipFuncAttributeMaxDynamicSharedMemorySize, LDS_BYTES) != hipSuccess) { fprintf(stderr, "kernel_launch: hipFuncSetAttribute failed\n"); grid = -1; return; }
        if (hipOccupancyMaxActiveBlocksPerMultiprocessor(&per_cu, (const void*)mk_fwd, NTHR, LDS_BYTES) != hipSuccess || per_cu < 1) { fprintf(stderr, "kernel_launch: occupancy query says %d\n", per_cu); }
        (void)hipGetLastError();
        grid = cus;
    }
    if (grid < 0) return;
    (void)hipMemsetAsync((char*)d_ws + WS_CTL, 0, CTL_BYTES, stream);
    Args a{};
    for (int i = 0; i < N_INPUTS; ++i) a.in[i] = (const float*)d_in[i];
    a.out = (float*)d_out; a.ws = (unsigned char*)d_ws;
#if MK_SPLIT
    for (int p = 0; p < NPHASE; ++p) { a.ph_lo = p; a.ph_hi = p + 1; hipLaunchKernelGGL(mk_fwd, dim3(grid), dim3(NTHR), LDS_BYTES, stream, a); }
#else
    a.ph_lo = 0; a.ph_hi = NPHASE;
    hipLaunchKernelGGL(mk_fwd, dim3(grid), dim3(NTHR), LDS_BYTES, stream, a);
#endif
}
```
